# Optimizing an MI355X kernel written in HIP

```python
import math
import jax, jax.numpy as jnp
from jax import lax
import numpy as np

D_MODEL = 1024
BATCH = 8
SEQ = 4096
DEPTH = 2

GRID_W = 64
CTX_LEN = 256
N_BRANCH = 4
BRANCH_W = 256
HEAD_DIM = 64
N_HEADS = BRANCH_W // HEAD_DIM
S5_GROUP = 16
S5_GROUPS = BRANCH_W // S5_GROUP
S5_STATE = 64
NA_ROWS = 8
NA_COLS = 16
HG_CHUNK = 16
RET_CHUNK = 128
N_EXPERTS = 16
EC_CAPACITY = 2
D_EXPERT = 2816
ROPE_BASE = 10000.0
EPS = 1e-6
IN_SPLITS = (BRANCH_W, 3 * BRANCH_W, 5 * BRANCH_W, 4 * BRANCH_W, N_BRANCH * D_MODEL)
D_IN = sum(IN_SPLITS)

kernel_name = "hybrid_s5_natten_hgrn2_retnet_ec_dit"


def rms_norm(x, w=None):
    xf = x.astype(jnp.float32)
    y = xf * lax.rsqrt(jnp.mean(jnp.square(xf), axis=-1, keepdims=True) + EPS)
    if w is not None:
        y = y * w.astype(jnp.float32)
    return y.astype(x.dtype)


def modulate(h, shift, scale):
    return h * (1 + scale) + shift


def to_heads(t):
    b, l, _ = t.shape
    return jnp.transpose(t.reshape(b, l, N_HEADS, -1), (0, 2, 1, 3))


def from_heads(t):
    b, h, l, d = t.shape
    return jnp.transpose(t, (0, 2, 1, 3)).reshape(b, l, h * d)


def axial_rope(n_tokens):
    t = np.arange(n_tokens)
    quarter = HEAD_DIM // 4
    inv = ROPE_BASE ** (-np.arange(quarter) / quarter)
    ang = np.concatenate([(t // GRID_W)[:, None] * inv, (t % GRID_W)[:, None] * inv], axis=1)
    return jnp.asarray(np.cos(ang), jnp.float32), jnp.asarray(np.sin(ang), jnp.float32)


def apply_rope(x, cos, sin):
    half = x.shape[-1] // 2
    x1, x2 = x[..., :half], x[..., half:]
    cos = cos[None, :, None, :]
    sin = sin[None, :, None, :]
    return jnp.concatenate([x1 * cos - x2 * sin, x2 * cos + x1 * sin], axis=-1)


def s5_scan(u, lam_re, lam_im, log_step, b_re, b_im, s0_re, s0_im):
    dt = jnp.exp(log_step)[:, None]
    mag = jnp.exp(lam_re * dt)
    ar = mag * jnp.cos(lam_im * dt)
    ai = mag * jnp.sin(lam_im * dt)
    den = lam_re * lam_re + lam_im * lam_im
    zr = ((ar - 1.0) * lam_re + ai * lam_im) / den
    zi = (ai * lam_re - (ar - 1.0) * lam_im) / den
    bb_re = zr[..., None] * b_re - zi[..., None] * b_im
    bb_im = zr[..., None] * b_im + zi[..., None] * b_re
    bu_re = jnp.einsum('blgp,gnp->blgn', u, bb_re)
    bu_im = jnp.einsum('blgp,gnp->blgn', u, bb_im)
    bu_re = bu_re.at[:, 0].add(ar * s0_re - ai * s0_im)
    bu_im = bu_im.at[:, 0].add(ar * s0_im + ai * s0_re)
    a_re = jnp.broadcast_to(ar, bu_re.shape)
    a_im = jnp.broadcast_to(ai, bu_im.shape)

    def combine(e1, e2):
        a1r, a1i, b1r, b1i = e1
        a2r, a2i, b2r, b2i = e2
        return (a1r * a2r - a1i * a2i, a1r * a2i + a1i * a2r,
                a2r * b1r - a2i * b1i + b2r, a2r * b1i + a2i * b1r + b2i)

    _, _, x_re, x_im = lax.associative_scan(combine, (a_re, a_im, bu_re, bu_im), axis=1)
    return x_re, x_im


def s5_readout(x_re, x_im, c_re, c_im):
    return jnp.einsum('blgn,gpn->blgp', x_re, c_re) - jnp.einsum('blgn,gpn->blgp', x_im, c_im)


def s5_mixer(u_ctx, u_lat, lam_re, lam_im, log_step, b_re, b_im, c_re, c_im, d_skip, w_glu, with_ctx_out):
    f32 = jnp.float32
    out_dtype = u_lat.dtype
    uc, ul = u_ctx.astype(f32), u_lat.astype(f32)
    gc = uc.reshape(uc.shape[0], uc.shape[1], S5_GROUPS, S5_GROUP)
    gl = ul.reshape(ul.shape[0], ul.shape[1], S5_GROUPS, S5_GROUP)
    zero = jnp.zeros((ul.shape[0], S5_GROUPS, S5_STATE), f32)
    y_ctx, y_lat = 0.0, 0.0
    for d in range(2):
        rev = (lambda t: t) if d == 0 else (lambda t: jnp.flip(t, axis=1))
        prm = (lam_re[d].astype(f32), lam_im[d].astype(f32), log_step[d].astype(f32),
               b_re[d].astype(f32), b_im[d].astype(f32))
        cr, ci = c_re[d].astype(f32), c_im[d].astype(f32)
        xc_re, xc_im = s5_scan(rev(gc), *prm, zero, zero)
        xl_re, xl_im = s5_scan(rev(gl), *prm, xc_re[:, -1], xc_im[:, -1])
        y_lat = y_lat + rev(s5_readout(xl_re, xl_im, cr, ci))
        if with_ctx_out:
            y_ctx = y_ctx + rev(s5_readout(xc_re, xc_im, cr, ci))

    def finish(y, u):
        y = y.reshape(u.shape) + d_skip.astype(f32) * u
        z = jax.nn.gelu(y)
        return (z * jax.nn.sigmoid(z @ w_glu.astype(f32))).astype(out_dtype)

    return (finish(y_ctx, uc) if with_ctx_out else None), finish(y_lat, ul)


def neighbourhood_attention(qkv_ctx, qkv_lat, q_norm_w, k_norm_w, rpb, with_ctx_out):
    b, l, _ = qkv_lat.shape
    lc = qkv_ctx.shape[1]
    rows = l // GRID_W
    wr = min(NA_ROWS, rows)
    scale = HEAD_DIM ** -0.5

    def split(t, n):
        q, k, v = jnp.split(t, 3, axis=-1)
        q = rms_norm(q.reshape(b, n, N_HEADS, HEAD_DIM), q_norm_w)
        k = rms_norm(k.reshape(b, n, N_HEADS, HEAD_DIM), k_norm_w)
        return q, k, v.reshape(b, n, N_HEADS, HEAD_DIM)

    qc, kc, vc = split(qkv_ctx, lc)
    ql, kl, vl = split(qkv_lat, l)
    qg = ql.reshape(b, rows, GRID_W, N_HEADS, HEAD_DIM)
    kg = kl.reshape(b, rows, GRID_W, N_HEADS, HEAD_DIM)
    vg = vl.reshape(b, rows, GRID_W, N_HEADS, HEAD_DIM)
    r = np.arange(rows)
    row_idx = np.clip(r - wr // 2, 0, rows - wr)[:, None] + np.arange(wr)[None, :]
    kband = kg[:, row_idx]
    vband = vg[:, row_idx]
    col = np.arange(GRID_W)
    col_start = np.clip(col - NA_COLS // 2, 0, GRID_W - NA_COLS)
    col_ok = (col[None, :] >= col_start[:, None]) & (col[None, :] < col_start[:, None] + NA_COLS)
    dr_idx = (row_idx - r[:, None] + NA_ROWS - 1).reshape(rows, 1, wr, 1)
    dc_idx = np.clip(col[None, :] - col[:, None] + NA_COLS - 1, 0, 2 * NA_COLS - 2).reshape(1, GRID_W, 1, GRID_W)
    bias = rpb[:, dr_idx, dc_idx]
    s_loc = jnp.einsum('brihd,brajhd->bhriaj', qg, kband).astype(jnp.float32) * scale + bias[None].astype(jnp.float32)
    s_loc = jnp.where(jnp.asarray(col_ok).reshape(1, 1, 1, GRID_W, 1, GRID_W), s_loc, -jnp.inf)
    s_ctx = jnp.einsum('brihd,bchd->bhric', qg, kc).astype(jnp.float32) * scale
    n_loc = wr * GRID_W
    s_all = jnp.concatenate([s_loc.reshape(b, N_HEADS, rows, GRID_W, n_loc), s_ctx], axis=-1)
    p = jax.nn.softmax(s_all, axis=-1).astype(vl.dtype)
    p_loc = p[..., :n_loc].reshape(b, N_HEADS, rows, GRID_W, wr, GRID_W)
    p_ctx = p[..., n_loc:]
    o_lat = jnp.einsum('bhriaj,brajhd->brihd', p_loc, vband) + jnp.einsum('bhric,bchd->brihd', p_ctx, vc)
    o_lat = o_lat.reshape(b, l, BRANCH_W)
    o_ctx = None
    if with_ctx_out:
        sc = jnp.einsum('bqhd,bkhd->bhqk', qc, kc).astype(jnp.float32) * scale
        pc = jax.nn.softmax(sc, axis=-1).astype(vc.dtype)
        o_ctx = jnp.einsum('bhqk,bkhd->bqhd', pc, vc).reshape(b, lc, BRANCH_W)
    return o_ctx, o_lat


def bidir_prefix(run, ctx_dirs, lat_dirs, with_ctx_out):
    o_ctx, o_lat = None, None
    for d in range(2):
        rev = (lambda t: t) if d == 0 else (lambda t: jnp.flip(t, axis=2))
        oc, sc = run(d, [rev(t) for t in ctx_dirs[d]], None)
        ol, _ = run(d, [rev(t) for t in lat_dirs[d]], sc)
        o_lat = rev(ol) if o_lat is None else o_lat + rev(ol)
        if with_ctx_out:
            o_ctx = rev(oc) if o_ctx is None else o_ctx + rev(oc)
    return o_ctx, o_lat


def blocks(t, chunk):
    b, h, l, d = t.shape
    return jnp.moveaxis(t.reshape(b, h, l // chunk, chunk, d), 2, 0)


def unblocks(t):
    n, b, h, c, d = t.shape
    return jnp.moveaxis(t, 0, 2).reshape(b, h, n * c, d)


def gated_chunk_scan(q, k, v, log_f, s0, chunk):
    b, h, _, dk = q.shape
    dv = v.shape[-1]
    if s0 is None:
        s0 = jnp.zeros((b, h, dk, dv), jnp.float32)
    qb, kb, vb, gb = blocks(q, chunk), blocks(k, chunk), blocks(v, chunk), blocks(log_f, chunk)
    cum = jnp.cumsum(gb, axis=3)
    last = cum[:, :, :, -1:, :]
    q_dec = qb * jnp.exp(cum)
    k_dec = kb * jnp.exp(-cum)
    k_end = kb * jnp.exp(last - cum)
    causal = jnp.tril(jnp.ones((chunk, chunk), bool))
    att = jnp.where(causal, jnp.einsum('nbhid,nbhjd->nbhij', q_dec, k_dec), 0.0)
    intra = jnp.einsum('nbhij,nbhje->nbhie', att, vb)
    kv = jnp.einsum('nbhjd,nbhje->nbhde', k_end, vb)
    decay_end = jnp.exp(last[:, :, :, 0, :])

    def step(s, xs):
        kv_n, d_n = xs
        return d_n[..., None] * s + kv_n, s

    s_fin, s_prev = lax.scan(step, s0, (kv, decay_end))
    cross = jnp.einsum('nbhid,nbhde->nbhie', q_dec, s_prev)
    return unblocks(intra + cross), s_fin


def hgrn2_mixer(p_ctx, p_lat, lower_bound, norm_w, with_ctx_out):
    f32 = jnp.float32
    out_dtype = p_lat.dtype
    lb = lower_bound.astype(f32)

    def prep(p):
        q, f_fw, f_bw, i, g = jnp.split(p.astype(f32), 5, axis=-1)
        qh = to_heads(jax.nn.silu(q))
        vh = to_heads(i)
        dirs = []
        for f_logit in (f_fw, f_bw):
            fg = lb + (1.0 - lb) * jax.nn.sigmoid(f_logit)
            dirs.append((qh, to_heads(1.0 - fg), vh, to_heads(jnp.log(fg))))
        return dirs, g

    ctx_dirs, g_ctx = prep(p_ctx)
    lat_dirs, g_lat = prep(p_lat)
    run = lambda d, a, s0: gated_chunk_scan(a[0], a[1], a[2], a[3], s0, HG_CHUNK)
    o_ctx, o_lat = bidir_prefix(run, ctx_dirs, lat_dirs, with_ctx_out)

    def finish(o, g):
        return (from_heads(rms_norm(o, norm_w)) * jax.nn.silu(g)).astype(out_dtype)

    return (finish(o_ctx, g_ctx) if with_ctx_out else None), finish(o_lat, g_lat)


def retention_chunk_scan(q, k, v, log_gamma, s0, chunk):
    b, h, _, dk = q.shape
    dv = v.shape[-1]
    if s0 is None:
        s0 = jnp.zeros((b, h, dk, dv), jnp.float32)
    qb, kb, vb = blocks(q, chunk), blocks(k, chunk), blocks(v, chunk)
    idx = jnp.arange(chunk, dtype=jnp.float32)
    diff = idx[:, None] - idx[None, :]
    lg = log_gamma[:, None, None]
    decay = jnp.where(diff >= 0, jnp.exp(jnp.maximum(diff, 0.0) * lg), 0.0)
    xi = jnp.exp((idx + 1.0)[None, :] * log_gamma[:, None])[..., None]
    zeta = jnp.exp((chunk - 1.0 - idx)[None, :] * log_gamma[:, None])[..., None]
    gamma_c = jnp.exp(chunk * log_gamma)[:, None, None]
    intra = jnp.einsum('nbhij,nbhje->nbhie', jnp.einsum('nbhid,nbhjd->nbhij', qb, kb) * decay, vb)
    kv = jnp.einsum('nbhjd,nbhje->nbhde', kb * zeta, vb)

    def step(s, kv_n):
        return gamma_c * s + kv_n, s

    s_fin, s_prev = lax.scan(step, s0, kv)
    cross = jnp.einsum('nbhid,nbhde->nbhie', qb, s_prev) * xi
    return unblocks(intra + cross), s_fin


def retention_mixer(p_ctx, p_lat, decay_logit, with_ctx_out):
    f32 = jnp.float32
    out_dtype = p_lat.dtype
    cos, sin = axial_rope(p_lat.shape[1])

    def prep(p, rope):
        b, n, _ = p.shape
        q, k, v, g = jnp.split(p.astype(f32), 4, axis=-1)
        q = q.reshape(b, n, N_HEADS, HEAD_DIM)
        k = k.reshape(b, n, N_HEADS, HEAD_DIM)
        if rope:
            q, k = apply_rope(q, cos, sin), apply_rope(k, cos, sin)
        qh = jnp.transpose(q, (0, 2, 1, 3))
        kh = jnp.transpose(k, (0, 2, 1, 3)) * (HEAD_DIM ** -0.5)
        return (qh, kh, to_heads(v)), g

    qkv_c, g_ctx = prep(p_ctx, False)
    qkv_l, g_lat = prep(p_lat, True)
    log_gamma = jax.nn.log_sigmoid(decay_logit.astype(f32))
    run = lambda d, a, s0: retention_chunk_scan(a[0], a[1], a[2], log_gamma[d], s0, RET_CHUNK)
    o_ctx, o_lat = bidir_prefix(run, [qkv_c, qkv_c], [qkv_l, qkv_l], with_ctx_out)

    def finish(o, g):
        return (from_heads(rms_norm(o)) * jax.nn.silu(g)).astype(out_dtype)

    return (finish(o_ctx, g_ctx) if with_ctx_out else None), finish(o_lat, g_lat)


def merge_branches(outs, gate_logits, w_branch, w_out):
    gates = jnp.split(gate_logits, N_BRANCH, axis=-1)
    m = 0.0
    for br in range(N_BRANCH):
        m = m + jax.nn.sigmoid(gates[br]) * (outs[br] @ w_branch[br])
    return m @ w_out


def token_mixers(h_ctx, h_lat, w_in, s5_lam_re, s5_lam_im, s5_log_step, s5_b_re, s5_b_im, s5_c_re, s5_c_im,
                 s5_d, s5_glu_w, na_q_norm, na_k_norm, na_rpb, hg_lb, hg_norm_w, ret_decay_logit,
                 w_branch, w_out, with_ctx_out):
    cuts = [int(v) for v in np.cumsum(IN_SPLITS)[:-1]]
    pl = jnp.split(h_lat @ w_in, cuts, axis=-1)
    pc = jnp.split(h_ctx @ w_in, cuts, axis=-1)
    s5_c, s5_l = s5_mixer(pc[0], pl[0], s5_lam_re, s5_lam_im, s5_log_step, s5_b_re, s5_b_im,
                          s5_c_re, s5_c_im, s5_d, s5_glu_w, with_ctx_out)
    na_c, na_l = neighbourhood_attention(pc[1], pl[1], na_q_norm, na_k_norm, na_rpb, with_ctx_out)
    hg_c, hg_l = hgrn2_mixer(pc[2], pl[2], hg_lb, hg_norm_w, with_ctx_out)
    rt_c, rt_l = retention_mixer(pc[3], pl[3], ret_decay_logit, with_ctx_out)
    out_l = merge_branches((s5_l, na_l, hg_l, rt_l), pl[4], w_branch, w_out)
    out_c = merge_branches((s5_c, na_c, hg_c, rt_c), pc[4], w_branch, w_out) if with_ctx_out else None
    return out_c, out_l


def expert_choice_ffn(h, router_w, w_gate, w_up, w_down):
    b, n, _ = h.shape
    cap = EC_CAPACITY * n // N_EXPERTS
    aff = jax.nn.softmax(jnp.einsum('bnd,de->bne', h.astype(jnp.float32), router_w.astype(jnp.float32)), axis=-1)
    g, idx = lax.top_k(jnp.swapaxes(aff, 1, 2), cap)
    idx_e = jnp.moveaxis(idx, 1, 0)
    g_e = jnp.moveaxis(g, 1, 0)
    b_idx = jnp.arange(b)[:, None]

    def one_expert(args):
        wg, wu, wd, ie, ge = args
        xe = h[b_idx, ie]
        ye = (jax.nn.silu(xe @ wg) * (xe @ wu)) @ wd
        return ye * ge[..., None].astype(ye.dtype)

    y = lax.map(one_expert, (w_gate, w_up, w_down, idx_e, g_e))
    return jnp.zeros_like(h).at[jnp.arange(b)[None, :, None], idx_e].add(y.astype(h.dtype))


def setup_inputs(seed: int = 0) -> dict:
    key = jax.random.key(seed)
    ks = iter(jax.random.split(key, 40))
    f32 = jnp.float32

    def nrm(shape, s):
        return s * jax.random.normal(next(ks), shape, f32)

    D, H, G, N, P, E, F = D_MODEL, N_HEADS, S5_GROUPS, S5_STATE, S5_GROUP, N_EXPERTS, D_EXPERT
    lam_im_base = jnp.pi * jnp.arange(N, dtype=f32)
    ret_base = jnp.log(jnp.exp2(5.0 + jnp.arange(H, dtype=f32)) - 1.0)
    return {
        'x': nrm((BATCH, SEQ, D), 1.0),
        'c': nrm((BATCH, D), 1.0),
        'ctx': nrm((BATCH, CTX_LEN, D), 1.0),
        'c_ctx': nrm((D,), 1.0),
        'ada_w': nrm((DEPTH, D, 6 * D), 0.02),
        'ada_b': nrm((DEPTH, 6 * D), 0.01),
        'norm_mix_w': 1.0 + nrm((DEPTH, D), 0.02),
        'norm_ffn_w': 1.0 + nrm((DEPTH, D), 0.02),
        'w_in': nrm((DEPTH, D, D_IN), D ** -0.5),
        's5_lam_re': -0.5 + nrm((DEPTH, 2, G, N), 0.01),
        's5_lam_im': lam_im_base + nrm((DEPTH, 2, G, N), 0.01),
        's5_log_step': jax.random.uniform(next(ks), (DEPTH, 2, G), f32, math.log(1e-3), math.log(1e-1)),
        's5_b_re': nrm((DEPTH, 2, G, N, P), (2.0 * P) ** -0.5),
        's5_b_im': nrm((DEPTH, 2, G, N, P), (2.0 * P) ** -0.5),
        's5_c_re': nrm((DEPTH, 2, G, P, N), N ** -0.5),
        's5_c_im': nrm((DEPTH, 2, G, P, N), N ** -0.5),
        's5_d': nrm((DEPTH, BRANCH_W), 1.0),
        's5_glu_w': nrm((DEPTH, BRANCH_W, BRANCH_W), BRANCH_W ** -0.5),
        'na_q_norm': 1.0 + nrm((DEPTH, HEAD_DIM), 0.02),
        'na_k_norm': 1.0 + nrm((DEPTH, HEAD_DIM), 0.02),
        'na_rpb': nrm((DEPTH, H, 2 * NA_ROWS - 1, 2 * NA_COLS - 1), 0.02),
        'hg_lower_bounds': nrm((DEPTH, BRANCH_W), 0.1),
        'hg_norm_w': 1.0 + nrm((DEPTH, HEAD_DIM), 0.02),
        'ret_decay_logit': ret_base + nrm((DEPTH, 2, H), 0.01),
        'w_branch': nrm((DEPTH, N_BRANCH, BRANCH_W, D), BRANCH_W ** -0.5),
        'w_out': nrm((DEPTH, D, D), D ** -0.5),
        'router_w': nrm((DEPTH, D, E), D ** -0.5),
        'ex_w_gate': nrm((DEPTH, E, D, F), D ** -0.5),
        'ex_w_up': nrm((DEPTH, E, D, F), D ** -0.5),
        'ex_w_down': nrm((DEPTH, E, F, D), F ** -0.5),
    }


def reference(x, c, ctx, c_ctx, ada_w, ada_b, norm_mix_w, norm_ffn_w, w_in, s5_lam_re, s5_lam_im,
              s5_log_step, s5_b_re, s5_b_im, s5_c_re, s5_c_im, s5_d, s5_glu_w, na_q_norm, na_k_norm,
              na_rpb, hg_lower_bounds, hg_norm_w, ret_decay_logit, w_branch, w_out, router_w,
              ex_w_gate, ex_w_up, ex_w_down):
    lb_p = jax.nn.softmax(hg_lower_bounds.astype(jnp.float32), axis=0)
    lower_bounds = jnp.cumsum(lb_p, axis=0) - lb_p[0]
    cond_lat = jax.nn.silu(c)
    cond_ctx = jax.nn.silu(c_ctx)[None]
    xc = ctx
    for li in range(DEPTH):
        last = li == DEPTH - 1
        mod_l = [m[:, None] for m in jnp.split(cond_lat @ ada_w[li] + ada_b[li], 6, axis=-1)]
        mod_c = [m[:, None] for m in jnp.split(cond_ctx @ ada_w[li] + ada_b[li], 6, axis=-1)]
        sh1_l, sc1_l, g1_l, sh2_l, sc2_l, g2_l = mod_l
        sh1_c, sc1_c, g1_c, sh2_c, sc2_c, g2_c = mod_c
        h_l = modulate(rms_norm(x, norm_mix_w[li]), sh1_l, sc1_l)
        h_c = modulate(rms_norm(xc, norm_mix_w[li]), sh1_c, sc1_c)
        mix_c, mix_l = token_mixers(h_c, h_l, w_in[li], s5_lam_re[li], s5_lam_im[li], s5_log_step[li],
                                    s5_b_re[li], s5_b_im[li], s5_c_re[li], s5_c_im[li], s5_d[li], s5_glu_w[li],
                                    na_q_norm[li], na_k_norm[li], na_rpb[li], lower_bounds[li], hg_norm_w[li],
                                    ret_decay_logit[li], w_branch[li], w_out[li], not last)
        x = x + g1_l * mix_l
        h_l = modulate(rms_norm(x, norm_ffn_w[li]), sh2_l, sc2_l)
        x = x + g2_l * expert_choice_ffn(h_l, router_w[li], ex_w_gate[li], ex_w_up[li], ex_w_down[li])
        if not last:
            xc = xc + g1_c * mix_c
            h_c = modulate(rms_norm(xc, norm_ffn_w[li]), sh2_c, sc2_c)
            xc = xc + g2_c * expert_choice_ffn(h_c, router_w[li], ex_w_gate[li], ex_w_up[li], ex_w_down[li])
    return x
```

```cpp
#include <hip/hip_runtime.h>
#include <cstdio>
#include <cstdint>

#ifndef MK_PER_PHASE
#define MK_PER_PHASE 0
#endif

#define LAS __attribute__((address_space(3)))
#define DI __device__ __forceinline__
typedef unsigned short bf16_t;
typedef short bf16x8 __attribute__((ext_vector_type(8)));
typedef float f32x4 __attribute__((ext_vector_type(4)));
typedef float f32x2 __attribute__((ext_vector_type(2)));
typedef unsigned u32x4 __attribute__((ext_vector_type(4)));
typedef unsigned u32x2 __attribute__((ext_vector_type(2)));

constexpr int DM = 1024, NB = 8, SEQ = 4096, CTXL = 256, LSEQ = SEQ + CTXL, NTOK = NB * LSEQ, DIN = 7424, NE = 16, DF = 2816, DEPTH = 2;
constexpr int CAP_L = 512, CAP_C = 32, EROWS = NB * CAP_L + NB * CAP_C;
constexpr float EPS = 1e-6f;
constexpr int C_S5U = 0, C_NAQ = 256, C_NAK = 512, C_NAV = 768, C_HGQ = 1024, C_HGF = 1280, C_HGI = 1792, C_HGG = 2048, C_RTQ = 2304, C_RTK = 2560, C_RTV = 2816, C_RTG = 3072, C_GATE = 3328;
enum { I_X = 0, I_C, I_CTX, I_CCTX, I_ADAW, I_ADAB, I_NMIX, I_NFFN, I_WIN, I_LRE, I_LIM, I_LSTEP, I_BRE, I_BIM, I_CRE, I_CIM, I_S5D, I_GLU, I_NAQN, I_NAKN, I_RPB, I_HGLB, I_HGNW, I_RETD, I_WBR, I_WOUT, I_RW, I_EWG, I_EWU, I_EWD, N_IN };

constexpr size_t MiB = 1u << 20;
constexpr size_t WS_CTL = 0, CTL_ZERO_BYTES = 1 * MiB;
constexpr size_t WS_MOD = 1 * MiB;
constexpr size_t WS_LB = 1 * MiB + 512 * 1024;
constexpr size_t WS_AFF = 2 * MiB;
constexpr size_t WS_SEL = 5 * MiB;
constexpr size_t WS_GATE = 8 * MiB;
constexpr size_t WS_WBR = 10 * MiB;
constexpr size_t WS_WOUT = 14 * MiB;
constexpr size_t WS_WIN = 18 * MiB;
constexpr size_t WS_X = 48 * MiB;
constexpr size_t WS_H = 184 * MiB;
constexpr size_t WS_O = 252 * MiB;
constexpr size_t WS_MB = 320 * MiB;
constexpr size_t WS_P = 388 * MiB;
constexpr size_t WS_XE = 881 * MiB;
constexpr size_t WS_EXW = 1017 * MiB;
constexpr size_t WS_W2T = WS_EXW + (size_t)NE * 5632 * 1024;
constexpr size_t WS_QKN = 1281 * MiB;
constexpr size_t WS_RETS = 1315 * MiB;
constexpr size_t WS_HGS = 1349 * MiB;
constexpr size_t WS_HGDEC = 1383 * MiB;
constexpr size_t WS_S5W1 = 1388 * MiB;
constexpr size_t WS_S5W2 = 1392 * MiB;
constexpr size_t WS_GLUT = 1400 * MiB;
constexpr size_t WS_HGDT = 1401 * MiB;
constexpr size_t WS_END = 1403 * MiB;
constexpr int S5CH = NTOK / 16, S5ROWS = 2304;
constexpr size_t WS_UG = WS_XE;
constexpr size_t WS_S5S = WS_XE + 36 * MiB;
constexpr size_t WS_OHG = WS_XE + 72 * MiB;
constexpr size_t WS_Z = WS_QKN;
constexpr size_t WS_HGP = WS_MB;
constexpr int NSUB = NTOK / 16;
constexpr size_t WS_H8 = WS_O;
constexpr size_t WS_WIN8_OFF = (size_t)C_GATE * DM * 2;
constexpr size_t WS_RETP = WS_H;
constexpr size_t RETP_T = (size_t)NTOK * 256;
constexpr int NCHK = LSEQ / 64;
static_assert(WS_W2T + (size_t)NE * 1024 * DF * 2 <= WS_QKN, "ws map");
static_assert(WS_P + (size_t)NTOK * DIN * 2 <= WS_XE && WS_XE + (size_t)NE * EROWS * 1024 * 2 <= WS_EXW, "ws map");

constexpr int RING_BYTES = 131072, LDSCTL_OFF = RING_BYTES, MISC_OFF = LDSCTL_OFF + 320, LDS_BYTES = 147456;

DI float bf2f(unsigned short h) { return __uint_as_float(((unsigned)h) << 16); }
DI float lo_f(unsigned w) { return __uint_as_float(w << 16); }
DI float hi_f(unsigned w) { return __uint_as_float(w & 0xffff0000u); }
DI unsigned f2bf(float f) { unsigned u = __float_as_uint(f); return (u + 0x7fffu + ((u >> 16) & 1u)) >> 16; }
DI unsigned pk2(float lo, float hi) { return f2bf(lo) | (f2bf(hi) << 16); }
DI unsigned pk4_fp8(float a, float b, float c, float d) {
    a = __builtin_amdgcn_fmed3f(a, -448.f, 448.f); b = __builtin_amdgcn_fmed3f(b, -448.f, 448.f); c = __builtin_amdgcn_fmed3f(c, -448.f, 448.f); d = __builtin_amdgcn_fmed3f(d, -448.f, 448.f);
    int p = 0; p = __builtin_amdgcn_cvt_pk_fp8_f32(a, b, p, false); p = __builtin_amdgcn_cvt_pk_fp8_f32(c, d, p, true); return (unsigned)p; }
DI int lane_id() { int l; asm volatile("v_mbcnt_lo_u32_b32 %0, -1, 0\n\tv_mbcnt_hi_u32_b32 %0, -1, %0" : "=v"(l)); return l; }
template <int M> DI float shx(float v) {
    if constexpr (M < 32) return __int_as_float(__builtin_amdgcn_ds_swizzle(__float_as_int(v), 0x1f | (M << 10)));
    else return __int_as_float(__builtin_amdgcn_ds_bpermute((lane_id() ^ 32) << 2, __float_as_int(v)));
}
DI float wave_sum(float v) { v += shx<1>(v); v += shx<2>(v); v += shx<4>(v); v += shx<8>(v); v += shx<16>(v); v += shx<32>(v); return v; }
DI float sigm(float x) { return __builtin_amdgcn_rcpf(1.0f + __expf(-x)); }
DI float silu_(float x) { return x * sigm(x); }
DI f32x4 exp2n4(f32x4 t) { return (f32x4){__builtin_amdgcn_exp2f(t[0]), __builtin_amdgcn_exp2f(t[1]), __builtin_amdgcn_exp2f(t[2]), __builtin_amdgcn_exp2f(t[3])}; }
DI f32x4 rcp4(f32x4 d) { return (f32x4){__builtin_amdgcn_rcpf(d[0]), __builtin_amdgcn_rcpf(d[1]), __builtin_amdgcn_rcpf(d[2]), __builtin_amdgcn_rcpf(d[3])}; }
DI f32x4 sigm4(f32x4 x) { return rcp4(exp2n4(x * -1.4426950408889634f) + 1.0f); }
DI unsigned pack_u8x4(f32x4 s) { const f32x4 t = s * 255.0f + 8388608.0f;
    const unsigned ab = __builtin_amdgcn_perm(__float_as_uint(t[1]), __float_as_uint(t[0]), 0x0c0c0400u), cd = __builtin_amdgcn_perm(__float_as_uint(t[3]), __float_as_uint(t[2]), 0x04000c0cu); return ab | cd; }
DI float gelu_tanh(float x) { const float u = 1.5957691216057308f * (x + 0.044715f * x * x * x); return x * __builtin_amdgcn_rcpf(1.0f + __expf(-u)); }
#define LDS_WAIT() asm volatile("s_waitcnt lgkmcnt(0)" ::: "memory")
#define VM_WAIT() asm volatile("s_waitcnt vmcnt(0)" ::: "memory")

#define XB_TMO      128
#define XB_XCNT(j)  (256  + 64 * (j))
#define XB_XSUB(j)  (1280 + 64 * (j))
#define XB_XGEN(j)  (2304 + 64 * (j))
#define XB_TOP      3328
#define XB_TOPGEN   3392
#define XCD_BAR_WORDS 3456
#define XB_SPIN_CAP (1u << 22)

__device__ __forceinline__ unsigned xb_ld(unsigned* p)              { return __hip_atomic_load(p, __ATOMIC_RELAXED, __HIP_MEMORY_SCOPE_AGENT); }
__device__ __forceinline__ unsigned xb_add(unsigned* p, unsigned v) { return __hip_atomic_fetch_add(p, v, __ATOMIC_RELAXED, __HIP_MEMORY_SCOPE_AGENT); }
__device__ __forceinline__ unsigned xb_xcc_id() { return (unsigned)__builtin_amdgcn_s_getreg((3 << 11) | 20) & 0xFu; }
#define XB_SPIN(cond, bar) do { unsigned _sp = 0; while (cond) { __builtin_amdgcn_s_sleep(1); \
    if ((++_sp & 255u) == 0u) { if (xb_ld(&(bar)[XB_TMO])) break; if (_sp > XB_SPIN_CAP) { atomicAdd(&(bar)[XB_TMO], 1u); break; } } } } while (0)

struct XcdBarrier { unsigned* bar; unsigned x; volatile LAS unsigned* st; int wave; };

__device__ __forceinline__ XcdBarrier xcd_barrier_post(unsigned* bar, volatile LAS unsigned* st, int wave) {
    XcdBarrier b; b.bar = bar; b.x = xb_xcc_id(); b.st = st; b.wave = wave;
    if (wave == 0 && lane_id() == 0) (void)xb_add(&bar[XB_XCNT(b.x)], 1u);
    return b;
}
__device__ __forceinline__ void xcd_barrier_complete(unsigned* bar, unsigned x, unsigned& nloc, unsigned& nx) {
    const unsigned G = gridDim.x * gridDim.y * gridDim.z;
    unsigned sum, cnt, mine, sp = 0u;
    for (;;) {
        sum = 0u; cnt = 0u; mine = 0u;
#pragma unroll
        for (unsigned j = 0; j < 16; ++j) { const unsigned c = xb_ld(&bar[XB_XCNT(j)]); sum += c; cnt += (c > 0u) ? 1u : 0u; mine = (j == x) ? c : mine; }
        if (sum == G) break;
        __builtin_amdgcn_s_sleep(1);
        if ((++sp & 255u) == 0u) { if (xb_ld(&bar[XB_TMO])) break; if (sp > XB_SPIN_CAP) { atomicAdd(&bar[XB_TMO], 1u); break; } }
    }
    nloc = mine > 0u ? mine : 1u; nx = cnt > 0u ? cnt : 1u;
}
__device__ __forceinline__ void xcd_barrier(const XcdBarrier& b) {
    asm volatile("s_waitcnt vmcnt(0)" ::: "memory");
    __syncthreads();
    if (b.wave == 0 && lane_id() == 0) {
        unsigned* bar = b.bar;
        __builtin_amdgcn_s_waitcnt(0);
        unsigned nloc = b.st[0], nx = b.st[1];
        unsigned bx = b.x; asm volatile("" : "+s"(bx));
        if (nloc == 0u) { xcd_barrier_complete(bar, bx, nloc, nx); b.st[0] = nloc; b.st[1] = nx; }
        const unsigned old = xb_add(&bar[XB_XSUB(bx)], 1u);
        const unsigned gen = old / nloc;
        if (old + 1u == (gen + 1u) * nloc) {
            __builtin_amdgcn_fence(__ATOMIC_RELEASE, "agent");
            asm volatile("s_waitcnt vmcnt(0)" ::: "memory");
            const unsigned og = xb_add(&bar[XB_TOP], 1u);
            const unsigned tg = og / nx;
            if (og + 1u == (tg + 1u) * nx) xb_add(&bar[XB_TOPGEN], 1u);
            else XB_SPIN(xb_ld(&bar[XB_TOPGEN]) == tg, bar);
            __builtin_amdgcn_fence(__ATOMIC_ACQUIRE, "agent");
            xb_add(&bar[XB_XGEN(bx)], 1u);
            asm volatile("s_waitcnt vmcnt(0)" ::: "memory");
        } else {
            XB_SPIN(xb_ld(&bar[XB_XGEN(bx)]) == gen, bar);
            __builtin_amdgcn_fence(__ATOMIC_ACQUIRE, "agent");
            asm volatile("s_waitcnt vmcnt(0)" ::: "memory");
        }
    }
    __syncthreads();
}

namespace pg8 {
constexpr int BM = 256, BK = 64, HALF = 128, HTB = HALF * BK * 2, STAGE_BYTES = 8 * HTB;
__host__ __device__ __forceinline__ int lds_byte(int r, int c) { const int st = (r >> 4) * 2 + (c >> 5), rr = r & 15, cc = c & 31, ob = rr * 64 + cc * 2; return st * 1024 + (ob ^ (((ob >> 9) & 1) << 5)); }
__host__ __device__ __forceinline__ void stage_rc(int b, int& R, int& C) { const int st = b / 1024, sb = b % 1024, swz = sb ^ (((sb >> 9) & 1) << 5); R = (st >> 1) * 16 + swz / 64; C = (st & 1) * 32 + (swz % 64) / 2; }
__host__ __device__ __forceinline__ int perm32(int rho) { const int n = rho >> 4, i = rho & 15; return 8 * (i >> 2) + 4 * n + (i & 3); }

struct Unit { unsigned a, b; int pm, pn, e, br;
    __device__ __forceinline__ void uniform() { a = __builtin_amdgcn_readfirstlane(a); b = __builtin_amdgcn_readfirstlane(b); pm = __builtin_amdgcn_readfirstlane(pm); pn = __builtin_amdgcn_readfirstlane(pn); e = __builtin_amdgcn_readfirstlane(e); br = __builtin_amdgcn_readfirstlane(br); } };

__device__ __forceinline__ unsigned cvt_pk_bf16(float lo, float hi) { unsigned r; asm volatile("v_cvt_pk_bf16_f32 %0, %1, %2" : "=v"(r) : "v"(lo), "v"(hi)); return r; }

typedef int i32x8 __attribute__((ext_vector_type(8)));
typedef int i32x4 __attribute__((ext_vector_type(4)));
template <class Epi, class Sched, bool FP8 = false, int MODE = 0>
__device__ __forceinline__ void gemm_phase(LAS unsigned char* lds, const int wid, const int lane, const char* base, const int K, const int lda, const int ldb, const Sched& S, const Epi& E) {
    const int tid = wid * 64 + lane, wr = wid >> 2, wc = wid & 3, fr = lane & 15, fq = lane >> 4;
    int nt = K / BK; asm volatile("" : "+s"(nt));
    unsigned voffA, voffB;
    { int R, C; stage_rc(tid * 16, R, C); const int Rb = Epi::PERM ? ((R & ~31) + perm32(R & 31)) : R; voffA = (unsigned)(R * lda + C) * 2u; voffB = (unsigned)(Rb * ldb + C) * 2u; }
    unsigned qstepA = (unsigned)(64 * lda * 2), qstepB = (unsigned)(64 * ldb * 2); asm volatile("" : "+s"(qstepA), "+s"(qstepB));
    unsigned kstep = (unsigned)(BK * 2), hstepA = (unsigned)(HALF * lda * 2), hstepB = (unsigned)(HALF * ldb * 2);
    asm volatile("" : "+s"(kstep), "+s"(hstepA), "+s"(hstepB));
    const unsigned ldsw = (unsigned)wid * 1024u;
    const int aoff = lds_byte(wr * 64 + fr, fq * 8), boff = lds_byte(wc * 32 + fr, fq * 8);
#define PG8_SA(b, h) (((b) * 2 + (h)) * HTB)
#define PG8_SB(b, h) ((4 + (b) * 2 + (h)) * HTB)
#define qoffA qstepA
#define qoffB qstepB
#define PG8_STAGE(bufoff, gbase, voff) do { _Pragma("unroll") for (int _i = 0; _i < 2; ++_i) \
        { unsigned sb_ = (gbase) + _i * q##voff; asm volatile("" : "+s"(sb_));     \
          __builtin_amdgcn_global_load_lds((const unsigned*)(base + (size_t)(unsigned)(sb_ + v##voff)), (LAS unsigned*)(lds + (bufoff) + ldsw + _i * 8192), 16, 0, 0); } } while (0)
#define PG8_LDA(dst, b, h) do { if constexpr (FP8) { _Pragma("unroll") for (int m = 0; m < 4; ++m) { const i32x4 lo_ = *(const LAS i32x4*)(lds + PG8_SA(b, h) + aoff + m * 2048), hi_ = *(const LAS i32x4*)(lds + PG8_SA(b, h) + aoff + 1024 + m * 2048); dst##8[m] = __builtin_shufflevector(lo_, hi_, 0, 1, 2, 3, 4, 5, 6, 7); } } \
        else { _Pragma("unroll") for (int m = 0; m < 4; ++m) _Pragma("unroll") for (int k = 0; k < 2; ++k) dst[m][k] = *(const LAS bf16x8*)(lds + PG8_SA(b, h) + aoff + m * 2048 + k * 1024); } } while (0)
#define PG8_LDB(dst, b, h) do { if constexpr (FP8) { _Pragma("unroll") for (int n = 0; n < 2; ++n) { const i32x4 lo_ = *(const LAS i32x4*)(lds + PG8_SB(b, h) + boff + n * 2048), hi_ = *(const LAS i32x4*)(lds + PG8_SB(b, h) + boff + 1024 + n * 2048); dst##8[n] = __builtin_shufflevector(lo_, hi_, 0, 1, 2, 3, 4, 5, 6, 7); } } \
        else { _Pragma("unroll") for (int n = 0; n < 2; ++n) _Pragma("unroll") for (int k = 0; k < 2; ++k) dst[n][k] = *(const LAS bf16x8*)(lds + PG8_SB(b, h) + boff + n * 2048 + k * 1024); } } while (0)
#define PG8_MMA_(ai, bj, At, Bt, Z) do { if constexpr (MODE == 1 && (bj) == 1) break; __builtin_amdgcn_s_setprio(1); if constexpr (FP8) { _Pragma("unroll") for (int m = 0; m < 4; ++m) _Pragma("unroll") for (int n = 0; n < 2; ++n) \
        acc[ai][bj][m][n] = __builtin_amdgcn_mfma_scale_f32_16x16x128_f8f6f4(Bt##8[n], At##8[m], (Z) ? (f32x4){0.f, 0.f, 0.f, 0.f} : acc[ai][bj][m][n], 0, 0, 0, Epi::SCALE_W, 0, Epi::SCALE_X); } \
        else { _Pragma("unroll") for (int m = 0; m < 4; ++m) _Pragma("unroll") for (int n = 0; n < 2; ++n) _Pragma("unroll") for (int k = 0; k < 2; ++k) \
        acc[ai][bj][m][n] = __builtin_amdgcn_mfma_f32_16x16x32_bf16(Bt[n][k], At[m][k], ((Z) && k == 0) ? (f32x4){0.f, 0.f, 0.f, 0.f} : acc[ai][bj][m][n], 0, 0, 0); } __builtin_amdgcn_s_setprio(0); } while (0)
#define PG8_MMA(ai, bj, At, Bt) PG8_MMA_(ai, bj, At, Bt, false)
#define PG8_MMA0(ai, bj, At, Bt) do { if (t == 0) PG8_MMA_(ai, bj, At, Bt, true); else PG8_MMA_(ai, bj, At, Bt, false); } while (0)
#define PG8_WAIT_V(n) asm volatile("s_waitcnt vmcnt(" #n ")" ::: "memory")
#define PG8_WAIT_L(n) asm volatile("s_waitcnt lgkmcnt(" #n ")" ::: "memory")
#define PG8_BAR __builtin_amdgcn_s_barrier()
#define PG8_SCHED __builtin_amdgcn_sched_barrier(0)
    Unit cur, nxt; int ui = 0;
    if (!S.next(0, cur)) return;
    f32x4 acc[2][2][4][2];
    if constexpr (MODE == 1) {
#pragma unroll
        for (int a = 0; a < 2; ++a)
#pragma unroll
            for (int m = 0; m < 4; ++m)
#pragma unroll
                for (int n = 0; n < 2; ++n) acc[a][1][m][n] = (f32x4){0.f, 0.f, 0.f, 0.f};
    }
    bf16x8 At[4][2], B0[2][2], B1[2][2]; i32x8 At8[4], B08[2], B18[2];
    unsigned cA = cur.a, cB = cur.b;
    PG8_STAGE(PG8_SB(0, 0), cB, offB); PG8_STAGE(PG8_SB(0, 1), cB + hstepB, offB); PG8_STAGE(PG8_SA(0, 0), cA, offA); PG8_STAGE(PG8_SA(0, 1), cA + hstepA, offA);
    if (wr == 1) PG8_BAR;
    PG8_WAIT_V(2); PG8_BAR;
    PG8_STAGE(PG8_SB(1, 0), cB + kstep, offB); PG8_STAGE(PG8_SA(1, 0), cA + kstep, offA); PG8_STAGE(PG8_SB(1, 1), cB + hstepB + kstep, offB);
    PG8_WAIT_V(6); PG8_BAR;
    for (;;) {
        const bool has_next = S.next(ui + 1, nxt);
        const unsigned nA = has_next ? nxt.a : cA, nB = has_next ? nxt.b : cB;
#pragma unroll 1
        for (int t = 0; t < nt; t += 2) {
            const bool last = (t == nt - 2);
            const unsigned a1 = cA + (unsigned)(t + 1) * kstep;
            const unsigned a2 = last ? nA : cA + (unsigned)(t + 2) * kstep, b2 = last ? nB : cB + (unsigned)(t + 2) * kstep;
            const unsigned a3 = a2 + kstep, b3 = b2 + kstep;
            PG8_LDB(B0, 0, 0); PG8_LDB(B1, 0, 1); PG8_SCHED; PG8_LDA(At, 0, 0); PG8_STAGE(PG8_SA(1, 1), a1 + hstepA, offA);
            PG8_WAIT_V(8); PG8_WAIT_L(0); PG8_BAR; PG8_MMA0(0, 0, At, B0); PG8_MMA0(0, 1, At, B1); PG8_BAR; PG8_SCHED;
            PG8_LDA(At, 0, 1); PG8_STAGE(PG8_SB(0, 0), b2, offB); PG8_STAGE(PG8_SB(0, 1), b2 + hstepB, offB); PG8_STAGE(PG8_SA(0, 0), a2, offA);
            PG8_WAIT_V(8); PG8_WAIT_L(0); PG8_BAR; PG8_MMA0(1, 0, At, B0); PG8_MMA0(1, 1, At, B1); PG8_BAR; PG8_SCHED;
            PG8_LDB(B0, 1, 0); PG8_LDB(B1, 1, 1); PG8_SCHED; PG8_LDA(At, 1, 0); PG8_STAGE(PG8_SA(0, 1), a2 + hstepA, offA);
            PG8_WAIT_V(8); PG8_WAIT_L(0); PG8_BAR; PG8_MMA(0, 0, At, B0); PG8_MMA(0, 1, At, B1); PG8_BAR; PG8_SCHED;
            PG8_LDA(At, 1, 1); PG8_STAGE(PG8_SB(1, 0), b3, offB); PG8_STAGE(PG8_SB(1, 1), b3 + hstepB, offB); PG8_STAGE(PG8_SA(1, 0), a3, offA);
            PG8_WAIT_V(8); PG8_WAIT_L(0); PG8_BAR; PG8_MMA(1, 0, At, B0); PG8_MMA(1, 1, At, B1); PG8_BAR; PG8_SCHED;
            if constexpr (MODE == 1) { if (((t + 2) & 3) == 0 && !last) { const int l2_ = lane_id(); E.mid(acc, cur, (t + 2) / 4 - 1, wr, wc, l2_ & 15, l2_ >> 4); } }
        }
        if (wr == 0) PG8_BAR;
        { const int l2_ = lane_id();
          E(acc, cur, wr, wc, l2_ & 15, l2_ >> 4); }
        if (!has_next) break;
        if constexpr (MODE == 1) {
#pragma unroll
            for (int a = 0; a < 2; ++a)
#pragma unroll
                for (int m = 0; m < 4; ++m)
#pragma unroll
                    for (int n = 0; n < 2; ++n) acc[a][1][m][n] = (f32x4){0.f, 0.f, 0.f, 0.f};
        }
        cur = nxt; cA = nA; cB = nB; ++ui;
        if (wr == 1) PG8_BAR;
    }
    PG8_WAIT_V(0);
    PG8_BAR;
#undef PG8_SA
#undef PG8_SB
#undef PG8_STAGE
#undef qoffA
#undef qoffB
#undef PG8_LDA
#undef PG8_LDB
#undef PG8_MMA
#undef PG8_MMA_
#undef PG8_MMA0
#undef PG8_WAIT_V
#undef PG8_WAIT_L
#undef PG8_BAR
#undef PG8_SCHED
}
}
using pg8::Unit;

typedef const __attribute__((address_space(4))) unsigned char* KPtr;
DI KPtr kargs() { KPtr p = (KPtr)__builtin_amdgcn_kernarg_segment_ptr(); asm volatile("" : "+s"(p)); return p; }
struct Ctx {
    KPtr ka;
    DI const float* in(int i) const { return *(const float* const __attribute__((address_space(4)))*)(ka + 8 * i); }
    DI float* out() const { return *(float* const __attribute__((address_space(4)))*)(ka + 8 * N_IN); }
    DI unsigned char* ws() const { return *(unsigned char* const __attribute__((address_space(4)))*)(ka + 8 * N_IN + 8); }
    DI float* mod() const { return (float*)(ws() + WS_MOD); }
    DI float* lb() const { return (float*)(ws() + WS_LB); }
    DI float* aff() const { return (float*)(ws() + WS_AFF); }
    DI float* gate() const { return (float*)(ws() + WS_GATE); }
    DI float* X() const { return (float*)(ws() + WS_X); }
    DI int* sel() const { return (int*)(ws() + WS_SEL); }
    DI bf16_t* wbr() const { return (bf16_t*)(ws() + WS_WBR); }
    DI bf16_t* wout() const { return (bf16_t*)(ws() + WS_WOUT); }
    DI bf16_t* win() const { return (bf16_t*)(ws() + WS_WIN); }
    DI bf16_t* H() const { return (bf16_t*)(ws() + WS_H); }
    DI bf16_t* O() const { return (bf16_t*)(ws() + WS_O); }
    DI bf16_t* MB() const { return (bf16_t*)(ws() + WS_MB); }
    DI bf16_t* P() const { return (bf16_t*)(ws() + WS_P); }
    DI bf16_t* XE() const { return (bf16_t*)(ws() + WS_XE); }
    DI unsigned char* W1T() const { return ws() + WS_EXW; }
    DI unsigned char* W2T() const { return ws() + WS_W2T; }
    DI bf16_t* QKN() const { return (bf16_t*)(ws() + WS_QKN); }
    DI float* YS5() const { return (float*)(ws() + WS_XE); }
    DI float* OHG() const { return (float*)(ws() + WS_XE + (size_t)2 * NTOK * 256 * 4); }
    DI float* ORET() const { return (float*)(ws() + WS_MB); }
    DI bf16_t* RETP() const { return (bf16_t*)(ws() + WS_RETP); }
    DI bf16_t* RETS() const { return (bf16_t*)(ws() + WS_RETS); }
    DI bf16_t* HGS() const { return (bf16_t*)(ws() + WS_HGS); }
    DI bf16_t* UG() const { return (bf16_t*)(ws() + WS_UG); }
    DI float* S5S() const { return (float*)(ws() + WS_S5S); }
    DI bf16_t* OHGB() const { return (bf16_t*)(ws() + WS_OHG); }
    DI bf16_t* Z() const { return (bf16_t*)(ws() + WS_Z); }
    DI bf16_t* S5W1() const { return (bf16_t*)(ws() + WS_S5W1); }
    DI bf16_t* S5W2() const { return (bf16_t*)(ws() + WS_S5W2); }
    DI bf16_t* GLUT() const { return (bf16_t*)(ws() + WS_GLUT); }
    DI bf16_t* HGP() const { return (bf16_t*)(ws() + WS_HGP); }
    DI float* HGDEC() const { return (float*)(ws() + WS_HGDEC); }
    DI float* HGDT() const { return (float*)(ws() + WS_HGDT); }
};
DI size_t seqrow(int b, int dir, int s) { return (size_t)b * LSEQ + (dir == 0 ? s : (s < CTXL ? (CTXL - 1 - s) : (LSEQ + CTXL - 1 - s))); }

struct EpiP {
    static constexpr bool PERM = true;
    bf16_t* O; int ldc;
    DI void operator()(const f32x4 (&acc)[2][2][4][2], const Unit& u, int wr, int wc, int fr, int fq) const {
        const int row0 = u.pm * 256 + wr * 64 + fr, col0 = u.pn * 256 + wc * 32 + 8 * fq;
#pragma unroll
        for (int ai = 0; ai < 2; ++ai)
#pragma unroll
            for (int m = 0; m < 4; ++m) { bf16_t* rowp = O + (size_t)(row0 + ai * 128 + m * 16) * ldc + col0;
#pragma unroll
                for (int bj = 0; bj < 2; ++bj) { const f32x4 v0 = acc[ai][bj][m][0], v1 = acc[ai][bj][m][1];
                    u32x4 w; w.x = pg8::cvt_pk_bf16(v0[0], v0[1]); w.y = pg8::cvt_pk_bf16(v0[2], v0[3]); w.z = pg8::cvt_pk_bf16(v1[0], v1[1]); w.w = pg8::cvt_pk_bf16(v1[2], v1[3]);
                    *(u32x4*)(rowp + bj * 128) = w; } }
    }
};
constexpr float FP8_WS = 16.0f, FP8_XS = 16.0f, FP8_AS = 16.0f;
struct EpiSig8 {
    static constexpr bool PERM = true; static constexpr int SCALE_W = 0x7b7b7b7b, SCALE_X = 0x7b7b7b7b;
    unsigned char* Pb;
    DI void operator()(const f32x4 (&acc)[2][2][4][2], const Unit& u, int wr, int wc, int fr, int fq) const {
        const int row0 = u.pm * 256 + wr * 64 + fr, col0 = u.pn * 256 + wc * 32 + 8 * fq;
#pragma unroll
        for (int ai = 0; ai < 2; ++ai)
#pragma unroll
            for (int m = 0; m < 4; ++m) { unsigned char* rowp = Pb + (size_t)(row0 + ai * 128 + m * 16) * (DIN * 2) + 2 * C_GATE + col0;
#pragma unroll
                for (int bj = 0; bj < 2; ++bj) { const f32x4 v0 = acc[ai][bj][m][0], v1 = acc[ai][bj][m][1];
                    u32x2 w; w.x = pack_u8x4(sigm4(v0)); w.y = pack_u8x4(sigm4(v1));
                    *(u32x2*)(rowp + bj * 128) = w; } }
    }
};
struct EpiMerge {
    static constexpr bool PERM = true;
    bf16_t* MB; const unsigned char* Pb;
    DI void mid(f32x4 (&acc)[2][2][4][2], const Unit& u, int br, int wr, int wc, int fr, int fq) const {
        const int row0 = u.pm * 256 + wr * 64 + fr, col0 = u.pn * 128 + wc * 32 + 8 * fq;
        u32x2 gt[2][4];
#pragma unroll
        for (int ai = 0; ai < 2; ++ai)
#pragma unroll
            for (int m = 0; m < 4; ++m) gt[ai][m] = *(const u32x2*)(Pb + (size_t)(row0 + ai * 128 + m * 16) * (DIN * 2) + 2 * C_GATE + br * 1024 + col0);
        const float q = 1.0f / 255.0f;
#pragma unroll
        for (int ai = 0; ai < 2; ++ai)
#pragma unroll
            for (int m = 0; m < 4; ++m) { const u32x2 g = gt[ai][m];
                acc[ai][1][m][0] = acc[ai][1][m][0] + acc[ai][0][m][0] * (f32x4){(float)(g.x & 255u) * q, (float)((g.x >> 8) & 255u) * q, (float)((g.x >> 16) & 255u) * q, (float)(g.x >> 24) * q};
                acc[ai][1][m][1] = acc[ai][1][m][1] + acc[ai][0][m][1] * (f32x4){(float)(g.y & 255u) * q, (float)((g.y >> 8) & 255u) * q, (float)((g.y >> 16) & 255u) * q, (float)(g.y >> 24) * q};
                acc[ai][0][m][0] = (f32x4){0.f, 0.f, 0.f, 0.f}; acc[ai][0][m][1] = (f32x4){0.f, 0.f, 0.f, 0.f}; }
    }
    DI void operator()(const f32x4 (&acc)[2][2][4][2], const Unit& u, int wr, int wc, int fr, int fq) const {
        const int row0 = u.pm * 256 + wr * 64 + fr, col0 = u.pn * 128 + wc * 32 + 8 * fq;
        u32x2 gt[2][4];
#pragma unroll
        for (int ai = 0; ai < 2; ++ai)
#pragma unroll
            for (int m = 0; m < 4; ++m) gt[ai][m] = *(const u32x2*)(Pb + (size_t)(row0 + ai * 128 + m * 16) * (DIN * 2) + 2 * C_GATE + 3 * 1024 + col0);
        const float q = 1.0f / 255.0f;
#pragma unroll
        for (int ai = 0; ai < 2; ++ai)
#pragma unroll
            for (int m = 0; m < 4; ++m) { const u32x2 g = gt[ai][m];
                const f32x4 r0 = acc[ai][1][m][0] + acc[ai][0][m][0] * (f32x4){(float)(g.x & 255u) * q, (float)((g.x >> 8) & 255u) * q, (float)((g.x >> 16) & 255u) * q, (float)(g.x >> 24) * q};
                const f32x4 r1 = acc[ai][1][m][1] + acc[ai][0][m][1] * (f32x4){(float)(g.y & 255u) * q, (float)((g.y >> 8) & 255u) * q, (float)((g.y >> 16) & 255u) * q, (float)(g.y >> 24) * q};
                u32x4 w; w.x = pg8::cvt_pk_bf16(r0[0], r0[1]); w.y = pg8::cvt_pk_bf16(r0[2], r0[3]); w.z = pg8::cvt_pk_bf16(r1[0], r1[1]); w.w = pg8::cvt_pk_bf16(r1[2], r1[3]);
                *(u32x4*)(MB + (size_t)(row0 + ai * 128 + m * 16) * DM + col0) = w; }
    }
};
struct EpiResid {
    static constexpr bool PERM = false;
    float* X; const float* mod; float* Xo; const float* xin; const float* cin;
    DI void operator()(const f32x4 (&acc)[2][2][4][2], const Unit& u, int wr, int wc, int fr, int fq) const {
        const int row0 = u.pm * 256 + wr * 64 + fr, col0 = u.pn * 256 + wc * 32 + 4 * fq;
        const int b = u.pm / 17, tl = u.pm % 17, mr = (tl == 0) ? 8 : b;
        const float* g1 = mod + mr * 6144 + 2 * 1024;
        const float* srcb = xin ? (tl == 0 ? cin + (size_t)b * CTXL * DM : xin + ((size_t)b * SEQ + (tl - 1) * 256) * DM) - (size_t)u.pm * 256 * DM : X;
        f32x4 gv[2][2];
#pragma unroll
        for (int bj = 0; bj < 2; ++bj)
#pragma unroll
            for (int n = 0; n < 2; ++n) gv[bj][n] = *(const f32x4*)(g1 + col0 + bj * 128 + n * 16);
#pragma unroll
        for (int ai = 0; ai < 2; ++ai)
#pragma unroll
            for (int mh = 0; mh < 2; ++mh) {
                f32x4 xv[2][2][2];
#pragma unroll
                for (int m2 = 0; m2 < 2; ++m2)
#pragma unroll
                    for (int bj = 0; bj < 2; ++bj)
#pragma unroll
                        for (int n = 0; n < 2; ++n) xv[m2][bj][n] = *(const f32x4*)(srcb + (size_t)(row0 + ai * 128 + (2 * mh + m2) * 16) * DM + col0 + bj * 128 + n * 16);
#pragma unroll
                for (int m2 = 0; m2 < 2; ++m2)
#pragma unroll
                    for (int bj = 0; bj < 2; ++bj)
#pragma unroll
                        for (int n = 0; n < 2; ++n) *(f32x4*)(Xo + (size_t)(row0 + ai * 128 + (2 * mh + m2) * 16) * DM + col0 + bj * 128 + n * 16) = xv[m2][bj][n] + gv[bj][n] * acc[ai][bj][2 * mh + m2][n];
                asm volatile("" ::: "memory"); }
    }
};
struct EpiSwiGLU {
    static constexpr bool PERM = true; static constexpr int SCALE_W = 0x7b7b7b7b, SCALE_X = 0x7b7b7b7b;
    unsigned char* ACT;
    DI void operator()(const f32x4 (&acc)[2][2][4][2], const Unit& u, int wr, int wc, int fr, int fq) const {
        const int row0 = u.pm * 256 + wr * 64 + fr, col0 = u.pn * 128 + wc * 32 + 8 * fq;
#pragma unroll
        for (int ai = 0; ai < 2; ++ai)
#pragma unroll
            for (int m = 0; m < 4; ++m) { unsigned char* rowp = ACT + ((size_t)u.e * EROWS + row0 + ai * 128 + m * 16) * DF + col0;
                f32x4 q[2];
#pragma unroll
                for (int n = 0; n < 2; ++n) { const f32x4 g = acc[ai][0][m][n], up = acc[ai][1][m][n];
                    q[n] = (g * up) * rcp4(exp2n4(g * -1.4426950408889634f) * (1.0f / FP8_AS) + (1.0f / FP8_AS)); }
                u32x2 w; w.x = pk4_fp8(q[0][0], q[0][1], q[0][2], q[0][3]); w.y = pk4_fp8(q[1][0], q[1][1], q[1][2], q[1][3]);
                *(u32x2*)rowp = w; }
    }
};
struct EpiExpOut {
    static constexpr bool PERM = true; static constexpr int SCALE_W = 0x7b7b7b7b, SCALE_X = 0x7b7b7b7b;
    bf16_t* YB; const float* gate;
    DI void operator()(const f32x4 (&acc)[2][2][4][2], const Unit& u, int wr, int wc, int fr, int fq) const {
        const int row0 = u.pm * 256 + wr * 64 + fr, col0 = u.pn * 256 + wc * 32 + 8 * fq;
#pragma unroll
        for (int ai = 0; ai < 2; ++ai)
#pragma unroll
            for (int m = 0; m < 4; ++m) { const size_t er = (size_t)u.e * EROWS + row0 + ai * 128 + m * 16; const float g = gate[er]; bf16_t* rowp = YB + er * DM + col0;
#pragma unroll
                for (int bj = 0; bj < 2; ++bj) { const f32x4 v0 = acc[ai][bj][m][0] * g, v1 = acc[ai][bj][m][1] * g;
                    u32x4 w; w.x = pg8::cvt_pk_bf16(v0[0], v0[1]); w.y = pg8::cvt_pk_bf16(v0[2], v0[3]); w.z = pg8::cvt_pk_bf16(v1[0], v1[1]); w.w = pg8::cvt_pk_bf16(v1[2], v1[3]);
                    *(u32x4*)(rowp + bj * 128) = w; } }
    }
};

DI int xcd_remap(int L, int nwg) { const int q = nwg / 8, r = nwg % 8, x = L % 8, off = L / 8; return (x < r ? x * (q + 1) : r * (q + 1) + (x - r) * q) + off; }
DI void tile_of(int T, int nM, int nN, int& pm, int& pn) { const int nig = 8 * nN, gid = T / nig, fm = gid * 8, gsz = (nM - fm) < 8 ? (nM - fm) : 8; pm = fm + ((T % nig) % gsz); pn = (T % nig) / gsz; }
struct SchedWin {
    unsigned A, B; int G, c, nN; unsigned rowb;
    DI bool next(int i, Unit& u) const {
        const int nM = NTOK / 256, L = i * G + c; if (L >= nM * nN) return false;
        tile_of(xcd_remap(L, nM * nN), nM, nN, u.pm, u.pn); u.e = 0; u.br = 0;
        u.a = A + (unsigned)u.pm * 256u * rowb; u.b = B + (unsigned)u.pn * 256u * rowb; u.uniform(); return true;
    }
};
DI int pm_of(int li, int pmi) { return li == 0 ? pmi : (pmi / 16) * 17 + 1 + (pmi % 16); }
struct SchedMerge {
    unsigned O, WBR; int G, c, li;
    DI bool next(int i, Unit& u) const {
        const int nM = (li == 0 ? 136 : 128), ntile = nM * 8, L = i * G + c; if (L >= ntile) return false;
        int pmi; tile_of(xcd_remap(L, ntile), nM, 8, pmi, u.pn); u.br = 0; u.pm = pm_of(li, pmi); u.e = 0;
        u.a = O + (unsigned)u.pm * 256u * DM * 2u; u.b = WBR + (unsigned)u.pn * 128u * DM * 2u; u.uniform(); return true;
    }
};
struct SchedOut {
    unsigned MBp, W; int G, c, li;
    DI bool next(int i, Unit& u) const {
        const int nM = (li == 0 ? 136 : 128), ntile = nM * 4, L = i * G + c; if (L >= ntile) return false;
        int pmi; tile_of(xcd_remap(L, ntile), nM, 4, pmi, u.pn); u.br = 0; u.pm = pm_of(li, pmi); u.e = 0;
        u.a = MBp + (unsigned)u.pm * 256u * DM * 2u; u.b = W + (unsigned)u.pn * 256u * DM * 2u; u.uniform(); return true;
    }
};
struct SchedE1 {
    unsigned XE, W; int G, c, pmN;
    DI bool next(int i, Unit& u) const {
        const int per = pmN * 22, L0 = i * G + c; if (L0 >= NE * per) return false;
        const int L = xcd_remap(L0, NE * per); u.e = L / per; tile_of(L % per, pmN, 22, u.pm, u.pn); u.br = 0;
        u.a = XE + ((unsigned)u.e * EROWS + u.pm * 256u) * DM; u.b = W + ((unsigned)u.e * 5632u + u.pn * 256u) * DM; u.uniform(); return true;
    }
};
struct SchedE2 {
    unsigned ACT, W; int G, c, pmN;
    DI bool next(int i, Unit& u) const {
        const int per = pmN * 4, L0 = i * G + c; if (L0 >= NE * per) return false;
        const int L = xcd_remap(L0, NE * per); u.e = L / per; tile_of(L % per, pmN, 4, u.pm, u.pn); u.br = 0;
        u.a = ACT + ((unsigned)u.e * EROWS + u.pm * 256u) * DF; u.b = W + ((unsigned)u.e * 1024u + u.pn * 256u) * DF; u.uniform(); return true;
    }
};


DI void s5_build_w(const Ctx& C, int li, int g, int part4, LAS float* L, int tid) {
    LAS float* pwr = L; LAS float* pwi = pwr + 2176; LAS float* bbr = pwi + 2176; LAS float* bbi = bbr + 2048; LAS float* ccr = bbi + 2048; LAS float* cci = ccr + 2048; LAS float* Kt = cci + 2048;
    __syncthreads();
    if (tid < 128) { const int d = tid >> 6, n = tid & 63, pg = (li * 2 + d) * 16 + g;
        const float lr = C.in(I_LRE)[pg * 64 + n], lim = C.in(I_LIM)[pg * 64 + n], dt = expf(C.in(I_LSTEP)[pg]);
        const float mag = expf(lr * dt); float sn, cs; sincosf(lim * dt, &sn, &cs);
        const float ar = mag * cs, ai = mag * sn, den = lr * lr + lim * lim;
        const float zr = ((ar - 1.0f) * lr + ai * lim) / den, zi = (ai * lr - (ar - 1.0f) * lim) / den;
        float pr = 1.0f, pi = 0.0f;
        for (int t = 0; t <= 16; ++t) { pwr[(d * 17 + t) * 64 + n] = pr; pwi[(d * 17 + t) * 64 + n] = pi; const float nr = pr * ar - pi * ai, ni = pr * ai + pi * ar; pr = nr; pi = ni; }
        for (int p = 0; p < 16; ++p) { const float br = C.in(I_BRE)[((size_t)pg * 64 + n) * 16 + p], bi = C.in(I_BIM)[((size_t)pg * 64 + n) * 16 + p];
            bbr[(d * 64 + n) * 16 + p] = zr * br - zi * bi; bbi[(d * 64 + n) * 16 + p] = zr * bi + zi * br;
            ccr[(d * 16 + p) * 64 + n] = C.in(I_CRE)[((size_t)pg * 16 + p) * 64 + n]; cci[(d * 16 + p) * 64 + n] = C.in(I_CIM)[((size_t)pg * 16 + p) * 64 + n]; } }
    __syncthreads();
    for (int e2 = tid; e2 < 2048; e2 += 512) { const int d = e2 >> 10, tau = (e2 >> 6) & 15, p = 4 * part4 + ((e2 >> 4) & 3), pp = e2 & 15; float acc = 0.f;
        for (int n = 0; n < 64; ++n) { const float cr = ccr[(d * 16 + p) * 64 + n], ci = cci[(d * 16 + p) * 64 + n], pr = pwr[(d * 17 + tau) * 64 + n], pi = pwi[(d * 17 + tau) * 64 + n];
            const float wr = cr * pr - ci * pi, wi = cr * pi + ci * pr; acc += wr * bbr[(d * 64 + n) * 16 + pp] - wi * bbi[(d * 64 + n) * 16 + pp]; }
        Kt[((d * 16 + tau) * 16 + p) * 16 + pp] = acc; }
    __syncthreads();
    {
        const int rl = tid >> 3, t = rl >> 2, p = 4 * part4 + (rl & 3), row = t * 16 + p; const float dsk = C.in(I_S5D)[li * 256 + g * 16 + p];
        bf16_t* dst = C.S5W2() + ((size_t)(li * 16 + g) * 256 + row) * 512;
        for (int k8 = (tid & 7) * 8; k8 < (tid & 7) * 8 + 8; ++k8) { float v[8];
#pragma unroll
            for (int j = 0; j < 8; ++j) { const int kk = (k8 * 8 + j) & 255;
                if (k8 < 32) { const int tp = kk >> 4, pp = kk & 15; float a = 0.f;
                    if (tp <= t) a += Kt[((0 * 16 + (t - tp)) * 16 + p) * 16 + pp];
                    if (tp >= t) a += Kt[((1 * 16 + (tp - t)) * 16 + p) * 16 + pp];
                    if (kk == row) a += dsk; v[j] = a; }
                else { const int d = kk >> 7, part = (kk >> 6) & 1, n = kk & 63, ex = d ? 16 - t : t + 1;
                    const float cr = ccr[(d * 16 + p) * 64 + n], ci = cci[(d * 16 + p) * 64 + n], pr = pwr[(d * 17 + ex) * 64 + n], pi = pwi[(d * 17 + ex) * 64 + n];
                    v[j] = part ? -(cr * pi + ci * pr) : (cr * pr - ci * pi); } }
            u32x4 o; o.x = pk2(v[0], v[1]); o.y = pk2(v[2], v[3]); o.z = pk2(v[4], v[5]); o.w = pk2(v[6], v[7]); *(u32x4*)(dst + k8 * 8) = o; } }
    {
        const int np = 64 * part4 + (tid >> 3), d = np >> 7, part = (np >> 6) & 1, n = np & 63;
        bf16_t* dst = C.S5W1() + ((size_t)(li * 16 + g) * 256 + np) * 256;
        for (int k8 = (tid & 7) * 4; k8 < (tid & 7) * 4 + 4; ++k8) { float v[8];
#pragma unroll
            for (int j = 0; j < 8; ++j) { const int kk = k8 * 8 + j, t = kk >> 4, p = kk & 15, ex = d ? t : 15 - t;
                const float pr = pwr[(d * 17 + ex) * 64 + n], pi = pwi[(d * 17 + ex) * 64 + n], br = bbr[(d * 64 + n) * 16 + p], bi = bbi[(d * 64 + n) * 16 + p];
                v[j] = part ? (pr * bi + pi * br) : (pr * br - pi * bi); }
            u32x4 o; o.x = pk2(v[0], v[1]); o.y = pk2(v[2], v[3]); o.z = pk2(v[4], v[5]); o.w = pk2(v[6], v[7]); *(u32x4*)(dst + k8 * 8) = o; } }
    __syncthreads();
}
DI void prep_s5(const Ctx& C, int gw, int ngw, int lane) {
    const bf16_t* P = C.P(); bf16_t* UG = C.UG();
    for (int ch = gw; ch < S5CH; ch += ngw) {
#pragma unroll
        for (int i = 0; i < 4; ++i) { const int pr = lane + 64 * i, t = pr >> 4, g = pr & 15;
            const u32x4* src = (const u32x4*)(P + ((size_t)ch * 16 + t) * DIN + C_S5U + g * 16); u32x4* dst = (u32x4*)(UG + ((size_t)g * S5ROWS + ch) * 512 + t * 16);
            dst[0] = src[0]; dst[1] = src[1]; }
    }
}
DI void s5_carry(const Ctx& C, int li, int gw, int ngw, int lane) {
    const float* SS = C.S5S(); bf16_t* UG = C.UG();
    for (int it = gw; it < NB * 2 * 16; it += ngw) {
        const int b = it >> 5, d = (it >> 4) & 1, g = it & 15, n = lane, pg = (li * 2 + d) * 16 + g;
        const float lr = C.in(I_LRE)[pg * 64 + n], lim = C.in(I_LIM)[pg * 64 + n], dt = expf(C.in(I_LSTEP)[pg]);
        const float mag = expf(16.0f * lr * dt); float sn, cs; sincosf(16.0f * lim * dt, &sn, &cs);
        const float ar = mag * cs, ai = mag * sn;
        float xr = 0.f, xi = 0.f;
#pragma unroll 1
        for (int s0 = 0; s0 < 272; s0 += 34) {
            float sr[34], si[34];
#pragma unroll
            for (int k = 0; k < 34; ++k) { const int s = s0 + k, c = d == 0 ? s : (s < 16 ? 15 - s : 287 - s); const size_t rowi = (size_t)g * S5ROWS + b * 272 + c;
                sr[k] = SS[rowi * 256 + d * 128 + n]; si[k] = SS[rowi * 256 + d * 128 + 64 + n]; }
#pragma unroll
            for (int k = 0; k < 34; ++k) { const int s = s0 + k, c = d == 0 ? s : (s < 16 ? 15 - s : 287 - s); const size_t rowi = (size_t)g * S5ROWS + b * 272 + c;
                UG[rowi * 512 + 256 + d * 128 + n] = (bf16_t)f2bf(xr); UG[rowi * 512 + 256 + d * 128 + 64 + n] = (bf16_t)f2bf(xi);
                const float nr = ar * xr - ai * xi + sr[k], ni = ar * xi + ai * xr + si[k]; xr = nr; xi = ni; }
        }
    }
}
struct SchedS5 {
    unsigned A, B; int G, c; unsigned bstride;
    DI bool next(int i, Unit& u) const {
        const int L = i * G + c; if (L >= 16 * 9) return false;
        u.e = L / 9; u.pm = L % 9; u.pn = 0; u.br = 0;
        u.a = A + ((unsigned)u.e * S5ROWS + u.pm * 256u) * 512u * 2u; u.b = B + (unsigned)u.e * bstride; u.uniform(); return true;
    }
};
struct EpiS5S {
    static constexpr bool PERM = false;
    float* SS;
    DI void operator()(const f32x4 (&acc)[2][2][4][2], const Unit& u, int wr, int wc, int fr, int fq) const {
        const int row0 = u.pm * 256 + wr * 64 + fr, col0 = wc * 32 + 4 * fq;
#pragma unroll
        for (int ai = 0; ai < 2; ++ai)
#pragma unroll
            for (int m = 0; m < 4; ++m) { float* rowp = SS + ((size_t)u.e * S5ROWS + row0 + ai * 128 + m * 16) * 256 + col0;
#pragma unroll
                for (int bj = 0; bj < 2; ++bj)
#pragma unroll
                    for (int n = 0; n < 2; ++n) *(f32x4*)(rowp + bj * 128 + n * 16) = acc[ai][bj][m][n]; }
    }
};
struct EpiS5Z {
    static constexpr bool PERM = true;
    bf16_t* Z;
    DI void operator()(const f32x4 (&acc)[2][2][4][2], const Unit& u, int wr, int wc, int fr, int fq) const {
        const int row0 = u.pm * 256 + wr * 64 + fr;
#pragma unroll
        for (int ai = 0; ai < 2; ++ai)
#pragma unroll
            for (int m = 0; m < 4; ++m) { const int ch = row0 + ai * 128 + m * 16; if (ch >= S5CH) continue;
#pragma unroll
                for (int bj = 0; bj < 2; ++bj) { const int col = bj * 128 + wc * 32 + 8 * fq, t = col >> 4, p0 = col & 15;
                    const f32x4 v0 = acc[ai][bj][m][0], v1 = acc[ai][bj][m][1];
                    u32x4 w; w.x = pk2(gelu_tanh(v0[0]), gelu_tanh(v0[1])); w.y = pk2(gelu_tanh(v0[2]), gelu_tanh(v0[3])); w.z = pk2(gelu_tanh(v1[0]), gelu_tanh(v1[1])); w.w = pk2(gelu_tanh(v1[2]), gelu_tanh(v1[3]));
                    *(u32x4*)(Z + ((size_t)ch * 16 + t) * 256 + u.e * 16 + p0) = w; } }
    }
};
struct SchedGlu {
    unsigned A, B; int G, c, li;
    DI bool next(int i, Unit& u) const {
        const int L = i * G + c; if (L >= (li == 0 ? 136 : 128)) return false;
        u.pm = pm_of(li, L); u.pn = 0; u.e = 0; u.br = 0; u.a = A + (unsigned)u.pm * 256u * 256u * 2u; u.b = B; u.uniform(); return true;
    }
};
struct EpiGlu {
    static constexpr bool PERM = true;
    bf16_t* O; const bf16_t* Z;
    DI void operator()(const f32x4 (&acc)[2][2][4][2], const Unit& u, int wr, int wc, int fr, int fq) const {
        const int row0 = u.pm * 256 + wr * 64 + fr, col0 = wc * 32 + 8 * fq;
#pragma unroll
        for (int ai = 0; ai < 2; ++ai)
#pragma unroll
            for (int m = 0; m < 4; ++m) { const size_t row = (size_t)(row0 + ai * 128 + m * 16);
#pragma unroll
                for (int bj = 0; bj < 2; ++bj) { const int col = col0 + bj * 128; const u32x4 z = *(const u32x4*)(Z + row * 256 + col);
                    const f32x4 v0 = acc[ai][bj][m][0], v1 = acc[ai][bj][m][1];
                    u32x4 w; w.x = pk2(lo_f(z.x) * sigm(v0[0]), hi_f(z.x) * sigm(v0[1])); w.y = pk2(lo_f(z.y) * sigm(v0[2]), hi_f(z.y) * sigm(v0[3]));
                    w.z = pk2(lo_f(z.z) * sigm(v1[0]), hi_f(z.z) * sigm(v1[1])); w.w = pk2(lo_f(z.w) * sigm(v1[2]), hi_f(z.w) * sigm(v1[3]));
                    *(u32x4*)(O + row * DM + col) = w; }
                if (m == 3) asm volatile("" ::: "memory"); }
    }
};

DI void transpose_item(const float* src, size_t ldw, bf16_t* dst, size_t ldo, LAS float* scr, int lane) {
    const int kq = lane >> 3, n4 = lane & 7;
    f32x4 tv[8];
#pragma unroll
    for (int i = 0; i < 8; ++i) tv[i] = *(const f32x4*)(src + (size_t)(8 * kq + i) * ldw + 4 * n4);
    LAS unsigned char* t8 = (LAS unsigned char*)scr;
#pragma unroll
    for (int j = 0; j < 4; ++j) { u32x4 w; w.x = pk2(tv[0][j], tv[1][j]); w.y = pk2(tv[2][j], tv[3][j]); w.z = pk2(tv[4][j], tv[5][j]); w.w = pk2(tv[6][j], tv[7][j]);
        *(LAS u32x4*)(t8 + (4 * n4 + j) * 144 + 16 * kq) = w; }
    LDS_WAIT(); asm volatile("" ::: "memory");
    { const int n = lane >> 1, hf = lane & 1; const LAS u32x4* rp = (const LAS u32x4*)(t8 + n * 144 + 64 * hf);
      const u32x4 a0 = rp[0], a1 = rp[1], a2 = rp[2], a3 = rp[3];
      u32x4* gp = (u32x4*)(dst + (size_t)n * ldo + 32 * hf);
      gp[0] = a0; gp[1] = a1; gp[2] = a2; gp[3] = a3; }
    LDS_WAIT(); asm volatile("" ::: "memory");
}
DI void tr_plain(const float* W, int K, int N, bf16_t* WT, LAS float* scr, int item, int lane) {
    const int nblk = N / 32, kb = item / nblk, nb = item % nblk;
    transpose_item(W + (size_t)(64 * kb) * N + 32 * nb, N, WT + (size_t)(32 * nb) * K + 64 * kb, K, scr, lane);
}
DI void transpose_item8(const float* src, size_t ldw, unsigned char* dst, size_t ldo, LAS float* scr, int lane) {
    const int kq = lane >> 3, n4 = lane & 7;
    f32x4 tv[8];
#pragma unroll
    for (int i = 0; i < 8; ++i) tv[i] = *(const f32x4*)(src + (size_t)(8 * kq + i) * ldw + 4 * n4);
    LAS unsigned char* t8 = (LAS unsigned char*)scr;
#pragma unroll
    for (int j = 0; j < 4; ++j) { u32x2 w; w.x = pk4_fp8(tv[0][j] * FP8_WS, tv[1][j] * FP8_WS, tv[2][j] * FP8_WS, tv[3][j] * FP8_WS); w.y = pk4_fp8(tv[4][j] * FP8_WS, tv[5][j] * FP8_WS, tv[6][j] * FP8_WS, tv[7][j] * FP8_WS);
        *(LAS u32x2*)(t8 + (4 * n4 + j) * 72 + 8 * kq) = w; }
    LDS_WAIT(); asm volatile("" ::: "memory");
    { const int n = lane >> 1, hf = lane & 1; const LAS u32x2* rp = (const LAS u32x2*)(t8 + n * 72 + 32 * hf);
      const u32x2 a0 = rp[0], a1 = rp[1], a2 = rp[2], a3 = rp[3];
      u32x4* gp = (u32x4*)(dst + (size_t)n * ldo + 32 * hf);
      gp[0] = (u32x4){a0.x, a0.y, a1.x, a1.y}; gp[1] = (u32x4){a2.x, a2.y, a3.x, a3.y}; }
    LDS_WAIT(); asm volatile("" ::: "memory");
}
DI void tr_gu(const float* W, unsigned char* W1T, int half, LAS float* scr, int item, int lane) {
    const int nblk = DF / 32, kb = item / nblk, nb = item % nblk, n0 = 32 * nb, drow = (n0 / 128) * 256 + half * 128 + (n0 % 128);
    transpose_item8(W + (size_t)(64 * kb) * DF + n0, DF, W1T + (size_t)drow * DM + 64 * kb, DM, scr, lane);
}
DI void convert_experts(const Ctx& C, int li, int it0, int gw, int ngw, LAS float* scr, int lane) {
    constexpr int PER = 16 * 88;
    for (int it = (gw - it0 + ngw) % ngw; it < 3 * NE * PER; it += ngw) {
        const int which = it / (NE * PER), r = it % (NE * PER), e = r / PER, item = r % PER;
        if (which == 0) tr_gu(C.in(I_EWG) + ((size_t)li * NE + e) * DM * DF, C.W1T() + (size_t)e * 5632 * DM, 0, scr, item, lane);
        else if (which == 1) tr_gu(C.in(I_EWU) + ((size_t)li * NE + e) * DM * DF, C.W1T() + (size_t)e * 5632 * DM, 1, scr, item, lane);
        else { const int nblk = DM / 32, kb = item / nblk, nb = item % nblk;
            transpose_item8(C.in(I_EWD) + ((size_t)li * NE + e) * DF * DM + (size_t)(64 * kb) * DM + 32 * nb, DM, C.W2T() + (size_t)e * DM * DF + (size_t)(32 * nb) * DF + 64 * kb, DF, scr, lane); }
    }
}
DI void phase_prologue(const Ctx& C, LAS unsigned char* lds, int gw, int ngw, int wave, int lane) {
    const int tid_ = wave * 64 + lane;
    if (blockIdx.x < 96) { for (int li = 0; li < 2; ++li) {
        const int col = (blockIdx.x % 96) * 64 + lane; const float* w = C.in(I_ADAW) + (size_t)li * DM * 6144 + (size_t)(128 * wave) * 6144 + col;
        float cr[9][2];
#pragma unroll
        for (int q = 0; q < 9; ++q)
#pragma unroll
            for (int j = 0; j < 2; ++j) { const int k = 128 * wave + 64 * j + lane; cr[q][j] = silu_(q < 8 ? C.in(I_C)[q * 1024 + k] : C.in(I_CCTX)[k]); }
        float acc[9];
#pragma unroll
        for (int q = 0; q < 9; ++q) acc[q] = 0.f;
#pragma unroll
        for (int k0 = 0; k0 < 128; k0 += 32) { float wv[32];
#pragma unroll
            for (int k = 0; k < 32; ++k) wv[k] = w[(size_t)(k0 + k) * 6144];
#pragma unroll
            for (int k = 0; k < 32; ++k)
#pragma unroll
                for (int q = 0; q < 9; ++q) acc[q] += __uint_as_float(__builtin_amdgcn_readlane(__float_as_uint(cr[q][(k0 + k) >> 6]), (k0 + k) & 63)) * wv[k]; }
        LAS float* red = (LAS float*)(lds + 40960);
#pragma unroll
        for (int q = 0; q < 9; ++q) red[(wave * 9 + q) * 64 + lane] = acc[q];
        __syncthreads();
        for (int e = tid_; e < 9 * 64; e += 512) { const int q = e >> 6, cl = e & 63; float sum = 0.f;
#pragma unroll
            for (int wv2 = 0; wv2 < 8; ++wv2) sum += red[(wv2 * 9 + q) * 64 + cl];
            const int cc = (blockIdx.x % 96) * 64 + cl; C.mod()[(li * 9 + q) * 6144 + cc] = sum + C.in(I_ADAB)[li * 6144 + cc]; }
        __syncthreads(); }
    } else if (blockIdx.x < 224) { const int j = blockIdx.x - 96; s5_build_w(C, j >> 6, (j >> 2) & 15, j & 3, (LAS float*)(lds + 40960), tid_); }
    LAS float* scr = (LAS float*)(lds + 40960 + wave * 8704);
    if (blockIdx.x == 0 && tid_ < 256) {
        const float v0 = C.in(I_HGLB)[tid_], v1 = C.in(I_HGLB)[256 + tid_];
        C.lb()[tid_] = 0.f; C.lb()[256 + tid_] = 1.0f / (1.0f + expf(v0 - v1));
    }
    constexpr int N_MOD = 0, N_WIN = 2 * 16 * 232,     N_WBR = 8 * 4 * 32, N_WOUT = 2 * 16 * 32, N_GLU = 2 * 4 * 8;
    for (int it = gw; it < N_MOD + N_WIN + N_WBR + N_WOUT + N_GLU; it += ngw) {
        int r = it;
        r -= N_MOD;
        if (r < N_WIN) { const int li = r / (16 * 232), it2 = r % (16 * 232), kb = it2 / 232, nb = it2 % 232; const float* src = C.in(I_WIN) + (size_t)li * DM * DIN + (size_t)(64 * kb) * DIN + 32 * nb;
            if (nb < C_GATE / 32) transpose_item(src, DIN, C.win() + (size_t)li * DIN * DM + (size_t)(32 * nb) * DM + 64 * kb, DM, scr, lane);
            else transpose_item8(src, DIN, C.ws() + WS_WIN + (size_t)li * DIN * DM * 2 + WS_WIN8_OFF + (size_t)(32 * nb - C_GATE) * DM + 64 * kb, DM, scr, lane);
            continue; }
        r -= N_WIN;
        if (r < N_WBR) { const int m = r / 128, it2 = r % 128, kb = it2 / 32, nb = it2 % 32;
            transpose_item(C.in(I_WBR) + (size_t)m * 256 * DM + (size_t)(64 * kb) * DM + 32 * nb, DM, C.wbr() + (size_t)(m >> 2) * DM * DM + (size_t)(32 * nb) * DM + (m & 3) * 256 + 64 * kb, DM, scr, lane); continue; }
        r -= N_WBR;
        if (r < N_WOUT) { const int li = r / 512; tr_plain(C.in(I_WOUT) + (size_t)li * DM * DM, DM, DM, C.wout() + (size_t)li * DM * DM, scr, r % 512, lane); continue; }
        r -= N_WOUT;
        { const int li = r / 32; tr_plain(C.in(I_GLU) + (size_t)li * 65536, 256, 256, C.GLUT() + (size_t)li * 65536, scr, r % 32, lane); }
    }
}

DI void moe_combine_row(const Ctx& C, size_t R, const float* g2, f32x4 (&v)[4], int lane) {
    f32x4 a[4];
#pragma unroll
    for (int j = 0; j < 4; ++j) a[j] = (f32x4){0.f, 0.f, 0.f, 0.f};
    int sv[NE];
#pragma unroll
    for (int e = 0; e < NE; ++e) sv[e] = C.sel()[(size_t)e * NTOK + R];
#pragma unroll
    for (int e = 0; e < NE; ++e) { const int s = __builtin_amdgcn_readfirstlane(sv[e]);
        if (s >= 0) { const bf16_t* y = C.XE() + ((size_t)e * EROWS + s) * DM;
#pragma unroll
            for (int j = 0; j < 4; ++j) { const u32x2 w = *(const u32x2*)(y + 4 * (lane + 64 * j)); a[j][0] += lo_f(w.x); a[j][1] += hi_f(w.x); a[j][2] += lo_f(w.y); a[j][3] += hi_f(w.y); } }
    }
#pragma unroll
    for (int j = 0; j < 4; ++j) v[j] = v[j] + *(const f32x4*)(g2 + 4 * (lane + 64 * j)) * a[j];
}
DI void norm1_row(const Ctx& C, int li, int R, const float* nw, int lane, float* Xout, f32x4 (&v)[4]) {
    const int b = R / LSEQ, i = R % LSEQ, mr = (i < CTXL) ? 8 : b;
    if (li > 0) moe_combine_row(C, R, C.mod() + ((li - 1) * 9 + mr) * 6144 + 5 * 1024, v, lane);
    float ss = 0.f;
#pragma unroll
    for (int j = 0; j < 4; ++j) { if (li > 0) *(f32x4*)(Xout + (size_t)R * DM + 4 * (lane + 64 * j)) = v[j];     ss += v[j][0] * v[j][0] + v[j][1] * v[j][1] + v[j][2] * v[j][2] + v[j][3] * v[j][3]; }
    const float rstd = 1.0f / sqrtf(wave_sum(ss) * (1.0f / DM) + EPS);
    const float* md = C.mod() + (li * 9 + mr) * 6144;
#pragma unroll
    for (int j = 0; j < 4; ++j) { const int c = 4 * (lane + 64 * j);
        const f32x4 w = *(const f32x4*)(nw + c), sh = *(const f32x4*)(md + c), sc = *(const f32x4*)(md + 1024 + c);
        const f32x4 h = v[j] * rstd * w * (sc + 1.0f) + sh;
        u32x2 o; o.x = pk2(h[0], h[1]); o.y = pk2(h[2], h[3]);
        *(u32x2*)(C.H() + (size_t)R * DM + c) = o;
        *(unsigned*)(C.ws() + WS_H8 + (size_t)R * DM + c) = pk4_fp8(h[0] * FP8_XS, h[1] * FP8_XS, h[2] * FP8_XS, h[3] * FP8_XS); }
}
DI const float* xrow_src(const Ctx& C, int li, int R) {
    if (li > 0) return C.X() + (size_t)R * DM;
    const int b = R / LSEQ, i = R % LSEQ;
    return (i < CTXL) ? C.in(I_CTX) + ((size_t)b * CTXL + i) * DM : C.in(I_X) + ((size_t)b * SEQ + (i - CTXL)) * DM;
}
DI void phase_norm1(const Ctx& C, int li, int gw, int ngw, int lane, float* Xout) {
    const float* nw = C.in(I_NMIX) + li * DM;
    for (int R = gw; R < NTOK; R += 4 * ngw) {
        f32x4 v[4][4];
#pragma unroll
        for (int q = 0; q < 4; ++q) { const int Rq = R + q * ngw; if (Rq < NTOK) { const float* src = xrow_src(C, li, Rq);
#pragma unroll
            for (int j = 0; j < 4; ++j) v[q][j] = *(const f32x4*)(src + 4 * (lane + 64 * j)); } }
#pragma unroll
        for (int q = 0; q < 4; ++q) { const int Rq = R + q * ngw; if (Rq < NTOK) norm1_row(C, li, Rq, nw, lane, Xout, v[q]); }
    }
}
DI void phase_final(const Ctx& C, int gw, int ngw, int lane) {
    for (int t0 = gw; t0 < NB * SEQ; t0 += 4 * ngw) {
        f32x4 v[4][4];
#pragma unroll
        for (int q = 0; q < 4; ++q) { const int t = t0 + q * ngw; if (t < NB * SEQ) { const size_t R = (size_t)(t / SEQ) * LSEQ + CTXL + (t % SEQ);
#pragma unroll
            for (int j = 0; j < 4; ++j) v[q][j] = *(const f32x4*)(C.X() + R * DM + 4 * (lane + 64 * j)); } }
#pragma unroll
        for (int q = 0; q < 4; ++q) { const int t = t0 + q * ngw; if (t < NB * SEQ) { const int b = t / SEQ; const size_t R = (size_t)b * LSEQ + CTXL + (t % SEQ);
            moe_combine_row(C, R, C.mod() + (1 * 9 + b) * 6144 + 5 * 1024, v[q], lane);
#pragma unroll
            for (int j = 0; j < 4; ++j) *(f32x4*)(C.out() + (size_t)t * DM + 4 * (lane + 64 * j)) = v[q][j]; } }
    }
}

DI void phase_norm2(const Ctx& C, int li, LAS unsigned char* lds, int gw, int ngw, int wave, int lane) {
    const int tid_ = wave * 64 + lane;
    LAS float* rwT = (LAS float*)lds;
    for (int i = tid_; i < DM * NE / 4; i += 512) { const f32x4 v = ((const f32x4*)(C.in(I_RW) + (size_t)li * DM * NE))[i]; const int c = i >> 2, e0 = (i & 3) * 4;
        rwT[(e0 + 0) * DM + c] = v[0]; rwT[(e0 + 1) * DM + c] = v[1]; rwT[(e0 + 2) * DM + c] = v[2]; rwT[(e0 + 3) * DM + c] = v[3]; }
    __syncthreads();
    const float* nw = C.in(I_NFFN) + li * DM;
    for (int R0 = gw; R0 < NTOK; R0 += 4 * ngw) {
      f32x4 vq[4][4];
#pragma unroll
      for (int q = 0; q < 4; ++q) { const int R = R0 + q * ngw; if (R < NTOK) {
#pragma unroll
          for (int j = 0; j < 4; ++j) vq[q][j] = *(const f32x4*)(C.X() + (size_t)R * DM + 4 * (lane + 64 * j)); } }
#pragma unroll
      for (int q = 0; q < 4; ++q) { const int R = R0 + q * ngw; if (R >= NTOK) continue;
        const int b = R / LSEQ, i = R % LSEQ, mr = (i < CTXL) ? 8 : b;
        if (li == DEPTH - 1 && i < CTXL) continue;
        f32x4 (&v)[4] = vq[q]; float ss = 0.f;
#pragma unroll
        for (int j = 0; j < 4; ++j) ss += v[j][0] * v[j][0] + v[j][1] * v[j][1] + v[j][2] * v[j][2] + v[j][3] * v[j][3];
        const float rstd = 1.0f / sqrtf(wave_sum(ss) * (1.0f / DM) + EPS);
        const float* md = C.mod() + (li * 9 + mr) * 6144;
        float y[NE];
#pragma unroll
        for (int e = 0; e < NE; ++e) y[e] = 0.f;
#pragma unroll
        for (int j = 0; j < 4; ++j) { const int c = 4 * (lane + 64 * j);
            const f32x4 w = *(const f32x4*)(nw + c), sh = *(const f32x4*)(md + 3 * 1024 + c), sc = *(const f32x4*)(md + 4 * 1024 + c);
            const f32x4 h = v[j] * rstd * w * (sc + 1.0f) + sh;
            u32x2 o; o.x = pk2(h[0], h[1]); o.y = pk2(h[2], h[3]);
            *(u32x2*)(C.H() + (size_t)R * DM + c) = o;
#pragma unroll
            for (int e = 0; e < NE; ++e) { const f32x4 r4 = *(const LAS f32x4*)(rwT + e * DM + c); y[e] += h[0] * r4[0] + h[1] * r4[1] + h[2] * r4[2] + h[3] * r4[3]; } }
        float y8[8], y4[4], y2[2], lg;
        { const bool hi = (lane & 32) != 0;
#pragma unroll
          for (int k = 0; k < 8; ++k) { const float keep = hi ? y[k + 8] : y[k], send = hi ? y[k] : y[k + 8]; y8[k] = keep + shx<32>(send); } }
        { const bool hi = (lane & 16) != 0;
#pragma unroll
          for (int k = 0; k < 4; ++k) { const float keep = hi ? y8[k + 4] : y8[k], send = hi ? y8[k] : y8[k + 4]; y4[k] = keep + shx<16>(send); } }
        { const bool hi = (lane & 8) != 0;
#pragma unroll
          for (int k = 0; k < 2; ++k) { const float keep = hi ? y4[k + 2] : y4[k], send = hi ? y4[k] : y4[k + 2]; y2[k] = keep + shx<8>(send); } }
        { const bool hi = (lane & 4) != 0; const float keep = hi ? y2[1] : y2[0], send = hi ? y2[0] : y2[1]; lg = keep + shx<4>(send); }
        lg += shx<2>(lg); lg += shx<1>(lg);
        float mx = lg;
        mx = fmaxf(mx, shx<4>(mx)); mx = fmaxf(mx, shx<8>(mx)); mx = fmaxf(mx, shx<16>(mx)); mx = fmaxf(mx, shx<32>(mx));
        const float ex = expf(lg - mx);
        float den = ex;
        den += shx<4>(den); den += shx<8>(den); den += shx<16>(den); den += shx<32>(den);
        if ((lane & 3) == 0) C.aff()[(size_t)R * NE + ((lane >> 2) & 15)] = ex / den;
      }
    }
}

DI void phase_topk(const Ctx& C, int li, LAS unsigned char* lds, int wave, int lane) {
    LAS unsigned* cnt = (LAS unsigned*)lds;
    LAS int* rows = (LAS int*)(lds + 64);
    const int tid = wave * 64 + lane, nunit = (li == DEPTH - 1) ? 128 : 256;
    for (int u = blockIdx.x; u < nunit; u += gridDim.x) {
        const int kind = u >> 7, b = (u >> 4) & 7, e = u & 15;
        const int n = kind ? CTXL : SEQ, cap = kind ? CAP_C : CAP_L, per = n / 512 + (kind ? 1 : 0);
        const size_t rbase = (size_t)b * LSEQ + (kind ? 0 : CTXL);
        unsigned v[8];
#pragma unroll
        for (int j = 0; j < 8; ++j) { const int t = tid + 512 * j; v[j] = (j < per && t < n) ? __float_as_uint(C.aff()[(rbase + t) * NE + e]) : 0u; }
        unsigned thr = 0u;
        for (int bit = 30; bit >= 0; --bit) {
            const unsigned cand = thr | (1u << bit);
            if (tid == 0) cnt[0] = 0u;
            __syncthreads();
            unsigned c = 0;
#pragma unroll
            for (int j = 0; j < 8; ++j) c += (v[j] >= cand) ? 1u : 0u;
            c = (unsigned)wave_sum((float)c);
            if (lane == 0) atomicAdd((unsigned*)cnt, c);
            __syncthreads();
            if (cnt[0] >= (unsigned)cap) thr = cand;
            __syncthreads();
        }
        if (tid == 0) { cnt[1] = 0u; cnt[2] = 0u; }
        __syncthreads();
        unsigned ngt = 0;
#pragma unroll
        for (int j = 0; j < 8; ++j) ngt += (v[j] > thr) ? 1u : 0u;
        ngt = (unsigned)wave_sum((float)ngt);
        if (lane == 0) atomicAdd((unsigned*)cnt + 1, ngt);
        __syncthreads();
        const unsigned n_gt = cnt[1];
        __syncthreads();
        if (tid == 0) cnt[1] = 0u;
        __syncthreads();
        const int srow0 = kind ? (NB * CAP_L + b * CAP_C) : b * CAP_L;
#pragma unroll
        for (int j = 0; j < 8; ++j) { const int t = tid + 512 * j;
            if (j < per && t < n) {
                int slot = -1;
                if (v[j] > thr) slot = (int)atomicAdd((unsigned*)cnt + 1, 1u);
                else if (v[j] == thr) { const unsigned k = atomicAdd((unsigned*)cnt + 2, 1u); if (n_gt + k < (unsigned)cap) slot = (int)(n_gt + k); }
                C.sel()[(size_t)e * NTOK + rbase + t] = (slot >= 0) ? srow0 + slot : -1;
                if (slot >= 0) { rows[slot] = (int)(rbase + t); C.gate()[(size_t)e * EROWS + srow0 + slot] = __uint_as_float(v[j]); }
            } }
        __syncthreads();
        for (int s0 = wave; s0 < cap; s0 += 32) {
            u32x4 xa[4], xb[4];
#pragma unroll
            for (int q = 0; q < 4; ++q) { const int sq = s0 + 8 * q; if (sq < cap) { const u32x4* src = (const u32x4*)(C.H() + (size_t)rows[sq] * DM) + 2 * lane; xa[q] = src[0]; xb[q] = src[1]; } }
#pragma unroll
            for (int q = 0; q < 4; ++q) { const int sq = s0 + 8 * q; if (sq >= cap) continue; const u32x4 x0 = xa[q], x1 = xb[q];
                u32x4 o; o.x = pk4_fp8(lo_f(x0.x) * FP8_XS, hi_f(x0.x) * FP8_XS, lo_f(x0.y) * FP8_XS, hi_f(x0.y) * FP8_XS); o.y = pk4_fp8(lo_f(x0.z) * FP8_XS, hi_f(x0.z) * FP8_XS, lo_f(x0.w) * FP8_XS, hi_f(x0.w) * FP8_XS);
                o.z = pk4_fp8(lo_f(x1.x) * FP8_XS, hi_f(x1.x) * FP8_XS, lo_f(x1.y) * FP8_XS, hi_f(x1.y) * FP8_XS); o.w = pk4_fp8(lo_f(x1.z) * FP8_XS, hi_f(x1.z) * FP8_XS, lo_f(x1.w) * FP8_XS, hi_f(x1.w) * FP8_XS);
                *((u32x4*)((unsigned char*)C.XE() + ((size_t)e * EROWS + srow0 + sq) * DM) + lane) = o; }
        }
        __syncthreads();
    }
}

DI void phase_prep(const Ctx& C, int li, int gw, int ngw, int lane) {
    const float* wq = C.in(I_NAQN) + li * 64; const float* wk = C.in(I_NAKN) + li * 64;
    const int d0 = (lane & 7) * 8; const bool isq = lane < 32;
    float w[8];
#pragma unroll
    for (int j = 0; j < 8; ++j) w[j] = isq ? wq[d0 + j] * 0.125f : wk[d0 + j];
    for (int R0 = gw; R0 < NTOK; R0 += 4 * ngw) {
        u32x4 xq[4];
#pragma unroll
        for (int q = 0; q < 4; ++q) { const int R = R0 + q * ngw; if (R < NTOK) xq[q] = *(const u32x4*)(C.P() + (size_t)R * DIN + C_NAQ + 8 * lane); }
#pragma unroll
        for (int q = 0; q < 4; ++q) { const int R = R0 + q * ngw; if (R >= NTOK) continue; const u32x4 x = xq[q];
            float f[8] = {lo_f(x.x), hi_f(x.x), lo_f(x.y), hi_f(x.y), lo_f(x.z), hi_f(x.z), lo_f(x.w), hi_f(x.w)};
            float ss = 0.f;
#pragma unroll
            for (int j = 0; j < 8; ++j) ss += f[j] * f[j];
            ss += shx<1>(ss); ss += shx<2>(ss); ss += shx<4>(ss);
            const float rs = __builtin_amdgcn_rsqf(ss * (1.0f / 64.0f) + EPS);
            u32x4 o; o.x = pk2(f[0] * rs * w[0], f[1] * rs * w[1]); o.y = pk2(f[2] * rs * w[2], f[3] * rs * w[3]); o.z = pk2(f[4] * rs * w[4], f[5] * rs * w[5]); o.w = pk2(f[6] * rs * w[6], f[7] * rs * w[7]);
            *(u32x4*)(C.QKN() + (size_t)R * 512 + 8 * lane) = o; }
    }
}

typedef short s16x4 __attribute__((ext_vector_type(4)));
#define MFMA16(a, b, c) __builtin_amdgcn_mfma_f32_16x16x32_bf16((a), (b), (c), 0, 0, 0)
DI bf16x8 ld16(const bf16_t* p) { return *(const bf16x8*)p; }
DI s16x4 tr16(const LAS bf16_t* p) { return __builtin_amdgcn_ds_read_tr16_b64_v4i16((LAS s16x4*)p); }
DI bf16x8 cat8(s16x4 a, s16x4 b) { return __builtin_shufflevector(a, b, 0, 1, 2, 3, 4, 5, 6, 7); }
DI bf16x8 pack8(const f32x4& a, const f32x4& b) { u32x4 w; w.x = pg8::cvt_pk_bf16(a[0], a[1]); w.y = pg8::cvt_pk_bf16(a[2], a[3]); w.z = pg8::cvt_pk_bf16(b[0], b[1]); w.w = pg8::cvt_pk_bf16(b[2], b[3]); return __builtin_bit_cast(bf16x8, w); }

constexpr int NA_VS = 80;
DI void na_unit(const Ctx& C, int li, int wu, bool isctx, int lane, LAS bf16_t* vl, const LAS float* rpbt) {
    const int cq = lane & 15, g = lane >> 4;
    int b, h, r, c; size_t Rq;
    if (!isctx) { c = wu & 3; h = (wu >> 2) & 3; r = (wu >> 4) & 63; b = wu >> 10; Rq = (size_t)b * LSEQ + CTXL + r * 64 + 16 * c + cq; }
    else { c = wu & 15; h = (wu >> 4) & 3; b = wu >> 6; r = 0; Rq = (size_t)b * LSEQ + 16 * c + cq; }
    const bf16_t* QKN = C.QKN(); const bf16_t* P = C.P();
    bf16x8 qf[2];
    qf[0] = ld16(QKN + Rq * 512 + h * 64 + 8 * g); qf[1] = ld16(QKN + Rq * 512 + h * 64 + 32 + 8 * g);
    f32x4 o[4];
#pragma unroll
    for (int d = 0; d < 4; ++d) o[d] = (f32x4){0.f, 0.f, 0.f, 0.f};
    float lsum = 0.f;
    const int r0 = min(max(r - 4, 0), 56), kc0 = (c == 0) ? 0 : (c == 1) ? 8 : (c == 2) ? 24 : 32, qi = 16 * c + cq, cs = min(max(qi - 8, 0), 48);
    const LAS float* rpb = rpbt + h * 465;
    const size_t rowb = (size_t)b * LSEQ;
    const int nch = isctx ? 4 : 8;
    const int dwin = kc0 + 4 * g - cs, ebias = kc0 + 4 * g - qi + 15;
    const unsigned voffV = (unsigned)((lane >> 3) * DIN + 8 * (lane & 7)) * 2u, voffK = (unsigned)(cq * 512 + 8 * g) * 2u;
    const __amdgpu_buffer_rsrc_t rsP = __builtin_amdgcn_make_buffer_rsrc((void*)P, 0, 0x7fffffff, 0x00020000), rsK = __builtin_amdgcn_make_buffer_rsrc((void*)QKN, 0, 0x7fffffff, 0x00020000);
    const unsigned Pv0 = (unsigned)(C_NAV + h * 64) * 2u, Kv0 = (unsigned)(256 + h * 64) * 2u;
#define NA_CHROW(ch_) ((!isctx && (ch_) < 4) ? (rowb + CTXL + (size_t)(r0 + 2 * (ch_)) * 64 + kc0) : (rowb + 64 * (size_t)(isctx ? (ch_) : (ch_) - 4)))
#define NA_VSTEP(ch_, i) ((!isctx && (ch_) < 4) ? (((i) >> 2) * 64 + 8 * ((i) & 3)) : 8 * (i))
#define NA_KSTEP(ch_, kb) ((!isctx && (ch_) < 4) ? (((kb) >> 1) * 64 + 16 * ((kb) & 1)) : 16 * (kb))
    bf16x8 vA[8], kA[8], vB[8], kB[8];
#define NA_PREFETCH(VR, KR, ch_) do { const size_t cr_ = NA_CHROW(ch_); \
        _Pragma("unroll") for (int i = 0; i < 8; ++i) VR[i] = __builtin_bit_cast(bf16x8, __builtin_amdgcn_raw_buffer_load_b128(rsP, voffV, (unsigned)(cr_ + NA_VSTEP(ch_, i)) * (unsigned)(DIN * 2) + Pv0, 0)); \
        _Pragma("unroll") for (int kb = 0; kb < 4; ++kb) { const unsigned ko_ = (unsigned)(cr_ + NA_KSTEP(ch_, kb)) * 1024u + Kv0; \
            KR[2 * kb] = __builtin_bit_cast(bf16x8, __builtin_amdgcn_raw_buffer_load_b128(rsK, voffK, ko_, 0)); KR[2 * kb + 1] = __builtin_bit_cast(bf16x8, __builtin_amdgcn_raw_buffer_load_b128(rsK, voffK, ko_ + 64u, 0)); } } while (0)
#define NA_BODY(VR, KR, ch_) do { const int chv = (ch_); const bool local = !isctx && chv < 4; \
          \
        _Pragma("unroll") for (int i = 0; i < 8; ++i) *(LAS bf16x8*)(vl + (lane >> 3) * NA_VS + 8 * (lane & 7) + i * 8 * NA_VS) = VR[i]; \
        f32x4 s[4]; \
        _Pragma("unroll") for (int kb = 0; kb < 4; ++kb) { s[kb] = MFMA16(KR[2 * kb], qf[0], ((f32x4){0.f, 0.f, 0.f, 0.f})); s[kb] = MFMA16(KR[2 * kb + 1], qf[1], s[kb]); } \
        asm volatile("" : "+v"(s[0]), "+v"(s[1]), "+v"(s[2]), "+v"(s[3]));     \
        if (chv + 2 < nch) NA_PREFETCH(VR, KR, chv + 2); \
        _Pragma("unroll") for (int kb = 0; kb < 4; ++kb) \
            _Pragma("unroll") for (int i = 0; i < 4; ++i) { float pv; \
                if (local) { const int dcol = dwin + 16 * (kb & 1) + i; const bool ok = (unsigned)dcol < 16u; \
                    const int bi = ok ? ((r0 + 2 * chv + (kb >> 1) - r + 7) * 31 + ebias + 16 * (kb & 1) + i) : 0; \
                    pv = ok ? __expf(s[kb][i] + rpb[bi] - 8.0f) : 0.f; } \
                else pv = __expf(s[kb][i] - 8.0f); \
                s[kb][i] = pv; lsum += pv; } \
        const bf16x8 pb0 = pack8(s[0], s[1]), pb1 = pack8(s[2], s[3]); \
        const int q4 = cq >> 2, p4 = cq & 3; \
        _Pragma("unroll") for (int db = 0; db < 4; ++db) { \
            const LAS bf16_t* base = vl + (4 * g + q4) * NA_VS + 16 * db + 4 * p4; \
            const bf16x8 va0 = cat8(tr16(base), tr16(base + 16 * NA_VS)), va1 = cat8(tr16(base + 32 * NA_VS), tr16(base + 48 * NA_VS)); \
            o[db] = MFMA16(va0, pb0, o[db]); o[db] = MFMA16(va1, pb1, o[db]); } } while (0)
    NA_PREFETCH(vA, kA, 0); NA_PREFETCH(vB, kB, 1);
    for (int ch = 0; ch < nch; ch += 2) { NA_BODY(vA, kA, ch); NA_BODY(vB, kB, ch + 1); }
#undef NA_BODY
#undef NA_CHROW
#undef NA_VSTEP
#undef NA_KSTEP
#undef NA_PREFETCH
    lsum += shx<16>(lsum); lsum += shx<32>(lsum);
    const float il = 1.0f / lsum;
    bf16_t* op = C.O() + Rq * DM + 256 + h * 64 + 4 * g;
#pragma unroll
    for (int db = 0; db < 4; ++db) { u32x2 w; w.x = pk2(o[db][0] * il, o[db][1] * il); w.y = pk2(o[db][2] * il, o[db][3] * il); *(u32x2*)(op + 16 * db) = w; }
}


DI void prep_ret(const Ctx& C, int li, int gw, int ngw, int lane) {
    const int rsub = lane >> 4, h = (lane >> 2) & 3, jb = lane & 3;
    const float lg0 = __log2f(sigm(C.in(I_RETD)[(li * 2 + 0) * 4 + h])), lg1 = __log2f(sigm(C.in(I_RETD)[(li * 2 + 1) * 4 + h]));
    float inv[8];
#pragma unroll
    for (int e = 0; e < 8; ++e) inv[e] = exp2f(-(float)(8 * (jb & 1) + e) * (13.287712379549449f / 16.0f));
    bf16_t* RP = C.RETP(); const bf16_t* P = C.P();
    for (int it = gw; it < NTOK / 4; it += ngw) {
        const size_t R = (size_t)it * 4 + rsub; const int i = (int)(R % LSEQ), il = i & 63;
        const size_t pq = R * DIN + C_RTQ + h * 64 + 8 * jb, pk = R * DIN + C_RTK + h * 64 + 8 * jb;
        const u32x4 q1w = *(const u32x4*)(P + pq), q2w = *(const u32x4*)(P + pq + 32), k1w = *(const u32x4*)(P + pk), k2w = *(const u32x4*)(P + pk + 32);
        float q1[8] = {lo_f(q1w.x), hi_f(q1w.x), lo_f(q1w.y), hi_f(q1w.y), lo_f(q1w.z), hi_f(q1w.z), lo_f(q1w.w), hi_f(q1w.w)};
        float q2[8] = {lo_f(q2w.x), hi_f(q2w.x), lo_f(q2w.y), hi_f(q2w.y), lo_f(q2w.z), hi_f(q2w.z), lo_f(q2w.w), hi_f(q2w.w)};
        float k1[8] = {lo_f(k1w.x), hi_f(k1w.x), lo_f(k1w.y), hi_f(k1w.y), lo_f(k1w.z), hi_f(k1w.z), lo_f(k1w.w), hi_f(k1w.w)};
        float k2[8] = {lo_f(k2w.x), hi_f(k2w.x), lo_f(k2w.y), hi_f(k2w.y), lo_f(k2w.z), hi_f(k2w.z), lo_f(k2w.w), hi_f(k2w.w)};
        if (i >= CTXL) { const int t = i - CTXL; const float pos = (float)((jb < 2) ? (t >> 6) : (t & 63));
#pragma unroll
            for (int e = 0; e < 8; ++e) { const float ang = pos * inv[e], sn = __sinf(ang), cs = __cosf(ang);
                const float a = q1[e] * cs - q2[e] * sn, b2 = q2[e] * cs + q1[e] * sn; q1[e] = a; q2[e] = b2;
                const float c2 = k1[e] * cs - k2[e] * sn, d2 = k2[e] * cs + k1[e] * sn; k1[e] = c2; k2[e] = d2; } }
        const float fil = (float)il;
        const float sq0 = exp2f(fil * lg0), sk0 = 0.125f * exp2f(-fil * lg0), sq1 = exp2f(-fil * lg1), sk1 = 0.125f * exp2f(fil * lg1);
        const size_t o = R * 256 + h * 64 + 8 * jb;
#define PK8(arr, sc) ((u32x4){pk2(arr[0] * sc, arr[1] * sc), pk2(arr[2] * sc, arr[3] * sc), pk2(arr[4] * sc, arr[5] * sc), pk2(arr[6] * sc, arr[7] * sc)})
        *(u32x4*)(RP + 0 * RETP_T + o) = PK8(q1, sq0); *(u32x4*)(RP + 0 * RETP_T + o + 32) = PK8(q2, sq0);
        *(u32x4*)(RP + 1 * RETP_T + o) = PK8(k1, sk0); *(u32x4*)(RP + 1 * RETP_T + o + 32) = PK8(k2, sk0);
        *(u32x4*)(RP + 2 * RETP_T + o) = PK8(q1, sq1); *(u32x4*)(RP + 2 * RETP_T + o + 32) = PK8(q2, sq1);
        *(u32x4*)(RP + 3 * RETP_T + o) = PK8(k1, sk1); *(u32x4*)(RP + 3 * RETP_T + o + 32) = PK8(k2, sk1);
#undef PK8
    }
}
constexpr int RT_TS = 272;
DI void stage_tile64x256(LAS bf16_t* dst, const bf16_t* src, size_t srcld, int tid) {
#pragma unroll
    for (int i = 0; i < 4; ++i) { const int p = tid + 512 * i, row = p >> 5, c16 = p & 31;
        *(LAS bf16x8*)(dst + row * RT_TS + 8 * c16) = ld16(src + (size_t)row * srcld + 8 * c16); }
}
DI size_t st_off(int b, int h, int d, int c) { return ((size_t)(((b * 4 + h) * 2 + d) * NCHK + c)) * 4096; }
DI void ret_pass1(const Ctx& C, LAS unsigned char* lds, int wave, int lane) {
    LAS bf16_t* vt = (LAS bf16_t*)lds; LAS bf16_t* k0t = vt + 64 * RT_TS; LAS bf16_t* k1t = k0t + 64 * RT_TS;
    const int tid = wave * 64 + lane, cq = lane & 15, g = lane >> 4, q4 = cq >> 2, p4 = cq & 3, h = wave & 3, d = wave >> 2;
    const bf16_t* P = C.P(); const bf16_t* RP = C.RETP(); bf16_t* ST = C.RETS();
    for (int u = blockIdx.x; u < NB * NCHK; u += gridDim.x) {
        const int b = u / NCHK, c = u % NCHK; const size_t R0 = (size_t)b * LSEQ + 64 * c;
        __syncthreads();
        stage_tile64x256(vt, P + R0 * DIN + C_RTV, DIN, tid);
        stage_tile64x256(k0t, RP + 1 * RETP_T + R0 * 256, 256, tid);
        stage_tile64x256(k1t, RP + 3 * RETP_T + R0 * 256, 256, tid);
        __syncthreads();
        const LAS bf16_t* kt = d ? k1t : k0t;
        f32x4 S[4][4];
#pragma unroll
        for (int mb = 0; mb < 4; ++mb)
#pragma unroll
            for (int nb = 0; nb < 4; ++nb) S[mb][nb] = (f32x4){0.f, 0.f, 0.f, 0.f};
#pragma unroll
        for (int ks = 0; ks < 2; ++ks) {
            bf16x8 a[4], bv[4];
#pragma unroll
            for (int mb = 0; mb < 4; ++mb) { const LAS bf16_t* p = kt + (32 * ks + 8 * g + q4) * RT_TS + h * 64 + 16 * mb + 4 * p4; a[mb] = cat8(tr16(p), tr16(p + 4 * RT_TS)); }
#pragma unroll
            for (int nb = 0; nb < 4; ++nb) { const LAS bf16_t* p = vt + (32 * ks + 8 * g + q4) * RT_TS + h * 64 + 16 * nb + 4 * p4; bv[nb] = cat8(tr16(p), tr16(p + 4 * RT_TS)); }
#pragma unroll
            for (int mb = 0; mb < 4; ++mb)
#pragma unroll
                for (int nb = 0; nb < 4; ++nb) S[mb][nb] = MFMA16(a[mb], bv[nb], S[mb][nb]);
        }
        bf16_t* sp = ST + st_off(b, h, d, c);
#pragma unroll
        for (int mb = 0; mb < 4; ++mb)
#pragma unroll
            for (int nb = 0; nb < 4; ++nb) { u32x2 w; w.x = pk2(S[mb][nb][0], S[mb][nb][1]); w.y = pk2(S[mb][nb][2], S[mb][nb][3]); *(u32x2*)(sp + (16 * nb + cq) * 64 + 16 * mb + 4 * g) = w; }
    }
}
DI int chunk_at(int d, int s) { return d == 0 ? s : (s < 4 ? 3 - s : NCHK + 3 - s); }
DI void ret_carry(const Ctx& C, int li, int gw, int ngw, int lane) {
    bf16_t* ST = C.RETS();
    for (int it = gw; it < 64 * 16; it += ngw) {
        const int chain = it >> 4, e0 = ((it & 15) * 64 + lane) * 4, d = chain & 1, h = (chain >> 1) & 3;
        const float gm = sigm(C.in(I_RETD)[(li * 2 + d) * 4 + h]), g64 = __powf(gm, 64.0f);
        const float fo = d ? g64 : gm, dc = g64, sc = d ? 1.0f : __powf(gm, 63.0f);
        const char* cb = (const char*)ST + (size_t)chain * NCHK * 8192; const unsigned voff = (unsigned)e0 * 2u;
        f32x4 S = (f32x4){0.f, 0.f, 0.f, 0.f};
#pragma unroll 1
        for (int s0 = 0; s0 < NCHK; s0 += NCHK / 2) {
            u32x2 w[NCHK / 2];
#pragma unroll
            for (int k = 0; k < NCHK / 2; ++k) w[k] = *(const u32x2*)(cb + (size_t)chunk_at(d, s0 + k) * 8192 + voff);
#pragma unroll
            for (int k = 0; k < NCHK / 2; ++k) { const f32x4 raw = (f32x4){lo_f(w[k].x), hi_f(w[k].x), lo_f(w[k].y), hi_f(w[k].y)};
                const f32x4 o = S * fo; u32x2 ow; ow.x = pk2(o[0], o[1]); ow.y = pk2(o[2], o[3]);
                *(u32x2*)((char*)cb + (size_t)chunk_at(d, s0 + k) * 8192 + voff) = ow;
                S = S * dc + raw * sc; }
        }
    }
}
DI void ret_pass2(const Ctx& C, int li, LAS unsigned char* lds, int wave, int lane) {
    LAS bf16_t* vt = (LAS bf16_t*)lds; LAS bf16_t* k0t = vt + 64 * RT_TS; LAS bf16_t* k1t = k0t + 64 * RT_TS;
    const int tid = wave * 64 + lane, cq = lane & 15, g = lane >> 4, q4 = cq >> 2, p4 = cq & 3, h = wave & 3, half = wave >> 2;
    const bf16_t* P = C.P(); const bf16_t* RP = C.RETP(); const bf16_t* ST = C.RETS(); bf16_t* O = C.O();
    for (int u = blockIdx.x; u < NB * NCHK; u += gridDim.x) {
        const int b = u / NCHK, c = u % NCHK; const size_t R0 = (size_t)b * LSEQ + 64 * c;
        if (li == DEPTH - 1 && c < 4) continue;
        __syncthreads();
        stage_tile64x256(vt, P + R0 * DIN + C_RTV, DIN, tid);
        stage_tile64x256(k0t, RP + 1 * RETP_T + R0 * 256, 256, tid);
        stage_tile64x256(k1t, RP + 3 * RETP_T + R0 * 256, 256, tid);
        bf16x8 sf[2][4][2];
#pragma unroll
        for (int d = 0; d < 2; ++d)
#pragma unroll
            for (int db = 0; db < 4; ++db) { const bf16_t* sp = ST + st_off(b, h, d, c) + (16 * db + cq) * 64 + 8 * g; sf[d][db][0] = ld16(sp); sf[d][db][1] = ld16(sp + 32); }
        __syncthreads();
#pragma unroll 1
        for (int ib = 2 * half; ib < 2 * half + 2; ++ib) {
            const size_t Ri = R0 + 16 * ib + cq;
            bf16x8 qb[2][2];
#pragma unroll
            for (int d = 0; d < 2; ++d)
#pragma unroll
                for (int ks = 0; ks < 2; ++ks) qb[d][ks] = ld16(RP + (size_t)(2 * d) * RETP_T + Ri * 256 + h * 64 + 32 * ks + 8 * g);
            u32x2 gq[4];
#pragma unroll
            for (int db = 0; db < 4; ++db) gq[db] = *(const u32x2*)(P + Ri * DIN + C_RTG + h * 64 + 16 * db + 4 * g);
            f32x4 pT[4];
#pragma unroll
            for (int jb = 0; jb < 4; ++jb) { const int kro = (16 * jb + cq) * RT_TS + h * 64 + 8 * g;
                f32x4 a0 = (f32x4){0.f, 0.f, 0.f, 0.f}, a1 = (f32x4){0.f, 0.f, 0.f, 0.f};
#pragma unroll
                for (int ks = 0; ks < 2; ++ks) { a0 = MFMA16(*(const LAS bf16x8*)(k0t + kro + 32 * ks), qb[0][ks], a0);
                                                 a1 = MFMA16(*(const LAS bf16x8*)(k1t + kro + 32 * ks), qb[1][ks], a1); }
#pragma unroll
                for (int e = 0; e < 4; ++e) { const int j = 16 * jb + 4 * g + e, i = 16 * ib + cq; pT[jb][e] = (j <= i ? a0[e] : 0.f) + (j >= i ? a1[e] : 0.f); } }
            const bf16x8 pb0 = pack8(pT[0], pT[1]), pb1 = pack8(pT[2], pT[3]);
            f32x4 o[4];
#pragma unroll
            for (int db = 0; db < 4; ++db) {
                const LAS bf16_t* base = vt + (4 * g + q4) * RT_TS + h * 64 + 16 * db + 4 * p4;
                const bf16x8 va0 = cat8(tr16(base), tr16(base + 16 * RT_TS)), va1 = cat8(tr16(base + 32 * RT_TS), tr16(base + 48 * RT_TS));
                o[db] = MFMA16(va0, pb0, ((f32x4){0.f, 0.f, 0.f, 0.f})); o[db] = MFMA16(va1, pb1, o[db]);
#pragma unroll
                for (int d = 0; d < 2; ++d) { o[db] = MFMA16(sf[d][db][0], qb[d][0], o[db]); o[db] = MFMA16(sf[d][db][1], qb[d][1], o[db]); }
            }
            float ss = 0.f;
#pragma unroll
            for (int db = 0; db < 4; ++db) ss += o[db][0] * o[db][0] + o[db][1] * o[db][1] + o[db][2] * o[db][2] + o[db][3] * o[db][3];
            ss += shx<16>(ss); ss += shx<32>(ss);
            const float rs = __builtin_amdgcn_rsqf(ss * (1.0f / 64.0f) + EPS);
#pragma unroll
            for (int db = 0; db < 4; ++db) { const u32x2 gw2 = gq[db];
                u32x2 w; w.x = pk2(o[db][0] * rs * silu_(lo_f(gw2.x)), o[db][1] * rs * silu_(hi_f(gw2.x))); w.y = pk2(o[db][2] * rs * silu_(lo_f(gw2.y)), o[db][3] * rs * silu_(hi_f(gw2.y)));
                *(u32x2*)(O + Ri * DM + 768 + h * 64 + 16 * db + 4 * g) = w; }
        }
    }
}


template <int CTRL> DI float dpp_mov0(float x) { return __int_as_float(__builtin_amdgcn_update_dpp(0, __float_as_int(x), CTRL, 0xf, 0xf, true)); }
DI float row_prefix(float x) { x += dpp_mov0<0x111>(x); x += dpp_mov0<0x112>(x); x += dpp_mov0<0x114>(x); x += dpp_mov0<0x118>(x); return x; }
DI float row_suffix(float x) { x += dpp_mov0<0x101>(x); x += dpp_mov0<0x102>(x); x += dpp_mov0<0x104>(x); x += dpp_mov0<0x108>(x); return x; }
DI void prep_hg(const Ctx& C, int li, int gw, int ngw, int lane) {
    const bf16_t* P = C.P(); bf16_t* HP = C.HGP(); float* DEC = C.HGDEC();
    const int t = lane & 15, cg = lane >> 4;
    for (int it = gw; it < NSUB * 8; it += ngw) {
        const int sc = it >> 3, ch0 = (it & 7) * 32 + 8 * cg; const size_t R = (size_t)sc * 16 + t;
        const u32x4 qw = *(const u32x4*)(P + R * DIN + C_HGQ + ch0), f0w = *(const u32x4*)(P + R * DIN + C_HGF + ch0), f1w = *(const u32x4*)(P + R * DIN + C_HGF + 256 + ch0);
        const f32x4 lb0 = *(const f32x4*)(C.lb() + li * 256 + ch0), lb1 = *(const f32x4*)(C.lb() + li * 256 + ch0 + 4);
        const float q[8] = {lo_f(qw.x), hi_f(qw.x), lo_f(qw.y), hi_f(qw.y), lo_f(qw.z), hi_f(qw.z), lo_f(qw.w), hi_f(qw.w)};
        const float f0[8] = {lo_f(f0w.x), hi_f(f0w.x), lo_f(f0w.y), hi_f(f0w.y), lo_f(f0w.z), hi_f(f0w.z), lo_f(f0w.w), hi_f(f0w.w)};
        const float f1[8] = {lo_f(f1w.x), hi_f(f1w.x), lo_f(f1w.y), hi_f(f1w.y), lo_f(f1w.z), hi_f(f1w.z), lo_f(f1w.w), hi_f(f1w.w)};
        float qd0[8], kd0[8], qd1[8], kd1[8], d0[8], d1[8];
#pragma unroll
        for (int e = 0; e < 8; ++e) { const float lb = e < 4 ? lb0[e] : lb1[e - 4];
            const float g0 = lb + (1.0f - lb) * sigm(f0[e]), g1 = lb + (1.0f - lb) * sigm(f1[e]), qs = silu_(q[e]);
            const float c0 = row_prefix(__logf(g0)), c1 = row_suffix(__logf(g1));
            qd0[e] = qs * __expf(c0); kd0[e] = (1.0f - g0) * __expf(fminf(-c0, 80.0f)); qd1[e] = qs * __expf(c1); kd1[e] = (1.0f - g1) * __expf(fminf(-c1, 80.0f));
            d0[e] = __expf(c0); d1[e] = __expf(c1); }
        const size_t o = R * 256 + ch0;
#define PK8V(a) ((u32x4){pk2(a[0], a[1]), pk2(a[2], a[3]), pk2(a[4], a[5]), pk2(a[6], a[7])})
        *(u32x4*)(HP + 0 * RETP_T + o) = PK8V(qd0); *(u32x4*)(HP + 1 * RETP_T + o) = PK8V(kd0); *(u32x4*)(HP + 2 * RETP_T + o) = PK8V(qd1); *(u32x4*)(HP + 3 * RETP_T + o) = PK8V(kd1);
#undef PK8V
        if (t == 15) { float* dp = DEC + (size_t)sc * 256 + ch0; *(f32x4*)dp = (f32x4){d0[0], d0[1], d0[2], d0[3]}; *(f32x4*)(dp + 4) = (f32x4){d0[4], d0[5], d0[6], d0[7]}; }
        if (t == 0) { float* dp = DEC + ((size_t)NSUB + sc) * 256 + ch0; *(f32x4*)dp = (f32x4){d1[0], d1[1], d1[2], d1[3]}; *(f32x4*)(dp + 4) = (f32x4){d1[4], d1[5], d1[6], d1[7]}; }
    }
}
DI void hg_state_step(f32x4 (&S)[4][4], const LAS bf16_t* kt, const LAS bf16_t* vt, int n, int h, int cq, int g, int q4, int p4, const float* dec  ) {
    const int r1 = 16 * n + ((8 * g + q4) & 15), r2 = 16 * n + ((8 * g + 4 + q4) & 15);
    bf16x8 a[4], bv[4];
#pragma unroll
    for (int mb = 0; mb < 4; ++mb) { const int co = h * 64 + 16 * mb + 4 * p4; a[mb] = cat8(tr16(kt + r1 * RT_TS + co), tr16(kt + r2 * RT_TS + co)); }
#pragma unroll
    for (int nb = 0; nb < 4; ++nb) { const int co = h * 64 + 16 * nb + 4 * p4; const bf16x8 v = cat8(tr16(vt + r1 * RT_TS + co), tr16(vt + r2 * RT_TS + co)); bv[nb] = (g < 2) ? v : (bf16x8){0, 0, 0, 0, 0, 0, 0, 0}; }
#pragma unroll
    for (int mb = 0; mb < 4; ++mb) { const f32x4 dv4 = *(const f32x4*)(dec + h * 64 + 16 * mb + 4 * g);
#pragma unroll
        for (int nb = 0; nb < 4; ++nb) { S[mb][nb] = MFMA16(a[mb], bv[nb], S[mb][nb]); S[mb][nb] = S[mb][nb] * dv4; } }
}
DI void hg_pass1(const Ctx& C, LAS unsigned char* lds, int wave, int lane) {
    LAS bf16_t* vt = (LAS bf16_t*)lds; LAS bf16_t* k0t = vt + 64 * RT_TS; LAS bf16_t* k1t = k0t + 64 * RT_TS;
    const int tid = wave * 64 + lane, cq = lane & 15, g = lane >> 4, q4 = cq >> 2, p4 = cq & 3, h = wave & 3, d = wave >> 2;
    const bf16_t* P = C.P(); const bf16_t* HP = C.HGP(); bf16_t* ST = C.HGS(); const float* DEC = C.HGDEC() + (size_t)d * NSUB * 256;
    for (int U = (int)blockIdx.x + ((NB * NCHK - (int)blockIdx.x + (int)gridDim.x - 1) / (int)gridDim.x) * (int)gridDim.x; U < 2 * NB * NCHK; U += gridDim.x) {
        const int u = U - NB * NCHK, b = u / NCHK, c = u % NCHK; const size_t R0 = (size_t)b * LSEQ + 64 * c;
        __syncthreads();
        stage_tile64x256(vt, P + R0 * DIN + C_HGI, DIN, tid);
        stage_tile64x256(k0t, HP + 1 * RETP_T + R0 * 256, 256, tid);
        stage_tile64x256(k1t, HP + 3 * RETP_T + R0 * 256, 256, tid);
        __syncthreads();
        const LAS bf16_t* kt = d ? k1t : k0t;
        f32x4 S[4][4];
#pragma unroll
        for (int mb = 0; mb < 4; ++mb)
#pragma unroll
            for (int nb = 0; nb < 4; ++nb) S[mb][nb] = (f32x4){0.f, 0.f, 0.f, 0.f};
#pragma unroll 1
        for (int sidx = 0; sidx < 4; ++sidx) { const int n = d ? 3 - sidx : sidx;
            hg_state_step(S, kt, vt, n, h, cq, g, q4, p4, DEC + (R0 / 16 + n) * 256); }
        if (lane < 16) { const float* dp = DEC + (R0 / 16) * 256 + h * 64 + 4 * lane;
            *(f32x4*)(C.HGDT() + ((size_t)(((b * 4 + h) * 2 + d) * NCHK + c)) * 64 + 4 * lane) = *(const f32x4*)dp * *(const f32x4*)(dp + 256) * *(const f32x4*)(dp + 512) * *(const f32x4*)(dp + 768); }
        bf16_t* sp = ST + st_off(b, h, d, c);
#pragma unroll
        for (int mb = 0; mb < 4; ++mb)
#pragma unroll
            for (int nb = 0; nb < 4; ++nb) { u32x2 w; w.x = pk2(S[mb][nb][0], S[mb][nb][1]); w.y = pk2(S[mb][nb][2], S[mb][nb][3]); *(u32x2*)(sp + (16 * nb + cq) * 64 + 16 * mb + 4 * g) = w; }
    }
}
DI void hg_carry(const Ctx& C, int gw, int ngw, int lane) {
    bf16_t* ST = C.HGS();
    for (int it = gw; it < 64 * 16; it += ngw) {
        const int chain = it >> 4, e0 = ((it & 15) * 64 + lane) * 4, d = chain & 1, dk0 = e0 & 63;
        const char* DTb = (const char*)(C.HGDT() + (size_t)chain * NCHK * 64); const unsigned doff = (unsigned)dk0 * 4u;
        const char* cb = (const char*)ST + (size_t)chain * NCHK * 8192; const unsigned voff = (unsigned)e0 * 2u;
        f32x4 S = (f32x4){0.f, 0.f, 0.f, 0.f};
#pragma unroll 1
        for (int s0 = 0; s0 < NCHK; s0 += NCHK / 4) {
            u32x2 w[NCHK / 4]; f32x4 dt[NCHK / 4];
#pragma unroll
            for (int k = 0; k < NCHK / 4; ++k) { const int c = chunk_at(d, s0 + k); w[k] = *(const u32x2*)(cb + (size_t)c * 8192 + voff); dt[k] = *(const f32x4*)(DTb + (size_t)c * 256 + doff); }
#pragma unroll
            for (int k = 0; k < NCHK / 4; ++k) { const f32x4 raw = (f32x4){lo_f(w[k].x), hi_f(w[k].x), lo_f(w[k].y), hi_f(w[k].y)};
                u32x2 ow; ow.x = pk2(S[0], S[1]); ow.y = pk2(S[2], S[3]);
                *(u32x2*)((char*)cb + (size_t)chunk_at(d, s0 + k) * 8192 + voff) = ow;
                S = S * dt[k] + raw; }
        }
    }
}
DI void hg_pass2(const Ctx& C, int li, LAS unsigned char* lds, int wave, int lane) {
    LAS bf16_t* vt = (LAS bf16_t*)lds; LAS bf16_t* k0t = vt + 64 * RT_TS; LAS bf16_t* k1t = k0t + 64 * RT_TS;
    const int tid = wave * 64 + lane, cq = lane & 15, g = lane >> 4, q4 = cq >> 2, p4 = cq & 3, h = wave & 3, d = wave >> 2;
    const bf16_t* P = C.P(); const bf16_t* HP = C.HGP(); const bf16_t* ST = C.HGS(); const float* DEC = C.HGDEC() + (size_t)d * NSUB * 256;
    const bf16_t* QD = HP + (size_t)(2 * d) * RETP_T; const bf16_t* KD = HP + (size_t)(2 * d + 1) * RETP_T;
    bf16_t* OUT = C.OHGB() + (size_t)d * NTOK * 256;
    for (int U = (int)blockIdx.x + ((NB * NCHK - (int)blockIdx.x + (int)gridDim.x - 1) / (int)gridDim.x) * (int)gridDim.x; U < 2 * NB * NCHK; U += gridDim.x) {
        const int u = U - NB * NCHK, b = u / NCHK, c = u % NCHK; const size_t R0 = (size_t)b * LSEQ + 64 * c;
        if (li == DEPTH - 1 && c < 4) continue;
        __syncthreads();
        stage_tile64x256(vt, P + R0 * DIN + C_HGI, DIN, tid);
        stage_tile64x256(k0t, HP + 1 * RETP_T + R0 * 256, 256, tid);
        stage_tile64x256(k1t, HP + 3 * RETP_T + R0 * 256, 256, tid);
        __syncthreads();
        const LAS bf16_t* kt = d ? k1t : k0t;
        f32x4 S[4][4];
        { const bf16_t* sp = ST + st_off(b, h, d, c);
#pragma unroll
          for (int mb = 0; mb < 4; ++mb)
#pragma unroll
            for (int nb = 0; nb < 4; ++nb) { const u32x2 w = *(const u32x2*)(sp + (16 * nb + cq) * 64 + 16 * mb + 4 * g); S[mb][nb] = (f32x4){lo_f(w.x), hi_f(w.x), lo_f(w.y), hi_f(w.y)}; } }
#pragma unroll 1
        for (int sidx = 0; sidx < 4; ++sidx) { const int n = d ? 3 - sidx : sidx;
            const size_t Rt = R0 + 16 * n + cq;
            f32x4 at = (f32x4){0.f, 0.f, 0.f, 0.f};
#pragma unroll
            for (int ks = 0; ks < 2; ++ks) at = MFMA16(*(const LAS bf16x8*)(kt + (16 * n + cq) * RT_TS + h * 64 + 32 * ks + 8 * g), ld16(QD + Rt * 256 + h * 64 + 32 * ks + 8 * g), at);
#pragma unroll
            for (int e = 0; e < 4; ++e) { const int j = 4 * g + e; at[e] = (d == 0 ? (j <= cq) : (j >= cq)) ? at[e] : 0.f; }
            const bf16x8 pb = pack8(at, ((f32x4){0.f, 0.f, 0.f, 0.f}));
            bf16x8 qc[2];
#pragma unroll
            for (int s2 = 0; s2 < 2; ++s2) { const bf16_t* qp = QD + Rt * 256 + h * 64 + 32 * s2 + 4 * g; qc[s2] = cat8(*(const s16x4*)qp, *(const s16x4*)(qp + 16)); }
            f32x4 o[4];
#pragma unroll
            for (int db = 0; db < 4; ++db) {
                const s16x4 vv = tr16(vt + (16 * n + 4 * g + q4) * RT_TS + h * 64 + 16 * db + 4 * p4);
                o[db] = MFMA16(cat8(vv, vv), pb, ((f32x4){0.f, 0.f, 0.f, 0.f}));
                o[db] = MFMA16(pack8(S[0][db], S[1][db]), qc[0], o[db]); o[db] = MFMA16(pack8(S[2][db], S[3][db]), qc[1], o[db]);
                { u32x2 w; w.x = pk2(o[db][0], o[db][1]); w.y = pk2(o[db][2], o[db][3]); *(u32x2*)(OUT + Rt * 256 + h * 64 + 16 * db + 4 * g) = w; } }
            if (sidx < 3) hg_state_step(S, kt, vt, n, h, cq, g, q4, p4, DEC + (R0 / 16 + n) * 256);
        }
    }
}

DI void phase_mix(const Ctx& C, int li, LAS unsigned char* lds, int gw, int ngw, int wave, int lane) {
    LAS bf16_t* vl = (LAS bf16_t*)(lds + 8192 + wave * (64 * NA_VS * 2));
    LAS float* rpbt = (LAS float*)(lds + 8192 + 8 * (64 * NA_VS * 2));
    for (int i = wave * 64 + lane; i < 4 * 465; i += 512) rpbt[i] = C.in(I_RPB)[(size_t)li * 4 * 465 + i];
    __syncthreads();
    const int G = (int)gridDim.x;
    if ((G & 7) == 0 && G >= 8) {
        const int xb = (int)blockIdx.x & 7, nxw = (G >> 3) * 8, xw = ((int)blockIdx.x >> 3) * 8 + wave;
        for (int b = xb; b < NB; b += 8)
            for (int h = 0; h < 4; ++h) {
                for (int rc = xw; rc < 256; rc += nxw) na_unit(C, li, ((b * 64 + (rc >> 2)) * 4 + h) * 4 + (rc & 3), false, lane, vl, rpbt);
                if (li == 0) for (int cg = xw; cg < 16; cg += nxw) na_unit(C, li, (b * 4 + h) * 16 + cg, true, lane, vl, rpbt);
            }
    } else {
        const int nNA = NB * 64 * 4 * 4, nNAc = (li == 0) ? NB * 4 * 16 : 0;
        for (int it = gw; it < nNA + nNAc; it += ngw) { if (it < nNA) na_unit(C, li, it, false, lane, vl, rpbt); else na_unit(C, li, it - nNA, true, lane, vl, rpbt); }
    }
}
DI void phase_fin(const Ctx& C, int li, int gw, int ngw, int lane) {
    const int c0 = 4 * lane;
    const f32x4 hw = *(const f32x4*)(C.in(I_HGNW) + li * 64 + (c0 & 63));
    const bf16_t* OH = C.OHGB();
    for (int R0 = gw; R0 < NTOK; R0 += 4 * ngw) {
        u32x2 w0q[4], w1q[4], gq[4];
#pragma unroll
        for (int q = 0; q < 4; ++q) { const int Ri = R0 + q * ngw; if (Ri < NTOK) { const size_t R = (size_t)Ri;
            w0q[q] = *(const u32x2*)(OH + R * 256 + c0); w1q[q] = *(const u32x2*)(OH + ((size_t)NTOK + R) * 256 + c0); gq[q] = *(const u32x2*)(C.P() + R * DIN + C_HGG + c0); } }
#pragma unroll
        for (int q = 0; q < 4; ++q) { const int Ri = R0 + q * ngw; if (Ri >= NTOK) continue; const size_t R = (size_t)Ri;
            if (li == DEPTH - 1 && (Ri % LSEQ) < CTXL) continue;
            const u32x2 w0 = w0q[q], w1 = w1q[q], gw2 = gq[q];
            const f32x4 a = (f32x4){lo_f(w0.x) + lo_f(w1.x), hi_f(w0.x) + hi_f(w1.x), lo_f(w0.y) + lo_f(w1.y), hi_f(w0.y) + hi_f(w1.y)};
            float ss = a[0] * a[0] + a[1] * a[1] + a[2] * a[2] + a[3] * a[3];
            ss += shx<1>(ss); ss += shx<2>(ss); ss += shx<4>(ss); ss += shx<8>(ss);
            const float rs = __builtin_amdgcn_rsqf(ss * (1.0f / 64.0f) + EPS);
            u32x2 oo; oo.x = pk2(a[0] * rs * hw[0] * silu_(lo_f(gw2.x)), a[1] * rs * hw[1] * silu_(hi_f(gw2.x))); oo.y = pk2(a[2] * rs * hw[2] * silu_(lo_f(gw2.y)), a[3] * rs * hw[3] * silu_(hi_f(gw2.y)));
            *(u32x2*)(C.O() + R * DM + 512 + c0) = oo; }
    }
}

struct Args { const float* in[N_IN]; float* out; unsigned char* ws; int ph_lo, ph_hi, bar_region, pad; };
constexpr int NPL = 13, PH_TOTAL = 2 + DEPTH * NPL;

__global__ void __launch_bounds__(512, 2) fwd(Args args) {
    extern __shared__ __attribute__((aligned(16))) unsigned char lds_raw[];
    LAS unsigned char* lds = (LAS unsigned char*)lds_raw;
    const int G = gridDim.x, ngw = G * 8;
    const int wave_id = __builtin_amdgcn_readfirstlane((int)threadIdx.x >> 6);
#define PHASE_IDS int wv_ = wave_id; asm volatile("" : "+s"(wv_)); int ln_ = lane_id(); asm volatile("" : "+v"(ln_)); const int lane = ln_, wave = wv_, gw = blockIdx.x * 8 + wave; (void)lane; (void)gw;
    { int t0 = wave_id * 64 + lane_id(); asm volatile("" : "+v"(t0)); for (int u = t0; u < (LDS_BYTES - LDSCTL_OFF) / 4; u += 512) ((LAS unsigned*)(lds + LDSCTL_OFF))[u] = 0u; }
    __syncthreads();
    int lo, hi; XcdBarrier bar;
    { const Ctx C0{kargs()}; lo = *(const __attribute__((address_space(4))) int*)(C0.ka + 8 * N_IN + 16); hi = *(const __attribute__((address_space(4))) int*)(C0.ka + 8 * N_IN + 20);
      bar.bar = (unsigned*)(C0.ws() + WS_CTL) + 4096 + *(const __attribute__((address_space(4))) int*)(C0.ka + 8 * N_IN + 24) * XCD_BAR_WORDS; bar.x = 0; bar.st = nullptr; bar.wave = wave_id;
      if (hi - lo > 1) bar = xcd_barrier_post(bar.bar, (volatile LAS unsigned*)(lds + MISC_OFF + 32), wave_id); }
#define IN(k) (lo <= (k) && (k) < hi)
#ifndef PH_MASK
#define PH_MASK 0xFFFF
#endif
#define PH_EN(k) (((PH_MASK) >> (k)) & 1)
#define SEAM(k) do { if ((k) + 1 < hi) xcd_barrier(bar); } while (0)
#ifndef PROBE_DUP
#define PROBE_DUP 0
#endif
#define REPS(k) for (int rep_ = 0; rep_ < ((((PROBE_DUP) >> (k)) & 1) ? 2 : 1); ++rep_)
#define REP_BAR(k) do { if ((((PROBE_DUP) >> (k)) & 1) && rep_ == 0) xcd_barrier(bar); } while (0)

#ifndef NO_PRO
    if (IN(0)) { const Ctx C{kargs()}; PHASE_IDS phase_prologue(C, lds, gw, ngw, wave, lane);
#ifdef PROBE_PRO
        xcd_barrier(bar); phase_prologue(C, lds, gw, ngw, wave, lane);
#endif
        SEAM(0); }
#endif

    for (int li = 0; li < DEPTH; ++li) {
        const int pb = 1 + li * NPL;
        if (PH_EN(0) && IN(pb + 0)) { REPS(0) {
            const Ctx C{kargs()}; PHASE_IDS
#ifdef PROBE_A1
            if (li == 1) { phase_norm1(C, li, gw, ngw, lane, (float*)C.P()); xcd_barrier(bar); }
#endif
            phase_norm1(C, li, gw, ngw, lane, C.X());
#ifdef PROBE_A0
            if (li == 0) { xcd_barrier(bar); phase_norm1(C, li, gw, ngw, lane, C.X()); }
#endif
            REP_BAR(0); } SEAM(pb + 0);
        }
        if (PH_EN(1) && IN(pb + 1)) { REPS(1) {
            const Ctx C{kargs()}; PHASE_IDS
            { SchedWin S{(unsigned)WS_H, (unsigned)(WS_WIN + (size_t)li * DIN * DM * 2), G, (int)blockIdx.x, C_GATE / 256, (unsigned)(DM * 2)};
              EpiP E{C.P(), DIN};
              pg8::gemm_phase<EpiP, SchedWin>(lds, wave, lane, (const char*)C.ws(), DM, DM, DM, S, E); }
            { const Ctx C2{kargs()}; int wv2 = wave_id; asm volatile("" : "+s"(wv2)); int ln2 = lane_id(); asm volatile("" : "+v"(ln2));
              SchedWin S{(unsigned)WS_H8, (unsigned)(WS_WIN + (size_t)li * DIN * DM * 2 + WS_WIN8_OFF), G, (int)blockIdx.x, 16, (unsigned)DM};
              EpiSig8 E{(unsigned char*)C2.P()};
              pg8::gemm_phase<EpiSig8, SchedWin, true>(lds, wv2, ln2, (const char*)C2.ws(), DM / 2, DM / 2, DM / 2, S, E); }
            REP_BAR(1); } SEAM(pb + 1);
        }
        if (PH_EN(2) && IN(pb + 2)) { REPS(2) { const Ctx C{kargs()}; PHASE_IDS phase_prep(C, li, gw, ngw, lane); prep_ret(C, li, gw, ngw, lane); prep_hg(C, li, gw, ngw, lane); prep_s5(C, gw, ngw, lane);
#if defined(PROBE_PREP) && PROBE_PREP == 1
            phase_prep(C, li, gw, ngw, lane);
#elif defined(PROBE_PREP) && PROBE_PREP == 2
            prep_ret(C, li, gw, ngw, lane);
#elif defined(PROBE_PREP) && PROBE_PREP == 3
            prep_hg(C, li, gw, ngw, lane);
#elif defined(PROBE_PREP) && PROBE_PREP == 4
            prep_s5(C, gw, ngw, lane);
#endif
            REP_BAR(2); } SEAM(pb + 2); }
        if (PH_EN(3) && IN(pb + 3)) { REPS(3) {
            const Ctx C{kargs()}; PHASE_IDS
            ret_pass1(C, lds, wave, lane); __syncthreads();
            hg_pass1(C, lds, wave, lane); __syncthreads();
#ifdef PROBE_P1
            xcd_barrier(bar); ret_pass1(C, lds, wave, lane); __syncthreads(); hg_pass1(C, lds, wave, lane); __syncthreads(); xcd_barrier(bar);
#endif
            phase_mix(C, li, lds, gw, ngw, wave, lane); __syncthreads();
#ifdef PROBE_NA
            xcd_barrier(bar); phase_mix(C, li, lds, gw, ngw, wave, lane); __syncthreads(); xcd_barrier(bar);
#endif
            { const Ctx C{kargs()}; PHASE_IDS SchedS5 S{(unsigned)WS_UG, (unsigned)(WS_S5W1 + (size_t)li * 16 * 65536 * 2), G, (int)blockIdx.x, 65536u * 2u}; EpiS5S E{C.S5S()};
              pg8::gemm_phase<EpiS5S, SchedS5>(lds, wave, lane, (const char*)C.ws(), 256, 512, 256, S, E); }
            REP_BAR(3); } SEAM(pb + 3); }
        if (PH_EN(4) && IN(pb + 4)) { REPS(4) { const Ctx C{kargs()}; PHASE_IDS ret_carry(C, li, gw, ngw, lane); hg_carry(C, gw, ngw, lane); s5_carry(C, li, gw, ngw, lane); convert_experts(C, li, 1280 % ngw, gw, ngw, (LAS float*)(lds + 40960 + wave * 8704), lane);     REP_BAR(4); } SEAM(pb + 4); }
        if (PH_EN(5) && IN(pb + 5)) { REPS(5) { const Ctx C{kargs()}; PHASE_IDS ret_pass2(C, li, lds, wave, lane); __syncthreads(); hg_pass2(C, li, lds, wave, lane); __syncthreads();
            { const Ctx C{kargs()}; PHASE_IDS SchedS5 S{(unsigned)WS_UG, (unsigned)(WS_S5W2 + (size_t)li * 16 * 131072 * 2), G, (int)blockIdx.x, 131072u * 2u}; EpiS5Z E{C.Z()};
              pg8::gemm_phase<EpiS5Z, SchedS5>(lds, wave, lane, (const char*)C.ws(), 512, 512, 512, S, E); }
            REP_BAR(5); } SEAM(pb + 5); }
        if (PH_EN(6) && IN(pb + 6)) { REPS(6) { const Ctx C{kargs()}; PHASE_IDS phase_fin(C, li, gw, ngw, lane);
            { const Ctx C{kargs()}; PHASE_IDS SchedGlu S{(unsigned)WS_Z, (unsigned)(WS_GLUT + (size_t)li * 65536 * 2), G, (int)blockIdx.x, li}; EpiGlu E{C.O(), C.Z()};
              pg8::gemm_phase<EpiGlu, SchedGlu>(lds, wave, lane, (const char*)C.ws(), 256, 256, 256, S, E); }
            REP_BAR(6); } SEAM(pb + 6); }
        if (PH_EN(7) && IN(pb + 7)) { REPS(7) {
            const Ctx C{kargs()}; PHASE_IDS
            SchedMerge S{(unsigned)WS_O, (unsigned)(WS_WBR + (size_t)li * DM * DM * 2), G, (int)blockIdx.x, li};
            EpiMerge E{C.MB(), (const unsigned char*)C.P()};
            pg8::gemm_phase<EpiMerge, SchedMerge, false, 1>(lds, wave, lane, (const char*)C.ws(), DM, DM, DM, S, E);
            REP_BAR(7); } SEAM(pb + 7);
        }
        if (PH_EN(8) && IN(pb + 8)) { REPS(8) {
            const Ctx C{kargs()}; PHASE_IDS
            SchedOut S{(unsigned)WS_MB, (unsigned)(WS_WOUT + (size_t)li * DM * DM * 2), G, (int)blockIdx.x, li};
#ifdef PROBE_D2
            { EpiResid E0{C.X(), C.mod() + li * 9 * 6144, (float*)C.P(), li == 0 ? C.in(I_X) : nullptr, li == 0 ? C.in(I_CTX) : nullptr}; pg8::gemm_phase<EpiResid, SchedOut>(lds, wave, lane, (const char*)C.ws(), DM, DM, DM, S, E0); xcd_barrier(bar); }
#endif
            EpiResid E{C.X(), C.mod() + li * 9 * 6144, C.X(), li == 0 ? C.in(I_X) : nullptr, li == 0 ? C.in(I_CTX) : nullptr};
            pg8::gemm_phase<EpiResid, SchedOut>(lds, wave, lane, (const char*)C.ws(), DM, DM, DM, S, E);
            REP_BAR(8); } SEAM(pb + 8);
        }
        if (PH_EN(9) && IN(pb + 9)) { REPS(9) { const Ctx C{kargs()}; PHASE_IDS phase_norm2(C, li, lds, gw, ngw, wave, lane); REP_BAR(9); } SEAM(pb + 9); }
        if (PH_EN(10) && IN(pb + 10)) { REPS(10) { const Ctx C{kargs()}; PHASE_IDS phase_topk(C, li, lds, wave, lane); REP_BAR(10); } SEAM(pb + 10); }
        if (PH_EN(11) && IN(pb + 11)) { REPS(11) {
            const Ctx C{kargs()}; PHASE_IDS
            SchedE1 S{(unsigned)WS_XE, (unsigned)WS_EXW, G, (int)blockIdx.x, li == 0 ? 17 : 16};
            EpiSwiGLU E{(unsigned char*)C.P()};
            pg8::gemm_phase<EpiSwiGLU, SchedE1, true>(lds, wave, lane, (const char*)C.ws(), DM / 2, DM / 2, DM / 2, S, E);
            REP_BAR(11); } SEAM(pb + 11);
        }
        if (PH_EN(12) && IN(pb + 12)) { REPS(12) {
            const Ctx C{kargs()}; PHASE_IDS
            SchedE2 S{(unsigned)WS_P, (unsigned)WS_W2T, G, (int)blockIdx.x, li == 0 ? 17 : 16};
            EpiExpOut E{C.XE(), C.gate()};
            pg8::gemm_phase<EpiExpOut, SchedE2, true>(lds, wave, lane, (const char*)C.ws(), DF / 2, DF / 2, DF / 2, S, E);
            REP_BAR(12); } SEAM(pb + 12);
        }
    }
    if (IN(PH_TOTAL - 1)) { const Ctx C{kargs()}; PHASE_IDS phase_final(C, gw, ngw, lane);
#ifdef PROBE_FINAL
        xcd_barrier(bar); phase_final(C, gw, ngw, lane);
#endif
    }
#undef IN
#undef SEAM
}

extern "C" void kernel_launch(void* const* d_in, const int* in_sizes, int n_in, void* d_out, int out_size, void* d_ws, size_t ws_size, hipStream_t stream) {
    static int grid = 0;
    if (grid == 0) {
        if (n_in != N_IN || ws_size < WS_END) { fprintf(stderr, "kernel_launch: unexpected n_in %d or ws_size %zu (need %zu)\n", n_in, ws_size, (size_t)WS_END); grid = -1; return; }
        int dev = 0, cus = 0, per_cu = 0;
        if (hipGetDevice(&dev) != hipSuccess || hipDeviceGetAttribute(&cus, hipDeviceAttributeMultiprocessorCount, dev) != hipSuccess) { grid = -1; return; }
        if (hipFuncSetAttribute((const void*)fwd, hipFuncAttributeMaxDynamicSharedMemorySize, LDS_BYTES) != hipSuccess) { fprintf(stderr, "kernel_launch: hipFuncSetAttribute failed\n"); grid = -1; return; }
        if (hipOccupancyMaxActiveBlocksPerMultiprocessor(&per_cu, (const void*)fwd, 512, LDS_BYTES) != hipSuccess || per_cu < 1) fprintf(stderr, "kernel_launch: occupancy query says %d\n", per_cu);
        (void)hipGetLastError();
        grid = cus;
    }
    if (grid < 0) return;
    (void)hipMemsetAsync((char*)d_ws + WS_CTL, 0, CTL_ZERO_BYTES, stream);
    Args a{};
    for (int i = 0; i < N_IN; ++i) a.in[i] = (const float*)d_in[i];
    a.out = (float*)d_out; a.ws = (unsigned char*)d_ws;
#if MK_PER_PHASE
    for (int p = 0; p < PH_TOTAL; ++p) { a.ph_lo = p; a.ph_hi = p + 1; a.bar_region = 0; hipLaunchKernelGGL(fwd, dim3(grid), dim3(512), LDS_BYTES, stream, a); }
#elif defined(PROBE_PH)
    a.ph_lo = 0; a.ph_hi = PROBE_PH + 1; a.bar_region = 0; hipLaunchKernelGGL(fwd, dim3(grid), dim3(512), LDS_BYTES, stream, a);
    a.ph_lo = PROBE_PH; a.ph_hi = PROBE_PH + 1; a.bar_region = 1; hipLaunchKernelGGL(fwd, dim3(grid), dim3(512), LDS_BYTES, stream, a);
    a.ph_lo = PROBE_PH + 1; a.ph_hi = PH_TOTAL; a.bar_region = 2; hipLaunchKernelGGL(fwd, dim3(grid), dim3(512), LDS_BYTES, stream, a);
#elif defined(PROBE_CUT)
    a.ph_lo = 0; a.ph_hi = PROBE_CUT + 1; a.bar_region = 0; hipLaunchKernelGGL(fwd, dim3(grid), dim3(512), LDS_BYTES, stream, a);
    a.ph_lo = PROBE_CUT + 1; a.ph_hi = PH_TOTAL; a.bar_region = 2; hipLaunchKernelGGL(fwd, dim3(grid), dim3(512), LDS_BYTES, stream, a);
#else
    a.ph_lo = 0; a.ph_hi = PH_TOTAL; a.bar_region = 0;
    hipLaunchKernelGGL(fwd, dim3(grid), dim3(512), LDS_BYTES, stream, a);
#endif
}
```

```cpp
#include <hip/hip_runtime.h>
#include <cstdio>
#include <cstdint>

#ifndef MK_PER_PHASE
#define MK_PER_PHASE 0
#endif

#define LAS __attribute__((address_space(3)))
#define DI __device__ __forceinline__
typedef unsigned short bf16_t;
typedef short bf16x8 __attribute__((ext_vector_type(8)));
typedef float f32x4 __attribute__((ext_vector_type(4)));
typedef float f32x2 __attribute__((ext_vector_type(2)));
typedef unsigned u32x4 __attribute__((ext_vector_type(4)));
typedef unsigned u32x2 __attribute__((ext_vector_type(2)));

constexpr int DM = 1024, NB = 8, SEQ = 4096, CTXL = 256, LSEQ = SEQ + CTXL, NTOK = NB * LSEQ, DIN = 7424, NE = 16, DF = 2816, DEPTH = 2;
constexpr int CAP_L = 512, CAP_C = 32, EROWS = NB * CAP_L + NB * CAP_C;
constexpr float EPS = 1e-6f;
constexpr int C_S5U = 0, C_NAQ = 256, C_NAK = 512, C_NAV = 768, C_HGQ = 1024, C_HGF = 1280, C_HGI = 1792, C_HGG = 2048, C_RTQ = 2304, C_RTK = 2560, C_RTV = 2816, C_RTG = 3072, C_GATE = 3328;
enum { I_X = 0, I_C, I_CTX, I_CCTX, I_ADAW, I_ADAB, I_NMIX, I_NFFN, I_WIN, I_LRE, I_LIM, I_LSTEP, I_BRE, I_BIM, I_CRE, I_CIM, I_S5D, I_GLU, I_NAQN, I_NAKN, I_RPB, I_HGLB, I_HGNW, I_RETD, I_WBR, I_WOUT, I_RW, I_EWG, I_EWU, I_EWD, N_IN };

constexpr size_t MiB = 1u << 20;
constexpr size_t WS_CTL = 0, CTL_ZERO_BYTES = 1 * MiB;
constexpr size_t WS_MOD = 1 * MiB;
constexpr size_t WS_LB = 1 * MiB + 512 * 1024;
constexpr size_t WS_AFF = 2 * MiB;
constexpr size_t WS_SEL = 5 * MiB;
constexpr size_t WS_GATE = 8 * MiB;
constexpr size_t WS_WBR = 10 * MiB;
constexpr size_t WS_WOUT = 14 * MiB;
constexpr size_t WS_WIN = 18 * MiB;
constexpr size_t WS_X = 48 * MiB;
constexpr size_t WS_H = 184 * MiB;
constexpr size_t WS_O = 252 * MiB;
constexpr size_t WS_MB = 320 * MiB;
constexpr size_t WS_P = 388 * MiB;
constexpr size_t WS_XE = 881 * MiB;
constexpr size_t WS_EXW = 1017 * MiB;
constexpr size_t WS_W2T = WS_EXW + (size_t)NE * 5632 * 1024;
constexpr size_t WS_QKN = 1281 * MiB;
constexpr size_t WS_RETS = 1315 * MiB;
constexpr size_t WS_HGS = 1349 * MiB;
constexpr size_t WS_HGDEC = 1383 * MiB;
constexpr size_t WS_S5W1 = 1388 * MiB;
constexpr size_t WS_S5W2 = 1392 * MiB;
constexpr size_t WS_GLUT = 1400 * MiB;
constexpr size_t WS_HGDT = 1401 * MiB;
constexpr size_t WS_END = 1403 * MiB;
constexpr int S5CH = NTOK / 16, S5ROWS = 2304;
constexpr size_t WS_UG = WS_XE;
constexpr size_t WS_S5S = WS_XE + 36 * MiB;
constexpr size_t WS_OHG = WS_XE + 72 * MiB;
constexpr size_t WS_Z = WS_QKN;
constexpr size_t WS_HGP = WS_MB;
constexpr int NSUB = NTOK / 16;
constexpr size_t WS_H8 = WS_O;
constexpr size_t WS_WIN8_OFF = (size_t)C_GATE * DM * 2;
constexpr size_t WS_RETP = WS_H;
constexpr size_t RETP_T = (size_t)NTOK * 256;
constexpr int NCHK = LSEQ / 64;
static_assert(WS_W2T + (size_t)NE * 1024 * DF * 2 <= WS_QKN, "ws map");
static_assert(WS_P + (size_t)NTOK * DIN * 2 <= WS_XE && WS_XE + (size_t)NE * EROWS * 1024 * 2 <= WS_EXW, "ws map");

constexpr int RING_BYTES = 131072, LDSCTL_OFF = RING_BYTES, MISC_OFF = LDSCTL_OFF + 320, LDS_BYTES = 147456;

DI float bf2f(unsigned short h) { return __uint_as_float(((unsigned)h) << 16); }
DI float lo_f(unsigned w) { return __uint_as_float(w << 16); }
DI float hi_f(unsigned w) { return __uint_as_float(w & 0xffff0000u); }
DI unsigned f2bf(float f) { unsigned u = __float_as_uint(f); return (u + 0x7fffu + ((u >> 16) & 1u)) >> 16; }
DI unsigned pk2(float lo, float hi) { return f2bf(lo) | (f2bf(hi) << 16); }
DI unsigned pk4_fp8(float a, float b, float c, float d) {
    a = __builtin_amdgcn_fmed3f(a, -448.f, 448.f); b = __builtin_amdgcn_fmed3f(b, -448.f, 448.f); c = __builtin_amdgcn_fmed3f(c, -448.f, 448.f); d = __builtin_amdgcn_fmed3f(d, -448.f, 448.f);
    int p = 0; p = __builtin_amdgcn_cvt_pk_fp8_f32(a, b, p, false); p = __builtin_amdgcn_cvt_pk_fp8_f32(c, d, p, true); return (unsigned)p; }
DI int lane_id() { int l; asm volatile("v_mbcnt_lo_u32_b32 %0, -1, 0\n\tv_mbcnt_hi_u32_b32 %0, -1, %0" : "=v"(l)); return l; }
template <int M> DI float shx(float v) {
    if constexpr (M < 32) return __int_as_float(__builtin_amdgcn_ds_swizzle(__float_as_int(v), 0x1f | (M << 10)));
    else return __int_as_float(__builtin_amdgcn_ds_bpermute((lane_id() ^ 32) << 2, __float_as_int(v)));
}
DI float wave_sum(float v) { v += shx<1>(v); v += shx<2>(v); v += shx<4>(v); v += shx<8>(v); v += shx<16>(v); v += shx<32>(v); return v; }
DI float sigm(float x) { return __builtin_amdgcn_rcpf(1.0f + __expf(-x)); }
DI float silu_(float x) { return x * sigm(x); }
DI f32x4 exp2n4(f32x4 t) { return (f32x4){__builtin_amdgcn_exp2f(t[0]), __builtin_amdgcn_exp2f(t[1]), __builtin_amdgcn_exp2f(t[2]), __builtin_amdgcn_exp2f(t[3])}; }
DI f32x4 rcp4(f32x4 d) { return (f32x4){__builtin_amdgcn_rcpf(d[0]), __builtin_amdgcn_rcpf(d[1]), __builtin_amdgcn_rcpf(d[2]), __builtin_amdgcn_rcpf(d[3])}; }
DI f32x4 sigm4(f32x4 x) { return rcp4(exp2n4(x * -1.4426950408889634f) + 1.0f); }
DI unsigned pack_u8x4(f32x4 s) { const f32x4 t = s * 255.0f + 8388608.0f;
    const unsigned ab = __builtin_amdgcn_perm(__float_as_uint(t[1]), __float_as_uint(t[0]), 0x0c0c0400u), cd = __builtin_amdgcn_perm(__float_as_uint(t[3]), __float_as_uint(t[2]), 0x04000c0cu); return ab | cd; }
DI float gelu_tanh(float x) { const float u = 1.5957691216057308f * (x + 0.044715f * x * x * x); return x * __builtin_amdgcn_rcpf(1.0f + __expf(-u)); }
#define LDS_WAIT() asm volatile("s_waitcnt lgkmcnt(0)" ::: "memory")
#define VM_WAIT() asm volatile("s_waitcnt vmcnt(0)" ::: "memory")

#define XB_TMO      128
#define XB_XCNT(j)  (256  + 64 * (j))
#define XB_XSUB(j)  (1280 + 64 * (j))
#define XB_XGEN(j)  (2304 + 64 * (j))
#define XB_TOP      3328
#define XB_TOPGEN   3392
#define XCD_BAR_WORDS 3456
#define XB_SPIN_CAP (1u << 22)

__device__ __forceinline__ unsigned xb_ld(unsigned* p)              { return __hip_atomic_load(p, __ATOMIC_RELAXED, __HIP_MEMORY_SCOPE_AGENT); }
__device__ __forceinline__ unsigned xb_add(unsigned* p, unsigned v) { return __hip_atomic_fetch_add(p, v, __ATOMIC_RELAXED, __HIP_MEMORY_SCOPE_AGENT); }
__device__ __forceinline__ unsigned xb_xcc_id() { return (unsigned)__builtin_amdgcn_s_getreg((3 << 11) | 20) & 0xFu; }
#define XB_SPIN(cond, bar) do { unsigned _sp = 0; while (cond) { __builtin_amdgcn_s_sleep(1); \
    if ((++_sp & 255u) == 0u) { if (xb_ld(&(bar)[XB_TMO])) break; if (_sp > XB_SPIN_CAP) { atomicAdd(&(bar)[XB_TMO], 1u); break; } } } } while (0)

struct XcdBarrier { unsigned* bar; unsigned x; volatile LAS unsigned* st; int wave; };

__device__ __forceinline__ XcdBarrier xcd_barrier_post(unsigned* bar, volatile LAS unsigned* st, int wave) {
    XcdBarrier b; b.bar = bar; b.x = xb_xcc_id(); b.st = st; b.wave = wave;
    if (wave == 0 && lane_id() == 0) (void)xb_add(&bar[XB_XCNT(b.x)], 1u);
    return b;
}
__device__ __forceinline__ void xcd_barrier_complete(unsigned* bar, unsigned x, unsigned& nloc, unsigned& nx) {
    const unsigned G = gridDim.x * gridDim.y * gridDim.z;
    unsigned sum, cnt, mine, sp = 0u;
    for (;;) {
        sum = 0u; cnt = 0u; mine = 0u;
#pragma unroll
        for (unsigned j = 0; j < 16; ++j) { const unsigned c = xb_ld(&bar[XB_XCNT(j)]); sum += c; cnt += (c > 0u) ? 1u : 0u; mine = (j == x) ? c : mine; }
        if (sum == G) break;
        __builtin_amdgcn_s_sleep(1);
        if ((++sp & 255u) == 0u) { if (xb_ld(&bar[XB_TMO])) break; if (sp > XB_SPIN_CAP) { atomicAdd(&bar[XB_TMO], 1u); break; } }
    }
    nloc = mine > 0u ? mine : 1u; nx = cnt > 0u ? cnt : 1u;
}
__device__ __forceinline__ void xcd_barrier(const XcdBarrier& b) {
    asm volatile("s_waitcnt vmcnt(0)" ::: "memory");
    __syncthreads();
    if (b.wave == 0 && lane_id() == 0) {
        unsigned* bar = b.bar;
        __builtin_amdgcn_s_waitcnt(0);
        unsigned nloc = b.st[0], nx = b.st[1];
        unsigned bx = b.x; asm volatile("" : "+s"(bx));
        if (nloc == 0u) { xcd_barrier_complete(bar, bx, nloc, nx); b.st[0] = nloc; b.st[1] = nx; }
        const unsigned old = xb_add(&bar[XB_XSUB(bx)], 1u);
        const unsigned gen = old / nloc;
        if (old + 1u == (gen + 1u) * nloc) {
            __builtin_amdgcn_fence(__ATOMIC_RELEASE, "agent");
            asm volatile("s_waitcnt vmcnt(0)" ::: "memory");
            const unsigned og = xb_add(&bar[XB_TOP], 1u);
            const unsigned tg = og / nx;
            if (og + 1u == (tg + 1u) * nx) xb_add(&bar[XB_TOPGEN], 1u);
            else XB_SPIN(xb_ld(&bar[XB_TOPGEN]) == tg, bar);
            __builtin_amdgcn_fence(__ATOMIC_ACQUIRE, "agent");
            xb_add(&bar[XB_XGEN(bx)], 1u);
            asm volatile("s_waitcnt vmcnt(0)" ::: "memory");
        } else {
            XB_SPIN(xb_ld(&bar[XB_XGEN(bx)]) == gen, bar);
            __builtin_amdgcn_fence(__ATOMIC_ACQUIRE, "agent");
            asm volatile("s_waitcnt vmcnt(0)" ::: "memory");
        }
    }
    __syncthreads();
}

namespace pg8 {
constexpr int BM = 256, BK = 64, HALF = 128, HTB = HALF * BK * 2, STAGE_BYTES = 8 * HTB;
__host__ __device__ __forceinline__ int lds_byte(int r, int c) { const int st = (r >> 4) * 2 + (c >> 5), rr = r & 15, cc = c & 31, ob = rr * 64 + cc * 2; return st * 1024 + (ob ^ (((ob >> 9) & 1) << 5)); }
__host__ __device__ __forceinline__ void stage_rc(int b, int& R, int& C) { const int st = b / 1024, sb = b % 1024, swz = sb ^ (((sb >> 9) & 1) << 5); R = (st >> 1) * 16 + swz / 64; C = (st & 1) * 32 + (swz % 64) / 2; }
__host__ __device__ __forceinline__ int perm32(int rho) { const int n = rho >> 4, i = rho & 15; return 8 * (i >> 2) + 4 * n + (i & 3); }

struct Unit { unsigned a, b; int pm, pn, e, br;
    __device__ __forceinline__ void uniform() { a = __builtin_amdgcn_readfirstlane(a); b = __builtin_amdgcn_readfirstlane(b); pm = __builtin_amdgcn_readfirstlane(pm); pn = __builtin_amdgcn_readfirstlane(pn); e = __builtin_amdgcn_readfirstlane(e); br = __builtin_amdgcn_readfirstlane(br); } };

__device__ __forceinline__ unsigned cvt_pk_bf16(float lo, float hi) { unsigned r; asm volatile("v_cvt_pk_bf16_f32 %0, %1, %2" : "=v"(r) : "v"(lo), "v"(hi)); return r; }

typedef int i32x8 __attribute__((ext_vector_type(8)));
typedef int i32x4 __attribute__((ext_vector_type(4)));
template <class Epi, class Sched, bool FP8 = false, int MODE = 0>
__device__ __forceinline__ void gemm_phase(LAS unsigned char* lds, const int wid, const int lane, const char* base, const int K, const int lda, const int ldb, const Sched& S, const Epi& E) {
    const int tid = wid * 64 + lane, wr = wid >> 2, wc = wid & 3, fr = lane & 15, fq = lane >> 4;
    int nt = K / BK; asm volatile("" : "+s"(nt));
    unsigned voffA, voffB;
    { int R, C; stage_rc(tid * 16, R, C); const int Rb = Epi::PERM ? ((R & ~31) + perm32(R & 31)) : R; voffA = (unsigned)(R * lda + C) * 2u; voffB = (unsigned)(Rb * ldb + C) * 2u; }
    unsigned qstepA = (unsigned)(64 * lda * 2), qstepB = (unsigned)(64 * ldb * 2); asm volatile("" : "+s"(qstepA), "+s"(qstepB));
    unsigned kstep = (unsigned)(BK * 2), hstepA = (unsigned)(HALF * lda * 2), hstepB = (unsigned)(HALF * ldb * 2);
    asm volatile("" : "+s"(kstep), "+s"(hstepA), "+s"(hstepB));
    const unsigned ldsw = (unsigned)wid * 1024u;
    const int aoff = lds_byte(wr * 64 + fr, fq * 8), boff = lds_byte(wc * 32 + fr, fq * 8);
#define PG8_SA(b, h) (((b) * 2 + (h)) * HTB)
#define PG8_SB(b, h) ((4 + (b) * 2 + (h)) * HTB)
#define qoffA qstepA
#define qoffB qstepB
#define PG8_STAGE(bufoff, gbase, voff) do { _Pragma("unroll") for (int _i = 0; _i < 2; ++_i) \
        { unsigned sb_ = (gbase) + _i * q##voff; asm volatile("" : "+s"(sb_));     \
          __builtin_amdgcn_global_load_lds((const unsigned*)(base + (size_t)(unsigned)(sb_ + v##voff)), (LAS unsigned*)(lds + (bufoff) + ldsw + _i * 8192), 16, 0, 0); } } while (0)
#define PG8_LDA(dst, b, h) do { if constexpr (FP8) { _Pragma("unroll") for (int m = 0; m < 4; ++m) { const i32x4 lo_ = *(const LAS i32x4*)(lds + PG8_SA(b, h) + aoff + m * 2048), hi_ = *(const LAS i32x4*)(lds + PG8_SA(b, h) + aoff + 1024 + m * 2048); dst##8[m] = __builtin_shufflevector(lo_, hi_, 0, 1, 2, 3, 4, 5, 6, 7); } } \
        else { _Pragma("unroll") for (int m = 0; m < 4; ++m) _Pragma("unroll") for (int k = 0; k < 2; ++k) dst[m][k] = *(const LAS bf16x8*)(lds + PG8_SA(b, h) + aoff + m * 2048 + k * 1024); } } while (0)
#define PG8_LDB(dst, b, h) do { if constexpr (FP8) { _Pragma("unroll") for (int n = 0; n < 2; ++n) { const i32x4 lo_ = *(const LAS i32x4*)(lds + PG8_SB(b, h) + boff + n * 2048), hi_ = *(const LAS i32x4*)(lds + PG8_SB(b, h) + boff + 1024 + n * 2048); dst##8[n] = __builtin_shufflevector(lo_, hi_, 0, 1, 2, 3, 4, 5, 6, 7); } } \
        else { _Pragma("unroll") for (int n = 0; n < 2; ++n) _Pragma("unroll") for (int k = 0; k < 2; ++k) dst[n][k] = *(const LAS bf16x8*)(lds + PG8_SB(b, h) + boff + n * 2048 + k * 1024); } } while (0)
#define PG8_MMA_(ai, bj, At, Bt, Z) do { if constexpr (MODE == 1 && (bj) == 1) break; __builtin_amdgcn_s_setprio(1); if constexpr (FP8) { _Pragma("unroll") for (int m = 0; m < 4; ++m) _Pragma("unroll") for (int n = 0; n < 2; ++n) \
        acc[ai][bj][m][n] = __builtin_amdgcn_mfma_scale_f32_16x16x128_f8f6f4(Bt##8[n], At##8[m], (Z) ? (f32x4){0.f, 0.f, 0.f, 0.f} : acc[ai][bj][m][n], 0, 0, 0, Epi::SCALE_W, 0, Epi::SCALE_X); } \
        else { _Pragma("unroll") for (int m = 0; m < 4; ++m) _Pragma("unroll") for (int n = 0; n < 2; ++n) _Pragma("unroll") for (int k = 0; k < 2; ++k) \
        acc[ai][bj][m][n] = __builtin_amdgcn_mfma_f32_16x16x32_bf16(Bt[n][k], At[m][k], ((Z) && k == 0) ? (f32x4){0.f, 0.f, 0.f, 0.f} : acc[ai][bj][m][n], 0, 0, 0); } __builtin_amdgcn_s_setprio(0); } while (0)
#define PG8_MMA(ai, bj, At, Bt) PG8_MMA_(ai, bj, At, Bt, false)
#define PG8_MMA0(ai, bj, At, Bt) do { if (t == 0) PG8_MMA_(ai, bj, At, Bt, true); else PG8_MMA_(ai, bj, At, Bt, false); } while (0)
#define PG8_WAIT_V(n) asm volatile("s_waitcnt vmcnt(" #n ")" ::: "memory")
#define PG8_WAIT_L(n) asm volatile("s_waitcnt lgkmcnt(" #n ")" ::: "memory")
#define PG8_BAR __builtin_amdgcn_s_barrier()
#define PG8_SCHED __builtin_amdgcn_sched_barrier(0)
    Unit cur, nxt; int ui = 0;
    if (!S.next(0, cur)) return;
    f32x4 acc[2][2][4][2];
    if constexpr (MODE == 1) {
#pragma unroll
        for (int a = 0; a < 2; ++a)
#pragma unroll
            for (int m = 0; m < 4; ++m)
#pragma unroll
                for (int n = 0; n < 2; ++n) acc[a][1][m][n] = (f32x4){0.f, 0.f, 0.f, 0.f};
    }
    bf16x8 At[4][2], B0[2][2], B1[2][2]; i32x8 At8[4], B08[2], B18[2];
    unsigned cA = cur.a, cB = cur.b;
    PG8_STAGE(PG8_SB(0, 0), cB, offB); PG8_STAGE(PG8_SB(0, 1), cB + hstepB, offB); PG8_STAGE(PG8_SA(0, 0), cA, offA); PG8_STAGE(PG8_SA(0, 1), cA + hstepA, offA);
    if (wr == 1) PG8_BAR;
    PG8_WAIT_V(2); PG8_BAR;
    PG8_STAGE(PG8_SB(1, 0), cB + kstep, offB); PG8_STAGE(PG8_SA(1, 0), cA + kstep, offA); PG8_STAGE(PG8_SB(1, 1), cB + hstepB + kstep, offB);
    PG8_WAIT_V(6); PG8_BAR;
    for (;;) {
        const bool has_next = S.next(ui + 1, nxt);
        const unsigned nA = has_next ? nxt.a : cA, nB = has_next ? nxt.b : cB;
#pragma unroll 1
        for (int t = 0; t < nt; t += 2) {
            const bool last = (t == nt - 2);
            const unsigned a1 = cA + (unsigned)(t + 1) * kstep;
            const unsigned a2 = last ? nA : cA + (unsigned)(t + 2) * kstep, b2 = last ? nB : cB + (unsigned)(t + 2) * kstep;
            const unsigned a3 = a2 + kstep, b3 = b2 + kstep;
            PG8_LDB(B0, 0, 0); PG8_LDB(B1, 0, 1); PG8_SCHED; PG8_LDA(At, 0, 0); PG8_STAGE(PG8_SA(1, 1), a1 + hstepA, offA);
            PG8_WAIT_V(8); PG8_WAIT_L(0); PG8_BAR; PG8_MMA0(0, 0, At, B0); PG8_MMA0(0, 1, At, B1); PG8_BAR; PG8_SCHED;
            PG8_LDA(At, 0, 1); PG8_STAGE(PG8_SB(0, 0), b2, offB); PG8_STAGE(PG8_SB(0, 1), b2 + hstepB, offB); PG8_STAGE(PG8_SA(0, 0), a2, offA);
            PG8_WAIT_V(8); PG8_WAIT_L(0); PG8_BAR; PG8_MMA0(1, 0, At, B0); PG8_MMA0(1, 1, At, B1); PG8_BAR; PG8_SCHED;
            PG8_LDB(B0, 1, 0); PG8_LDB(B1, 1, 1); PG8_SCHED; PG8_LDA(At, 1, 0); PG8_STAGE(PG8_SA(0, 1), a2 + hstepA, offA);
            PG8_WAIT_V(8); PG8_WAIT_L(0); PG8_BAR; PG8_MMA(0, 0, At, B0); PG8_MMA(0, 1, At, B1); PG8_BAR; PG8_SCHED;
            PG8_LDA(At, 1, 1); PG8_STAGE(PG8_SB(1, 0), b3, offB); PG8_STAGE(PG8_SB(1, 1), b3 + hstepB, offB); PG8_STAGE(PG8_SA(1, 0), a3, offA);
            PG8_WAIT_V(8); PG8_WAIT_L(0); PG8_BAR; PG8_MMA(1, 0, At, B0); PG8_MMA(1, 1, At, B1); PG8_BAR; PG8_SCHED;
            if constexpr (MODE == 1) { if (((t + 2) & 3) == 0 && !last) { const int l2_ = lane_id(); E.mid(acc, cur, (t + 2) / 4 - 1, wr, wc, l2_ & 15, l2_ >> 4); } }
        }
        if (wr == 0) PG8_BAR;
        { const int l2_ = lane_id();
          E(acc, cur, wr, wc, l2_ & 15, l2_ >> 4); }
        if (!has_next) break;
        if constexpr (MODE == 1) {
#pragma unroll
            for (int a = 0; a < 2; ++a)
#pragma unroll
                for (int m = 0; m < 4; ++m)
#pragma unroll
                    for (int n = 0; n < 2; ++n) acc[a][1][m][n] = (f32x4){0.f, 0.f, 0.f, 0.f};
        }
        cur = nxt; cA = nA; cB = nB; ++ui;
        if (wr == 1) PG8_BAR;
    }
    PG8_WAIT_V(0);
    PG8_BAR;
#undef PG8_SA
#undef PG8_SB
#undef PG8_STAGE
#undef qoffA
#undef qoffB
#undef PG8_LDA
#undef PG8_LDB
#undef PG8_MMA
#undef PG8_MMA_
#undef PG8_MMA0
#undef PG8_WAIT_V
#undef PG8_WAIT_L
#undef PG8_BAR
#undef PG8_SCHED
}
}
using pg8::Unit;

typedef const __attribute__((address_space(4))) unsigned char* KPtr;
DI KPtr kargs() { KPtr p = (KPtr)__builtin_amdgcn_kernarg_segment_ptr(); asm volatile("" : "+s"(p)); return p; }
struct Ctx {
    KPtr ka;
    DI const float* in(int i) const { return *(const float* const __attribute__((address_space(4)))*)(ka + 8 * i); }
    DI float* out() const { return *(float* const __attribute__((address_space(4)))*)(ka + 8 * N_IN); }
    DI unsigned char* ws() const { return *(unsigned char* const __attribute__((address_space(4)))*)(ka + 8 * N_IN + 8); }
    DI float* mod() const { return (float*)(ws() + WS_MOD); }
    DI float* lb() const { return (float*)(ws() + WS_LB); }
    DI float* aff() const { return (float*)(ws() + WS_AFF); }
    DI float* gate() const { return (float*)(ws() + WS_GATE); }
    DI float* X() const { return (float*)(ws() + WS_X); }
    DI int* sel() const { return (int*)(ws() + WS_SEL); }
    DI bf16_t* wbr() const { return (bf16_t*)(ws() + WS_WBR); }
    DI bf16_t* wout() const { return (bf16_t*)(ws() + WS_WOUT); }
    DI bf16_t* win() const { return (bf16_t*)(ws() + WS_WIN); }
    DI bf16_t* H() const { return (bf16_t*)(ws() + WS_H); }
    DI bf16_t* O() const { return (bf16_t*)(ws() + WS_O); }
    DI bf16_t* MB() const { return (bf16_t*)(ws() + WS_MB); }
    DI bf16_t* P() const { return (bf16_t*)(ws() + WS_P); }
    DI bf16_t* XE() const { return (bf16_t*)(ws() + WS_XE); }
    DI unsigned char* W1T() const { return ws() + WS_EXW; }
    DI unsigned char* W2T() const { return ws() + WS_W2T; }
    DI bf16_t* QKN() const { return (bf16_t*)(ws() + WS_QKN); }
    DI float* YS5() const { return (float*)(ws() + WS_XE); }
    DI float* OHG() const { return (float*)(ws() + WS_XE + (size_t)2 * NTOK * 256 * 4); }
    DI float* ORET() const { return (float*)(ws() + WS_MB); }
    DI bf16_t* RETP() const { return (bf16_t*)(ws() + WS_RETP); }
    DI bf16_t* RETS() const { return (bf16_t*)(ws() + WS_RETS); }
    DI bf16_t* HGS() const { return (bf16_t*)(ws() + WS_HGS); }
    DI bf16_t* UG() const { return (bf16_t*)(ws() + WS_UG); }
    DI float* S5S() const { return (float*)(ws() + WS_S5S); }
    DI bf16_t* OHGB() const { return (bf16_t*)(ws() + WS_OHG); }
    DI bf16_t* Z() const { return (bf16_t*)(ws() + WS_Z); }
    DI bf16_t* S5W1() const { return (bf16_t*)(ws() + WS_S5W1); }
    DI bf16_t* S5W2() const { return (bf16_t*)(ws() + WS_S5W2); }
    DI bf16_t* GLUT() const { return (bf16_t*)(ws() + WS_GLUT); }
    DI bf16_t* HGP() const { return (bf16_t*)(ws() + WS_HGP); }
    DI float* HGDEC() const { return (float*)(ws() + WS_HGDEC); }
    DI float* HGDT() const { return (float*)(ws() + WS_HGDT); }
};
DI size_t seqrow(int b, int dir, int s) { return (size_t)b * LSEQ + (dir == 0 ? s : (s < CTXL ? (CTXL - 1 - s) : (LSEQ + CTXL - 1 - s))); }

struct EpiP {
    static constexpr bool PERM = true;
    bf16_t* O; int ldc;
    DI void operator()(const f32x4 (&acc)[2][2][4][2], const Unit& u, int wr, int wc, int fr, int fq) const {
        const int row0 = u.pm * 256 + wr * 64 + fr, col0 = u.pn * 256 + wc * 32 + 8 * fq;
#pragma unroll
        for (int ai = 0; ai < 2; ++ai)
#pragma unroll
            for (int m = 0; m < 4; ++m) { bf16_t* rowp = O + (size_t)(row0 + ai * 128 + m * 16) * ldc + col0;
#pragma unroll
                for (int bj = 0; bj < 2; ++bj) { const f32x4 v0 = acc[ai][bj][m][0], v1 = acc[ai][bj][m][1];
                    u32x4 w; w.x = pg8::cvt_pk_bf16(v0[0], v0[1]); w.y = pg8::cvt_pk_bf16(v0[2], v0[3]); w.z = pg8::cvt_pk_bf16(v1[0], v1[1]); w.w = pg8::cvt_pk_bf16(v1[2], v1[3]);
                    *(u32x4*)(rowp + bj * 128) = w; } }
    }
};
constexpr float FP8_WS = 16.0f, FP8_XS = 16.0f, FP8_AS = 16.0f;
struct EpiSig8 {
    static constexpr bool PERM = true; static constexpr int SCALE_W = 0x7b7b7b7b, SCALE_X = 0x7b7b7b7b;
    unsigned char* Pb;
    DI void operator()(const f32x4 (&acc)[2][2][4][2], const Unit& u, int wr, int wc, int fr, int fq) const {
        const int row0 = u.pm * 256 + wr * 64 + fr, col0 = u.pn * 256 + wc * 32 + 8 * fq;
#pragma unroll
        for (int ai = 0; ai < 2; ++ai)
#pragma unroll
            for (int m = 0; m < 4; ++m) { unsigned char* rowp = Pb + (size_t)(row0 + ai * 128 + m * 16) * (DIN * 2) + 2 * C_GATE + col0;
#pragma unroll
                for (int bj = 0; bj < 2; ++bj) { const f32x4 v0 = acc[ai][bj][m][0], v1 = acc[ai][bj][m][1];
                    u32x2 w; w.x = pack_u8x4(sigm4(v0)); w.y = pack_u8x4(sigm4(v1));
                    *(u32x2*)(rowp + bj * 128) = w; } }
    }
};
struct EpiMerge {
    static constexpr bool PERM = true;
    bf16_t* MB; const unsigned char* Pb;
    DI void mid(f32x4 (&acc)[2][2][4][2], const Unit& u, int br, int wr, int wc, int fr, int fq) const {
        const int row0 = u.pm * 256 + wr * 64 + fr, col0 = u.pn * 128 + wc * 32 + 8 * fq;
        u32x2 gt[2][4];
#pragma unroll
        for (int ai = 0; ai < 2; ++ai)
#pragma unroll
            for (int m = 0; m < 4; ++m) gt[ai][m] = *(const u32x2*)(Pb + (size_t)(row0 + ai * 128 + m * 16) * (DIN * 2) + 2 * C_GATE + br * 1024 + col0);
        const float q = 1.0f / 255.0f;
#pragma unroll
        for (int ai = 0; ai < 2; ++ai)
#pragma unroll
            for (int m = 0; m < 4; ++m) { const u32x2 g = gt[ai][m];
                acc[ai][1][m][0] = acc[ai][1][m][0] + acc[ai][0][m][0] * (f32x4){(float)(g.x & 255u) * q, (float)((g.x >> 8) & 255u) * q, (float)((g.x >> 16) & 255u) * q, (float)(g.x >> 24) * q};
                acc[ai][1][m][1] = acc[ai][1][m][1] + acc[ai][0][m][1] * (f32x4){(float)(g.y & 255u) * q, (float)((g.y >> 8) & 255u) * q, (float)((g.y >> 16) & 255u) * q, (float)(g.y >> 24) * q};
                acc[ai][0][m][0] = (f32x4){0.f, 0.f, 0.f, 0.f}; acc[ai][0][m][1] = (f32x4){0.f, 0.f, 0.f, 0.f}; }
    }
    DI void operator()(const f32x4 (&acc)[2][2][4][2], const Unit& u, int wr, int wc, int fr, int fq) const {
        const int row0 = u.pm * 256 + wr * 64 + fr, col0 = u.pn * 128 + wc * 32 + 8 * fq;
        u32x2 gt[2][4];
#pragma unroll
        for (int ai = 0; ai < 2; ++ai)
#pragma unroll
            for (int m = 0; m < 4; ++m) gt[ai][m] = *(const u32x2*)(Pb + (size_t)(row0 + ai * 128 + m * 16) * (DIN * 2) + 2 * C_GATE + 3 * 1024 + col0);
        const float q = 1.0f / 255.0f;
#pragma unroll
        for (int ai = 0; ai < 2; ++ai)
#pragma unroll
            for (int m = 0; m < 4; ++m) { const u32x2 g = gt[ai][m];
                const f32x4 r0 = acc[ai][1][m][0] + acc[ai][0][m][0] * (f32x4){(float)(g.x & 255u) * q, (float)((g.x >> 8) & 255u) * q, (float)((g.x >> 16) & 255u) * q, (float)(g.x >> 24) * q};
                const f32x4 r1 = acc[ai][1][m][1] + acc[ai][0][m][1] * (f32x4){(float)(g.y & 255u) * q, (float)((g.y >> 8) & 255u) * q, (float)((g.y >> 16) & 255u) * q, (float)(g.y >> 24) * q};
                u32x4 w; w.x = pg8::cvt_pk_bf16(r0[0], r0[1]); w.y = pg8::cvt_pk_bf16(r0[2], r0[3]); w.z = pg8::cvt_pk_bf16(r1[0], r1[1]); w.w = pg8::cvt_pk_bf16(r1[2], r1[3]);
                *(u32x4*)(MB + (size_t)(row0 + ai * 128 + m * 16) * DM + col0) = w; }
    }
};
struct EpiResid {
    static constexpr bool PERM = false;
    float* X; const float* mod; float* Xo; const float* xin; const float* cin;
    DI void operator()(const f32x4 (&acc)[2][2][4][2], const Unit& u, int wr, int wc, int fr, int fq) const {
        const int row0 = u.pm * 256 + wr * 64 + fr, col0 = u.pn * 256 + wc * 32 + 4 * fq;
        const int b = u.pm / 17, tl = u.pm % 17, mr = (tl == 0) ? 8 : b;
        const float* g1 = mod + mr * 6144 + 2 * 1024;
        const float* srcb = xin ? (tl == 0 ? cin + (size_t)b * CTXL * DM : xin + ((size_t)b * SEQ + (tl - 1) * 256) * DM) - (size_t)u.pm * 256 * DM : X;
        f32x4 gv[2][2];
#pragma unroll
        for (int bj = 0; bj < 2; ++bj)
#pragma unroll
            for (int n = 0; n < 2; ++n) gv[bj][n] = *(const f32x4*)(g1 + col0 + bj * 128 + n * 16);
#pragma unroll
        for (int ai = 0; ai < 2; ++ai)
#pragma unroll
            for (int mh = 0; mh < 2; ++mh) {
                f32x4 xv[2][2][2];
#pragma unroll
                for (int m2 = 0; m2 < 2; ++m2)
#pragma unroll
                    for (int bj = 0; bj < 2; ++bj)
#pragma unroll
                        for (int n = 0; n < 2; ++n) xv[m2][bj][n] = *(const f32x4*)(srcb + (size_t)(row0 + ai * 128 + (2 * mh + m2) * 16) * DM + col0 + bj * 128 + n * 16);
#pragma unroll
                for (int m2 = 0; m2 < 2; ++m2)
#pragma unroll
                    for (int bj = 0; bj < 2; ++bj)
#pragma unroll
                        for (int n = 0; n < 2; ++n) *(f32x4*)(Xo + (size_t)(row0 + ai * 128 + (2 * mh + m2) * 16) * DM + col0 + bj * 128 + n * 16) = xv[m2][bj][n] + gv[bj][n] * acc[ai][bj][2 * mh + m2][n];
                asm volatile("" ::: "memory"); }
    }
};
struct EpiSwiGLU {
    static constexpr bool PERM = true; static constexpr int SCALE_W = 0x7b7b7b7b, SCALE_X = 0x7b7b7b7b;
    unsigned char* ACT;
    DI void operator()(const f32x4 (&acc)[2][2][4][2], const Unit& u, int wr, int wc, int fr, int fq) const {
        const int row0 = u.pm * 256 + wr * 64 + fr, col0 = u.pn * 128 + wc * 32 + 8 * fq;
#pragma unroll
        for (int ai = 0; ai < 2; ++ai)
#pragma unroll
            for (int m = 0; m < 4; ++m) { unsigned char* rowp = ACT + ((size_t)u.e * EROWS + row0 + ai * 128 + m * 16) * DF + col0;
                f32x4 q[2];
#pragma unroll
                for (int n = 0; n < 2; ++n) { const f32x4 g = acc[ai][0][m][n], up = acc[ai][1][m][n];
                    q[n] = (g * up) * rcp4(exp2n4(g * -1.4426950408889634f) * (1.0f / FP8_AS) + (1.0f / FP8_AS)); }
                u32x2 w; w.x = pk4_fp8(q[0][0], q[0][1], q[0][2], q[0][3]); w.y = pk4_fp8(q[1][0], q[1][1], q[1][2], q[1][3]);
                *(u32x2*)rowp = w; }
    }
};
struct EpiExpOut {
    static constexpr bool PERM = true; static constexpr int SCALE_W = 0x7b7b7b7b, SCALE_X = 0x7b7b7b7b;
    bf16_t* YB; const float* gate;
    DI void operator()(const f32x4 (&acc)[2][2][4][2], const Unit& u, int wr, int wc, int fr, int fq) const {
        const int row0 = u.pm * 256 + wr * 64 + fr, col0 = u.pn * 256 + wc * 32 + 8 * fq;
#pragma unroll
        for (int ai = 0; ai < 2; ++ai)
#pragma unroll
            for (int m = 0; m < 4; ++m) { const size_t er = (size_t)u.e * EROWS + row0 + ai * 128 + m * 16; const float g = gate[er]; bf16_t* rowp = YB + er * DM + col0;
#pragma unroll
                for (int bj = 0; bj < 2; ++bj) { const f32x4 v0 = acc[ai][bj][m][0] * g, v1 = acc[ai][bj][m][1] * g;
                    u32x4 w; w.x = pg8::cvt_pk_bf16(v0[0], v0[1]); w.y = pg8::cvt_pk_bf16(v0[2], v0[3]); w.z = pg8::cvt_pk_bf16(v1[0], v1[1]); w.w = pg8::cvt_pk_bf16(v1[2], v1[3]);
                    *(u32x4*)(rowp + bj * 128) = w; } }
    }
};

DI int xcd_remap(int L, int nwg) { const int q = nwg / 8, r = nwg % 8, x = L % 8, off = L / 8; return (x < r ? x * (q + 1) : r * (q + 1) + (x - r) * q) + off; }
DI void tile_of(int T, int nM, int nN, int& pm, int& pn) { const int nig = 8 * nN, gid = T / nig, fm = gid * 8, gsz = (nM - fm) < 8 ? (nM - fm) : 8; pm = fm + ((T % nig) % gsz); pn = (T % nig) / gsz; }
struct SchedWin {
    unsigned A, B; int G, c, nN; unsigned rowb;
    DI bool next(int i, Unit& u) const {
        const int nM = NTOK / 256, L = i * G + c; if (L >= nM * nN) return false;
        tile_of(xcd_remap(L, nM * nN), nM, nN, u.pm, u.pn); u.e = 0; u.br = 0;
        u.a = A + (unsigned)u.pm * 256u * rowb; u.b = B + (unsigned)u.pn * 256u * rowb; u.uniform(); return true;
    }
};
DI int pm_of(int li, int pmi) { return li == 0 ? pmi : (pmi / 16) * 17 + 1 + (pmi % 16); }
struct SchedMerge {
    unsigned O, WBR; int G, c, li;
    DI bool next(int i, Unit& u) const {
        const int nM = (li == 0 ? 136 : 128), ntile = nM * 8, L = i * G + c; if (L >= ntile) return false;
        int pmi; tile_of(xcd_remap(L, ntile), nM, 8, pmi, u.pn); u.br = 0; u.pm = pm_of(li, pmi); u.e = 0;
        u.a = O + (unsigned)u.pm * 256u * DM * 2u; u.b = WBR + (unsigned)u.pn * 128u * DM * 2u; u.uniform(); return true;
    }
};
struct SchedOut {
    unsigned MBp, W; int G, c, li;
    DI bool next(int i, Unit& u) const {
        const int nM = (li == 0 ? 136 : 128), ntile = nM * 4, L = i * G + c; if (L >= ntile) return false;
        int pmi; tile_of(xcd_remap(L, ntile), nM, 4, pmi, u.pn); u.br = 0; u.pm = pm_of(li, pmi); u.e = 0;
        u.a = MBp + (unsigned)u.pm * 256u * DM * 2u; u.b = W + (unsigned)u.pn * 256u * DM * 2u; u.uniform(); return true;
    }
};
struct SchedE1 {
    unsigned XE, W; int G, c, pmN;
    DI bool next(int i, Unit& u) const {
        const int per = pmN * 22, L0 = i * G + c; if (L0 >= NE * per) return false;
        const int L = xcd_remap(L0, NE * per); u.e = L / per; tile_of(L % per, pmN, 22, u.pm, u.pn); u.br = 0;
        u.a = XE + ((unsigned)u.e * EROWS + u.pm * 256u) * DM; u.b = W + ((unsigned)u.e * 5632u + u.pn * 256u) * DM; u.uniform(); return true;
    }
};
struct SchedE2 {
    unsigned ACT, W; int G, c, pmN;
    DI bool next(int i, Unit& u) const {
        const int per = pmN * 4, L0 = i * G + c; if (L0 >= NE * per) return false;
        const int L = xcd_remap(L0, NE * per); u.e = L / per; tile_of(L % per, pmN, 4, u.pm, u.pn); u.br = 0;
        u.a = ACT + ((unsigned)u.e * EROWS + u.pm * 256u) * DF; u.b = W + ((unsigned)u.e * 1024u + u.pn * 256u) * DF; u.uniform(); return true;
    }
};


DI void s5_build_w(const Ctx& C, int li, int g, int part4, LAS float* L, int tid) {
    LAS float* pwr = L; LAS float* pwi = pwr + 2176; LAS float* bbr = pwi + 2176; LAS float* bbi = bbr + 2048; LAS float* ccr = bbi + 2048; LAS float* cci = ccr + 2048; LAS float* Kt = cci + 2048;
    __syncthreads();
    if (tid < 128) { const int d = tid >> 6, n = tid & 63, pg = (li * 2 + d) * 16 + g;
        const float lr = C.in(I_LRE)[pg * 64 + n], lim = C.in(I_LIM)[pg * 64 + n], dt = expf(C.in(I_LSTEP)[pg]);
        const float mag = expf(lr * dt); float sn, cs; sincosf(lim * dt, &sn, &cs);
        const float ar = mag * cs, ai = mag * sn, den = lr * lr + lim * lim;
        const float zr = ((ar - 1.0f) * lr + ai * lim) / den, zi = (ai * lr - (ar - 1.0f) * lim) / den;
        float pr = 1.0f, pi = 0.0f;
        for (int t = 0; t <= 16; ++t) { pwr[(d * 17 + t) * 64 + n] = pr; pwi[(d * 17 + t) * 64 + n] = pi; const float nr = pr * ar - pi * ai, ni = pr * ai + pi * ar; pr = nr; pi = ni; }
        for (int p = 0; p < 16; ++p) { const float br = C.in(I_BRE)[((size_t)pg * 64 + n) * 16 + p], bi = C.in(I_BIM)[((size_t)pg * 64 + n) * 16 + p];
            bbr[(d * 64 + n) * 16 + p] = zr * br - zi * bi; bbi[(d * 64 + n) * 16 + p] = zr * bi + zi * br;
            ccr[(d * 16 + p) * 64 + n] = C.in(I_CRE)[((size_t)pg * 16 + p) * 64 + n]; cci[(d * 16 + p) * 64 + n] = C.in(I_CIM)[((size_t)pg * 16 + p) * 64 + n]; } }
    __syncthreads();
    for (int e2 = tid; e2 < 2048; e2 += 512) { const int d = e2 >> 10, tau = (e2 >> 6) & 15, p = 4 * part4 + ((e2 >> 4) & 3), pp = e2 & 15; float acc = 0.f;
        for (int n = 0; n < 64; ++n) { const float cr = ccr[(d * 16 + p) * 64 + n], ci = cci[(d * 16 + p) * 64 + n], pr = pwr[(d * 17 + tau) * 64 + n], pi = pwi[(d * 17 + tau) * 64 + n];
            const float wr = cr * pr - ci * pi, wi = cr * pi + ci * pr; acc += wr * bbr[(d * 64 + n) * 16 + pp] - wi * bbi[(d * 64 + n) * 16 + pp]; }
        Kt[((d * 16 + tau) * 16 + p) * 16 + pp] = acc; }
    __syncthreads();
    {
        const int rl = tid >> 3, t = rl >> 2, p = 4 * part4 + (rl & 3), row = t * 16 + p; const float dsk = C.in(I_S5D)[li * 256 + g * 16 + p];
        bf16_t* dst = C.S5W2() + ((size_t)(li * 16 + g) * 256 + row) * 512;
        for (int k8 = (tid & 7) * 8; k8 < (tid & 7) * 8 + 8; ++k8) { float v[8];
#pragma unroll
            for (int j = 0; j < 8; ++j) { const int kk = (k8 * 8 + j) & 255;
                if (k8 < 32) { const int tp = kk >> 4, pp = kk & 15; float a = 0.f;
                    if (tp <= t) a += Kt[((0 * 16 + (t - tp)) * 16 + p) * 16 + pp];
                    if (tp >= t) a += Kt[((1 * 16 + (tp - t)) * 16 + p) * 16 + pp];
                    if (kk == row) a += dsk; v[j] = a; }
                else { const int d = kk >> 7, part = (kk >> 6) & 1, n = kk & 63, ex = d ? 16 - t : t + 1;
                    const float cr = ccr[(d * 16 + p) * 64 + n], ci = cci[(d * 16 + p) * 64 + n], pr = pwr[(d * 17 + ex) * 64 + n], pi = pwi[(d * 17 + ex) * 64 + n];
                    v[j] = part ? -(cr * pi + ci * pr) : (cr * pr - ci * pi); } }
            u32x4 o; o.x = pk2(v[0], v[1]); o.y = pk2(v[2], v[3]); o.z = pk2(v[4], v[5]); o.w = pk2(v[6], v[7]); *(u32x4*)(dst + k8 * 8) = o; } }
    {
        const int np = 64 * part4 + (tid >> 3), d = np >> 7, part = (np >> 6) & 1, n = np & 63;
        bf16_t* dst = C.S5W1() + ((size_t)(li * 16 + g) * 256 + np) * 256;
        for (int k8 = (tid & 7) * 4; k8 < (tid & 7) * 4 + 4; ++k8) { float v[8];
#pragma unroll
            for (int j = 0; j < 8; ++j) { const int kk = k8 * 8 + j, t = kk >> 4, p = kk & 15, ex = d ? t : 15 - t;
                const float pr = pwr[(d * 17 + ex) * 64 + n], pi = pwi[(d * 17 + ex) * 64 + n], br = bbr[(d * 64 + n) * 16 + p], bi = bbi[(d * 64 + n) * 16 + p];
                v[j] = part ? (pr * bi + pi * br) : (pr * br - pi * bi); }
            u32x4 o; o.x = pk2(v[0], v[1]); o.y = pk2(v[2], v[3]); o.z = pk2(v[4], v[5]); o.w = pk2(v[6], v[7]); *(u32x4*)(dst + k8 * 8) = o; } }
    __syncthreads();
}
DI void prep_s5(const Ctx& C, int gw, int ngw, int lane) {
    const bf16_t* P = C.P(); bf16_t* UG = C.UG();
    for (int ch = gw; ch < S5CH; ch += ngw) {
#pragma unroll
        for (int i = 0; i < 4; ++i) { const int pr = lane + 64 * i, t = pr >> 4, g = pr & 15;
            const u32x4* src = (const u32x4*)(P + ((size_t)ch * 16 + t) * DIN + C_S5U + g * 16); u32x4* dst = (u32x4*)(UG + ((size_t)g * S5ROWS + ch) * 512 + t * 16);
            dst[0] = src[0]; dst[1] = src[1]; }
    }
}
DI void s5_carry(const Ctx& C, int li, int gw, int ngw, int lane) {
    const float* SS = C.S5S(); bf16_t* UG = C.UG();
    for (int it = gw; it < NB * 2 * 16; it += ngw) {
        const int b = it >> 5, d = (it >> 4) & 1, g = it & 15, n = lane, pg = (li * 2 + d) * 16 + g;
        const float lr = C.in(I_LRE)[pg * 64 + n], lim = C.in(I_LIM)[pg * 64 + n], dt = expf(C.in(I_LSTEP)[pg]);
        const float mag = expf(16.0f * lr * dt); float sn, cs; sincosf(16.0f * lim * dt, &sn, &cs);
        const float ar = mag * cs, ai = mag * sn;
        float xr = 0.f, xi = 0.f;
#pragma unroll 1
        for (int s0 = 0; s0 < 272; s0 += 34) {
            float sr[34], si[34];
#pragma unroll
            for (int k = 0; k < 34; ++k) { const int s = s0 + k, c = d == 0 ? s : (s < 16 ? 15 - s : 287 - s); const size_t rowi = (size_t)g * S5ROWS + b * 272 + c;
                sr[k] = SS[rowi * 256 + d * 128 + n]; si[k] = SS[rowi * 256 + d * 128 + 64 + n]; }
#pragma unroll
            for (int k = 0; k < 34; ++k) { const int s = s0 + k, c = d == 0 ? s : (s < 16 ? 15 - s : 287 - s); const size_t rowi = (size_t)g * S5ROWS + b * 272 + c;
                UG[rowi * 512 + 256 + d * 128 + n] = (bf16_t)f2bf(xr); UG[rowi * 512 + 256 + d * 128 + 64 + n] = (bf16_t)f2bf(xi);
                const float nr = ar * xr - ai * xi + sr[k], ni = ar * xi + ai * xr + si[k]; xr = nr; xi = ni; }
        }
    }
}
struct SchedS5 {
    unsigned A, B; int G, c; unsigned bstride;
    DI bool next(int i, Unit& u) const {
        const int L = i * G + c; if (L >= 16 * 9) return false;
        u.e = L / 9; u.pm = L % 9; u.pn = 0; u.br = 0;
        u.a = A + ((unsigned)u.e * S5ROWS + u.pm * 256u) * 512u * 2u; u.b = B + (unsigned)u.e * bstride; u.uniform(); return true;
    }
};
struct EpiS5S {
    static constexpr bool PERM = false;
    float* SS;
    DI void operator()(const f32x4 (&acc)[2][2][4][2], const Unit& u, int wr, int wc, int fr, int fq) const {
        const int row0 = u.pm * 256 + wr * 64 + fr, col0 = wc * 32 + 4 * fq;
#pragma unroll
        for (int ai = 0; ai < 2; ++ai)
#pragma unroll
            for (int m = 0; m < 4; ++m) { float* rowp = SS + ((size_t)u.e * S5ROWS + row0 + ai * 128 + m * 16) * 256 + col0;
#pragma unroll
                for (int bj = 0; bj < 2; ++bj)
#pragma unroll
                    for (int n = 0; n < 2; ++n) *(f32x4*)(rowp + bj * 128 + n * 16) = acc[ai][bj][m][n]; }
    }
};
struct EpiS5Z {
    static constexpr bool PERM = true;
    bf16_t* Z;
    DI void operator()(const f32x4 (&acc)[2][2][4][2], const Unit& u, int wr, int wc, int fr, int fq) const {
        const int row0 = u.pm * 256 + wr * 64 + fr;
#pragma unroll
        for (int ai = 0; ai < 2; ++ai)
#pragma unroll
            for (int m = 0; m < 4; ++m) { const int ch = row0 + ai * 128 + m * 16; if (ch >= S5CH) continue;
#pragma unroll
                for (int bj = 0; bj < 2; ++bj) { const int col = bj * 128 + wc * 32 + 8 * fq, t = col >> 4, p0 = col & 15;
                    const f32x4 v0 = acc[ai][bj][m][0], v1 = acc[ai][bj][m][1];
                    u32x4 w; w.x = pk2(gelu_tanh(v0[0]), gelu_tanh(v0[1])); w.y = pk2(gelu_tanh(v0[2]), gelu_tanh(v0[3])); w.z = pk2(gelu_tanh(v1[0]), gelu_tanh(v1[1])); w.w = pk2(gelu_tanh(v1[2]), gelu_tanh(v1[3]));
                    *(u32x4*)(Z + ((size_t)ch * 16 + t) * 256 + u.e * 16 + p0) = w; } }
    }
};
struct SchedGlu {
    unsigned A, B; int G, c, li;
    DI bool next(int i, Unit& u) const {
        const int L = i * G + c; if (L >= (li == 0 ? 136 : 128)) return false;
        u.pm = pm_of(li, L); u.pn = 0; u.e = 0; u.br = 0; u.a = A + (unsigned)u.pm * 256u * 256u * 2u; u.b = B; u.uniform(); return true;
    }
};
struct EpiGlu {
    static constexpr bool PERM = true;
    bf16_t* O; const bf16_t* Z;
    DI void operator()(const f32x4 (&acc)[2][2][4][2], const Unit& u, int wr, int wc, int fr, int fq) const {
        const int row0 = u.pm * 256 + wr * 64 + fr, col0 = wc * 32 + 8 * fq;
#pragma unroll
        for (int ai = 0; ai < 2; ++ai)
#pragma unroll
            for (int m = 0; m < 4; ++m) { const size_t row = (size_t)(row0 + ai * 128 + m * 16);
#pragma unroll
                for (int bj = 0; bj < 2; ++bj) { const int col = col0 + bj * 128; const u32x4 z = *(const u32x4*)(Z + row * 256 + col);
                    const f32x4 v0 = acc[ai][bj][m][0], v1 = acc[ai][bj][m][1];
                    u32x4 w; w.x = pk2(lo_f(z.x) * sigm(v0[0]), hi_f(z.x) * sigm(v0[1])); w.y = pk2(lo_f(z.y) * sigm(v0[2]), hi_f(z.y) * sigm(v0[3]));
                    w.z = pk2(lo_f(z.z) * sigm(v1[0]), hi_f(z.z) * sigm(v1[1])); w.w = pk2(lo_f(z.w) * sigm(v1[2]), hi_f(z.w) * sigm(v1[3]));
                    *(u32x4*)(O + row * DM + col) = w; }
                if (m == 3) asm volatile("" ::: "memory"); }
    }
};

DI void transpose_item(const float* src, size_t ldw, bf16_t* dst, size_t ldo, LAS float* scr, int lane) {
    const int kq = lane >> 3, n4 = lane & 7;
    f32x4 tv[8];
#pragma unroll
    for (int i = 0; i < 8; ++i) tv[i] = __builtin_nontemporal_load((const f32x4*)(src + (size_t)(8 * kq + i) * ldw + 4 * n4));
    LAS unsigned char* t8 = (LAS unsigned char*)scr;
#pragma unroll
    for (int j = 0; j < 4; ++j) { u32x4 w; w.x = pk2(tv[0][j], tv[1][j]); w.y = pk2(tv[2][j], tv[3][j]); w.z = pk2(tv[4][j], tv[5][j]); w.w = pk2(tv[6][j], tv[7][j]);
        *(LAS u32x4*)(t8 + (4 * n4 + j) * 144 + 16 * kq) = w; }
    LDS_WAIT(); asm volatile("" ::: "memory");
    { const int n = lane >> 1, hf = lane & 1; const LAS u32x4* rp = (const LAS u32x4*)(t8 + n * 144 + 64 * hf);
      const u32x4 a0 = rp[0], a1 = rp[1], a2 = rp[2], a3 = rp[3];
      u32x4* gp = (u32x4*)(dst + (size_t)n * ldo + 32 * hf);
      gp[0] = a0; gp[1] = a1; gp[2] = a2; gp[3] = a3; }
    LDS_WAIT(); asm volatile("" ::: "memory");
}
DI void tr_plain(const float* W, int K, int N, bf16_t* WT, LAS float* scr, int item, int lane) {
    const int nblk = N / 32, kb = item / nblk, nb = item % nblk;
    transpose_item(W + (size_t)(64 * kb) * N + 32 * nb, N, WT + (size_t)(32 * nb) * K + 64 * kb, K, scr, lane);
}
DI void transpose_item8(const float* src, size_t ldw, unsigned char* dst, size_t ldo, LAS float* scr, int lane) {
    const int kq = lane >> 3, n4 = lane & 7;
    f32x4 tv[8];
#pragma unroll
    for (int i = 0; i < 8; ++i) tv[i] = __builtin_nontemporal_load((const f32x4*)(src + (size_t)(8 * kq + i) * ldw + 4 * n4));
    LAS unsigned char* t8 = (LAS unsigned char*)scr;
#pragma unroll
    for (int j = 0; j < 4; ++j) { u32x2 w; w.x = pk4_fp8(tv[0][j] * FP8_WS, tv[1][j] * FP8_WS, tv[2][j] * FP8_WS, tv[3][j] * FP8_WS); w.y = pk4_fp8(tv[4][j] * FP8_WS, tv[5][j] * FP8_WS, tv[6][j] * FP8_WS, tv[7][j] * FP8_WS);
        *(LAS u32x2*)(t8 + (4 * n4 + j) * 72 + 8 * kq) = w; }
    LDS_WAIT(); asm volatile("" ::: "memory");
    { const int n = lane >> 1, hf = lane & 1; const LAS u32x2* rp = (const LAS u32x2*)(t8 + n * 72 + 32 * hf);
      const u32x2 a0 = rp[0], a1 = rp[1], a2 = rp[2], a3 = rp[3];
      u32x4* gp = (u32x4*)(dst + (size_t)n * ldo + 32 * hf);
      gp[0] = (u32x4){a0.x, a0.y, a1.x, a1.y}; gp[1] = (u32x4){a2.x, a2.y, a3.x, a3.y}; }
    LDS_WAIT(); asm volatile("" ::: "memory");
}
DI void tr_gu(const float* W, unsigned char* W1T, int half, LAS float* scr, int item, int lane) {
    const int nblk = DF / 32, kb = item / nblk, nb = item % nblk, n0 = 32 * nb, drow = (n0 / 128) * 256 + half * 128 + (n0 % 128);
    transpose_item8(W + (size_t)(64 * kb) * DF + n0, DF, W1T + (size_t)drow * DM + 64 * kb, DM, scr, lane);
}
DI void convert_experts(const Ctx& C, int li, int it0, int gw, int ngw, LAS float* scr, int lane) {
    constexpr int PER = 16 * 88;
    for (int it = (gw - it0 + ngw) % ngw; it < 3 * NE * PER; it += ngw) {
        const int which = it / (NE * PER), r = it % (NE * PER), e = r / PER, item = r % PER;
        if (which == 0) tr_gu(C.in(I_EWG) + ((size_t)li * NE + e) * DM * DF, C.W1T() + (size_t)e * 5632 * DM, 0, scr, item, lane);
        else if (which == 1) tr_gu(C.in(I_EWU) + ((size_t)li * NE + e) * DM * DF, C.W1T() + (size_t)e * 5632 * DM, 1, scr, item, lane);
        else { const int nblk = DM / 32, kb = item / nblk, nb = item % nblk;
            transpose_item8(C.in(I_EWD) + ((size_t)li * NE + e) * DF * DM + (size_t)(64 * kb) * DM + 32 * nb, DM, C.W2T() + (size_t)e * DM * DF + (size_t)(32 * nb) * DF + 64 * kb, DF, scr, lane); }
    }
}
DI void phase_prologue(const Ctx& C, LAS unsigned char* lds, int gw, int ngw, int wave, int lane) {
    const int tid_ = wave * 64 + lane;
    if (blockIdx.x < 96) { for (int li = 0; li < 2; ++li) {
        const int col = (blockIdx.x % 96) * 64 + lane; const float* w = C.in(I_ADAW) + (size_t)li * DM * 6144 + (size_t)(128 * wave) * 6144 + col;
        float cr[9][2];
#pragma unroll
        for (int q = 0; q < 9; ++q)
#pragma unroll
            for (int j = 0; j < 2; ++j) { const int k = 128 * wave + 64 * j + lane; cr[q][j] = silu_(q < 8 ? C.in(I_C)[q * 1024 + k] : C.in(I_CCTX)[k]); }
        float acc[9];
#pragma unroll
        for (int q = 0; q < 9; ++q) acc[q] = 0.f;
#pragma unroll
        for (int k0 = 0; k0 < 128; k0 += 32) { float wv[32];
#pragma unroll
            for (int k = 0; k < 32; ++k) wv[k] = w[(size_t)(k0 + k) * 6144];
#pragma unroll
            for (int k = 0; k < 32; ++k)
#pragma unroll
                for (int q = 0; q < 9; ++q) acc[q] += __uint_as_float(__builtin_amdgcn_readlane(__float_as_uint(cr[q][(k0 + k) >> 6]), (k0 + k) & 63)) * wv[k]; }
        LAS float* red = (LAS float*)(lds + 40960);
#pragma unroll
        for (int q = 0; q < 9; ++q) red[(wave * 9 + q) * 64 + lane] = acc[q];
        __syncthreads();
        for (int e = tid_; e < 9 * 64; e += 512) { const int q = e >> 6, cl = e & 63; float sum = 0.f;
#pragma unroll
            for (int wv2 = 0; wv2 < 8; ++wv2) sum += red[(wv2 * 9 + q) * 64 + cl];
            const int cc = (blockIdx.x % 96) * 64 + cl; C.mod()[(li * 9 + q) * 6144 + cc] = sum + C.in(I_ADAB)[li * 6144 + cc]; }
        __syncthreads(); }
    } else if (blockIdx.x < 224) { const int j = blockIdx.x - 96; s5_build_w(C, j >> 6, (j >> 2) & 15, j & 3, (LAS float*)(lds + 40960), tid_); }
    LAS float* scr = (LAS float*)(lds + 40960 + wave * 8704);
    if (blockIdx.x == 0 && tid_ < 256) {
        const float v0 = C.in(I_HGLB)[tid_], v1 = C.in(I_HGLB)[256 + tid_];
        C.lb()[tid_] = 0.f; C.lb()[256 + tid_] = 1.0f / (1.0f + expf(v0 - v1));
    }
    constexpr int N_MOD = 0, N_WIN = 2 * 16 * 232,     N_WBR = 8 * 4 * 32, N_WOUT = 2 * 16 * 32, N_GLU = 2 * 4 * 8;
    for (int it = gw; it < N_MOD + N_WIN + N_WBR + N_WOUT + N_GLU; it += ngw) {
        int r = it;
        r -= N_MOD;
        if (r < N_WIN) { const int li = r / (16 * 232), it2 = r % (16 * 232), kb = it2 / 232, nb = it2 % 232; const float* src = C.in(I_WIN) + (size_t)li * DM * DIN + (size_t)(64 * kb) * DIN + 32 * nb;
            if (nb < C_GATE / 32) transpose_item(src, DIN, C.win() + (size_t)li * DIN * DM + (size_t)(32 * nb) * DM + 64 * kb, DM, scr, lane);
            else transpose_item8(src, DIN, C.ws() + WS_WIN + (size_t)li * DIN * DM * 2 + WS_WIN8_OFF + (size_t)(32 * nb - C_GATE) * DM + 64 * kb, DM, scr, lane);
            continue; }
        r -= N_WIN;
        if (r < N_WBR) { const int m = r / 128, it2 = r % 128, kb = it2 / 32, nb = it2 % 32;
            transpose_item(C.in(I_WBR) + (size_t)m * 256 * DM + (size_t)(64 * kb) * DM + 32 * nb, DM, C.wbr() + (size_t)(m >> 2) * DM * DM + (size_t)(32 * nb) * DM + (m & 3) * 256 + 64 * kb, DM, scr, lane); continue; }
        r -= N_WBR;
        if (r < N_WOUT) { const int li = r / 512; tr_plain(C.in(I_WOUT) + (size_t)li * DM * DM, DM, DM, C.wout() + (size_t)li * DM * DM, scr, r % 512, lane); continue; }
        r -= N_WOUT;
        { const int li = r / 32; tr_plain(C.in(I_GLU) + (size_t)li * 65536, 256, 256, C.GLUT() + (size_t)li * 65536, scr, r % 32, lane); }
    }
}

DI void moe_combine_row(const Ctx& C, size_t R, const float* g2, f32x4 (&v)[4], int lane) {
    f32x4 a[4];
#pragma unroll
    for (int j = 0; j < 4; ++j) a[j] = (f32x4){0.f, 0.f, 0.f, 0.f};
    int sv[NE];
#pragma unroll
    for (int e = 0; e < NE; ++e) sv[e] = C.sel()[(size_t)e * NTOK + R];
#pragma unroll
    for (int e = 0; e < NE; ++e) { const int s = __builtin_amdgcn_readfirstlane(sv[e]);
        if (s >= 0) { const bf16_t* y = C.XE() + ((size_t)e * EROWS + s) * DM;
#pragma unroll
            for (int j = 0; j < 4; ++j) { const u32x2 w = *(const u32x2*)(y + 4 * (lane + 64 * j)); a[j][0] += lo_f(w.x); a[j][1] += hi_f(w.x); a[j][2] += lo_f(w.y); a[j][3] += hi_f(w.y); } }
    }
#pragma unroll
    for (int j = 0; j < 4; ++j) v[j] = v[j] + *(const f32x4*)(g2 + 4 * (lane + 64 * j)) * a[j];
}
DI void norm1_row(const Ctx& C, int li, int R, const float* nw, int lane, float* Xout, f32x4 (&v)[4]) {
    const int b = R / LSEQ, i = R % LSEQ, mr = (i < CTXL) ? 8 : b;
    if (li > 0) moe_combine_row(C, R, C.mod() + ((li - 1) * 9 + mr) * 6144 + 5 * 1024, v, lane);
    float ss = 0.f;
#pragma unroll
    for (int j = 0; j < 4; ++j) { if (li > 0) *(f32x4*)(Xout + (size_t)R * DM + 4 * (lane + 64 * j)) = v[j];     ss += v[j][0] * v[j][0] + v[j][1] * v[j][1] + v[j][2] * v[j][2] + v[j][3] * v[j][3]; }
    const float rstd = 1.0f / sqrtf(wave_sum(ss) * (1.0f / DM) + EPS);
    const float* md = C.mod() + (li * 9 + mr) * 6144;
#pragma unroll
    for (int j = 0; j < 4; ++j) { const int c = 4 * (lane + 64 * j);
        const f32x4 w = *(const f32x4*)(nw + c), sh = *(const f32x4*)(md + c), sc = *(const f32x4*)(md + 1024 + c);
        const f32x4 h = v[j] * rstd * w * (sc + 1.0f) + sh;
        u32x2 o; o.x = pk2(h[0], h[1]); o.y = pk2(h[2], h[3]);
        *(u32x2*)(C.H() + (size_t)R * DM + c) = o;
        *(unsigned*)(C.ws() + WS_H8 + (size_t)R * DM + c) = pk4_fp8(h[0] * FP8_XS, h[1] * FP8_XS, h[2] * FP8_XS, h[3] * FP8_XS); }
}
DI const float* xrow_src(const Ctx& C, int li, int R) {
    if (li > 0) return C.X() + (size_t)R * DM;
    const int b = R / LSEQ, i = R % LSEQ;
    return (i < CTXL) ? C.in(I_CTX) + ((size_t)b * CTXL + i) * DM : C.in(I_X) + ((size_t)b * SEQ + (i - CTXL)) * DM;
}
DI void phase_norm1(const Ctx& C, int li, int gw, int ngw, int lane, float* Xout) {
    const float* nw = C.in(I_NMIX) + li * DM;
    for (int R = gw; R < NTOK; R += 4 * ngw) {
        f32x4 v[4][4];
#pragma unroll
        for (int q = 0; q < 4; ++q) { const int Rq = R + q * ngw; if (Rq < NTOK) { const float* src = xrow_src(C, li, Rq);
#pragma unroll
            for (int j = 0; j < 4; ++j) v[q][j] = *(const f32x4*)(src + 4 * (lane + 64 * j)); } }
#pragma unroll
        for (int q = 0; q < 4; ++q) { const int Rq = R + q * ngw; if (Rq < NTOK) norm1_row(C, li, Rq, nw, lane, Xout, v[q]); }
    }
}
DI void phase_final(const Ctx& C, int gw, int ngw, int lane) {
    for (int t0 = gw; t0 < NB * SEQ; t0 += 4 * ngw) {
        f32x4 v[4][4];
#pragma unroll
        for (int q = 0; q < 4; ++q) { const int t = t0 + q * ngw; if (t < NB * SEQ) { const size_t R = (size_t)(t / SEQ) * LSEQ + CTXL + (t % SEQ);
#pragma unroll
            for (int j = 0; j < 4; ++j) v[q][j] = *(const f32x4*)(C.X() + R * DM + 4 * (lane + 64 * j)); } }
#pragma unroll
        for (int q = 0; q < 4; ++q) { const int t = t0 + q * ngw; if (t < NB * SEQ) { const int b = t / SEQ; const size_t R = (size_t)b * LSEQ + CTXL + (t % SEQ);
            moe_combine_row(C, R, C.mod() + (1 * 9 + b) * 6144 + 5 * 1024, v[q], lane);
#pragma unroll
            for (int j = 0; j < 4; ++j) *(f32x4*)(C.out() + (size_t)t * DM + 4 * (lane + 64 * j)) = v[q][j]; } }
    }
}

DI void phase_norm2(const Ctx& C, int li, LAS unsigned char* lds, int gw, int ngw, int wave, int lane) {
    const int tid_ = wave * 64 + lane;
    LAS float* rwT = (LAS float*)lds;
    for (int i = tid_; i < DM * NE / 4; i += 512) { const f32x4 v = ((const f32x4*)(C.in(I_RW) + (size_t)li * DM * NE))[i]; const int c = i >> 2, e0 = (i & 3) * 4;
        rwT[(e0 + 0) * DM + c] = v[0]; rwT[(e0 + 1) * DM + c] = v[1]; rwT[(e0 + 2) * DM + c] = v[2]; rwT[(e0 + 3) * DM + c] = v[3]; }
    __syncthreads();
    const float* nw = C.in(I_NFFN) + li * DM;
    for (int R0 = gw; R0 < NTOK; R0 += 4 * ngw) {
      f32x4 vq[4][4];
#pragma unroll
      for (int q = 0; q < 4; ++q) { const int R = R0 + q * ngw; if (R < NTOK) {
#pragma unroll
          for (int j = 0; j < 4; ++j) vq[q][j] = *(const f32x4*)(C.X() + (size_t)R * DM + 4 * (lane + 64 * j)); } }
#pragma unroll
      for (int q = 0; q < 4; ++q) { const int R = R0 + q * ngw; if (R >= NTOK) continue;
        const int b = R / LSEQ, i = R % LSEQ, mr = (i < CTXL) ? 8 : b;
        if (li == DEPTH - 1 && i < CTXL) continue;
        f32x4 (&v)[4] = vq[q]; float ss = 0.f;
#pragma unroll
        for (int j = 0; j < 4; ++j) ss += v[j][0] * v[j][0] + v[j][1] * v[j][1] + v[j][2] * v[j][2] + v[j][3] * v[j][3];
        const float rstd = 1.0f / sqrtf(wave_sum(ss) * (1.0f / DM) + EPS);
        const float* md = C.mod() + (li * 9 + mr) * 6144;
        float y[NE];
#pragma unroll
        for (int e = 0; e < NE; ++e) y[e] = 0.f;
#pragma unroll
        for (int j = 0; j < 4; ++j) { const int c = 4 * (lane + 64 * j);
            const f32x4 w = *(const f32x4*)(nw + c), sh = *(const f32x4*)(md + 3 * 1024 + c), sc = *(const f32x4*)(md + 4 * 1024 + c);
            const f32x4 h = v[j] * rstd * w * (sc + 1.0f) + sh;
            u32x2 o; o.x = pk2(h[0], h[1]); o.y = pk2(h[2], h[3]);
            *(u32x2*)(C.H() + (size_t)R * DM + c) = o;
#pragma unroll
            for (int e = 0; e < NE; ++e) { const f32x4 r4 = *(const LAS f32x4*)(rwT + e * DM + c); y[e] += h[0] * r4[0] + h[1] * r4[1] + h[2] * r4[2] + h[3] * r4[3]; } }
        float y8[8], y4[4], y2[2], lg;
        { const bool hi = (lane & 32) != 0;
#pragma unroll
          for (int k = 0; k < 8; ++k) { const float keep = hi ? y[k + 8] : y[k], send = hi ? y[k] : y[k + 8]; y8[k] = keep + shx<32>(send); } }
        { const bool hi = (lane & 16) != 0;
#pragma unroll
          for (int k = 0; k < 4; ++k) { const float keep = hi ? y8[k + 4] : y8[k], send = hi ? y8[k] : y8[k + 4]; y4[k] = keep + shx<16>(send); } }
        { const bool hi = (lane & 8) != 0;
#pragma unroll
          for (int k = 0; k < 2; ++k) { const float keep = hi ? y4[k + 2] : y4[k], send = hi ? y4[k] : y4[k + 2]; y2[k] = keep + shx<8>(send); } }
        { const bool hi = (lane & 4) != 0; const float keep = hi ? y2[1] : y2[0], send = hi ? y2[0] : y2[1]; lg = keep + shx<4>(send); }
        lg += shx<2>(lg); lg += shx<1>(lg);
        float mx = lg;
        mx = fmaxf(mx, shx<4>(mx)); mx = fmaxf(mx, shx<8>(mx)); mx = fmaxf(mx, shx<16>(mx)); mx = fmaxf(mx, shx<32>(mx));
        const float ex = expf(lg - mx);
        float den = ex;
        den += shx<4>(den); den += shx<8>(den); den += shx<16>(den); den += shx<32>(den);
        if ((lane & 3) == 0) C.aff()[(size_t)R * NE + ((lane >> 2) & 15)] = ex / den;
      }
    }
}

DI void phase_topk(const Ctx& C, int li, LAS unsigned char* lds, int wave, int lane) {
    LAS unsigned* cnt = (LAS unsigned*)lds;
    LAS int* rows = (LAS int*)(lds + 64);
    const int tid = wave * 64 + lane, nunit = (li == DEPTH - 1) ? 128 : 256;
    for (int u = blockIdx.x; u < nunit; u += gridDim.x) {
        const int kind = u >> 7, b = (u >> 4) & 7, e = u & 15;
        const int n = kind ? CTXL : SEQ, cap = kind ? CAP_C : CAP_L, per = n / 512 + (kind ? 1 : 0);
        const size_t rbase = (size_t)b * LSEQ + (kind ? 0 : CTXL);
        unsigned v[8];
#pragma unroll
        for (int j = 0; j < 8; ++j) { const int t = tid + 512 * j; v[j] = (j < per && t < n) ? __float_as_uint(C.aff()[(rbase + t) * NE + e]) : 0u; }
        unsigned thr = 0u;
        for (int bit = 30; bit >= 0; --bit) {
            const unsigned cand = thr | (1u << bit);
            if (tid == 0) cnt[0] = 0u;
            __syncthreads();
            unsigned c = 0;
#pragma unroll
            for (int j = 0; j < 8; ++j) c += (v[j] >= cand) ? 1u : 0u;
            c = (unsigned)wave_sum((float)c);
            if (lane == 0) atomicAdd((unsigned*)cnt, c);
            __syncthreads();
            if (cnt[0] >= (unsigned)cap) thr = cand;
            __syncthreads();
        }
        if (tid == 0) { cnt[1] = 0u; cnt[2] = 0u; }
        __syncthreads();
        unsigned ngt = 0;
#pragma unroll
        for (int j = 0; j < 8; ++j) ngt += (v[j] > thr) ? 1u : 0u;
        ngt = (unsigned)wave_sum((float)ngt);
        if (lane == 0) atomicAdd((unsigned*)cnt + 1, ngt);
        __syncthreads();
        const unsigned n_gt = cnt[1];
        __syncthreads();
        if (tid == 0) cnt[1] = 0u;
        __syncthreads();
        const int srow0 = kind ? (NB * CAP_L + b * CAP_C) : b * CAP_L;
#pragma unroll
        for (int j = 0; j < 8; ++j) { const int t = tid + 512 * j;
            if (j < per && t < n) {
                int slot = -1;
                if (v[j] > thr) slot = (int)atomicAdd((unsigned*)cnt + 1, 1u);
                else if (v[j] == thr) { const unsigned k = atomicAdd((unsigned*)cnt + 2, 1u); if (n_gt + k < (unsigned)cap) slot = (int)(n_gt + k); }
                C.sel()[(size_t)e * NTOK + rbase + t] = (slot >= 0) ? srow0 + slot : -1;
                if (slot >= 0) { rows[slot] = (int)(rbase + t); C.gate()[(size_t)e * EROWS + srow0 + slot] = __uint_as_float(v[j]); }
            } }
        __syncthreads();
        for (int s0 = wave; s0 < cap; s0 += 32) {
            u32x4 xa[4], xb[4];
#pragma unroll
            for (int q = 0; q < 4; ++q) { const int sq = s0 + 8 * q; if (sq < cap) { const u32x4* src = (const u32x4*)(C.H() + (size_t)rows[sq] * DM) + 2 * lane; xa[q] = src[0]; xb[q] = src[1]; } }
#pragma unroll
            for (int q = 0; q < 4; ++q) { const int sq = s0 + 8 * q; if (sq >= cap) continue; const u32x4 x0 = xa[q], x1 = xb[q];
                u32x4 o; o.x = pk4_fp8(lo_f(x0.x) * FP8_XS, hi_f(x0.x) * FP8_XS, lo_f(x0.y) * FP8_XS, hi_f(x0.y) * FP8_XS); o.y = pk4_fp8(lo_f(x0.z) * FP8_XS, hi_f(x0.z) * FP8_XS, lo_f(x0.w) * FP8_XS, hi_f(x0.w) * FP8_XS);
                o.z = pk4_fp8(lo_f(x1.x) * FP8_XS, hi_f(x1.x) * FP8_XS, lo_f(x1.y) * FP8_XS, hi_f(x1.y) * FP8_XS); o.w = pk4_fp8(lo_f(x1.z) * FP8_XS, hi_f(x1.z) * FP8_XS, lo_f(x1.w) * FP8_XS, hi_f(x1.w) * FP8_XS);
                *((u32x4*)((unsigned char*)C.XE() + ((size_t)e * EROWS + srow0 + sq) * DM) + lane) = o; }
        }
        __syncthreads();
    }
}

DI void phase_prep(const Ctx& C, int li, int gw, int ngw, int lane) {
    const float* wq = C.in(I_NAQN) + li * 64; const float* wk = C.in(I_NAKN) + li * 64;
    const int d0 = (lane & 7) * 8; const bool isq = lane < 32;
    float w[8];
#pragma unroll
    for (int j = 0; j < 8; ++j) w[j] = isq ? wq[d0 + j] * 0.125f : wk[d0 + j];
    for (int R0 = gw; R0 < NTOK; R0 += 4 * ngw) {
        u32x4 xq[4];
#pragma unroll
        for (int q = 0; q < 4; ++q) { const int R = R0 + q * ngw; if (R < NTOK) xq[q] = *(const u32x4*)(C.P() + (size_t)R * DIN + C_NAQ + 8 * lane); }
#pragma unroll
        for (int q = 0; q < 4; ++q) { const int R = R0 + q * ngw; if (R >= NTOK) continue; const u32x4 x = xq[q];
            float f[8] = {lo_f(x.x), hi_f(x.x), lo_f(x.y), hi_f(x.y), lo_f(x.z), hi_f(x.z), lo_f(x.w), hi_f(x.w)};
            float ss = 0.f;
#pragma unroll
            for (int j = 0; j < 8; ++j) ss += f[j] * f[j];
            ss += shx<1>(ss); ss += shx<2>(ss); ss += shx<4>(ss);
            const float rs = __builtin_amdgcn_rsqf(ss * (1.0f / 64.0f) + EPS);
            u32x4 o; o.x = pk2(f[0] * rs * w[0], f[1] * rs * w[1]); o.y = pk2(f[2] * rs * w[2], f[3] * rs * w[3]); o.z = pk2(f[4] * rs * w[4], f[5] * rs * w[5]); o.w = pk2(f[6] * rs * w[6], f[7] * rs * w[7]);
            *(u32x4*)(C.QKN() + (size_t)R * 512 + 8 * lane) = o; }
    }
}

typedef short s16x4 __attribute__((ext_vector_type(4)));
#define MFMA16(a, b, c) __builtin_amdgcn_mfma_f32_16x16x32_bf16((a), (b), (c), 0, 0, 0)
DI bf16x8 ld16(const bf16_t* p) { return *(const bf16x8*)p; }
DI s16x4 tr16(const LAS bf16_t* p) { return __builtin_amdgcn_ds_read_tr16_b64_v4i16((LAS s16x4*)p); }
DI bf16x8 cat8(s16x4 a, s16x4 b) { return __builtin_shufflevector(a, b, 0, 1, 2, 3, 4, 5, 6, 7); }
DI bf16x8 pack8(const f32x4& a, const f32x4& b) { u32x4 w; w.x = pg8::cvt_pk_bf16(a[0], a[1]); w.y = pg8::cvt_pk_bf16(a[2], a[3]); w.z = pg8::cvt_pk_bf16(b[0], b[1]); w.w = pg8::cvt_pk_bf16(b[2], b[3]); return __builtin_bit_cast(bf16x8, w); }

constexpr int NA_VS = 80;
DI void na_unit(const Ctx& C, int li, int wu, bool isctx, int lane, LAS bf16_t* vl, const LAS float* rpbt) {
    const int cq = lane & 15, g = lane >> 4;
    int b, h, r, c; size_t Rq;
    if (!isctx) { c = wu & 3; h = (wu >> 2) & 3; r = (wu >> 4) & 63; b = wu >> 10; Rq = (size_t)b * LSEQ + CTXL + r * 64 + 16 * c + cq; }
    else { c = wu & 15; h = (wu >> 4) & 3; b = wu >> 6; r = 0; Rq = (size_t)b * LSEQ + 16 * c + cq; }
    const bf16_t* QKN = C.QKN(); const bf16_t* P = C.P();
    bf16x8 qf[2];
    qf[0] = ld16(QKN + Rq * 512 + h * 64 + 8 * g); qf[1] = ld16(QKN + Rq * 512 + h * 64 + 32 + 8 * g);
    f32x4 o[4];
#pragma unroll
    for (int d = 0; d < 4; ++d) o[d] = (f32x4){0.f, 0.f, 0.f, 0.f};
    float lsum = 0.f;
    const int r0 = min(max(r - 4, 0), 56), kc0 = (c == 0) ? 0 : (c == 1) ? 8 : (c == 2) ? 24 : 32, qi = 16 * c + cq, cs = min(max(qi - 8, 0), 48);
    const LAS float* rpb = rpbt + h * 465;
    const size_t rowb = (size_t)b * LSEQ;
    const int nch = isctx ? 4 : 8;
    const int dwin = kc0 + 4 * g - cs, ebias = kc0 + 4 * g - qi + 15;
    const unsigned voffV = (unsigned)((lane >> 3) * DIN + 8 * (lane & 7)) * 2u, voffK = (unsigned)(cq * 512 + 8 * g) * 2u;
    const __amdgpu_buffer_rsrc_t rsP = __builtin_amdgcn_make_buffer_rsrc((void*)P, 0, 0x7fffffff, 0x00020000), rsK = __builtin_amdgcn_make_buffer_rsrc((void*)QKN, 0, 0x7fffffff, 0x00020000);
    const unsigned Pv0 = (unsigned)(C_NAV + h * 64) * 2u, Kv0 = (unsigned)(256 + h * 64) * 2u;
#define NA_CHROW(ch_) ((!isctx && (ch_) < 4) ? (rowb + CTXL + (size_t)(r0 + 2 * (ch_)) * 64 + kc0) : (rowb + 64 * (size_t)(isctx ? (ch_) : (ch_) - 4)))
#define NA_VSTEP(ch_, i) ((!isctx && (ch_) < 4) ? (((i) >> 2) * 64 + 8 * ((i) & 3)) : 8 * (i))
#define NA_KSTEP(ch_, kb) ((!isctx && (ch_) < 4) ? (((kb) >> 1) * 64 + 16 * ((kb) & 1)) : 16 * (kb))
    bf16x8 vA[8], kA[8], vB[8], kB[8];
#define NA_PREFETCH(VR, KR, ch_) do { const size_t cr_ = NA_CHROW(ch_); \
        _Pragma("unroll") for (int i = 0; i < 8; ++i) VR[i] = __builtin_bit_cast(bf16x8, __builtin_amdgcn_raw_buffer_load_b128(rsP, voffV, (unsigned)(cr_ + NA_VSTEP(ch_, i)) * (unsigned)(DIN * 2) + Pv0, 0)); \
        _Pragma("unroll") for (int kb = 0; kb < 4; ++kb) { const unsigned ko_ = (unsigned)(cr_ + NA_KSTEP(ch_, kb)) * 1024u + Kv0; \
            KR[2 * kb] = __builtin_bit_cast(bf16x8, __builtin_amdgcn_raw_buffer_load_b128(rsK, voffK, ko_, 0)); KR[2 * kb + 1] = __builtin_bit_cast(bf16x8, __builtin_amdgcn_raw_buffer_load_b128(rsK, voffK, ko_ + 64u, 0)); } } while (0)
#define NA_BODY(VR, KR, ch_) do { const int chv = (ch_); const bool local = !isctx && chv < 4; \
          \
        _Pragma("unroll") for (int i = 0; i < 8; ++i) *(LAS bf16x8*)(vl + (lane >> 3) * NA_VS + 8 * (lane & 7) + i * 8 * NA_VS) = VR[i]; \
        f32x4 s[4]; \
        _Pragma("unroll") for (int kb = 0; kb < 4; ++kb) { s[kb] = MFMA16(KR[2 * kb], qf[0], ((f32x4){0.f, 0.f, 0.f, 0.f})); s[kb] = MFMA16(KR[2 * kb + 1], qf[1], s[kb]); } \
        asm volatile("" : "+v"(s[0]), "+v"(s[1]), "+v"(s[2]), "+v"(s[3]));     \
        if (chv + 2 < nch) NA_PREFETCH(VR, KR, chv + 2); \
        _Pragma("unroll") for (int kb = 0; kb < 4; ++kb) \
            _Pragma("unroll") for (int i = 0; i < 4; ++i) { float pv; \
                if (local) { const int dcol = dwin + 16 * (kb & 1) + i; const bool ok = (unsigned)dcol < 16u; \
                    const int bi = ok ? ((r0 + 2 * chv + (kb >> 1) - r + 7) * 31 + ebias + 16 * (kb & 1) + i) : 0; \
                    pv = ok ? __expf(s[kb][i] + rpb[bi] - 8.0f) : 0.f; } \
                else pv = __expf(s[kb][i] - 8.0f); \
                s[kb][i] = pv; lsum += pv; } \
        const bf16x8 pb0 = pack8(s[0], s[1]), pb1 = pack8(s[2], s[3]); \
        const int q4 = cq >> 2, p4 = cq & 3; \
        _Pragma("unroll") for (int db = 0; db < 4; ++db) { \
            const LAS bf16_t* base = vl + (4 * g + q4) * NA_VS + 16 * db + 4 * p4; \
            const bf16x8 va0 = cat8(tr16(base), tr16(base + 16 * NA_VS)), va1 = cat8(tr16(base + 32 * NA_VS), tr16(base + 48 * NA_VS)); \
            o[db] = MFMA16(va0, pb0, o[db]); o[db] = MFMA16(va1, pb1, o[db]); } } while (0)
    NA_PREFETCH(vA, kA, 0); NA_PREFETCH(vB, kB, 1);
    for (int ch = 0; ch < nch; ch += 2) { NA_BODY(vA, kA, ch); NA_BODY(vB, kB, ch + 1); }
#undef NA_BODY
#undef NA_CHROW
#undef NA_VSTEP
#undef NA_KSTEP
#undef NA_PREFETCH
    lsum += shx<16>(lsum); lsum += shx<32>(lsum);
    const float il = 1.0f / lsum;
    bf16_t* op = C.O() + Rq * DM + 256 + h * 64 + 4 * g;
#pragma unroll
    for (int db = 0; db < 4; ++db) { u32x2 w; w.x = pk2(o[db][0] * il, o[db][1] * il); w.y = pk2(o[db][2] * il, o[db][3] * il); *(u32x2*)(op + 16 * db) = w; }
}


DI void prep_ret(const Ctx& C, int li, int gw, int ngw, int lane) {
    const int rsub = lane >> 4, h = (lane >> 2) & 3, jb = lane & 3;
    const float lg0 = __log2f(sigm(C.in(I_RETD)[(li * 2 + 0) * 4 + h])), lg1 = __log2f(sigm(C.in(I_RETD)[(li * 2 + 1) * 4 + h]));
    float inv[8];
#pragma unroll
    for (int e = 0; e < 8; ++e) inv[e] = exp2f(-(float)(8 * (jb & 1) + e) * (13.287712379549449f / 16.0f));
    bf16_t* RP = C.RETP(); const bf16_t* P = C.P();
    for (int it = gw; it < NTOK / 4; it += ngw) {
        const size_t R = (size_t)it * 4 + rsub; const int i = (int)(R % LSEQ), il = i & 63;
        const size_t pq = R * DIN + C_RTQ + h * 64 + 8 * jb, pk = R * DIN + C_RTK + h * 64 + 8 * jb;
        const u32x4 q1w = *(const u32x4*)(P + pq), q2w = *(const u32x4*)(P + pq + 32), k1w = *(const u32x4*)(P + pk), k2w = *(const u32x4*)(P + pk + 32);
        float q1[8] = {lo_f(q1w.x), hi_f(q1w.x), lo_f(q1w.y), hi_f(q1w.y), lo_f(q1w.z), hi_f(q1w.z), lo_f(q1w.w), hi_f(q1w.w)};
        float q2[8] = {lo_f(q2w.x), hi_f(q2w.x), lo_f(q2w.y), hi_f(q2w.y), lo_f(q2w.z), hi_f(q2w.z), lo_f(q2w.w), hi_f(q2w.w)};
        float k1[8] = {lo_f(k1w.x), hi_f(k1w.x), lo_f(k1w.y), hi_f(k1w.y), lo_f(k1w.z), hi_f(k1w.z), lo_f(k1w.w), hi_f(k1w.w)};
        float k2[8] = {lo_f(k2w.x), hi_f(k2w.x), lo_f(k2w.y), hi_f(k2w.y), lo_f(k2w.z), hi_f(k2w.z), lo_f(k2w.w), hi_f(k2w.w)};
        if (i >= CTXL) { const int t = i - CTXL; const float pos = (float)((jb < 2) ? (t >> 6) : (t & 63));
#pragma unroll
            for (int e = 0; e < 8; ++e) { const float ang = pos * inv[e], sn = __sinf(ang), cs = __cosf(ang);
                const float a = q1[e] * cs - q2[e] * sn, b2 = q2[e] * cs + q1[e] * sn; q1[e] = a; q2[e] = b2;
                const float c2 = k1[e] * cs - k2[e] * sn, d2 = k2[e] * cs + k1[e] * sn; k1[e] = c2; k2[e] = d2; } }
        const float fil = (float)il;
        const float sq0 = exp2f(fil * lg0), sk0 = 0.125f * exp2f(-fil * lg0), sq1 = exp2f(-fil * lg1), sk1 = 0.125f * exp2f(fil * lg1);
        const size_t o = R * 256 + h * 64 + 8 * jb;
#define PK8(arr, sc) ((u32x4){pk2(arr[0] * sc, arr[1] * sc), pk2(arr[2] * sc, arr[3] * sc), pk2(arr[4] * sc, arr[5] * sc), pk2(arr[6] * sc, arr[7] * sc)})
        *(u32x4*)(RP + 0 * RETP_T + o) = PK8(q1, sq0); *(u32x4*)(RP + 0 * RETP_T + o + 32) = PK8(q2, sq0);
        *(u32x4*)(RP + 1 * RETP_T + o) = PK8(k1, sk0); *(u32x4*)(RP + 1 * RETP_T + o + 32) = PK8(k2, sk0);
        *(u32x4*)(RP + 2 * RETP_T + o) = PK8(q1, sq1); *(u32x4*)(RP + 2 * RETP_T + o + 32) = PK8(q2, sq1);
        *(u32x4*)(RP + 3 * RETP_T + o) = PK8(k1, sk1); *(u32x4*)(RP + 3 * RETP_T + o + 32) = PK8(k2, sk1);
#undef PK8
    }
}
constexpr int RT_TS = 272;
DI void stage_tile64x256(LAS bf16_t* dst, const bf16_t* src, size_t srcld, int tid) {
#pragma unroll
    for (int i = 0; i < 4; ++i) { const int p = tid + 512 * i, row = p >> 5, c16 = p & 31;
        *(LAS bf16x8*)(dst + row * RT_TS + 8 * c16) = ld16(src + (size_t)row * srcld + 8 * c16); }
}
DI size_t st_off(int b, int h, int d, int c) { return ((size_t)(((b * 4 + h) * 2 + d) * NCHK + c)) * 4096; }
DI void ret_pass1(const Ctx& C, LAS unsigned char* lds, int wave, int lane) {
    LAS bf16_t* vt = (LAS bf16_t*)lds; LAS bf16_t* k0t = vt + 64 * RT_TS; LAS bf16_t* k1t = k0t + 64 * RT_TS;
    const int tid = wave * 64 + lane, cq = lane & 15, g = lane >> 4, q4 = cq >> 2, p4 = cq & 3, h = wave & 3, d = wave >> 2;
    const bf16_t* P = C.P(); const bf16_t* RP = C.RETP(); bf16_t* ST = C.RETS();
    for (int u = blockIdx.x; u < NB * NCHK; u += gridDim.x) {
        const int b = u / NCHK, c = u % NCHK; const size_t R0 = (size_t)b * LSEQ + 64 * c;
        __syncthreads();
        stage_tile64x256(vt, P + R0 * DIN + C_RTV, DIN, tid);
        stage_tile64x256(k0t, RP + 1 * RETP_T + R0 * 256, 256, tid);
        stage_tile64x256(k1t, RP + 3 * RETP_T + R0 * 256, 256, tid);
        __syncthreads();
        const LAS bf16_t* kt = d ? k1t : k0t;
        f32x4 S[4][4];
#pragma unroll
        for (int mb = 0; mb < 4; ++mb)
#pragma unroll
            for (int nb = 0; nb < 4; ++nb) S[mb][nb] = (f32x4){0.f, 0.f, 0.f, 0.f};
#pragma unroll
        for (int ks = 0; ks < 2; ++ks) {
            bf16x8 a[4], bv[4];
#pragma unroll
            for (int mb = 0; mb < 4; ++mb) { const LAS bf16_t* p = kt + (32 * ks + 8 * g + q4) * RT_TS + h * 64 + 16 * mb + 4 * p4; a[mb] = cat8(tr16(p), tr16(p + 4 * RT_TS)); }
#pragma unroll
            for (int nb = 0; nb < 4; ++nb) { const LAS bf16_t* p = vt + (32 * ks + 8 * g + q4) * RT_TS + h * 64 + 16 * nb + 4 * p4; bv[nb] = cat8(tr16(p), tr16(p + 4 * RT_TS)); }
#pragma unroll
            for (int mb = 0; mb < 4; ++mb)
#pragma unroll
                for (int nb = 0; nb < 4; ++nb) S[mb][nb] = MFMA16(a[mb], bv[nb], S[mb][nb]);
        }
        bf16_t* sp = ST + st_off(b, h, d, c);
#pragma unroll
        for (int mb = 0; mb < 4; ++mb)
#pragma unroll
            for (int nb = 0; nb < 4; ++nb) { u32x2 w; w.x = pk2(S[mb][nb][0], S[mb][nb][1]); w.y = pk2(S[mb][nb][2], S[mb][nb][3]); *(u32x2*)(sp + (16 * nb + cq) * 64 + 16 * mb + 4 * g) = w; }
    }
}
DI int chunk_at(int d, int s) { return d == 0 ? s : (s < 4 ? 3 - s : NCHK + 3 - s); }
DI void ret_carry(const Ctx& C, int li, int gw, int ngw, int lane) {
    bf16_t* ST = C.RETS();
    for (int it = gw; it < 64 * 16; it += ngw) {
        const int chain = it >> 4, e0 = ((it & 15) * 64 + lane) * 4, d = chain & 1, h = (chain >> 1) & 3;
        const float gm = sigm(C.in(I_RETD)[(li * 2 + d) * 4 + h]), g64 = __powf(gm, 64.0f);
        const float fo = d ? g64 : gm, dc = g64, sc = d ? 1.0f : __powf(gm, 63.0f);
        const char* cb = (const char*)ST + (size_t)chain * NCHK * 8192; const unsigned voff = (unsigned)e0 * 2u;
        f32x4 S = (f32x4){0.f, 0.f, 0.f, 0.f};
#pragma unroll 1
        for (int s0 = 0; s0 < NCHK; s0 += NCHK / 2) {
            u32x2 w[NCHK / 2];
#pragma unroll
            for (int k = 0; k < NCHK / 2; ++k) w[k] = *(const u32x2*)(cb + (size_t)chunk_at(d, s0 + k) * 8192 + voff);
#pragma unroll
            for (int k = 0; k < NCHK / 2; ++k) { const f32x4 raw = (f32x4){lo_f(w[k].x), hi_f(w[k].x), lo_f(w[k].y), hi_f(w[k].y)};
                const f32x4 o = S * fo; u32x2 ow; ow.x = pk2(o[0], o[1]); ow.y = pk2(o[2], o[3]);
                *(u32x2*)((char*)cb + (size_t)chunk_at(d, s0 + k) * 8192 + voff) = ow;
                S = S * dc + raw * sc; }
        }
    }
}
DI void ret_pass2(const Ctx& C, int li, LAS unsigned char* lds, int wave, int lane) {
    LAS bf16_t* vt = (LAS bf16_t*)lds; LAS bf16_t* k0t = vt + 64 * RT_TS; LAS bf16_t* k1t = k0t + 64 * RT_TS;
    const int tid = wave * 64 + lane, cq = lane & 15, g = lane >> 4, q4 = cq >> 2, p4 = cq & 3, h = wave & 3, half = wave >> 2;
    const bf16_t* P = C.P(); const bf16_t* RP = C.RETP(); const bf16_t* ST = C.RETS(); bf16_t* O = C.O();
    for (int u = blockIdx.x; u < NB * NCHK; u += gridDim.x) {
        const int b = u / NCHK, c = u % NCHK; const size_t R0 = (size_t)b * LSEQ + 64 * c;
        if (li == DEPTH - 1 && c < 4) continue;
        __syncthreads();
        stage_tile64x256(vt, P + R0 * DIN + C_RTV, DIN, tid);
        stage_tile64x256(k0t, RP + 1 * RETP_T + R0 * 256, 256, tid);
        stage_tile64x256(k1t, RP + 3 * RETP_T + R0 * 256, 256, tid);
        bf16x8 sf[2][4][2];
#pragma unroll
        for (int d = 0; d < 2; ++d)
#pragma unroll
            for (int db = 0; db < 4; ++db) { const bf16_t* sp = ST + st_off(b, h, d, c) + (16 * db + cq) * 64 + 8 * g; sf[d][db][0] = ld16(sp); sf[d][db][1] = ld16(sp + 32); }
        __syncthreads();
#pragma unroll 1
        for (int ib = 2 * half; ib < 2 * half + 2; ++ib) {
            const size_t Ri = R0 + 16 * ib + cq;
            bf16x8 qb[2][2];
#pragma unroll
            for (int d = 0; d < 2; ++d)
#pragma unroll
                for (int ks = 0; ks < 2; ++ks) qb[d][ks] = ld16(RP + (size_t)(2 * d) * RETP_T + Ri * 256 + h * 64 + 32 * ks + 8 * g);
            u32x2 gq[4];
#pragma unroll
            for (int db = 0; db < 4; ++db) gq[db] = *(const u32x2*)(P + Ri * DIN + C_RTG + h * 64 + 16 * db + 4 * g);
            f32x4 pT[4];
#pragma unroll
            for (int jb = 0; jb < 4; ++jb) { const int kro = (16 * jb + cq) * RT_TS + h * 64 + 8 * g;
                f32x4 a0 = (f32x4){0.f, 0.f, 0.f, 0.f}, a1 = (f32x4){0.f, 0.f, 0.f, 0.f};
#pragma unroll
                for (int ks = 0; ks < 2; ++ks) { a0 = MFMA16(*(const LAS bf16x8*)(k0t + kro + 32 * ks), qb[0][ks], a0);
                                                 a1 = MFMA16(*(const LAS bf16x8*)(k1t + kro + 32 * ks), qb[1][ks], a1); }
#pragma unroll
                for (int e = 0; e < 4; ++e) { const int j = 16 * jb + 4 * g + e, i = 16 * ib + cq; pT[jb][e] = (j <= i ? a0[e] : 0.f) + (j >= i ? a1[e] : 0.f); } }
            const bf16x8 pb0 = pack8(pT[0], pT[1]), pb1 = pack8(pT[2], pT[3]);
            f32x4 o[4];
#pragma unroll
            for (int db = 0; db < 4; ++db) {
                const LAS bf16_t* base = vt + (4 * g + q4) * RT_TS + h * 64 + 16 * db + 4 * p4;
                const bf16x8 va0 = cat8(tr16(base), tr16(base + 16 * RT_TS)), va1 = cat8(tr16(base + 32 * RT_TS), tr16(base + 48 * RT_TS));
                o[db] = MFMA16(va0, pb0, ((f32x4){0.f, 0.f, 0.f, 0.f})); o[db] = MFMA16(va1, pb1, o[db]);
#pragma unroll
                for (int d = 0; d < 2; ++d) { o[db] = MFMA16(sf[d][db][0], qb[d][0], o[db]); o[db] = MFMA16(sf[d][db][1], qb[d][1], o[db]); }
            }
            float ss = 0.f;
#pragma unroll
            for (int db = 0; db < 4; ++db) ss += o[db][0] * o[db][0] + o[db][1] * o[db][1] + o[db][2] * o[db][2] + o[db][3] * o[db][3];
            ss += shx<16>(ss); ss += shx<32>(ss);
            const float rs = __builtin_amdgcn_rsqf(ss * (1.0f / 64.0f) + EPS);
#pragma unroll
            for (int db = 0; db < 4; ++db) { const u32x2 gw2 = gq[db];
                u32x2 w; w.x = pk2(o[db][0] * rs * silu_(lo_f(gw2.x)), o[db][1] * rs * silu_(hi_f(gw2.x))); w.y = pk2(o[db][2] * rs * silu_(lo_f(gw2.y)), o[db][3] * rs * silu_(hi_f(gw2.y)));
                *(u32x2*)(O + Ri * DM + 768 + h * 64 + 16 * db + 4 * g) = w; }
        }
    }
}


template <int CTRL> DI float dpp_mov0(float x) { return __int_as_float(__builtin_amdgcn_update_dpp(0, __float_as_int(x), CTRL, 0xf, 0xf, true)); }
DI float row_prefix(float x) { x += dpp_mov0<0x111>(x); x += dpp_mov0<0x112>(x); x += dpp_mov0<0x114>(x); x += dpp_mov0<0x118>(x); return x; }
DI float row_suffix(float x) { x += dpp_mov0<0x101>(x); x += dpp_mov0<0x102>(x); x += dpp_mov0<0x104>(x); x += dpp_mov0<0x108>(x); return x; }
DI void prep_hg(const Ctx& C, int li, int gw, int ngw, int lane) {
    const bf16_t* P = C.P(); bf16_t* HP = C.HGP(); float* DEC = C.HGDEC();
    const int t = lane & 15, cg = lane >> 4;
    for (int it = gw; it < NSUB * 8; it += ngw) {
        const int sc = it >> 3, ch0 = (it & 7) * 32 + 8 * cg; const size_t R = (size_t)sc * 16 + t;
        const u32x4 qw = *(const u32x4*)(P + R * DIN + C_HGQ + ch0), f0w = *(const u32x4*)(P + R * DIN + C_HGF + ch0), f1w = *(const u32x4*)(P + R * DIN + C_HGF + 256 + ch0);
        const f32x4 lb0 = *(const f32x4*)(C.lb() + li * 256 + ch0), lb1 = *(const f32x4*)(C.lb() + li * 256 + ch0 + 4);
        const float q[8] = {lo_f(qw.x), hi_f(qw.x), lo_f(qw.y), hi_f(qw.y), lo_f(qw.z), hi_f(qw.z), lo_f(qw.w), hi_f(qw.w)};
        const float f0[8] = {lo_f(f0w.x), hi_f(f0w.x), lo_f(f0w.y), hi_f(f0w.y), lo_f(f0w.z), hi_f(f0w.z), lo_f(f0w.w), hi_f(f0w.w)};
        const float f1[8] = {lo_f(f1w.x), hi_f(f1w.x), lo_f(f1w.y), hi_f(f1w.y), lo_f(f1w.z), hi_f(f1w.z), lo_f(f1w.w), hi_f(f1w.w)};
        float qd0[8], kd0[8], qd1[8], kd1[8], d0[8], d1[8];
#pragma unroll
        for (int e = 0; e < 8; ++e) { const float lb = e < 4 ? lb0[e] : lb1[e - 4];
            const float g0 = lb + (1.0f - lb) * sigm(f0[e]), g1 = lb + (1.0f - lb) * sigm(f1[e]), qs = silu_(q[e]);
            const float c0 = row_prefix(__logf(g0)), c1 = row_suffix(__logf(g1));
            qd0[e] = qs * __expf(c0); kd0[e] = (1.0f - g0) * __expf(fminf(-c0, 80.0f)); qd1[e] = qs * __expf(c1); kd1[e] = (1.0f - g1) * __expf(fminf(-c1, 80.0f));
            d0[e] = __expf(c0); d1[e] = __expf(c1); }
        const size_t o = R * 256 + ch0;
#define PK8V(a) ((u32x4){pk2(a[0], a[1]), pk2(a[2], a[3]), pk2(a[4], a[5]), pk2(a[6], a[7])})
        *(u32x4*)(HP + 0 * RETP_T + o) = PK8V(qd0); *(u32x4*)(HP + 1 * RETP_T + o) = PK8V(kd0); *(u32x4*)(HP + 2 * RETP_T + o) = PK8V(qd1); *(u32x4*)(HP + 3 * RETP_T + o) = PK8V(kd1);
#undef PK8V
        if (t == 15) { float* dp = DEC + (size_t)sc * 256 + ch0; *(f32x4*)dp = (f32x4){d0[0], d0[1], d0[2], d0[3]}; *(f32x4*)(dp + 4) = (f32x4){d0[4], d0[5], d0[6], d0[7]}; }
        if (t == 0) { float* dp = DEC + ((size_t)NSUB + sc) * 256 + ch0; *(f32x4*)dp = (f32x4){d1[0], d1[1], d1[2], d1[3]}; *(f32x4*)(dp + 4) = (f32x4){d1[4], d1[5], d1[6], d1[7]}; }
    }
}
DI void hg_state_step(f32x4 (&S)[4][4], const LAS bf16_t* kt, const LAS bf16_t* vt, int n, int h, int cq, int g, int q4, int p4, const float* dec  ) {
    const int r1 = 16 * n + ((8 * g + q4) & 15), r2 = 16 * n + ((8 * g + 4 + q4) & 15);
    bf16x8 a[4], bv[4];
#pragma unroll
    for (int mb = 0; mb < 4; ++mb) { const int co = h * 64 + 16 * mb + 4 * p4; a[mb] = cat8(tr16(kt + r1 * RT_TS + co), tr16(kt + r2 * RT_TS + co)); }
#pragma unroll
    for (int nb = 0; nb < 4; ++nb) { const int co = h * 64 + 16 * nb + 4 * p4; const bf16x8 v = cat8(tr16(vt + r1 * RT_TS + co), tr16(vt + r2 * RT_TS + co)); bv[nb] = (g < 2) ? v : (bf16x8){0, 0, 0, 0, 0, 0, 0, 0}; }
#pragma unroll
    for (int mb = 0; mb < 4; ++mb) { const f32x4 dv4 = *(const f32x4*)(dec + h * 64 + 16 * mb + 4 * g);
#pragma unroll
        for (int nb = 0; nb < 4; ++nb) { S[mb][nb] = MFMA16(a[mb], bv[nb], S[mb][nb]); S[mb][nb] = S[mb][nb] * dv4; } }
}
DI void hg_pass1(const Ctx& C, LAS unsigned char* lds, int wave, int lane) {
    LAS bf16_t* vt = (LAS bf16_t*)lds; LAS bf16_t* k0t = vt + 64 * RT_TS; LAS bf16_t* k1t = k0t + 64 * RT_TS;
    const int tid = wave * 64 + lane, cq = lane & 15, g = lane >> 4, q4 = cq >> 2, p4 = cq & 3, h = wave & 3, d = wave >> 2;
    const bf16_t* P = C.P(); const bf16_t* HP = C.HGP(); bf16_t* ST = C.HGS(); const float* DEC = C.HGDEC() + (size_t)d * NSUB * 256;
    for (int U = (int)blockIdx.x + ((NB * NCHK - (int)blockIdx.x + (int)gridDim.x - 1) / (int)gridDim.x) * (int)gridDim.x; U < 2 * NB * NCHK; U += gridDim.x) {
        const int u = U - NB * NCHK, b = u / NCHK, c = u % NCHK; const size_t R0 = (size_t)b * LSEQ + 64 * c;
        __syncthreads();
        stage_tile64x256(vt, P + R0 * DIN + C_HGI, DIN, tid);
        stage_tile64x256(k0t, HP + 1 * RETP_T + R0 * 256, 256, tid);
        stage_tile64x256(k1t, HP + 3 * RETP_T + R0 * 256, 256, tid);
        __syncthreads();
        const LAS bf16_t* kt = d ? k1t : k0t;
        f32x4 S[4][4];
#pragma unroll
        for (int mb = 0; mb < 4; ++mb)
#pragma unroll
            for (int nb = 0; nb < 4; ++nb) S[mb][nb] = (f32x4){0.f, 0.f, 0.f, 0.f};
#pragma unroll 1
        for (int sidx = 0; sidx < 4; ++sidx) { const int n = d ? 3 - sidx : sidx;
            hg_state_step(S, kt, vt, n, h, cq, g, q4, p4, DEC + (R0 / 16 + n) * 256); }
        if (lane < 16) { const float* dp = DEC + (R0 / 16) * 256 + h * 64 + 4 * lane;
            *(f32x4*)(C.HGDT() + ((size_t)(((b * 4 + h) * 2 + d) * NCHK + c)) * 64 + 4 * lane) = *(const f32x4*)dp * *(const f32x4*)(dp + 256) * *(const f32x4*)(dp + 512) * *(const f32x4*)(dp + 768); }
        bf16_t* sp = ST + st_off(b, h, d, c);
#pragma unroll
        for (int mb = 0; mb < 4; ++mb)
#pragma unroll
            for (int nb = 0; nb < 4; ++nb) { u32x2 w; w.x = pk2(S[mb][nb][0], S[mb][nb][1]); w.y = pk2(S[mb][nb][2], S[mb][nb][3]); *(u32x2*)(sp + (16 * nb + cq) * 64 + 16 * mb + 4 * g) = w; }
    }
}
DI void hg_carry(const Ctx& C, int gw, int ngw, int lane) {
    bf16_t* ST = C.HGS();
    for (int it = gw; it < 64 * 16; it += ngw) {
        const int chain = it >> 4, e0 = ((it & 15) * 64 + lane) * 4, d = chain & 1, dk0 = e0 & 63;
        const char* DTb = (const char*)(C.HGDT() + (size_t)chain * NCHK * 64); const unsigned doff = (unsigned)dk0 * 4u;
        const char* cb = (const char*)ST + (size_t)chain * NCHK * 8192; const unsigned voff = (unsigned)e0 * 2u;
        f32x4 S = (f32x4){0.f, 0.f, 0.f, 0.f};
#pragma unroll 1
        for (int s0 = 0; s0 < NCHK; s0 += NCHK / 4) {
            u32x2 w[NCHK / 4]; f32x4 dt[NCHK / 4];
#pragma unroll
            for (int k = 0; k < NCHK / 4; ++k) { const int c = chunk_at(d, s0 + k); w[k] = *(const u32x2*)(cb + (size_t)c * 8192 + voff); dt[k] = *(const f32x4*)(DTb + (size_t)c * 256 + doff); }
#pragma unroll
            for (int k = 0; k < NCHK / 4; ++k) { const f32x4 raw = (f32x4){lo_f(w[k].x), hi_f(w[k].x), lo_f(w[k].y), hi_f(w[k].y)};
                u32x2 ow; ow.x = pk2(S[0], S[1]); ow.y = pk2(S[2], S[3]);
                *(u32x2*)((char*)cb + (size_t)chunk_at(d, s0 + k) * 8192 + voff) = ow;
                S = S * dt[k] + raw; }
        }
    }
}
DI void hg_pass2(const Ctx& C, int li, LAS unsigned char* lds, int wave, int lane) {
    LAS bf16_t* vt = (LAS bf16_t*)lds; LAS bf16_t* k0t = vt + 64 * RT_TS; LAS bf16_t* k1t = k0t + 64 * RT_TS;
    const int tid = wave * 64 + lane, cq = lane & 15, g = lane >> 4, q4 = cq >> 2, p4 = cq & 3, h = wave & 3, d = wave >> 2;
    const bf16_t* P = C.P(); const bf16_t* HP = C.HGP(); const bf16_t* ST = C.HGS(); const float* DEC = C.HGDEC() + (size_t)d * NSUB * 256;
    const bf16_t* QD = HP + (size_t)(2 * d) * RETP_T; const bf16_t* KD = HP + (size_t)(2 * d + 1) * RETP_T;
    bf16_t* OUT = C.OHGB() + (size_t)d * NTOK * 256;
    for (int U = (int)blockIdx.x + ((NB * NCHK - (int)blockIdx.x + (int)gridDim.x - 1) / (int)gridDim.x) * (int)gridDim.x; U < 2 * NB * NCHK; U += gridDim.x) {
        const int u = U - NB * NCHK, b = u / NCHK, c = u % NCHK; const size_t R0 = (size_t)b * LSEQ + 64 * c;
        if (li == DEPTH - 1 && c < 4) continue;
        __syncthreads();
        stage_tile64x256(vt, P + R0 * DIN + C_HGI, DIN, tid);
        stage_tile64x256(k0t, HP + 1 * RETP_T + R0 * 256, 256, tid);
        stage_tile64x256(k1t, HP + 3 * RETP_T + R0 * 256, 256, tid);
        __syncthreads();
        const LAS bf16_t* kt = d ? k1t : k0t;
        f32x4 S[4][4];
        { const bf16_t* sp = ST + st_off(b, h, d, c);
#pragma unroll
          for (int mb = 0; mb < 4; ++mb)
#pragma unroll
            for (int nb = 0; nb < 4; ++nb) { const u32x2 w = *(const u32x2*)(sp + (16 * nb + cq) * 64 + 16 * mb + 4 * g); S[mb][nb] = (f32x4){lo_f(w.x), hi_f(w.x), lo_f(w.y), hi_f(w.y)}; } }
#pragma unroll 1
        for (int sidx = 0; sidx < 4; ++sidx) { const int n = d ? 3 - sidx : sidx;
            const size_t Rt = R0 + 16 * n + cq;
            f32x4 at = (f32x4){0.f, 0.f, 0.f, 0.f};
#pragma unroll
            for (int ks = 0; ks < 2; ++ks) at = MFMA16(*(const LAS bf16x8*)(kt + (16 * n + cq) * RT_TS + h * 64 + 32 * ks + 8 * g), ld16(QD + Rt * 256 + h * 64 + 32 * ks + 8 * g), at);
#pragma unroll
            for (int e = 0; e < 4; ++e) { const int j = 4 * g + e; at[e] = (d == 0 ? (j <= cq) : (j >= cq)) ? at[e] : 0.f; }
            const bf16x8 pb = pack8(at, ((f32x4){0.f, 0.f, 0.f, 0.f}));
            bf16x8 qc[2];
#pragma unroll
            for (int s2 = 0; s2 < 2; ++s2) { const bf16_t* qp = QD + Rt * 256 + h * 64 + 32 * s2 + 4 * g; qc[s2] = cat8(*(const s16x4*)qp, *(const s16x4*)(qp + 16)); }
            f32x4 o[4];
#pragma unroll
            for (int db = 0; db < 4; ++db) {
                const s16x4 vv = tr16(vt + (16 * n + 4 * g + q4) * RT_TS + h * 64 + 16 * db + 4 * p4);
                o[db] = MFMA16(cat8(vv, vv), pb, ((f32x4){0.f, 0.f, 0.f, 0.f}));
                o[db] = MFMA16(pack8(S[0][db], S[1][db]), qc[0], o[db]); o[db] = MFMA16(pack8(S[2][db], S[3][db]), qc[1], o[db]);
                { u32x2 w; w.x = pk2(o[db][0], o[db][1]); w.y = pk2(o[db][2], o[db][3]); *(u32x2*)(OUT + Rt * 256 + h * 64 + 16 * db + 4 * g) = w; } }
            if (sidx < 3) hg_state_step(S, kt, vt, n, h, cq, g, q4, p4, DEC + (R0 / 16 + n) * 256);
        }
    }
}

DI void phase_mix(const Ctx& C, int li, LAS unsigned char* lds, int gw, int ngw, int wave, int lane) {
    LAS bf16_t* vl = (LAS bf16_t*)(lds + 8192 + wave * (64 * NA_VS * 2));
    LAS float* rpbt = (LAS float*)(lds + 8192 + 8 * (64 * NA_VS * 2));
    for (int i = wave * 64 + lane; i < 4 * 465; i += 512) rpbt[i] = C.in(I_RPB)[(size_t)li * 4 * 465 + i];
    __syncthreads();
    const int G = (int)gridDim.x;
    if ((G & 7) == 0 && G >= 8) {
        const int xb = (int)blockIdx.x & 7, nxw = (G >> 3) * 8, xw = ((int)blockIdx.x >> 3) * 8 + wave;
        for (int b = xb; b < NB; b += 8)
            for (int h = 0; h < 4; ++h) {
                for (int rc = xw; rc < 256; rc += nxw) na_unit(C, li, ((b * 64 + (rc >> 2)) * 4 + h) * 4 + (rc & 3), false, lane, vl, rpbt);
                if (li == 0) for (int cg = xw; cg < 16; cg += nxw) na_unit(C, li, (b * 4 + h) * 16 + cg, true, lane, vl, rpbt);
            }
    } else {
        const int nNA = NB * 64 * 4 * 4, nNAc = (li == 0) ? NB * 4 * 16 : 0;
        for (int it = gw; it < nNA + nNAc; it += ngw) { if (it < nNA) na_unit(C, li, it, false, lane, vl, rpbt); else na_unit(C, li, it - nNA, true, lane, vl, rpbt); }
    }
}
DI void phase_fin(const Ctx& C, int li, int gw, int ngw, int lane) {
    const int c0 = 4 * lane;
    const f32x4 hw = *(const f32x4*)(C.in(I_HGNW) + li * 64 + (c0 & 63));
    const bf16_t* OH = C.OHGB();
    for (int R0 = gw; R0 < NTOK; R0 += 4 * ngw) {
        u32x2 w0q[4], w1q[4], gq[4];
#pragma unroll
        for (int q = 0; q < 4; ++q) { const int Ri = R0 + q * ngw; if (Ri < NTOK) { const size_t R = (size_t)Ri;
            w0q[q] = *(const u32x2*)(OH + R * 256 + c0); w1q[q] = *(const u32x2*)(OH + ((size_t)NTOK + R) * 256 + c0); gq[q] = *(const u32x2*)(C.P() + R * DIN + C_HGG + c0); } }
#pragma unroll
        for (int q = 0; q < 4; ++q) { const int Ri = R0 + q * ngw; if (Ri >= NTOK) continue; const size_t R = (size_t)Ri;
            if (li == DEPTH - 1 && (Ri % LSEQ) < CTXL) continue;
            const u32x2 w0 = w0q[q], w1 = w1q[q], gw2 = gq[q];
            const f32x4 a = (f32x4){lo_f(w0.x) + lo_f(w1.x), hi_f(w0.x) + hi_f(w1.x), lo_f(w0.y) + lo_f(w1.y), hi_f(w0.y) + hi_f(w1.y)};
            float ss = a[0] * a[0] + a[1] * a[1] + a[2] * a[2] + a[3] * a[3];
            ss += shx<1>(ss); ss += shx<2>(ss); ss += shx<4>(ss); ss += shx<8>(ss);
            const float rs = __builtin_amdgcn_rsqf(ss * (1.0f / 64.0f) + EPS);
            u32x2 oo; oo.x = pk2(a[0] * rs * hw[0] * silu_(lo_f(gw2.x)), a[1] * rs * hw[1] * silu_(hi_f(gw2.x))); oo.y = pk2(a[2] * rs * hw[2] * silu_(lo_f(gw2.y)), a[3] * rs * hw[3] * silu_(hi_f(gw2.y)));
            *(u32x2*)(C.O() + R * DM + 512 + c0) = oo; }
    }
}

struct Args { const float* in[N_IN]; float* out; unsigned char* ws; int ph_lo, ph_hi, bar_region, pad; };
constexpr int NPL = 13, PH_TOTAL = 2 + DEPTH * NPL;

__global__ void __launch_bounds__(512, 2) fwd(Args args) {
    extern __shared__ __attribute__((aligned(16))) unsigned char lds_raw[];
    LAS unsigned char* lds = (LAS unsigned char*)lds_raw;
    const int G = gridDim.x, ngw = G * 8;
    const int wave_id = __builtin_amdgcn_readfirstlane((int)threadIdx.x >> 6);
#define PHASE_IDS int wv_ = wave_id; asm volatile("" : "+s"(wv_)); int ln_ = lane_id(); asm volatile("" : "+v"(ln_)); const int lane = ln_, wave = wv_, gw = blockIdx.x * 8 + wave; (void)lane; (void)gw;
    { int t0 = wave_id * 64 + lane_id(); asm volatile("" : "+v"(t0)); for (int u = t0; u < (LDS_BYTES - LDSCTL_OFF) / 4; u += 512) ((LAS unsigned*)(lds + LDSCTL_OFF))[u] = 0u; }
    __syncthreads();
    int lo, hi; XcdBarrier bar;
    { const Ctx C0{kargs()}; lo = *(const __attribute__((address_space(4))) int*)(C0.ka + 8 * N_IN + 16); hi = *(const __attribute__((address_space(4))) int*)(C0.ka + 8 * N_IN + 20);
      bar.bar = (unsigned*)(C0.ws() + WS_CTL) + 4096 + *(const __attribute__((address_space(4))) int*)(C0.ka + 8 * N_IN + 24) * XCD_BAR_WORDS; bar.x = 0; bar.st = nullptr; bar.wave = wave_id;
      if (hi - lo > 1) bar = xcd_barrier_post(bar.bar, (volatile LAS unsigned*)(lds + MISC_OFF + 32), wave_id); }
#define IN(k) (lo <= (k) && (k) < hi)
#ifndef PH_MASK
#define PH_MASK 0xFFFF
#endif
#define PH_EN(k) (((PH_MASK) >> (k)) & 1)
#define SEAM(k) do { if ((k) + 1 < hi) xcd_barrier(bar); } while (0)
#ifndef PROBE_DUP
#define PROBE_DUP 0
#endif
#define REPS(k) for (int rep_ = 0; rep_ < ((((PROBE_DUP) >> (k)) & 1) ? 2 : 1); ++rep_)
#define REP_BAR(k) do { if ((((PROBE_DUP) >> (k)) & 1) && rep_ == 0) xcd_barrier(bar); } while (0)

#ifndef NO_PRO
    if (IN(0)) { const Ctx C{kargs()}; PHASE_IDS phase_prologue(C, lds, gw, ngw, wave, lane);
#ifdef PROBE_PRO
        xcd_barrier(bar); phase_prologue(C, lds, gw, ngw, wave, lane);
#endif
        SEAM(0); }
#endif

    for (int li = 0; li < DEPTH; ++li) {
        const int pb = 1 + li * NPL;
        if (PH_EN(0) && IN(pb + 0)) { REPS(0) {
            const Ctx C{kargs()}; PHASE_IDS
#ifdef PROBE_A1
            if (li == 1) { phase_norm1(C, li, gw, ngw, lane, (float*)C.P()); xcd_barrier(bar); }
#endif
            phase_norm1(C, li, gw, ngw, lane, C.X());
#ifdef PROBE_A0
            if (li == 0) { xcd_barrier(bar); phase_norm1(C, li, gw, ngw, lane, C.X()); }
#endif
            REP_BAR(0); } SEAM(pb + 0);
        }
        if (PH_EN(1) && IN(pb + 1)) { REPS(1) {
            const Ctx C{kargs()}; PHASE_IDS
            { SchedWin S{(unsigned)WS_H, (unsigned)(WS_WIN + (size_t)li * DIN * DM * 2), G, (int)blockIdx.x, C_GATE / 256, (unsigned)(DM * 2)};
              EpiP E{C.P(), DIN};
              pg8::gemm_phase<EpiP, SchedWin>(lds, wave, lane, (const char*)C.ws(), DM, DM, DM, S, E); }
            { const Ctx C2{kargs()}; int wv2 = wave_id; asm volatile("" : "+s"(wv2)); int ln2 = lane_id(); asm volatile("" : "+v"(ln2));
              SchedWin S{(unsigned)WS_H8, (unsigned)(WS_WIN + (size_t)li * DIN * DM * 2 + WS_WIN8_OFF), G, (int)blockIdx.x, 16, (unsigned)DM};
              EpiSig8 E{(unsigned char*)C2.P()};
              pg8::gemm_phase<EpiSig8, SchedWin, true>(lds, wv2, ln2, (const char*)C2.ws(), DM / 2, DM / 2, DM / 2, S, E); }
            REP_BAR(1); } SEAM(pb + 1);
        }
        if (PH_EN(2) && IN(pb + 2)) { REPS(2) { const Ctx C{kargs()}; PHASE_IDS phase_prep(C, li, gw, ngw, lane); prep_ret(C, li, gw, ngw, lane); prep_hg(C, li, gw, ngw, lane); prep_s5(C, gw, ngw, lane);
#if defined(PROBE_PREP) && PROBE_PREP == 1
            phase_prep(C, li, gw, ngw, lane);
#elif defined(PROBE_PREP) && PROBE_PREP == 2
            prep_ret(C, li, gw, ngw, lane);
#elif defined(PROBE_PREP) && PROBE_PREP == 3
            prep_hg(C, li, gw, ngw, lane);
#elif defined(PROBE_PREP) && PROBE_PREP == 4
            prep_s5(C, gw, ngw, lane);
#endif
            REP_BAR(2); } SEAM(pb + 2); }
        if (PH_EN(3) && IN(pb + 3)) { REPS(3) {
            const Ctx C{kargs()}; PHASE_IDS
            ret_pass1(C, lds, wave, lane); __syncthreads();
            hg_pass1(C, lds, wave, lane); __syncthreads();
#ifdef PROBE_P1
            xcd_barrier(bar); ret_pass1(C, lds, wave, lane); __syncthreads(); hg_pass1(C, lds, wave, lane); __syncthreads(); xcd_barrier(bar);
#endif
            phase_mix(C, li, lds, gw, ngw, wave, lane); __syncthreads();
#ifdef PROBE_NA
            xcd_barrier(bar); phase_mix(C, li, lds, gw, ngw, wave, lane); __syncthreads(); xcd_barrier(bar);
#endif
            { const Ctx C{kargs()}; PHASE_IDS SchedS5 S{(unsigned)WS_UG, (unsigned)(WS_S5W1 + (size_t)li * 16 * 65536 * 2), G, (int)blockIdx.x, 65536u * 2u}; EpiS5S E{C.S5S()};
              pg8::gemm_phase<EpiS5S, SchedS5>(lds, wave, lane, (const char*)C.ws(), 256, 512, 256, S, E); }
            REP_BAR(3); } SEAM(pb + 3); }
        if (PH_EN(4) && IN(pb + 4)) { REPS(4) { const Ctx C{kargs()}; PHASE_IDS ret_carry(C, li, gw, ngw, lane); hg_carry(C, gw, ngw, lane); s5_carry(C, li, gw, ngw, lane); convert_experts(C, li, 1280 % ngw, gw, ngw, (LAS float*)(lds + 40960 + wave * 8704), lane);     REP_BAR(4); } SEAM(pb + 4); }
        if (PH_EN(5) && IN(pb + 5)) { REPS(5) { const Ctx C{kargs()}; PHASE_IDS ret_pass2(C, li, lds, wave, lane); __syncthreads(); hg_pass2(C, li, lds, wave, lane); __syncthreads();
            { const Ctx C{kargs()}; PHASE_IDS SchedS5 S{(unsigned)WS_UG, (unsigned)(WS_S5W2 + (size_t)li * 16 * 131072 * 2), G, (int)blockIdx.x, 131072u * 2u}; EpiS5Z E{C.Z()};
              pg8::gemm_phase<EpiS5Z, SchedS5>(lds, wave, lane, (const char*)C.ws(), 512, 512, 512, S, E); }
            REP_BAR(5); } SEAM(pb + 5); }
        if (PH_EN(6) && IN(pb + 6)) { REPS(6) { const Ctx C{kargs()}; PHASE_IDS phase_fin(C, li, gw, ngw, lane);
            { const Ctx C{kargs()}; PHASE_IDS SchedGlu S{(unsigned)WS_Z, (unsigned)(WS_GLUT + (size_t)li * 65536 * 2), G, (int)blockIdx.x, li}; EpiGlu E{C.O(), C.Z()};
              pg8::gemm_phase<EpiGlu, SchedGlu>(lds, wave, lane, (const char*)C.ws(), 256, 256, 256, S, E); }
            REP_BAR(6); } SEAM(pb + 6); }
        if (PH_EN(7) && IN(pb + 7)) { REPS(7) {
            const Ctx C{kargs()}; PHASE_IDS
            SchedMerge S{(unsigned)WS_O, (unsigned)(WS_WBR + (size_t)li * DM * DM * 2), G, (int)blockIdx.x, li};
            EpiMerge E{C.MB(), (const unsigned char*)C.P()};
            pg8::gemm_phase<EpiMerge, SchedMerge, false, 1>(lds, wave, lane, (const char*)C.ws(), DM, DM, DM, S, E);
            REP_BAR(7); } SEAM(pb + 7);
        }
        if (PH_EN(8) && IN(pb + 8)) { REPS(8) {
            const Ctx C{kargs()}; PHASE_IDS
            SchedOut S{(unsigned)WS_MB, (unsigned)(WS_WOUT + (size_t)li * DM * DM * 2), G, (int)blockIdx.x, li};
#ifdef PROBE_D2
            { EpiResid E0{C.X(), C.mod() + li * 9 * 6144, (float*)C.P(), li == 0 ? C.in(I_X) : nullptr, li == 0 ? C.in(I_CTX) : nullptr}; pg8::gemm_phase<EpiResid, SchedOut>(lds, wave, lane, (const char*)C.ws(), DM, DM, DM, S, E0); xcd_barrier(bar); }
#endif
            EpiResid E{C.X(), C.mod() + li * 9 * 6144, C.X(), li == 0 ? C.in(I_X) : nullptr, li == 0 ? C.in(I_CTX) : nullptr};
            pg8::gemm_phase<EpiResid, SchedOut>(lds, wave, lane, (const char*)C.ws(), DM, DM, DM, S, E);
            REP_BAR(8); } SEAM(pb + 8);
        }
        if (PH_EN(9) && IN(pb + 9)) { REPS(9) { const Ctx C{kargs()}; PHASE_IDS phase_norm2(C, li, lds, gw, ngw, wave, lane); REP_BAR(9); } SEAM(pb + 9); }
        if (PH_EN(10) && IN(pb + 10)) { REPS(10) { const Ctx C{kargs()}; PHASE_IDS phase_topk(C, li, lds, wave, lane); REP_BAR(10); } SEAM(pb + 10); }
        if (PH_EN(11) && IN(pb + 11)) { REPS(11) {
            const Ctx C{kargs()}; PHASE_IDS
            SchedE1 S{(unsigned)WS_XE, (unsigned)WS_EXW, G, (int)blockIdx.x, li == 0 ? 17 : 16};
            EpiSwiGLU E{(unsigned char*)C.P()};
            pg8::gemm_phase<EpiSwiGLU, SchedE1, true>(lds, wave, lane, (const char*)C.ws(), DM / 2, DM / 2, DM / 2, S, E);
            REP_BAR(11); } SEAM(pb + 11);
        }
        if (PH_EN(12) && IN(pb + 12)) { REPS(12) {
            const Ctx C{kargs()}; PHASE_IDS
            SchedE2 S{(unsigned)WS_P, (unsigned)WS_W2T, G, (int)blockIdx.x, li == 0 ? 17 : 16};
            EpiExpOut E{C.XE(), C.gate()};
            pg8::gemm_phase<EpiExpOut, SchedE2, true>(lds, wave, lane, (const char*)C.ws(), DF / 2, DF / 2, DF / 2, S, E);
            REP_BAR(12); } SEAM(pb + 12);
        }
    }
    if (IN(PH_TOTAL - 1)) { const Ctx C{kargs()}; PHASE_IDS phase_final(C, gw, ngw, lane);
#ifdef PROBE_FINAL
        xcd_barrier(bar); phase_final(C, gw, ngw, lane);
#endif
    }
#undef IN
#undef SEAM
}

extern "C" void kernel_launch(void* const* d_in, const int* in_sizes, int n_in, void* d_out, int out_size, void* d_ws, size_t ws_size, hipStream_t stream) {
    static int grid = 0;
    if (grid == 0) {
        if (n_in != N_IN || ws_size < WS_END) { fprintf(stderr, "kernel_launch: unexpected n_in %d or ws_size %zu (need %zu)\n", n_in, ws_size, (size_t)WS_END); grid = -1; return; }
        int dev = 0, cus = 0, per_cu = 0;
        if (hipGetDevice(&dev) != hipSuccess || hipDeviceGetAttribute(&cus, hipDeviceAttributeMultiprocessorCount, dev) != hipSuccess) { grid = -1; return; }
        if (hipFuncSetAttribute((const void*)fwd, hipFuncAttributeMaxDynamicSharedMemorySize, LDS_BYTES) != hipSuccess) { fprintf(stderr, "kernel_launch: hipFuncSetAttribute failed\n"); grid = -1; return; }
        if (hipOccupancyMaxActiveBlocksPerMultiprocessor(&per_cu, (const void*)fwd, 512, LDS_BYTES) != hipSuccess || per_cu < 1) fprintf(stderr, "kernel_launch: occupancy query says %d\n", per_cu);
        (void)hipGetLastError();
        grid = cus;
    }
    if (grid < 0) return;
    (void)hipMemsetAsync((char*)d_ws + WS_CTL, 0, CTL_ZERO_BYTES, stream);
    Args a{};
    for (int i = 0; i < N_IN; ++i) a.in[i] = (const float*)d_in[i];
    a.out = (float*)d_out; a.ws = (unsigned char*)d_ws;
#if MK_PER_PHASE
    for (int p = 0; p < PH_TOTAL; ++p) { a.ph_lo = p; a.ph_hi = p + 1; a.bar_region = 0; hipLaunchKernelGGL(fwd, dim3(grid), dim3(512), LDS_BYTES, stream, a); }
#elif defined(PROBE_PH)
    a.ph_lo = 0; a.ph_hi = PROBE_PH + 1; a.bar_region = 0; hipLaunchKernelGGL(fwd, dim3(grid), dim3(512), LDS_BYTES, stream, a);
    a.ph_lo = PROBE_PH; a.ph_hi = PROBE_PH + 1; a.bar_region = 1; hipLaunchKernelGGL(fwd, dim3(grid), dim3(512), LDS_BYTES, stream, a);
    a.ph_lo = PROBE_PH + 1; a.ph_hi = PH_TOTAL; a.bar_region = 2; hipLaunchKernelGGL(fwd, dim3(grid), dim3(512), LDS_BYTES, stream, a);
#elif defined(PROBE_CUT)
    a.ph_lo = 0; a.ph_hi = PROBE_CUT + 1; a.bar_region = 0; hipLaunchKernelGGL(fwd, dim3(grid), dim3(512), LDS_BYTES, stream, a);
    a.ph_lo = PROBE_CUT + 1; a.ph_hi = PH_TOTAL; a.bar_region = 2; hipLaunchKernelGGL(fwd, dim3(grid), dim3(512), LDS_BYTES, stream, a);
#else
    a.ph_lo = 0; a.ph_hi = PH_TOTAL; a.bar_region = 0;
    hipLaunchKernelGGL(fwd, dim3(grid), dim3(512), LDS_BYTES, stream, a);
#endif
}
```

```cpp
#include <hip/hip_runtime.h>
#include <cstdio>
#include <cstdint>

#ifndef MK_PER_PHASE
#define MK_PER_PHASE 0
#endif

#define LAS __attribute__((address_space(3)))
#define DI __device__ __forceinline__
typedef unsigned short bf16_t;
typedef short bf16x8 __attribute__((ext_vector_type(8)));
typedef float f32x4 __attribute__((ext_vector_type(4)));
typedef float f32x2 __attribute__((ext_vector_type(2)));
typedef unsigned u32x4 __attribute__((ext_vector_type(4)));
typedef unsigned u32x2 __attribute__((ext_vector_type(2)));

constexpr int DM = 1024, NB = 8, SEQ = 4096, CTXL = 256, LSEQ = SEQ + CTXL, NTOK = NB * LSEQ, DIN = 7424, NE = 16, DF = 2816, DEPTH = 2;
constexpr int CAP_L = 512, CAP_C = 32, EROWS = NB * CAP_L + NB * CAP_C;
constexpr float EPS = 1e-6f;
constexpr int C_S5U = 0, C_NAQ = 256, C_NAK = 512, C_NAV = 768, C_HGQ = 1024, C_HGF = 1280, C_HGI = 1792, C_HGG = 2048, C_RTQ = 2304, C_RTK = 2560, C_RTV = 2816, C_RTG = 3072, C_GATE = 3328;
enum { I_X = 0, I_C, I_CTX, I_CCTX, I_ADAW, I_ADAB, I_NMIX, I_NFFN, I_WIN, I_LRE, I_LIM, I_LSTEP, I_BRE, I_BIM, I_CRE, I_CIM, I_S5D, I_GLU, I_NAQN, I_NAKN, I_RPB, I_HGLB, I_HGNW, I_RETD, I_WBR, I_WOUT, I_RW, I_EWG, I_EWU, I_EWD, N_IN };

constexpr size_t MiB = 1u << 20;
constexpr size_t WS_CTL = 0, CTL_ZERO_BYTES = 1 * MiB;
constexpr size_t WS_MOD = 1 * MiB;
constexpr size_t WS_LB = 1 * MiB + 512 * 1024;
constexpr size_t WS_AFF = 2 * MiB;
constexpr size_t WS_SEL = 5 * MiB;
constexpr size_t WS_GATE = 8 * MiB;
constexpr size_t WS_WBR = 10 * MiB;
constexpr size_t WS_WOUT = 14 * MiB;
constexpr size_t WS_WIN = 18 * MiB;
constexpr size_t WS_X = 48 * MiB;
constexpr size_t WS_H = 184 * MiB;
constexpr size_t WS_O = 252 * MiB;
constexpr size_t WS_MB = 320 * MiB;
constexpr size_t WS_P = 388 * MiB;
constexpr size_t WS_XE = 881 * MiB;
constexpr size_t WS_EXW = 1017 * MiB;
constexpr size_t WS_W2T = WS_EXW + (size_t)NE * 5632 * 1024;
constexpr size_t WS_QKN = 1281 * MiB;
constexpr size_t WS_RETS = 1315 * MiB;
constexpr size_t WS_HGS = 1349 * MiB;
constexpr size_t WS_HGDEC = 1383 * MiB;
constexpr size_t WS_S5W1 = 1388 * MiB;
constexpr size_t WS_S5W2 = 1392 * MiB;
constexpr size_t WS_GLUT = 1400 * MiB;
constexpr size_t WS_HGDT = 1401 * MiB;
constexpr size_t WS_END = 1403 * MiB;
constexpr int S5CH = NTOK / 16, S5ROWS = 2304;
constexpr size_t WS_UG = WS_XE;
constexpr size_t WS_S5S = WS_XE + 36 * MiB;
constexpr size_t WS_OHG = WS_XE + 72 * MiB;
constexpr size_t WS_Z = WS_QKN;
constexpr size_t WS_HGP = WS_MB;
constexpr int NSUB = NTOK / 16;
constexpr size_t WS_H8 = WS_O;
constexpr size_t WS_WIN8_OFF = (size_t)C_GATE * DM * 2;
constexpr size_t WS_RETP = WS_H;
constexpr size_t RETP_T = (size_t)NTOK * 256;
constexpr int NCHK = LSEQ / 64;
static_assert(WS_W2T + (size_t)NE * 1024 * DF * 2 <= WS_QKN, "ws map");
static_assert(WS_P + (size_t)NTOK * DIN * 2 <= WS_XE && WS_XE + (size_t)NE * EROWS * 1024 * 2 <= WS_EXW, "ws map");

constexpr int RING_BYTES = 131072, LDSCTL_OFF = RING_BYTES, MISC_OFF = LDSCTL_OFF + 320, LDS_BYTES = 147456;

DI float bf2f(unsigned short h) { return __uint_as_float(((unsigned)h) << 16); }
DI float lo_f(unsigned w) { return __uint_as_float(w << 16); }
DI float hi_f(unsigned w) { return __uint_as_float(w & 0xffff0000u); }
DI unsigned f2bf(float f) { unsigned u = __float_as_uint(f); return (u + 0x7fffu + ((u >> 16) & 1u)) >> 16; }
DI unsigned pk2(float lo, float hi) { return f2bf(lo) | (f2bf(hi) << 16); }
DI unsigned pk4_fp8(float a, float b, float c, float d) {
    a = __builtin_amdgcn_fmed3f(a, -448.f, 448.f); b = __builtin_amdgcn_fmed3f(b, -448.f, 448.f); c = __builtin_amdgcn_fmed3f(c, -448.f, 448.f); d = __builtin_amdgcn_fmed3f(d, -448.f, 448.f);
    int p = 0; p = __builtin_amdgcn_cvt_pk_fp8_f32(a, b, p, false); p = __builtin_amdgcn_cvt_pk_fp8_f32(c, d, p, true); return (unsigned)p; }
DI int lane_id() { int l; asm volatile("v_mbcnt_lo_u32_b32 %0, -1, 0\n\tv_mbcnt_hi_u32_b32 %0, -1, %0" : "=v"(l)); return l; }
template <int M> DI float shx(float v) {
    if constexpr (M < 32) return __int_as_float(__builtin_amdgcn_ds_swizzle(__float_as_int(v), 0x1f | (M << 10)));
    else return __int_as_float(__builtin_amdgcn_ds_bpermute((lane_id() ^ 32) << 2, __float_as_int(v)));
}
DI float wave_sum(float v) { v += shx<1>(v); v += shx<2>(v); v += shx<4>(v); v += shx<8>(v); v += shx<16>(v); v += shx<32>(v); return v; }
DI float sigm(float x) { return __builtin_amdgcn_rcpf(1.0f + __expf(-x)); }
DI float silu_(float x) { return x * sigm(x); }
DI f32x4 exp2n4(f32x4 t) { return (f32x4){__builtin_amdgcn_exp2f(t[0]), __builtin_amdgcn_exp2f(t[1]), __builtin_amdgcn_exp2f(t[2]), __builtin_amdgcn_exp2f(t[3])}; }
DI f32x4 rcp4(f32x4 d) { return (f32x4){__builtin_amdgcn_rcpf(d[0]), __builtin_amdgcn_rcpf(d[1]), __builtin_amdgcn_rcpf(d[2]), __builtin_amdgcn_rcpf(d[3])}; }
DI f32x4 sigm4(f32x4 x) { return rcp4(exp2n4(x * -1.4426950408889634f) + 1.0f); }
DI unsigned pack_u8x4(f32x4 s) { const f32x4 t = s * 255.0f + 8388608.0f;
    const unsigned ab = __builtin_amdgcn_perm(__float_as_uint(t[1]), __float_as_uint(t[0]), 0x0c0c0400u), cd = __builtin_amdgcn_perm(__float_as_uint(t[3]), __float_as_uint(t[2]), 0x04000c0cu); return ab | cd; }
DI float gelu_tanh(float x) { const float u = 1.5957691216057308f * (x + 0.044715f * x * x * x); return x * __builtin_amdgcn_rcpf(1.0f + __expf(-u)); }
#define LDS_WAIT() asm volatile("s_waitcnt lgkmcnt(0)" ::: "memory")
#define VM_WAIT() asm volatile("s_waitcnt vmcnt(0)" ::: "memory")

#define XB_TMO      128
#define XB_XCNT(j)  (256  + 64 * (j))
#define XB_XSUB(j)  (1280 + 64 * (j))
#define XB_XGEN(j)  (2304 + 64 * (j))
#define XB_TOP      3328
#define XB_TOPGEN   3392
#define XCD_BAR_WORDS 3456
#define XB_SPIN_CAP (1u << 22)

__device__ __forceinline__ unsigned xb_ld(unsigned* p)              { return __hip_atomic_load(p, __ATOMIC_RELAXED, __HIP_MEMORY_SCOPE_AGENT); }
__device__ __forceinline__ unsigned xb_add(unsigned* p, unsigned v) { return __hip_atomic_fetch_add(p, v, __ATOMIC_RELAXED, __HIP_MEMORY_SCOPE_AGENT); }
__device__ __forceinline__ unsigned xb_xcc_id() { return (unsigned)__builtin_amdgcn_s_getreg((3 << 11) | 20) & 0xFu; }
#define XB_SPIN(cond, bar) do { unsigned _sp = 0; while (cond) { __builtin_amdgcn_s_sleep(1); \
    if ((++_sp & 255u) == 0u) { if (xb_ld(&(bar)[XB_TMO])) break; if (_sp > XB_SPIN_CAP) { atomicAdd(&(bar)[XB_TMO], 1u); break; } } } } while (0)

struct XcdBarrier { unsigned* bar; unsigned x; volatile LAS unsigned* st; int wave; };

__device__ __forceinline__ XcdBarrier xcd_barrier_post(unsigned* bar, volatile LAS unsigned* st, int wave) {
    XcdBarrier b; b.bar = bar; b.x = xb_xcc_id(); b.st = st; b.wave = wave;
    if (wave == 0 && lane_id() == 0) (void)xb_add(&bar[XB_XCNT(b.x)], 1u);
    return b;
}
__device__ __forceinline__ void xcd_barrier_complete(unsigned* bar, unsigned x, unsigned& nloc, unsigned& nx) {
    const unsigned G = gridDim.x * gridDim.y * gridDim.z;
    unsigned sum, cnt, mine, sp = 0u;
    for (;;) {
        sum = 0u; cnt = 0u; mine = 0u;
#pragma unroll
        for (unsigned j = 0; j < 16; ++j) { const unsigned c = xb_ld(&bar[XB_XCNT(j)]); sum += c; cnt += (c > 0u) ? 1u : 0u; mine = (j == x) ? c : mine; }
        if (sum == G) break;
        __builtin_amdgcn_s_sleep(1);
        if ((++sp & 255u) == 0u) { if (xb_ld(&bar[XB_TMO])) break; if (sp > XB_SPIN_CAP) { atomicAdd(&bar[XB_TMO], 1u); break; } }
    }
    nloc = mine > 0u ? mine : 1u; nx = cnt > 0u ? cnt : 1u;
}
__device__ __forceinline__ void xcd_barrier(const XcdBarrier& b) {
    asm volatile("s_waitcnt vmcnt(0)" ::: "memory");
    __syncthreads();
    if (b.wave == 0 && lane_id() == 0) {
        unsigned* bar = b.bar;
        __builtin_amdgcn_s_waitcnt(0);
        unsigned nloc = b.st[0], nx = b.st[1];
        unsigned bx = b.x; asm volatile("" : "+s"(bx));
        if (nloc == 0u) { xcd_barrier_complete(bar, bx, nloc, nx); b.st[0] = nloc; b.st[1] = nx; }
        const unsigned old = xb_add(&bar[XB_XSUB(bx)], 1u);
        const unsigned gen = old / nloc;
        if (old + 1u == (gen + 1u) * nloc) {
            __builtin_amdgcn_fence(__ATOMIC_RELEASE, "agent");
            asm volatile("s_waitcnt vmcnt(0)" ::: "memory");
            const unsigned og = xb_add(&bar[XB_TOP], 1u);
            const unsigned tg = og / nx;
            if (og + 1u == (tg + 1u) * nx) xb_add(&bar[XB_TOPGEN], 1u);
            else XB_SPIN(xb_ld(&bar[XB_TOPGEN]) == tg, bar);
            __builtin_amdgcn_fence(__ATOMIC_ACQUIRE, "agent");
            xb_add(&bar[XB_XGEN(bx)], 1u);
            asm volatile("s_waitcnt vmcnt(0)" ::: "memory");
        } else {
            XB_SPIN(xb_ld(&bar[XB_XGEN(bx)]) == gen, bar);
            __builtin_amdgcn_fence(__ATOMIC_ACQUIRE, "agent");
            asm volatile("s_waitcnt vmcnt(0)" ::: "memory");
        }
    }
    __syncthreads();
}

namespace pg8 {
constexpr int BM = 256, BK = 64, HALF = 128, HTB = HALF * BK * 2, STAGE_BYTES = 8 * HTB;
__host__ __device__ __forceinline__ int lds_byte(int r, int c) { const int st = (r >> 4) * 2 + (c >> 5), rr = r & 15, cc = c & 31, ob = rr * 64 + cc * 2; return st * 1024 + (ob ^ (((ob >> 9) & 1) << 5)); }
__host__ __device__ __forceinline__ void stage_rc(int b, int& R, int& C) { const int st = b / 1024, sb = b % 1024, swz = sb ^ (((sb >> 9) & 1) << 5); R = (st >> 1) * 16 + swz / 64; C = (st & 1) * 32 + (swz % 64) / 2; }
__host__ __device__ __forceinline__ int perm32(int rho) { const int n = rho >> 4, i = rho & 15; return 8 * (i >> 2) + 4 * n + (i & 3); }

struct Unit { unsigned a, b; int pm, pn, e, br;
    __device__ __forceinline__ void uniform() { a = __builtin_amdgcn_readfirstlane(a); b = __builtin_amdgcn_readfirstlane(b); pm = __builtin_amdgcn_readfirstlane(pm); pn = __builtin_amdgcn_readfirstlane(pn); e = __builtin_amdgcn_readfirstlane(e); br = __builtin_amdgcn_readfirstlane(br); } };

__device__ __forceinline__ unsigned cvt_pk_bf16(float lo, float hi) { unsigned r; asm volatile("v_cvt_pk_bf16_f32 %0, %1, %2" : "=v"(r) : "v"(lo), "v"(hi)); return r; }

typedef int i32x8 __attribute__((ext_vector_type(8)));
typedef int i32x4 __attribute__((ext_vector_type(4)));
template <class Epi, class Sched, bool FP8 = false, int MODE = 0>
__device__ __forceinline__ void gemm_phase(LAS unsigned char* lds, const int wid, const int lane, const char* base, const int K, const int lda, const int ldb, const Sched& S, const Epi& E) {
    const int tid = wid * 64 + lane, wr = wid >> 2, wc = wid & 3, fr = lane & 15, fq = lane >> 4;
    int nt = K / BK; asm volatile("" : "+s"(nt));
    unsigned voffA, voffB;
    { int R, C; stage_rc(tid * 16, R, C); const int Rb = Epi::PERM ? ((R & ~31) + perm32(R & 31)) : R; voffA = (unsigned)(R * lda + C) * 2u; voffB = (unsigned)(Rb * ldb + C) * 2u; }
    unsigned qstepA = (unsigned)(64 * lda * 2), qstepB = (unsigned)(64 * ldb * 2); asm volatile("" : "+s"(qstepA), "+s"(qstepB));
    unsigned kstep = (unsigned)(BK * 2), hstepA = (unsigned)(HALF * lda * 2), hstepB = (unsigned)(HALF * ldb * 2);
    asm volatile("" : "+s"(kstep), "+s"(hstepA), "+s"(hstepB));
    const unsigned ldsw = (unsigned)wid * 1024u;
    const int aoff = lds_byte(wr * 64 + fr, fq * 8), boff = lds_byte(wc * 32 + fr, fq * 8);
#define PG8_SA(b, h) (((b) * 2 + (h)) * HTB)
#define PG8_SB(b, h) ((4 + (b) * 2 + (h)) * HTB)
#define qoffA qstepA
#define qoffB qstepB
#define PG8_STAGE(bufoff, gbase, voff) do { _Pragma("unroll") for (int _i = 0; _i < 2; ++_i) \
        { unsigned sb_ = (gbase) + _i * q##voff; asm volatile("" : "+s"(sb_));     \
          __builtin_amdgcn_global_load_lds((const unsigned*)(base + (size_t)(unsigned)(sb_ + v##voff)), (LAS unsigned*)(lds + (bufoff) + ldsw + _i * 8192), 16, 0, 0); } } while (0)
#define PG8_LDA(dst, b, h) do { if constexpr (FP8) { _Pragma("unroll") for (int m = 0; m < 4; ++m) { const i32x4 lo_ = *(const LAS i32x4*)(lds + PG8_SA(b, h) + aoff + m * 2048), hi_ = *(const LAS i32x4*)(lds + PG8_SA(b, h) + aoff + 1024 + m * 2048); dst##8[m] = __builtin_shufflevector(lo_, hi_, 0, 1, 2, 3, 4, 5, 6, 7); } } \
        else { _Pragma("unroll") for (int m = 0; m < 4; ++m) _Pragma("unroll") for (int k = 0; k < 2; ++k) dst[m][k] = *(const LAS bf16x8*)(lds + PG8_SA(b, h) + aoff + m * 2048 + k * 1024); } } while (0)
#define PG8_LDB(dst, b, h) do { if constexpr (FP8) { _Pragma("unroll") for (int n = 0; n < 2; ++n) { const i32x4 lo_ = *(const LAS i32x4*)(lds + PG8_SB(b, h) + boff + n * 2048), hi_ = *(const LAS i32x4*)(lds + PG8_SB(b, h) + boff + 1024 + n * 2048); dst##8[n] = __builtin_shufflevector(lo_, hi_, 0, 1, 2, 3, 4, 5, 6, 7); } } \
        else { _Pragma("unroll") for (int n = 0; n < 2; ++n) _Pragma("unroll") for (int k = 0; k < 2; ++k) dst[n][k] = *(const LAS bf16x8*)(lds + PG8_SB(b, h) + boff + n * 2048 + k * 1024); } } while (0)
#define PG8_MMA_(ai, bj, At, Bt, Z) do { if constexpr (MODE == 1 && (bj) == 1) break; __builtin_amdgcn_s_setprio(1); if constexpr (FP8) { _Pragma("unroll") for (int m = 0; m < 4; ++m) _Pragma("unroll") for (int n = 0; n < 2; ++n) \
        acc[ai][bj][m][n] = __builtin_amdgcn_mfma_scale_f32_16x16x128_f8f6f4(Bt##8[n], At##8[m], (Z) ? (f32x4){0.f, 0.f, 0.f, 0.f} : acc[ai][bj][m][n], 0, 0, 0, Epi::SCALE_W, 0, Epi::SCALE_X); } \
        else { _Pragma("unroll") for (int m = 0; m < 4; ++m) _Pragma("unroll") for (int n = 0; n < 2; ++n) _Pragma("unroll") for (int k = 0; k < 2; ++k) \
        acc[ai][bj][m][n] = __builtin_amdgcn_mfma_f32_16x16x32_bf16(Bt[n][k], At[m][k], ((Z) && k == 0) ? (f32x4){0.f, 0.f, 0.f, 0.f} : acc[ai][bj][m][n], 0, 0, 0); } __builtin_amdgcn_s_setprio(0); } while (0)
#define PG8_MMA(ai, bj, At, Bt) PG8_MMA_(ai, bj, At, Bt, false)
#define PG8_MMA0(ai, bj, At, Bt) do { if (t == 0) PG8_MMA_(ai, bj, At, Bt, true); else PG8_MMA_(ai, bj, At, Bt, false); } while (0)
#define PG8_WAIT_V(n) asm volatile("s_waitcnt vmcnt(" #n ")" ::: "memory")
#define PG8_WAIT_L(n) asm volatile("s_waitcnt lgkmcnt(" #n ")" ::: "memory")
#define PG8_BAR __builtin_amdgcn_s_barrier()
#define PG8_SCHED __builtin_amdgcn_sched_barrier(0)
    Unit cur, nxt; int ui = 0;
    if (!S.next(0, cur)) return;
    f32x4 acc[2][2][4][2];
    if constexpr (MODE == 1) {
#pragma unroll
        for (int a = 0; a < 2; ++a)
#pragma unroll
            for (int m = 0; m < 4; ++m)
#pragma unroll
                for (int n = 0; n < 2; ++n) acc[a][1][m][n] = (f32x4){0.f, 0.f, 0.f, 0.f};
    }
    bf16x8 At[4][2], B0[2][2], B1[2][2]; i32x8 At8[4], B08[2], B18[2];
    unsigned cA = cur.a, cB = cur.b;
    PG8_STAGE(PG8_SB(0, 0), cB, offB); PG8_STAGE(PG8_SB(0, 1), cB + hstepB, offB); PG8_STAGE(PG8_SA(0, 0), cA, offA); PG8_STAGE(PG8_SA(0, 1), cA + hstepA, offA);
    if (wr == 1) PG8_BAR;
    PG8_WAIT_V(2); PG8_BAR;
    PG8_STAGE(PG8_SB(1, 0), cB + kstep, offB); PG8_STAGE(PG8_SA(1, 0), cA + kstep, offA); PG8_STAGE(PG8_SB(1, 1), cB + hstepB + kstep, offB);
    PG8_WAIT_V(6); PG8_BAR;
    for (;;) {
        const bool has_next = S.next(ui + 1, nxt);
        const unsigned nA = has_next ? nxt.a : cA, nB = has_next ? nxt.b : cB;
#pragma unroll 1
        for (int t = 0; t < nt; t += 2) {
            const bool last = (t == nt - 2);
            const unsigned a1 = cA + (unsigned)(t + 1) * kstep;
            const unsigned a2 = last ? nA : cA + (unsigned)(t + 2) * kstep, b2 = last ? nB : cB + (unsigned)(t + 2) * kstep;
            const unsigned a3 = a2 + kstep, b3 = b2 + kstep;
            PG8_LDB(B0, 0, 0); PG8_LDB(B1, 0, 1); PG8_SCHED; PG8_LDA(At, 0, 0); PG8_STAGE(PG8_SA(1, 1), a1 + hstepA, offA);
            PG8_WAIT_V(8); PG8_WAIT_L(0); PG8_BAR; PG8_MMA0(0, 0, At, B0); PG8_MMA0(0, 1, At, B1); PG8_BAR; PG8_SCHED;
            PG8_LDA(At, 0, 1); PG8_STAGE(PG8_SB(0, 0), b2, offB); PG8_STAGE(PG8_SB(0, 1), b2 + hstepB, offB); PG8_STAGE(PG8_SA(0, 0), a2, offA);
            PG8_WAIT_V(8); PG8_WAIT_L(0); PG8_BAR; PG8_MMA0(1, 0, At, B0); PG8_MMA0(1, 1, At, B1); PG8_BAR; PG8_SCHED;
            PG8_LDB(B0, 1, 0); PG8_LDB(B1, 1, 1); PG8_SCHED; PG8_LDA(At, 1, 0); PG8_STAGE(PG8_SA(0, 1), a2 + hstepA, offA);
            PG8_WAIT_V(8); PG8_WAIT_L(0); PG8_BAR; PG8_MMA(0, 0, At, B0); PG8_MMA(0, 1, At, B1); PG8_BAR; PG8_SCHED;
            PG8_LDA(At, 1, 1); PG8_STAGE(PG8_SB(1, 0), b3, offB); PG8_STAGE(PG8_SB(1, 1), b3 + hstepB, offB); PG8_STAGE(PG8_SA(1, 0), a3, offA);
            PG8_WAIT_V(8); PG8_WAIT_L(0); PG8_BAR; PG8_MMA(1, 0, At, B0); PG8_MMA(1, 1, At, B1); PG8_BAR; PG8_SCHED;
            if constexpr (MODE == 1) { if (((t + 2) & 3) == 0 && !last) { const int l2_ = lane_id(); E.mid(acc, cur, (t + 2) / 4 - 1, wr, wc, l2_ & 15, l2_ >> 4); } }
        }
        if (wr == 0) PG8_BAR;
        { const int l2_ = lane_id();
          E(acc, cur, wr, wc, l2_ & 15, l2_ >> 4); }
        if (!has_next) break;
        if constexpr (MODE == 1) {
#pragma unroll
            for (int a = 0; a < 2; ++a)
#pragma unroll
                for (int m = 0; m < 4; ++m)
#pragma unroll
                    for (int n = 0; n < 2; ++n) acc[a][1][m][n] = (f32x4){0.f, 0.f, 0.f, 0.f};
        }
        cur = nxt; cA = nA; cB = nB; ++ui;
        if (wr == 1) PG8_BAR;
    }
    PG8_WAIT_V(0);
    PG8_BAR;
#undef PG8_SA
#undef PG8_SB
#undef PG8_STAGE
#undef qoffA
#undef qoffB
#undef PG8_LDA
#undef PG8_LDB
#undef PG8_MMA
#undef PG8_MMA_
#undef PG8_MMA0
#undef PG8_WAIT_V
#undef PG8_WAIT_L
#undef PG8_BAR
#undef PG8_SCHED
}
}
using pg8::Unit;

typedef const __attribute__((address_space(4))) unsigned char* KPtr;
DI KPtr kargs() { KPtr p = (KPtr)__builtin_amdgcn_kernarg_segment_ptr(); asm volatile("" : "+s"(p)); return p; }
struct Ctx {
    KPtr ka;
    DI const float* in(int i) const { return *(const float* const __attribute__((address_space(4)))*)(ka + 8 * i); }
    DI float* out() const { return *(float* const __attribute__((address_space(4)))*)(ka + 8 * N_IN); }
    DI unsigned char* ws() const { return *(unsigned char* const __attribute__((address_space(4)))*)(ka + 8 * N_IN + 8); }
    DI float* mod() const { return (float*)(ws() + WS_MOD); }
    DI float* lb() const { return (float*)(ws() + WS_LB); }
    DI float* aff() const { return (float*)(ws() + WS_AFF); }
    DI float* gate() const { return (float*)(ws() + WS_GATE); }
    DI float* X() const { return (float*)(ws() + WS_X); }
    DI int* sel() const { return (int*)(ws() + WS_SEL); }
    DI bf16_t* wbr() const { return (bf16_t*)(ws() + WS_WBR); }
    DI bf16_t* wout() const { return (bf16_t*)(ws() + WS_WOUT); }
    DI bf16_t* win() const { return (bf16_t*)(ws() + WS_WIN); }
    DI bf16_t* H() const { return (bf16_t*)(ws() + WS_H); }
    DI bf16_t* O() const { return (bf16_t*)(ws() + WS_O); }
    DI bf16_t* MB() const { return (bf16_t*)(ws() + WS_MB); }
    DI bf16_t* P() const { return (bf16_t*)(ws() + WS_P); }
    DI bf16_t* XE() const { return (bf16_t*)(ws() + WS_XE); }
    DI unsigned char* W1T() const { return ws() + WS_EXW; }
    DI unsigned char* W2T() const { return ws() + WS_W2T; }
    DI bf16_t* QKN() const { return (bf16_t*)(ws() + WS_QKN); }
    DI float* YS5() const { return (float*)(ws() + WS_XE); }
    DI float* OHG() const { return (float*)(ws() + WS_XE + (size_t)2 * NTOK * 256 * 4); }
    DI float* ORET() const { return (float*)(ws() + WS_MB); }
    DI bf16_t* RETP() const { return (bf16_t*)(ws() + WS_RETP); }
    DI bf16_t* RETS() const { return (bf16_t*)(ws() + WS_RETS); }
    DI bf16_t* HGS() const { return (bf16_t*)(ws() + WS_HGS); }
    DI bf16_t* UG() const { return (bf16_t*)(ws() + WS_UG); }
    DI float* S5S() const { return (float*)(ws() + WS_S5S); }
    DI bf16_t* OHGB() const { return (bf16_t*)(ws() + WS_OHG); }
    DI bf16_t* Z() const { return (bf16_t*)(ws() + WS_Z); }
    DI bf16_t* S5W1() const { return (bf16_t*)(ws() + WS_S5W1); }
    DI bf16_t* S5W2() const { return (bf16_t*)(ws() + WS_S5W2); }
    DI bf16_t* GLUT() const { return (bf16_t*)(ws() + WS_GLUT); }
    DI bf16_t* HGP() const { return (bf16_t*)(ws() + WS_HGP); }
    DI float* HGDEC() const { return (float*)(ws() + WS_HGDEC); }
    DI float* HGDT() const { return (float*)(ws() + WS_HGDT); }
};
DI size_t seqrow(int b, int dir, int s) { return (size_t)b * LSEQ + (dir == 0 ? s : (s < CTXL ? (CTXL - 1 - s) : (LSEQ + CTXL - 1 - s))); }

struct EpiP {
    static constexpr bool PERM = true;
    bf16_t* O; int ldc;
    DI void operator()(const f32x4 (&acc)[2][2][4][2], const Unit& u, int wr, int wc, int fr, int fq) const {
        const int row0 = u.pm * 256 + wr * 64 + fr, col0 = u.pn * 256 + wc * 32 + 8 * fq;
#pragma unroll
        for (int ai = 0; ai < 2; ++ai)
#pragma unroll
            for (int m = 0; m < 4; ++m) { bf16_t* rowp = O + (size_t)(row0 + ai * 128 + m * 16) * ldc + col0;
#pragma unroll
                for (int bj = 0; bj < 2; ++bj) { const f32x4 v0 = acc[ai][bj][m][0], v1 = acc[ai][bj][m][1];
                    u32x4 w; w.x = pg8::cvt_pk_bf16(v0[0], v0[1]); w.y = pg8::cvt_pk_bf16(v0[2], v0[3]); w.z = pg8::cvt_pk_bf16(v1[0], v1[1]); w.w = pg8::cvt_pk_bf16(v1[2], v1[3]);
                    *(u32x4*)(rowp + bj * 128) = w; } }
    }
};
constexpr float FP8_WS = 16.0f, FP8_XS = 16.0f, FP8_AS = 16.0f;
struct EpiSig8 {
    static constexpr bool PERM = true; static constexpr int SCALE_W = 0x7b7b7b7b, SCALE_X = 0x7b7b7b7b;
    unsigned char* Pb;
    DI void operator()(const f32x4 (&acc)[2][2][4][2], const Unit& u, int wr, int wc, int fr, int fq) const {
        const int row0 = u.pm * 256 + wr * 64 + fr, col0 = u.pn * 256 + wc * 32 + 8 * fq;
#pragma unroll
        for (int ai = 0; ai < 2; ++ai)
#pragma unroll
            for (int m = 0; m < 4; ++m) { unsigned char* rowp = Pb + (size_t)(row0 + ai * 128 + m * 16) * (DIN * 2) + 2 * C_GATE + col0;
#pragma unroll
                for (int bj = 0; bj < 2; ++bj) { const f32x4 v0 = acc[ai][bj][m][0], v1 = acc[ai][bj][m][1];
                    u32x2 w; w.x = pack_u8x4(sigm4(v0)); w.y = pack_u8x4(sigm4(v1));
                    *(u32x2*)(rowp + bj * 128) = w; } }
    }
};
struct EpiMerge {
    static constexpr bool PERM = true;
    bf16_t* MB; const unsigned char* Pb;
    DI void mid(f32x4 (&acc)[2][2][4][2], const Unit& u, int br, int wr, int wc, int fr, int fq) const {
        const int row0 = u.pm * 256 + wr * 64 + fr, col0 = u.pn * 128 + wc * 32 + 8 * fq;
        u32x2 gt[2][4];
#pragma unroll
        for (int ai = 0; ai < 2; ++ai)
#pragma unroll
            for (int m = 0; m < 4; ++m) gt[ai][m] = *(const u32x2*)(Pb + (size_t)(row0 + ai * 128 + m * 16) * (DIN * 2) + 2 * C_GATE + br * 1024 + col0);
        const float q = 1.0f / 255.0f;
#pragma unroll
        for (int ai = 0; ai < 2; ++ai)
#pragma unroll
            for (int m = 0; m < 4; ++m) { const u32x2 g = gt[ai][m];
                acc[ai][1][m][0] = acc[ai][1][m][0] + acc[ai][0][m][0] * (f32x4){(float)(g.x & 255u) * q, (float)((g.x >> 8) & 255u) * q, (float)((g.x >> 16) & 255u) * q, (float)(g.x >> 24) * q};
                acc[ai][1][m][1] = acc[ai][1][m][1] + acc[ai][0][m][1] * (f32x4){(float)(g.y & 255u) * q, (float)((g.y >> 8) & 255u) * q, (float)((g.y >> 16) & 255u) * q, (float)(g.y >> 24) * q};
                acc[ai][0][m][0] = (f32x4){0.f, 0.f, 0.f, 0.f}; acc[ai][0][m][1] = (f32x4){0.f, 0.f, 0.f, 0.f}; }
    }
    DI void operator()(const f32x4 (&acc)[2][2][4][2], const Unit& u, int wr, int wc, int fr, int fq) const {
        const int row0 = u.pm * 256 + wr * 64 + fr, col0 = u.pn * 128 + wc * 32 + 8 * fq;
        u32x2 gt[2][4];
#pragma unroll
        for (int ai = 0; ai < 2; ++ai)
#pragma unroll
            for (int m = 0; m < 4; ++m) gt[ai][m] = *(const u32x2*)(Pb + (size_t)(row0 + ai * 128 + m * 16) * (DIN * 2) + 2 * C_GATE + 3 * 1024 + col0);
        const float q = 1.0f / 255.0f;
#pragma unroll
        for (int ai = 0; ai < 2; ++ai)
#pragma unroll
            for (int m = 0; m < 4; ++m) { const u32x2 g = gt[ai][m];
                const f32x4 r0 = acc[ai][1][m][0] + acc[ai][0][m][0] * (f32x4){(float)(g.x & 255u) * q, (float)((g.x >> 8) & 255u) * q, (float)((g.x >> 16) & 255u) * q, (float)(g.x >> 24) * q};
                const f32x4 r1 = acc[ai][1][m][1] + acc[ai][0][m][1] * (f32x4){(float)(g.y & 255u) * q, (float)((g.y >> 8) & 255u) * q, (float)((g.y >> 16) & 255u) * q, (float)(g.y >> 24) * q};
                u32x4 w; w.x = pg8::cvt_pk_bf16(r0[0], r0[1]); w.y = pg8::cvt_pk_bf16(r0[2], r0[3]); w.z = pg8::cvt_pk_bf16(r1[0], r1[1]); w.w = pg8::cvt_pk_bf16(r1[2], r1[3]);
                *(u32x4*)(MB + (size_t)(row0 + ai * 128 + m * 16) * DM + col0) = w; }
    }
};
struct EpiResid {
    static constexpr bool PERM = false;
    float* X; const float* mod; float* Xo; const float* xin; const float* cin;
    DI void operator()(const f32x4 (&acc)[2][2][4][2], const Unit& u, int wr, int wc, int fr, int fq) const {
        const int row0 = u.pm * 256 + wr * 64 + fr, col0 = u.pn * 256 + wc * 32 + 4 * fq;
        const int b = u.pm / 17, tl = u.pm % 17, mr = (tl == 0) ? 8 : b;
        const float* g1 = mod + mr * 6144 + 2 * 1024;
        const float* srcb = xin ? (tl == 0 ? cin + (size_t)b * CTXL * DM : xin + ((size_t)b * SEQ + (tl - 1) * 256) * DM) - (size_t)u.pm * 256 * DM : X;
        f32x4 gv[2][2];
#pragma unroll
        for (int bj = 0; bj < 2; ++bj)
#pragma unroll
            for (int n = 0; n < 2; ++n) gv[bj][n] = *(const f32x4*)(g1 + col0 + bj * 128 + n * 16);
#pragma unroll
        for (int ai = 0; ai < 2; ++ai)
#pragma unroll
            for (int mh = 0; mh < 2; ++mh) {
                f32x4 xv[2][2][2];
#pragma unroll
                for (int m2 = 0; m2 < 2; ++m2)
#pragma unroll
                    for (int bj = 0; bj < 2; ++bj)
#pragma unroll
                        for (int n = 0; n < 2; ++n) xv[m2][bj][n] = *(const f32x4*)(srcb + (size_t)(row0 + ai * 128 + (2 * mh + m2) * 16) * DM + col0 + bj * 128 + n * 16);
#pragma unroll
                for (int m2 = 0; m2 < 2; ++m2)
#pragma unroll
                    for (int bj = 0; bj < 2; ++bj)
#pragma unroll
                        for (int n = 0; n < 2; ++n) *(f32x4*)(Xo + (size_t)(row0 + ai * 128 + (2 * mh + m2) * 16) * DM + col0 + bj * 128 + n * 16) = xv[m2][bj][n] + gv[bj][n] * acc[ai][bj][2 * mh + m2][n];
                asm volatile("" ::: "memory"); }
    }
};
struct EpiSwiGLU {
    static constexpr bool PERM = true; static constexpr int SCALE_W = 0x7b7b7b7b, SCALE_X = 0x7b7b7b7b;
    unsigned char* ACT;
    DI void operator()(const f32x4 (&acc)[2][2][4][2], const Unit& u, int wr, int wc, int fr, int fq) const {
        const int row0 = u.pm * 256 + wr * 64 + fr, col0 = u.pn * 128 + wc * 32 + 8 * fq;
#pragma unroll
        for (int ai = 0; ai < 2; ++ai)
#pragma unroll
            for (int m = 0; m < 4; ++m) { unsigned char* rowp = ACT + ((size_t)u.e * EROWS + row0 + ai * 128 + m * 16) * DF + col0;
                f32x4 q[2];
#pragma unroll
                for (int n = 0; n < 2; ++n) { const f32x4 g = acc[ai][0][m][n], up = acc[ai][1][m][n];
                    q[n] = (g * up) * rcp4(exp2n4(g * -1.4426950408889634f) * (1.0f / FP8_AS) + (1.0f / FP8_AS)); }
                u32x2 w; w.x = pk4_fp8(q[0][0], q[0][1], q[0][2], q[0][3]); w.y = pk4_fp8(q[1][0], q[1][1], q[1][2], q[1][3]);
                *(u32x2*)rowp = w; }
    }
};
struct EpiExpOut {
    static constexpr bool PERM = true; static constexpr int SCALE_W = 0x7b7b7b7b, SCALE_X = 0x7b7b7b7b;
    bf16_t* YB; const float* gate;
    DI void operator()(const f32x4 (&acc)[2][2][4][2], const Unit& u, int wr, int wc, int fr, int fq) const {
        const int row0 = u.pm * 256 + wr * 64 + fr, col0 = u.pn * 256 + wc * 32 + 8 * fq;
#pragma unroll
        for (int ai = 0; ai < 2; ++ai)
#pragma unroll
            for (int m = 0; m < 4; ++m) { const size_t er = (size_t)u.e * EROWS + row0 + ai * 128 + m * 16; const float g = gate[er]; bf16_t* rowp = YB + er * DM + col0;
#pragma unroll
                for (int bj = 0; bj < 2; ++bj) { const f32x4 v0 = acc[ai][bj][m][0] * g, v1 = acc[ai][bj][m][1] * g;
                    u32x4 w; w.x = pg8::cvt_pk_bf16(v0[0], v0[1]); w.y = pg8::cvt_pk_bf16(v0[2], v0[3]); w.z = pg8::cvt_pk_bf16(v1[0], v1[1]); w.w = pg8::cvt_pk_bf16(v1[2], v1[3]);
                    *(u32x4*)(rowp + bj * 128) = w; } }
    }
};

DI int xcd_remap(int L, int nwg) { const int q = nwg / 8, r = nwg % 8, x = L % 8, off = L / 8; return (x < r ? x * (q + 1) : r * (q + 1) + (x - r) * q) + off; }
DI void tile_of(int T, int nM, int nN, int& pm, int& pn) { const int nig = 8 * nN, gid = T / nig, fm = gid * 8, gsz = (nM - fm) < 8 ? (nM - fm) : 8; pm = fm + ((T % nig) % gsz); pn = (T % nig) / gsz; }
struct SchedWin {
    unsigned A, B; int G, c, nN; unsigned rowb;
    DI bool next(int i, Unit& u) const {
        const int nM = NTOK / 256, L = i * G + c; if (L >= nM * nN) return false;
        tile_of(xcd_remap(L, nM * nN), nM, nN, u.pm, u.pn); u.e = 0; u.br = 0;
        u.a = A + (unsigned)u.pm * 256u * rowb; u.b = B + (unsigned)u.pn * 256u * rowb; u.uniform(); return true;
    }
};
DI int pm_of(int li, int pmi) { return li == 0 ? pmi : (pmi / 16) * 17 + 1 + (pmi % 16); }
struct SchedMerge {
    unsigned O, WBR; int G, c, li;
    DI bool next(int i, Unit& u) const {
        const int nM = (li == 0 ? 136 : 128), ntile = nM * 8, L = i * G + c; if (L >= ntile) return false;
        int pmi; tile_of(xcd_remap(L, ntile), nM, 8, pmi, u.pn); u.br = 0; u.pm = pm_of(li, pmi); u.e = 0;
        u.a = O + (unsigned)u.pm * 256u * DM * 2u; u.b = WBR + (unsigned)u.pn * 128u * DM * 2u; u.uniform(); return true;
    }
};
struct SchedOut {
    unsigned MBp, W; int G, c, li;
    DI bool next(int i, Unit& u) const {
        const int nM = (li == 0 ? 136 : 128), ntile = nM * 4, L = i * G + c; if (L >= ntile) return false;
        int pmi; tile_of(xcd_remap(L, ntile), nM, 4, pmi, u.pn); u.br = 0; u.pm = pm_of(li, pmi); u.e = 0;
        u.a = MBp + (unsigned)u.pm * 256u * DM * 2u; u.b = W + (unsigned)u.pn * 256u * DM * 2u; u.uniform(); return true;
    }
};
struct SchedE1 {
    unsigned XE, W; int G, c, pmN;
    DI bool next(int i, Unit& u) const {
        const int per = pmN * 22, L0 = i * G + c; if (L0 >= NE * per) return false;
        const int L = xcd_remap(L0, NE * per); u.e = L / per; tile_of(L % per, pmN, 22, u.pm, u.pn); u.br = 0;
        u.a = XE + ((unsigned)u.e * EROWS + u.pm * 256u) * DM; u.b = W + ((unsigned)u.e * 5632u + u.pn * 256u) * DM; u.uniform(); return true;
    }
};
struct SchedE2 {
    unsigned ACT, W; int G, c, pmN;
    DI bool next(int i, Unit& u) const {
        const int per = pmN * 4, L0 = i * G + c; if (L0 >= NE * per) return false;
        const int L = xcd_remap(L0, NE * per); u.e = L / per; tile_of(L % per, pmN, 4, u.pm, u.pn); u.br = 0;
        u.a = ACT + ((unsigned)u.e * EROWS + u.pm * 256u) * DF; u.b = W + ((unsigned)u.e * 1024u + u.pn * 256u) * DF; u.uniform(); return true;
    }
};


DI void s5_build_w(const Ctx& C, int li, int g, int part4, LAS float* L, int tid) {
    LAS float* pwr = L; LAS float* pwi = pwr + 2176; LAS float* bbr = pwi + 2176; LAS float* bbi = bbr + 2048; LAS float* ccr = bbi + 2048; LAS float* cci = ccr + 2048; LAS float* Kt = cci + 2048;
    __syncthreads();
    if (tid < 128) { const int d = tid >> 6, n = tid & 63, pg = (li * 2 + d) * 16 + g;
        const float lr = C.in(I_LRE)[pg * 64 + n], lim = C.in(I_LIM)[pg * 64 + n], dt = expf(C.in(I_LSTEP)[pg]);
        const float mag = expf(lr * dt); float sn, cs; sincosf(lim * dt, &sn, &cs);
        const float ar = mag * cs, ai = mag * sn, den = lr * lr + lim * lim;
        const float zr = ((ar - 1.0f) * lr + ai * lim) / den, zi = (ai * lr - (ar - 1.0f) * lim) / den;
        float pr = 1.0f, pi = 0.0f;
        for (int t = 0; t <= 16; ++t) { pwr[(d * 17 + t) * 64 + n] = pr; pwi[(d * 17 + t) * 64 + n] = pi; const float nr = pr * ar - pi * ai, ni = pr * ai + pi * ar; pr = nr; pi = ni; }
        for (int p = 0; p < 16; ++p) { const float br = C.in(I_BRE)[((size_t)pg * 64 + n) * 16 + p], bi = C.in(I_BIM)[((size_t)pg * 64 + n) * 16 + p];
            bbr[(d * 64 + n) * 16 + p] = zr * br - zi * bi; bbi[(d * 64 + n) * 16 + p] = zr * bi + zi * br;
            ccr[(d * 16 + p) * 64 + n] = C.in(I_CRE)[((size_t)pg * 16 + p) * 64 + n]; cci[(d * 16 + p) * 64 + n] = C.in(I_CIM)[((size_t)pg * 16 + p) * 64 + n]; } }
    __syncthreads();
    for (int e2 = tid; e2 < 2048; e2 += 512) { const int d = e2 >> 10, tau = (e2 >> 6) & 15, p = 4 * part4 + ((e2 >> 4) & 3), pp = e2 & 15; float acc = 0.f;
        for (int n = 0; n < 64; ++n) { const float cr = ccr[(d * 16 + p) * 64 + n], ci = cci[(d * 16 + p) * 64 + n], pr = pwr[(d * 17 + tau) * 64 + n], pi = pwi[(d * 17 + tau) * 64 + n];
            const float wr = cr * pr - ci * pi, wi = cr * pi + ci * pr; acc += wr * bbr[(d * 64 + n) * 16 + pp] - wi * bbi[(d * 64 + n) * 16 + pp]; }
        Kt[((d * 16 + tau) * 16 + p) * 16 + pp] = acc; }
    __syncthreads();
    {
        const int rl = tid >> 3, t = rl >> 2, p = 4 * part4 + (rl & 3), row = t * 16 + p; const float dsk = C.in(I_S5D)[li * 256 + g * 16 + p];
        bf16_t* dst = C.S5W2() + ((size_t)(li * 16 + g) * 256 + row) * 512;
        for (int k8 = (tid & 7) * 8; k8 < (tid & 7) * 8 + 8; ++k8) { float v[8];
#pragma unroll
            for (int j = 0; j < 8; ++j) { const int kk = (k8 * 8 + j) & 255;
                if (k8 < 32) { const int tp = kk >> 4, pp = kk & 15; float a = 0.f;
                    if (tp <= t) a += Kt[((0 * 16 + (t - tp)) * 16 + p) * 16 + pp];
                    if (tp >= t) a += Kt[((1 * 16 + (tp - t)) * 16 + p) * 16 + pp];
                    if (kk == row) a += dsk; v[j] = a; }
                else { const int d = kk >> 7, part = (kk >> 6) & 1, n = kk & 63, ex = d ? 16 - t : t + 1;
                    const float cr = ccr[(d * 16 + p) * 64 + n], ci = cci[(d * 16 + p) * 64 + n], pr = pwr[(d * 17 + ex) * 64 + n], pi = pwi[(d * 17 + ex) * 64 + n];
                    v[j] = part ? -(cr * pi + ci * pr) : (cr * pr - ci * pi); } }
            u32x4 o; o.x = pk2(v[0], v[1]); o.y = pk2(v[2], v[3]); o.z = pk2(v[4], v[5]); o.w = pk2(v[6], v[7]); *(u32x4*)(dst + k8 * 8) = o; } }
    {
        const int np = 64 * part4 + (tid >> 3), d = np >> 7, part = (np >> 6) & 1, n = np & 63;
        bf16_t* dst = C.S5W1() + ((size_t)(li * 16 + g) * 256 + np) * 256;
        for (int k8 = (tid & 7) * 4; k8 < (tid & 7) * 4 + 4; ++k8) { float v[8];
#pragma unroll
            for (int j = 0; j < 8; ++j) { const int kk = k8 * 8 + j, t = kk >> 4, p = kk & 15, ex = d ? t : 15 - t;
                const float pr = pwr[(d * 17 + ex) * 64 + n], pi = pwi[(d * 17 + ex) * 64 + n], br = bbr[(d * 64 + n) * 16 + p], bi = bbi[(d * 64 + n) * 16 + p];
                v[j] = part ? (pr * bi + pi * br) : (pr * br - pi * bi); }
            u32x4 o; o.x = pk2(v[0], v[1]); o.y = pk2(v[2], v[3]); o.z = pk2(v[4], v[5]); o.w = pk2(v[6], v[7]); *(u32x4*)(dst + k8 * 8) = o; } }
    __syncthreads();
}
DI void prep_s5(const Ctx& C, int gw, int ngw, int lane) {
    const bf16_t* P = C.P(); bf16_t* UG = C.UG();
    for (int ch = gw; ch < S5CH; ch += ngw) {
#pragma unroll
        for (int i = 0; i < 4; ++i) { const int pr = lane + 64 * i, t = pr >> 4, g = pr & 15;
            const u32x4* src = (const u32x4*)(P + ((size_t)ch * 16 + t) * DIN + C_S5U + g * 16); u32x4* dst = (u32x4*)(UG + ((size_t)g * S5ROWS + ch) * 512 + t * 16);
            dst[0] = src[0]; dst[1] = src[1]; }
    }
}
DI void s5_carry(const Ctx& C, int li, int gw, int ngw, int lane) {
    const float* SS = C.S5S(); bf16_t* UG = C.UG();
    for (int it = gw; it < NB * 2 * 16; it += ngw) {
        const int b = it >> 5, d = (it >> 4) & 1, g = it & 15, n = lane, pg = (li * 2 + d) * 16 + g;
        const float lr = C.in(I_LRE)[pg * 64 + n], lim = C.in(I_LIM)[pg * 64 + n], dt = expf(C.in(I_LSTEP)[pg]);
        const float mag = expf(16.0f * lr * dt); float sn, cs; sincosf(16.0f * lim * dt, &sn, &cs);
        const float ar = mag * cs, ai = mag * sn;
        float xr = 0.f, xi = 0.f;
#pragma unroll 1
        for (int s0 = 0; s0 < 272; s0 += 34) {
            float sr[34], si[34];
#pragma unroll
            for (int k = 0; k < 34; ++k) { const int s = s0 + k, c = d == 0 ? s : (s < 16 ? 15 - s : 287 - s); const size_t rowi = (size_t)g * S5ROWS + b * 272 + c;
                sr[k] = SS[rowi * 256 + d * 128 + n]; si[k] = SS[rowi * 256 + d * 128 + 64 + n]; }
#pragma unroll
            for (int k = 0; k < 34; ++k) { const int s = s0 + k, c = d == 0 ? s : (s < 16 ? 15 - s : 287 - s); const size_t rowi = (size_t)g * S5ROWS + b * 272 + c;
                UG[rowi * 512 + 256 + d * 128 + n] = (bf16_t)f2bf(xr); UG[rowi * 512 + 256 + d * 128 + 64 + n] = (bf16_t)f2bf(xi);
                const float nr = ar * xr - ai * xi + sr[k], ni = ar * xi + ai * xr + si[k]; xr = nr; xi = ni; }
        }
    }
}
struct SchedS5 {
    unsigned A, B; int G, c; unsigned bstride;
    DI bool next(int i, Unit& u) const {
        const int L = i * G + c; if (L >= 16 * 9) return false;
        u.e = L / 9; u.pm = L % 9; u.pn = 0; u.br = 0;
        u.a = A + ((unsigned)u.e * S5ROWS + u.pm * 256u) * 512u * 2u; u.b = B + (unsigned)u.e * bstride; u.uniform(); return true;
    }
};
struct EpiS5S {
    static constexpr bool PERM = false;
    float* SS;
    DI void operator()(const f32x4 (&acc)[2][2][4][2], const Unit& u, int wr, int wc, int fr, int fq) const {
        const int row0 = u.pm * 256 + wr * 64 + fr, col0 = wc * 32 + 4 * fq;
#pragma unroll
        for (int ai = 0; ai < 2; ++ai)
#pragma unroll
            for (int m = 0; m < 4; ++m) { float* rowp = SS + ((size_t)u.e * S5ROWS + row0 + ai * 128 + m * 16) * 256 + col0;
#pragma unroll
                for (int bj = 0; bj < 2; ++bj)
#pragma unroll
                    for (int n = 0; n < 2; ++n) *(f32x4*)(rowp + bj * 128 + n * 16) = acc[ai][bj][m][n]; }
    }
};
struct EpiS5Z {
    static constexpr bool PERM = true;
    bf16_t* Z;
    DI void operator()(const f32x4 (&acc)[2][2][4][2], const Unit& u, int wr, int wc, int fr, int fq) const {
        const int row0 = u.pm * 256 + wr * 64 + fr;
#pragma unroll
        for (int ai = 0; ai < 2; ++ai)
#pragma unroll
            for (int m = 0; m < 4; ++m) { const int ch = row0 + ai * 128 + m * 16; if (ch >= S5CH) continue;
#pragma unroll
                for (int bj = 0; bj < 2; ++bj) { const int col = bj * 128 + wc * 32 + 8 * fq, t = col >> 4, p0 = col & 15;
                    const f32x4 v0 = acc[ai][bj][m][0], v1 = acc[ai][bj][m][1];
                    u32x4 w; w.x = pk2(gelu_tanh(v0[0]), gelu_tanh(v0[1])); w.y = pk2(gelu_tanh(v0[2]), gelu_tanh(v0[3])); w.z = pk2(gelu_tanh(v1[0]), gelu_tanh(v1[1])); w.w = pk2(gelu_tanh(v1[2]), gelu_tanh(v1[3]));
                    *(u32x4*)(Z + ((size_t)ch * 16 + t) * 256 + u.e * 16 + p0) = w; } }
    }
};
struct SchedGlu {
    unsigned A, B; int G, c, li;
    DI bool next(int i, Unit& u) const {
        const int L = i * G + c; if (L >= (li == 0 ? 136 : 128)) return false;
        u.pm = pm_of(li, L); u.pn = 0; u.e = 0; u.br = 0; u.a = A + (unsigned)u.pm * 256u * 256u * 2u; u.b = B; u.uniform(); return true;
    }
};
struct EpiGlu {
    static constexpr bool PERM = true;
    bf16_t* O; const bf16_t* Z;
    DI void operator()(const f32x4 (&acc)[2][2][4][2], const Unit& u, int wr, int wc, int fr, int fq) const {
        const int row0 = u.pm * 256 + wr * 64 + fr, col0 = wc * 32 + 8 * fq;
#pragma unroll
        for (int ai = 0; ai < 2; ++ai)
#pragma unroll
            for (int m = 0; m < 4; ++m) { const size_t row = (size_t)(row0 + ai * 128 + m * 16);
#pragma unroll
                for (int bj = 0; bj < 2; ++bj) { const int col = col0 + bj * 128; const u32x4 z = *(const u32x4*)(Z + row * 256 + col);
                    const f32x4 v0 = acc[ai][bj][m][0], v1 = acc[ai][bj][m][1];
                    u32x4 w; w.x = pk2(lo_f(z.x) * sigm(v0[0]), hi_f(z.x) * sigm(v0[1])); w.y = pk2(lo_f(z.y) * sigm(v0[2]), hi_f(z.y) * sigm(v0[3]));
                    w.z = pk2(lo_f(z.z) * sigm(v1[0]), hi_f(z.z) * sigm(v1[1])); w.w = pk2(lo_f(z.w) * sigm(v1[2]), hi_f(z.w) * sigm(v1[3]));
                    *(u32x4*)(O + row * DM + col) = w; }
                if (m == 3) asm volatile("" ::: "memory"); }
    }
};

DI void transpose_item(const float* src, size_t ldw, bf16_t* dst, size_t ldo, LAS float* scr, int lane) {
    const int kq = lane >> 3, n4 = lane & 7;
    f32x4 tv[8];
#pragma unroll
    for (int i = 0; i < 8; ++i) tv[i] = __builtin_nontemporal_load((const f32x4*)(src + (size_t)(8 * kq + i) * ldw + 4 * n4));
    LAS unsigned char* t8 = (LAS unsigned char*)scr;
#pragma unroll
    for (int j = 0; j < 4; ++j) { u32x4 w; w.x = pk2(tv[0][j], tv[1][j]); w.y = pk2(tv[2][j], tv[3][j]); w.z = pk2(tv[4][j], tv[5][j]); w.w = pk2(tv[6][j], tv[7][j]);
        *(LAS u32x4*)(t8 + (4 * n4 + j) * 144 + 16 * kq) = w; }
    LDS_WAIT(); asm volatile("" ::: "memory");
    { const int n = lane >> 1, hf = lane & 1; const LAS u32x4* rp = (const LAS u32x4*)(t8 + n * 144 + 64 * hf);
      const u32x4 a0 = rp[0], a1 = rp[1], a2 = rp[2], a3 = rp[3];
      u32x4* gp = (u32x4*)(dst + (size_t)n * ldo + 32 * hf);
      gp[0] = a0; gp[1] = a1; gp[2] = a2; gp[3] = a3; }
    LDS_WAIT(); asm volatile("" ::: "memory");
}
DI void tr_plain(const float* W, int K, int N, bf16_t* WT, LAS float* scr, int item, int lane) {
    const int nblk = N / 32, kb = item / nblk, nb = item % nblk;
    transpose_item(W + (size_t)(64 * kb) * N + 32 * nb, N, WT + (size_t)(32 * nb) * K + 64 * kb, K, scr, lane);
}
DI void transpose_item8(const float* src, size_t ldw, unsigned char* dst, size_t ldo, LAS float* scr, int lane) {
    const int kq = lane >> 3, n4 = lane & 7;
    f32x4 tv[8];
#pragma unroll
    for (int i = 0; i < 8; ++i) tv[i] = __builtin_nontemporal_load((const f32x4*)(src + (size_t)(8 * kq + i) * ldw + 4 * n4));
    LAS unsigned char* t8 = (LAS unsigned char*)scr;
#pragma unroll
    for (int j = 0; j < 4; ++j) { u32x2 w; w.x = pk4_fp8(tv[0][j] * FP8_WS, tv[1][j] * FP8_WS, tv[2][j] * FP8_WS, tv[3][j] * FP8_WS); w.y = pk4_fp8(tv[4][j] * FP8_WS, tv[5][j] * FP8_WS, tv[6][j] * FP8_WS, tv[7][j] * FP8_WS);
        *(LAS u32x2*)(t8 + (4 * n4 + j) * 72 + 8 * kq) = w; }
    LDS_WAIT(); asm volatile("" ::: "memory");
    { const int n = lane >> 1, hf = lane & 1; const LAS u32x2* rp = (const LAS u32x2*)(t8 + n * 72 + 32 * hf);
      const u32x2 a0 = rp[0], a1 = rp[1], a2 = rp[2], a3 = rp[3];
      u32x4* gp = (u32x4*)(dst + (size_t)n * ldo + 32 * hf);
      gp[0] = (u32x4){a0.x, a0.y, a1.x, a1.y}; gp[1] = (u32x4){a2.x, a2.y, a3.x, a3.y}; }
    LDS_WAIT(); asm volatile("" ::: "memory");
}
DI void tr_gu(const float* W, unsigned char* W1T, int half, LAS float* scr, int item, int lane) {
    const int nblk = DF / 32, kb = item / nblk, nb = item % nblk, n0 = 32 * nb, drow = (n0 / 128) * 256 + half * 128 + (n0 % 128);
    transpose_item8(W + (size_t)(64 * kb) * DF + n0, DF, W1T + (size_t)drow * DM + 64 * kb, DM, scr, lane);
}
DI void convert_experts(const Ctx& C, int li, int it0, int gw, int ngw, LAS float* scr, int lane) {
    constexpr int PER = 16 * 88;
    for (int it = (gw - it0 + ngw) % ngw; it < 3 * NE * PER; it += ngw) {
        const int which = it / (NE * PER), r = it % (NE * PER), e = r / PER, item = r % PER;
        if (which == 0) tr_gu(C.in(I_EWG) + ((size_t)li * NE + e) * DM * DF, C.W1T() + (size_t)e * 5632 * DM, 0, scr, item, lane);
        else if (which == 1) tr_gu(C.in(I_EWU) + ((size_t)li * NE + e) * DM * DF, C.W1T() + (size_t)e * 5632 * DM, 1, scr, item, lane);
        else { const int nblk = DM / 32, kb = item / nblk, nb = item % nblk;
            transpose_item8(C.in(I_EWD) + ((size_t)li * NE + e) * DF * DM + (size_t)(64 * kb) * DM + 32 * nb, DM, C.W2T() + (size_t)e * DM * DF + (size_t)(32 * nb) * DF + 64 * kb, DF, scr, lane); }
    }
}
DI void phase_prologue(const Ctx& C, LAS unsigned char* lds, int gw, int ngw, int wave, int lane) {
    const int tid_ = wave * 64 + lane;
    if (blockIdx.x < 96) { for (int li = 0; li < 2; ++li) {
        const int col = (blockIdx.x % 96) * 64 + lane; const float* w = C.in(I_ADAW) + (size_t)li * DM * 6144 + (size_t)(128 * wave) * 6144 + col;
        float cr[9][2];
#pragma unroll
        for (int q = 0; q < 9; ++q)
#pragma unroll
            for (int j = 0; j < 2; ++j) { const int k = 128 * wave + 64 * j + lane; cr[q][j] = silu_(q < 8 ? C.in(I_C)[q * 1024 + k] : C.in(I_CCTX)[k]); }
        float acc[9];
#pragma unroll
        for (int q = 0; q < 9; ++q) acc[q] = 0.f;
#pragma unroll
        for (int k0 = 0; k0 < 128; k0 += 32) { float wv[32];
#pragma unroll
            for (int k = 0; k < 32; ++k) wv[k] = w[(size_t)(k0 + k) * 6144];
#pragma unroll
            for (int k = 0; k < 32; ++k)
#pragma unroll
                for (int q = 0; q < 9; ++q) acc[q] += __uint_as_float(__builtin_amdgcn_readlane(__float_as_uint(cr[q][(k0 + k) >> 6]), (k0 + k) & 63)) * wv[k]; }
        LAS float* red = (LAS float*)(lds + 40960);
#pragma unroll
        for (int q = 0; q < 9; ++q) red[(wave * 9 + q) * 64 + lane] = acc[q];
        __syncthreads();
        for (int e = tid_; e < 9 * 64; e += 512) { const int q = e >> 6, cl = e & 63; float sum = 0.f;
#pragma unroll
            for (int wv2 = 0; wv2 < 8; ++wv2) sum += red[(wv2 * 9 + q) * 64 + cl];
            const int cc = (blockIdx.x % 96) * 64 + cl; C.mod()[(li * 9 + q) * 6144 + cc] = sum + C.in(I_ADAB)[li * 6144 + cc]; }
        __syncthreads(); }
    } else if (blockIdx.x < 224) { const int j = blockIdx.x - 96; s5_build_w(C, j >> 6, (j >> 2) & 15, j & 3, (LAS float*)(lds + 40960), tid_); }
    LAS float* scr = (LAS float*)(lds + 40960 + wave * 8704);
    if (blockIdx.x == 0 && tid_ < 256) {
        const float v0 = C.in(I_HGLB)[tid_], v1 = C.in(I_HGLB)[256 + tid_];
        C.lb()[tid_] = 0.f; C.lb()[256 + tid_] = 1.0f / (1.0f + expf(v0 - v1));
    }
    constexpr int N_MOD = 0, N_WIN = 2 * 16 * 232,     N_WBR = 8 * 4 * 32, N_WOUT = 2 * 16 * 32, N_GLU = 2 * 4 * 8;
    for (int it = gw; it < N_MOD + N_WIN + N_WBR + N_WOUT + N_GLU; it += ngw) {
        int r = it;
        r -= N_MOD;
        if (r < N_WIN) { const int li = r / (16 * 232), it2 = r % (16 * 232), kb = it2 / 232, nb = it2 % 232; const float* src = C.in(I_WIN) + (size_t)li * DM * DIN + (size_t)(64 * kb) * DIN + 32 * nb;
            if (nb < C_GATE / 32) transpose_item(src, DIN, C.win() + (size_t)li * DIN * DM + (size_t)(32 * nb) * DM + 64 * kb, DM, scr, lane);
            else transpose_item8(src, DIN, C.ws() + WS_WIN + (size_t)li * DIN * DM * 2 + WS_WIN8_OFF + (size_t)(32 * nb - C_GATE) * DM + 64 * kb, DM, scr, lane);
            continue; }
        r -= N_WIN;
        if (r < N_WBR) { const int m = r / 128, it2 = r % 128, kb = it2 / 32, nb = it2 % 32;
            transpose_item(C.in(I_WBR) + (size_t)m * 256 * DM + (size_t)(64 * kb) * DM + 32 * nb, DM, C.wbr() + (size_t)(m >> 2) * DM * DM + (size_t)(32 * nb) * DM + (m & 3) * 256 + 64 * kb, DM, scr, lane); continue; }
        r -= N_WBR;
        if (r < N_WOUT) { const int li = r / 512; tr_plain(C.in(I_WOUT) + (size_t)li * DM * DM, DM, DM, C.wout() + (size_t)li * DM * DM, scr, r % 512, lane); continue; }
        r -= N_WOUT;
        { const int li = r / 32; tr_plain(C.in(I_GLU) + (size_t)li * 65536, 256, 256, C.GLUT() + (size_t)li * 65536, scr, r % 32, lane); }
    }
}

DI void moe_combine_row(const Ctx& C, size_t R, const float* g2, f32x4 (&v)[4], int lane) {
    f32x4 a[4];
#pragma unroll
    for (int j = 0; j < 4; ++j) a[j] = (f32x4){0.f, 0.f, 0.f, 0.f};
    int sv[NE];
#pragma unroll
    for (int e = 0; e < NE; ++e) sv[e] = C.sel()[(size_t)e * NTOK + R];
#pragma unroll
    for (int e = 0; e < NE; ++e) { const int s = __builtin_amdgcn_readfirstlane(sv[e]);
        if (s >= 0) { const bf16_t* y = C.XE() + ((size_t)e * EROWS + s) * DM;
#pragma unroll
            for (int j = 0; j < 4; ++j) { const u32x2 w = __builtin_nontemporal_load((const u32x2*)(y + 4 * (lane + 64 * j))); a[j][0] += lo_f(w.x); a[j][1] += hi_f(w.x); a[j][2] += lo_f(w.y); a[j][3] += hi_f(w.y); } }
    }
#pragma unroll
    for (int j = 0; j < 4; ++j) v[j] = v[j] + *(const f32x4*)(g2 + 4 * (lane + 64 * j)) * a[j];
}
DI void norm1_row(const Ctx& C, int li, int R, const float* nw, int lane, float* Xout, f32x4 (&v)[4]) {
    const int b = R / LSEQ, i = R % LSEQ, mr = (i < CTXL) ? 8 : b;
    if (li > 0) moe_combine_row(C, R, C.mod() + ((li - 1) * 9 + mr) * 6144 + 5 * 1024, v, lane);
    float ss = 0.f;
#pragma unroll
    for (int j = 0; j < 4; ++j) { if (li > 0) *(f32x4*)(Xout + (size_t)R * DM + 4 * (lane + 64 * j)) = v[j];     ss += v[j][0] * v[j][0] + v[j][1] * v[j][1] + v[j][2] * v[j][2] + v[j][3] * v[j][3]; }
    const float rstd = 1.0f / sqrtf(wave_sum(ss) * (1.0f / DM) + EPS);
    const float* md = C.mod() + (li * 9 + mr) * 6144;
#pragma unroll
    for (int j = 0; j < 4; ++j) { const int c = 4 * (lane + 64 * j);
        const f32x4 w = *(const f32x4*)(nw + c), sh = *(const f32x4*)(md + c), sc = *(const f32x4*)(md + 1024 + c);
        const f32x4 h = v[j] * rstd * w * (sc + 1.0f) + sh;
        u32x2 o; o.x = pk2(h[0], h[1]); o.y = pk2(h[2], h[3]);
        *(u32x2*)(C.H() + (size_t)R * DM + c) = o;
        *(unsigned*)(C.ws() + WS_H8 + (size_t)R * DM + c) = pk4_fp8(h[0] * FP8_XS, h[1] * FP8_XS, h[2] * FP8_XS, h[3] * FP8_XS); }
}
DI const float* xrow_src(const Ctx& C, int li, int R) {
    if (li > 0) return C.X() + (size_t)R * DM;
    const int b = R / LSEQ, i = R % LSEQ;
    return (i < CTXL) ? C.in(I_CTX) + ((size_t)b * CTXL + i) * DM : C.in(I_X) + ((size_t)b * SEQ + (i - CTXL)) * DM;
}
DI void phase_norm1(const Ctx& C, int li, int gw, int ngw, int lane, float* Xout) {
    const float* nw = C.in(I_NMIX) + li * DM;
    for (int R = gw; R < NTOK; R += 4 * ngw) {
        f32x4 v[4][4];
#pragma unroll
        for (int q = 0; q < 4; ++q) { const int Rq = R + q * ngw; if (Rq < NTOK) { const float* src = xrow_src(C, li, Rq);
#pragma unroll
            for (int j = 0; j < 4; ++j) v[q][j] = *(const f32x4*)(src + 4 * (lane + 64 * j)); } }
#pragma unroll
        for (int q = 0; q < 4; ++q) { const int Rq = R + q * ngw; if (Rq < NTOK) norm1_row(C, li, Rq, nw, lane, Xout, v[q]); }
    }
}
DI void phase_final(const Ctx& C, int gw, int ngw, int lane) {
    for (int t0 = gw; t0 < NB * SEQ; t0 += 4 * ngw) {
        f32x4 v[4][4];
#pragma unroll
        for (int q = 0; q < 4; ++q) { const int t = t0 + q * ngw; if (t < NB * SEQ) { const size_t R = (size_t)(t / SEQ) * LSEQ + CTXL + (t % SEQ);
#pragma unroll
            for (int j = 0; j < 4; ++j) v[q][j] = __builtin_nontemporal_load((const f32x4*)(C.X() + R * DM + 4 * (lane + 64 * j))); } }
#pragma unroll
        for (int q = 0; q < 4; ++q) { const int t = t0 + q * ngw; if (t < NB * SEQ) { const int b = t / SEQ; const size_t R = (size_t)b * LSEQ + CTXL + (t % SEQ);
            moe_combine_row(C, R, C.mod() + (1 * 9 + b) * 6144 + 5 * 1024, v[q], lane);
#pragma unroll
            for (int j = 0; j < 4; ++j) __builtin_nontemporal_store(v[q][j], (f32x4*)(C.out() + (size_t)t * DM + 4 * (lane + 64 * j))); } }
    }
}

DI void phase_norm2(const Ctx& C, int li, LAS unsigned char* lds, int gw, int ngw, int wave, int lane) {
    const int tid_ = wave * 64 + lane;
    LAS float* rwT = (LAS float*)lds;
    for (int i = tid_; i < DM * NE / 4; i += 512) { const f32x4 v = ((const f32x4*)(C.in(I_RW) + (size_t)li * DM * NE))[i]; const int c = i >> 2, e0 = (i & 3) * 4;
        rwT[(e0 + 0) * DM + c] = v[0]; rwT[(e0 + 1) * DM + c] = v[1]; rwT[(e0 + 2) * DM + c] = v[2]; rwT[(e0 + 3) * DM + c] = v[3]; }
    __syncthreads();
    const float* nw = C.in(I_NFFN) + li * DM;
    for (int R0 = gw; R0 < NTOK; R0 += 4 * ngw) {
      f32x4 vq[4][4];
#pragma unroll
      for (int q = 0; q < 4; ++q) { const int R = R0 + q * ngw; if (R < NTOK) {
#pragma unroll
          for (int j = 0; j < 4; ++j) vq[q][j] = *(const f32x4*)(C.X() + (size_t)R * DM + 4 * (lane + 64 * j)); } }
#pragma unroll
      for (int q = 0; q < 4; ++q) { const int R = R0 + q * ngw; if (R >= NTOK) continue;
        const int b = R / LSEQ, i = R % LSEQ, mr = (i < CTXL) ? 8 : b;
        if (li == DEPTH - 1 && i < CTXL) continue;
        f32x4 (&v)[4] = vq[q]; float ss = 0.f;
#pragma unroll
        for (int j = 0; j < 4; ++j) ss += v[j][0] * v[j][0] + v[j][1] * v[j][1] + v[j][2] * v[j][2] + v[j][3] * v[j][3];
        const float rstd = 1.0f / sqrtf(wave_sum(ss) * (1.0f / DM) + EPS);
        const float* md = C.mod() + (li * 9 + mr) * 6144;
        float y[NE];
#pragma unroll
        for (int e = 0; e < NE; ++e) y[e] = 0.f;
#pragma unroll
        for (int j = 0; j < 4; ++j) { const int c = 4 * (lane + 64 * j);
            const f32x4 w = *(const f32x4*)(nw + c), sh = *(const f32x4*)(md + 3 * 1024 + c), sc = *(const f32x4*)(md + 4 * 1024 + c);
            const f32x4 h = v[j] * rstd * w * (sc + 1.0f) + sh;
            u32x2 o; o.x = pk2(h[0], h[1]); o.y = pk2(h[2], h[3]);
            *(u32x2*)(C.H() + (size_t)R * DM + c) = o;
#pragma unroll
            for (int e = 0; e < NE; ++e) { const f32x4 r4 = *(const LAS f32x4*)(rwT + e * DM + c); y[e] += h[0] * r4[0] + h[1] * r4[1] + h[2] * r4[2] + h[3] * r4[3]; } }
        float y8[8], y4[4], y2[2], lg;
        { const bool hi = (lane & 32) != 0;
#pragma unroll
          for (int k = 0; k < 8; ++k) { const float keep = hi ? y[k + 8] : y[k], send = hi ? y[k] : y[k + 8]; y8[k] = keep + shx<32>(send); } }
        { const bool hi = (lane & 16) != 0;
#pragma unroll
          for (int k = 0; k < 4; ++k) { const float keep = hi ? y8[k + 4] : y8[k], send = hi ? y8[k] : y8[k + 4]; y4[k] = keep + shx<16>(send); } }
        { const bool hi = (lane & 8) != 0;
#pragma unroll
          for (int k = 0; k < 2; ++k) { const float keep = hi ? y4[k + 2] : y4[k], send = hi ? y4[k] : y4[k + 2]; y2[k] = keep + shx<8>(send); } }
        { const bool hi = (lane & 4) != 0; const float keep = hi ? y2[1] : y2[0], send = hi ? y2[0] : y2[1]; lg = keep + shx<4>(send); }
        lg += shx<2>(lg); lg += shx<1>(lg);
        float mx = lg;
        mx = fmaxf(mx, shx<4>(mx)); mx = fmaxf(mx, shx<8>(mx)); mx = fmaxf(mx, shx<16>(mx)); mx = fmaxf(mx, shx<32>(mx));
        const float ex = expf(lg - mx);
        float den = ex;
        den += shx<4>(den); den += shx<8>(den); den += shx<16>(den); den += shx<32>(den);
        if ((lane & 3) == 0) C.aff()[(size_t)R * NE + ((lane >> 2) & 15)] = ex / den;
      }
    }
}

DI void phase_topk(const Ctx& C, int li, LAS unsigned char* lds, int wave, int lane) {
    LAS unsigned* cnt = (LAS unsigned*)lds;
    LAS int* rows = (LAS int*)(lds + 64);
    const int tid = wave * 64 + lane, nunit = (li == DEPTH - 1) ? 128 : 256;
    for (int u = blockIdx.x; u < nunit; u += gridDim.x) {
        const int kind = u >> 7, b = (u >> 4) & 7, e = u & 15;
        const int n = kind ? CTXL : SEQ, cap = kind ? CAP_C : CAP_L, per = n / 512 + (kind ? 1 : 0);
        const size_t rbase = (size_t)b * LSEQ + (kind ? 0 : CTXL);
        unsigned v[8];
#pragma unroll
        for (int j = 0; j < 8; ++j) { const int t = tid + 512 * j; v[j] = (j < per && t < n) ? __float_as_uint(C.aff()[(rbase + t) * NE + e]) : 0u; }
        unsigned thr = 0u;
        for (int bit = 30; bit >= 0; --bit) {
            const unsigned cand = thr | (1u << bit);
            if (tid == 0) cnt[0] = 0u;
            __syncthreads();
            unsigned c = 0;
#pragma unroll
            for (int j = 0; j < 8; ++j) c += (v[j] >= cand) ? 1u : 0u;
            c = (unsigned)wave_sum((float)c);
            if (lane == 0) atomicAdd((unsigned*)cnt, c);
            __syncthreads();
            if (cnt[0] >= (unsigned)cap) thr = cand;
            __syncthreads();
        }
        if (tid == 0) { cnt[1] = 0u; cnt[2] = 0u; }
        __syncthreads();
        unsigned ngt = 0;
#pragma unroll
        for (int j = 0; j < 8; ++j) ngt += (v[j] > thr) ? 1u : 0u;
        ngt = (unsigned)wave_sum((float)ngt);
        if (lane == 0) atomicAdd((unsigned*)cnt + 1, ngt);
        __syncthreads();
        const unsigned n_gt = cnt[1];
        __syncthreads();
        if (tid == 0) cnt[1] = 0u;
        __syncthreads();
        const int srow0 = kind ? (NB * CAP_L + b * CAP_C) : b * CAP_L;
#pragma unroll
        for (int j = 0; j < 8; ++j) { const int t = tid + 512 * j;
            if (j < per && t < n) {
                int slot = -1;
                if (v[j] > thr) slot = (int)atomicAdd((unsigned*)cnt + 1, 1u);
                else if (v[j] == thr) { const unsigned k = atomicAdd((unsigned*)cnt + 2, 1u); if (n_gt + k < (unsigned)cap) slot = (int)(n_gt + k); }
                C.sel()[(size_t)e * NTOK + rbase + t] = (slot >= 0) ? srow0 + slot : -1;
                if (slot >= 0) { rows[slot] = (int)(rbase + t); C.gate()[(size_t)e * EROWS + srow0 + slot] = __uint_as_float(v[j]); }
            } }
        __syncthreads();
        for (int s0 = wave; s0 < cap; s0 += 32) {
            u32x4 xa[4], xb[4];
#pragma unroll
            for (int q = 0; q < 4; ++q) { const int sq = s0 + 8 * q; if (sq < cap) { const u32x4* src = (const u32x4*)(C.H() + (size_t)rows[sq] * DM) + 2 * lane; xa[q] = src[0]; xb[q] = src[1]; } }
#pragma unroll
            for (int q = 0; q < 4; ++q) { const int sq = s0 + 8 * q; if (sq >= cap) continue; const u32x4 x0 = xa[q], x1 = xb[q];
                u32x4 o; o.x = pk4_fp8(lo_f(x0.x) * FP8_XS, hi_f(x0.x) * FP8_XS, lo_f(x0.y) * FP8_XS, hi_f(x0.y) * FP8_XS); o.y = pk4_fp8(lo_f(x0.z) * FP8_XS, hi_f(x0.z) * FP8_XS, lo_f(x0.w) * FP8_XS, hi_f(x0.w) * FP8_XS);
                o.z = pk4_fp8(lo_f(x1.x) * FP8_XS, hi_f(x1.x) * FP8_XS, lo_f(x1.y) * FP8_XS, hi_f(x1.y) * FP8_XS); o.w = pk4_fp8(lo_f(x1.z) * FP8_XS, hi_f(x1.z) * FP8_XS, lo_f(x1.w) * FP8_XS, hi_f(x1.w) * FP8_XS);
                *((u32x4*)((unsigned char*)C.XE() + ((size_t)e * EROWS + srow0 + sq) * DM) + lane) = o; }
        }
        __syncthreads();
    }
}

DI void phase_prep(const Ctx& C, int li, int gw, int ngw, int lane) {
    const float* wq = C.in(I_NAQN) + li * 64; const float* wk = C.in(I_NAKN) + li * 64;
    const int d0 = (lane & 7) * 8; const bool isq = lane < 32;
    float w[8];
#pragma unroll
    for (int j = 0; j < 8; ++j) w[j] = isq ? wq[d0 + j] * 0.125f : wk[d0 + j];
    for (int R0 = gw; R0 < NTOK; R0 += 4 * ngw) {
        u32x4 xq[4];
#pragma unroll
        for (int q = 0; q < 4; ++q) { const int R = R0 + q * ngw; if (R < NTOK) xq[q] = *(const u32x4*)(C.P() + (size_t)R * DIN + C_NAQ + 8 * lane); }
#pragma unroll
        for (int q = 0; q < 4; ++q) { const int R = R0 + q * ngw; if (R >= NTOK) continue; const u32x4 x = xq[q];
            float f[8] = {lo_f(x.x), hi_f(x.x), lo_f(x.y), hi_f(x.y), lo_f(x.z), hi_f(x.z), lo_f(x.w), hi_f(x.w)};
            float ss = 0.f;
#pragma unroll
            for (int j = 0; j < 8; ++j) ss += f[j] * f[j];
            ss += shx<1>(ss); ss += shx<2>(ss); ss += shx<4>(ss);
            const float rs = __builtin_amdgcn_rsqf(ss * (1.0f / 64.0f) + EPS);
            u32x4 o; o.x = pk2(f[0] * rs * w[0], f[1] * rs * w[1]); o.y = pk2(f[2] * rs * w[2], f[3] * rs * w[3]); o.z = pk2(f[4] * rs * w[4], f[5] * rs * w[5]); o.w = pk2(f[6] * rs * w[6], f[7] * rs * w[7]);
            *(u32x4*)(C.QKN() + (size_t)R * 512 + 8 * lane) = o; }
    }
}

typedef short s16x4 __attribute__((ext_vector_type(4)));
#define MFMA16(a, b, c) __builtin_amdgcn_mfma_f32_16x16x32_bf16((a), (b), (c), 0, 0, 0)
DI bf16x8 ld16(const bf16_t* p) { return *(const bf16x8*)p; }
DI s16x4 tr16(const LAS bf16_t* p) { return __builtin_amdgcn_ds_read_tr16_b64_v4i16((LAS s16x4*)p); }
DI bf16x8 cat8(s16x4 a, s16x4 b) { return __builtin_shufflevector(a, b, 0, 1, 2, 3, 4, 5, 6, 7); }
DI bf16x8 pack8(const f32x4& a, const f32x4& b) { u32x4 w; w.x = pg8::cvt_pk_bf16(a[0], a[1]); w.y = pg8::cvt_pk_bf16(a[2], a[3]); w.z = pg8::cvt_pk_bf16(b[0], b[1]); w.w = pg8::cvt_pk_bf16(b[2], b[3]); return __builtin_bit_cast(bf16x8, w); }

constexpr int NA_VS = 80;
DI void na_unit(const Ctx& C, int li, int wu, bool isctx, int lane, LAS bf16_t* vl, const LAS float* rpbt) {
    const int cq = lane & 15, g = lane >> 4;
    int b, h, r, c; size_t Rq;
    if (!isctx) { c = wu & 3; h = (wu >> 2) & 3; r = (wu >> 4) & 63; b = wu >> 10; Rq = (size_t)b * LSEQ + CTXL + r * 64 + 16 * c + cq; }
    else { c = wu & 15; h = (wu >> 4) & 3; b = wu >> 6; r = 0; Rq = (size_t)b * LSEQ + 16 * c + cq; }
    const bf16_t* QKN = C.QKN(); const bf16_t* P = C.P();
    bf16x8 qf[2];
    qf[0] = ld16(QKN + Rq * 512 + h * 64 + 8 * g); qf[1] = ld16(QKN + Rq * 512 + h * 64 + 32 + 8 * g);
    f32x4 o[4];
#pragma unroll
    for (int d = 0; d < 4; ++d) o[d] = (f32x4){0.f, 0.f, 0.f, 0.f};
    float lsum = 0.f;
    const int r0 = min(max(r - 4, 0), 56), kc0 = (c == 0) ? 0 : (c == 1) ? 8 : (c == 2) ? 24 : 32, qi = 16 * c + cq, cs = min(max(qi - 8, 0), 48);
    const LAS float* rpb = rpbt + h * 465;
    const size_t rowb = (size_t)b * LSEQ;
    const int nch = isctx ? 4 : 8;
    const int dwin = kc0 + 4 * g - cs, ebias = kc0 + 4 * g - qi + 15;
    const unsigned voffV = (unsigned)((lane >> 3) * DIN + 8 * (lane & 7)) * 2u, voffK = (unsigned)(cq * 512 + 8 * g) * 2u;
    const __amdgpu_buffer_rsrc_t rsP = __builtin_amdgcn_make_buffer_rsrc((void*)P, 0, 0x7fffffff, 0x00020000), rsK = __builtin_amdgcn_make_buffer_rsrc((void*)QKN, 0, 0x7fffffff, 0x00020000);
    const unsigned Pv0 = (unsigned)(C_NAV + h * 64) * 2u, Kv0 = (unsigned)(256 + h * 64) * 2u;
#define NA_CHROW(ch_) ((!isctx && (ch_) < 4) ? (rowb + CTXL + (size_t)(r0 + 2 * (ch_)) * 64 + kc0) : (rowb + 64 * (size_t)(isctx ? (ch_) : (ch_) - 4)))
#define NA_VSTEP(ch_, i) ((!isctx && (ch_) < 4) ? (((i) >> 2) * 64 + 8 * ((i) & 3)) : 8 * (i))
#define NA_KSTEP(ch_, kb) ((!isctx && (ch_) < 4) ? (((kb) >> 1) * 64 + 16 * ((kb) & 1)) : 16 * (kb))
    bf16x8 vA[8], kA[8], vB[8], kB[8];
#define NA_PREFETCH(VR, KR, ch_) do { const size_t cr_ = NA_CHROW(ch_); \
        _Pragma("unroll") for (int i = 0; i < 8; ++i) VR[i] = __builtin_bit_cast(bf16x8, __builtin_amdgcn_raw_buffer_load_b128(rsP, voffV, (unsigned)(cr_ + NA_VSTEP(ch_, i)) * (unsigned)(DIN * 2) + Pv0, 0)); \
        _Pragma("unroll") for (int kb = 0; kb < 4; ++kb) { const unsigned ko_ = (unsigned)(cr_ + NA_KSTEP(ch_, kb)) * 1024u + Kv0; \
            KR[2 * kb] = __builtin_bit_cast(bf16x8, __builtin_amdgcn_raw_buffer_load_b128(rsK, voffK, ko_, 0)); KR[2 * kb + 1] = __builtin_bit_cast(bf16x8, __builtin_amdgcn_raw_buffer_load_b128(rsK, voffK, ko_ + 64u, 0)); } } while (0)
#define NA_BODY(VR, KR, ch_) do { const int chv = (ch_); const bool local = !isctx && chv < 4; \
          \
        _Pragma("unroll") for (int i = 0; i < 8; ++i) *(LAS bf16x8*)(vl + (lane >> 3) * NA_VS + 8 * (lane & 7) + i * 8 * NA_VS) = VR[i]; \
        f32x4 s[4]; \
        _Pragma("unroll") for (int kb = 0; kb < 4; ++kb) { s[kb] = MFMA16(KR[2 * kb], qf[0], ((f32x4){0.f, 0.f, 0.f, 0.f})); s[kb] = MFMA16(KR[2 * kb + 1], qf[1], s[kb]); } \
        asm volatile("" : "+v"(s[0]), "+v"(s[1]), "+v"(s[2]), "+v"(s[3]));     \
        if (chv + 2 < nch) NA_PREFETCH(VR, KR, chv + 2); \
        _Pragma("unroll") for (int kb = 0; kb < 4; ++kb) \
            _Pragma("unroll") for (int i = 0; i < 4; ++i) { float pv; \
                if (local) { const int dcol = dwin + 16 * (kb & 1) + i; const bool ok = (unsigned)dcol < 16u; \
                    const int bi = ok ? ((r0 + 2 * chv + (kb >> 1) - r + 7) * 31 + ebias + 16 * (kb & 1) + i) : 0; \
                    pv = ok ? __expf(s[kb][i] + rpb[bi] - 8.0f) : 0.f; } \
                else pv = __expf(s[kb][i] - 8.0f); \
                s[kb][i] = pv; lsum += pv; } \
        const bf16x8 pb0 = pack8(s[0], s[1]), pb1 = pack8(s[2], s[3]); \
        const int q4 = cq >> 2, p4 = cq & 3; \
        _Pragma("unroll") for (int db = 0; db < 4; ++db) { \
            const LAS bf16_t* base = vl + (4 * g + q4) * NA_VS + 16 * db + 4 * p4; \
            const bf16x8 va0 = cat8(tr16(base), tr16(base + 16 * NA_VS)), va1 = cat8(tr16(base + 32 * NA_VS), tr16(base + 48 * NA_VS)); \
            o[db] = MFMA16(va0, pb0, o[db]); o[db] = MFMA16(va1, pb1, o[db]); } } while (0)
    NA_PREFETCH(vA, kA, 0); NA_PREFETCH(vB, kB, 1);
    for (int ch = 0; ch < nch; ch += 2) { NA_BODY(vA, kA, ch); NA_BODY(vB, kB, ch + 1); }
#undef NA_BODY
#undef NA_CHROW
#undef NA_VSTEP
#undef NA_KSTEP
#undef NA_PREFETCH
    lsum += shx<16>(lsum); lsum += shx<32>(lsum);
    const float il = 1.0f / lsum;
    bf16_t* op = C.O() + Rq * DM + 256 + h * 64 + 4 * g;
#pragma unroll
    for (int db = 0; db < 4; ++db) { u32x2 w; w.x = pk2(o[db][0] * il, o[db][1] * il); w.y = pk2(o[db][2] * il, o[db][3] * il); *(u32x2*)(op + 16 * db) = w; }
}


DI void prep_ret(const Ctx& C, int li, int gw, int ngw, int lane) {
    const int rsub = lane >> 4, h = (lane >> 2) & 3, jb = lane & 3;
    const float lg0 = __log2f(sigm(C.in(I_RETD)[(li * 2 + 0) * 4 + h])), lg1 = __log2f(sigm(C.in(I_RETD)[(li * 2 + 1) * 4 + h]));
    float inv[8];
#pragma unroll
    for (int e = 0; e < 8; ++e) inv[e] = exp2f(-(float)(8 * (jb & 1) + e) * (13.287712379549449f / 16.0f));
    bf16_t* RP = C.RETP(); const bf16_t* P = C.P();
    for (int it = gw; it < NTOK / 4; it += ngw) {
        const size_t R = (size_t)it * 4 + rsub; const int i = (int)(R % LSEQ), il = i & 63;
        const size_t pq = R * DIN + C_RTQ + h * 64 + 8 * jb, pk = R * DIN + C_RTK + h * 64 + 8 * jb;
        const u32x4 q1w = *(const u32x4*)(P + pq), q2w = *(const u32x4*)(P + pq + 32), k1w = *(const u32x4*)(P + pk), k2w = *(const u32x4*)(P + pk + 32);
        float q1[8] = {lo_f(q1w.x), hi_f(q1w.x), lo_f(q1w.y), hi_f(q1w.y), lo_f(q1w.z), hi_f(q1w.z), lo_f(q1w.w), hi_f(q1w.w)};
        float q2[8] = {lo_f(q2w.x), hi_f(q2w.x), lo_f(q2w.y), hi_f(q2w.y), lo_f(q2w.z), hi_f(q2w.z), lo_f(q2w.w), hi_f(q2w.w)};
        float k1[8] = {lo_f(k1w.x), hi_f(k1w.x), lo_f(k1w.y), hi_f(k1w.y), lo_f(k1w.z), hi_f(k1w.z), lo_f(k1w.w), hi_f(k1w.w)};
        float k2[8] = {lo_f(k2w.x), hi_f(k2w.x), lo_f(k2w.y), hi_f(k2w.y), lo_f(k2w.z), hi_f(k2w.z), lo_f(k2w.w), hi_f(k2w.w)};
        if (i >= CTXL) { const int t = i - CTXL; const float pos = (float)((jb < 2) ? (t >> 6) : (t & 63));
#pragma unroll
            for (int e = 0; e < 8; ++e) { const float ang = pos * inv[e], sn = __sinf(ang), cs = __cosf(ang);
                const float a = q1[e] * cs - q2[e] * sn, b2 = q2[e] * cs + q1[e] * sn; q1[e] = a; q2[e] = b2;
                const float c2 = k1[e] * cs - k2[e] * sn, d2 = k2[e] * cs + k1[e] * sn; k1[e] = c2; k2[e] = d2; } }
        const float fil = (float)il;
        const float sq0 = exp2f(fil * lg0), sk0 = 0.125f * exp2f(-fil * lg0), sq1 = exp2f(-fil * lg1), sk1 = 0.125f * exp2f(fil * lg1);
        const size_t o = R * 256 + h * 64 + 8 * jb;
#define PK8(arr, sc) ((u32x4){pk2(arr[0] * sc, arr[1] * sc), pk2(arr[2] * sc, arr[3] * sc), pk2(arr[4] * sc, arr[5] * sc), pk2(arr[6] * sc, arr[7] * sc)})
        *(u32x4*)(RP + 0 * RETP_T + o) = PK8(q1, sq0); *(u32x4*)(RP + 0 * RETP_T + o + 32) = PK8(q2, sq0);
        *(u32x4*)(RP + 1 * RETP_T + o) = PK8(k1, sk0); *(u32x4*)(RP + 1 * RETP_T + o + 32) = PK8(k2, sk0);
        *(u32x4*)(RP + 2 * RETP_T + o) = PK8(q1, sq1); *(u32x4*)(RP + 2 * RETP_T + o + 32) = PK8(q2, sq1);
        *(u32x4*)(RP + 3 * RETP_T + o) = PK8(k1, sk1); *(u32x4*)(RP + 3 * RETP_T + o + 32) = PK8(k2, sk1);
#undef PK8
    }
}
constexpr int RT_TS = 272;
DI void stage_tile64x256(LAS bf16_t* dst, const bf16_t* src, size_t srcld, int tid) {
#pragma unroll
    for (int i = 0; i < 4; ++i) { const int p = tid + 512 * i, row = p >> 5, c16 = p & 31;
        *(LAS bf16x8*)(dst + row * RT_TS + 8 * c16) = ld16(src + (size_t)row * srcld + 8 * c16); }
}
DI size_t st_off(int b, int h, int d, int c) { return ((size_t)(((b * 4 + h) * 2 + d) * NCHK + c)) * 4096; }
DI void ret_pass1(const Ctx& C, LAS unsigned char* lds, int wave, int lane) {
    LAS bf16_t* vt = (LAS bf16_t*)lds; LAS bf16_t* k0t = vt + 64 * RT_TS; LAS bf16_t* k1t = k0t + 64 * RT_TS;
    const int tid = wave * 64 + lane, cq = lane & 15, g = lane >> 4, q4 = cq >> 2, p4 = cq & 3, h = wave & 3, d = wave >> 2;
    const bf16_t* P = C.P(); const bf16_t* RP = C.RETP(); bf16_t* ST = C.RETS();
    for (int u = blockIdx.x; u < NB * NCHK; u += gridDim.x) {
        const int b = u / NCHK, c = u % NCHK; const size_t R0 = (size_t)b * LSEQ + 64 * c;
        __syncthreads();
        stage_tile64x256(vt, P + R0 * DIN + C_RTV, DIN, tid);
        stage_tile64x256(k0t, RP + 1 * RETP_T + R0 * 256, 256, tid);
        stage_tile64x256(k1t, RP + 3 * RETP_T + R0 * 256, 256, tid);
        __syncthreads();
        const LAS bf16_t* kt = d ? k1t : k0t;
        f32x4 S[4][4];
#pragma unroll
        for (int mb = 0; mb < 4; ++mb)
#pragma unroll
            for (int nb = 0; nb < 4; ++nb) S[mb][nb] = (f32x4){0.f, 0.f, 0.f, 0.f};
#pragma unroll
        for (int ks = 0; ks < 2; ++ks) {
            bf16x8 a[4], bv[4];
#pragma unroll
            for (int mb = 0; mb < 4; ++mb) { const LAS bf16_t* p = kt + (32 * ks + 8 * g + q4) * RT_TS + h * 64 + 16 * mb + 4 * p4; a[mb] = cat8(tr16(p), tr16(p + 4 * RT_TS)); }
#pragma unroll
            for (int nb = 0; nb < 4; ++nb) { const LAS bf16_t* p = vt + (32 * ks + 8 * g + q4) * RT_TS + h * 64 + 16 * nb + 4 * p4; bv[nb] = cat8(tr16(p), tr16(p + 4 * RT_TS)); }
#pragma unroll
            for (int mb = 0; mb < 4; ++mb)
#pragma unroll
                for (int nb = 0; nb < 4; ++nb) S[mb][nb] = MFMA16(a[mb], bv[nb], S[mb][nb]);
        }
        bf16_t* sp = ST + st_off(b, h, d, c);
#pragma unroll
        for (int mb = 0; mb < 4; ++mb)
#pragma unroll
            for (int nb = 0; nb < 4; ++nb) { u32x2 w; w.x = pk2(S[mb][nb][0], S[mb][nb][1]); w.y = pk2(S[mb][nb][2], S[mb][nb][3]); *(u32x2*)(sp + (16 * nb + cq) * 64 + 16 * mb + 4 * g) = w; }
    }
}
DI int chunk_at(int d, int s) { return d == 0 ? s : (s < 4 ? 3 - s : NCHK + 3 - s); }
DI void ret_carry(const Ctx& C, int li, int gw, int ngw, int lane) {
    bf16_t* ST = C.RETS();
    for (int it = gw; it < 64 * 16; it += ngw) {
        const int chain = it >> 4, e0 = ((it & 15) * 64 + lane) * 4, d = chain & 1, h = (chain >> 1) & 3;
        const float gm = sigm(C.in(I_RETD)[(li * 2 + d) * 4 + h]), g64 = __powf(gm, 64.0f);
        const float fo = d ? g64 : gm, dc = g64, sc = d ? 1.0f : __powf(gm, 63.0f);
        const char* cb = (const char*)ST + (size_t)chain * NCHK * 8192; const unsigned voff = (unsigned)e0 * 2u;
        f32x4 S = (f32x4){0.f, 0.f, 0.f, 0.f};
#pragma unroll 1
        for (int s0 = 0; s0 < NCHK; s0 += NCHK / 2) {
            u32x2 w[NCHK / 2];
#pragma unroll
            for (int k = 0; k < NCHK / 2; ++k) w[k] = *(const u32x2*)(cb + (size_t)chunk_at(d, s0 + k) * 8192 + voff);
#pragma unroll
            for (int k = 0; k < NCHK / 2; ++k) { const f32x4 raw = (f32x4){lo_f(w[k].x), hi_f(w[k].x), lo_f(w[k].y), hi_f(w[k].y)};
                const f32x4 o = S * fo; u32x2 ow; ow.x = pk2(o[0], o[1]); ow.y = pk2(o[2], o[3]);
                *(u32x2*)((char*)cb + (size_t)chunk_at(d, s0 + k) * 8192 + voff) = ow;
                S = S * dc + raw * sc; }
        }
    }
}
DI void ret_pass2(const Ctx& C, int li, LAS unsigned char* lds, int wave, int lane) {
    LAS bf16_t* vt = (LAS bf16_t*)lds; LAS bf16_t* k0t = vt + 64 * RT_TS; LAS bf16_t* k1t = k0t + 64 * RT_TS;
    const int tid = wave * 64 + lane, cq = lane & 15, g = lane >> 4, q4 = cq >> 2, p4 = cq & 3, h = wave & 3, half = wave >> 2;
    const bf16_t* P = C.P(); const bf16_t* RP = C.RETP(); const bf16_t* ST = C.RETS(); bf16_t* O = C.O();
    for (int u = blockIdx.x; u < NB * NCHK; u += gridDim.x) {
        const int b = u / NCHK, c = u % NCHK; const size_t R0 = (size_t)b * LSEQ + 64 * c;
        if (li == DEPTH - 1 && c < 4) continue;
        __syncthreads();
        stage_tile64x256(vt, P + R0 * DIN + C_RTV, DIN, tid);
        stage_tile64x256(k0t, RP + 1 * RETP_T + R0 * 256, 256, tid);
        stage_tile64x256(k1t, RP + 3 * RETP_T + R0 * 256, 256, tid);
        bf16x8 sf[2][4][2];
#pragma unroll
        for (int d = 0; d < 2; ++d)
#pragma unroll
            for (int db = 0; db < 4; ++db) { const bf16_t* sp = ST + st_off(b, h, d, c) + (16 * db + cq) * 64 + 8 * g; sf[d][db][0] = ld16(sp); sf[d][db][1] = ld16(sp + 32); }
        __syncthreads();
#pragma unroll 1
        for (int ib = 2 * half; ib < 2 * half + 2; ++ib) {
            const size_t Ri = R0 + 16 * ib + cq;
            bf16x8 qb[2][2];
#pragma unroll
            for (int d = 0; d < 2; ++d)
#pragma unroll
                for (int ks = 0; ks < 2; ++ks) qb[d][ks] = ld16(RP + (size_t)(2 * d) * RETP_T + Ri * 256 + h * 64 + 32 * ks + 8 * g);
            u32x2 gq[4];
#pragma unroll
            for (int db = 0; db < 4; ++db) gq[db] = *(const u32x2*)(P + Ri * DIN + C_RTG + h * 64 + 16 * db + 4 * g);
            f32x4 pT[4];
#pragma unroll
            for (int jb = 0; jb < 4; ++jb) { const int kro = (16 * jb + cq) * RT_TS + h * 64 + 8 * g;
                f32x4 a0 = (f32x4){0.f, 0.f, 0.f, 0.f}, a1 = (f32x4){0.f, 0.f, 0.f, 0.f};
#pragma unroll
                for (int ks = 0; ks < 2; ++ks) { a0 = MFMA16(*(const LAS bf16x8*)(k0t + kro + 32 * ks), qb[0][ks], a0);
                                                 a1 = MFMA16(*(const LAS bf16x8*)(k1t + kro + 32 * ks), qb[1][ks], a1); }
#pragma unroll
                for (int e = 0; e < 4; ++e) { const int j = 16 * jb + 4 * g + e, i = 16 * ib + cq; pT[jb][e] = (j <= i ? a0[e] : 0.f) + (j >= i ? a1[e] : 0.f); } }
            const bf16x8 pb0 = pack8(pT[0], pT[1]), pb1 = pack8(pT[2], pT[3]);
            f32x4 o[4];
#pragma unroll
            for (int db = 0; db < 4; ++db) {
                const LAS bf16_t* base = vt + (4 * g + q4) * RT_TS + h * 64 + 16 * db + 4 * p4;
                const bf16x8 va0 = cat8(tr16(base), tr16(base + 16 * RT_TS)), va1 = cat8(tr16(base + 32 * RT_TS), tr16(base + 48 * RT_TS));
                o[db] = MFMA16(va0, pb0, ((f32x4){0.f, 0.f, 0.f, 0.f})); o[db] = MFMA16(va1, pb1, o[db]);
#pragma unroll
                for (int d = 0; d < 2; ++d) { o[db] = MFMA16(sf[d][db][0], qb[d][0], o[db]); o[db] = MFMA16(sf[d][db][1], qb[d][1], o[db]); }
            }
            float ss = 0.f;
#pragma unroll
            for (int db = 0; db < 4; ++db) ss += o[db][0] * o[db][0] + o[db][1] * o[db][1] + o[db][2] * o[db][2] + o[db][3] * o[db][3];
            ss += shx<16>(ss); ss += shx<32>(ss);
            const float rs = __builtin_amdgcn_rsqf(ss * (1.0f / 64.0f) + EPS);
#pragma unroll
            for (int db = 0; db < 4; ++db) { const u32x2 gw2 = gq[db];
                u32x2 w; w.x = pk2(o[db][0] * rs * silu_(lo_f(gw2.x)), o[db][1] * rs * silu_(hi_f(gw2.x))); w.y = pk2(o[db][2] * rs * silu_(lo_f(gw2.y)), o[db][3] * rs * silu_(hi_f(gw2.y)));
                *(u32x2*)(O + Ri * DM + 768 + h * 64 + 16 * db + 4 * g) = w; }
        }
    }
}


template <int CTRL> DI float dpp_mov0(float x) { return __int_as_float(__builtin_amdgcn_update_dpp(0, __float_as_int(x), CTRL, 0xf, 0xf, true)); }
DI float row_prefix(float x) { x += dpp_mov0<0x111>(x); x += dpp_mov0<0x112>(x); x += dpp_mov0<0x114>(x); x += dpp_mov0<0x118>(x); return x; }
DI float row_suffix(float x) { x += dpp_mov0<0x101>(x); x += dpp_mov0<0x102>(x); x += dpp_mov0<0x104>(x); x += dpp_mov0<0x108>(x); return x; }
DI void prep_hg(const Ctx& C, int li, int gw, int ngw, int lane) {
    const bf16_t* P = C.P(); bf16_t* HP = C.HGP(); float* DEC = C.HGDEC();
    const int t = lane & 15, cg = lane >> 4;
    for (int it = gw; it < NSUB * 8; it += ngw) {
        const int sc = it >> 3, ch0 = (it & 7) * 32 + 8 * cg; const size_t R = (size_t)sc * 16 + t;
        const u32x4 qw = *(const u32x4*)(P + R * DIN + C_HGQ + ch0), f0w = *(const u32x4*)(P + R * DIN + C_HGF + ch0), f1w = *(const u32x4*)(P + R * DIN + C_HGF + 256 + ch0);
        const f32x4 lb0 = *(const f32x4*)(C.lb() + li * 256 + ch0), lb1 = *(const f32x4*)(C.lb() + li * 256 + ch0 + 4);
        const float q[8] = {lo_f(qw.x), hi_f(qw.x), lo_f(qw.y), hi_f(qw.y), lo_f(qw.z), hi_f(qw.z), lo_f(qw.w), hi_f(qw.w)};
        const float f0[8] = {lo_f(f0w.x), hi_f(f0w.x), lo_f(f0w.y), hi_f(f0w.y), lo_f(f0w.z), hi_f(f0w.z), lo_f(f0w.w), hi_f(f0w.w)};
        const float f1[8] = {lo_f(f1w.x), hi_f(f1w.x), lo_f(f1w.y), hi_f(f1w.y), lo_f(f1w.z), hi_f(f1w.z), lo_f(f1w.w), hi_f(f1w.w)};
        float qd0[8], kd0[8], qd1[8], kd1[8], d0[8], d1[8];
#pragma unroll
        for (int e = 0; e < 8; ++e) { const float lb = e < 4 ? lb0[e] : lb1[e - 4];
            const float g0 = lb + (1.0f - lb) * sigm(f0[e]), g1 = lb + (1.0f - lb) * sigm(f1[e]), qs = silu_(q[e]);
            const float c0 = row_prefix(__logf(g0)), c1 = row_suffix(__logf(g1));
            qd0[e] = qs * __expf(c0); kd0[e] = (1.0f - g0) * __expf(fminf(-c0, 80.0f)); qd1[e] = qs * __expf(c1); kd1[e] = (1.0f - g1) * __expf(fminf(-c1, 80.0f));
            d0[e] = __expf(c0); d1[e] = __expf(c1); }
        const size_t o = R * 256 + ch0;
#define PK8V(a) ((u32x4){pk2(a[0], a[1]), pk2(a[2], a[3]), pk2(a[4], a[5]), pk2(a[6], a[7])})
        *(u32x4*)(HP + 0 * RETP_T + o) = PK8V(qd0); *(u32x4*)(HP + 1 * RETP_T + o) = PK8V(kd0); *(u32x4*)(HP + 2 * RETP_T + o) = PK8V(qd1); *(u32x4*)(HP + 3 * RETP_T + o) = PK8V(kd1);
#undef PK8V
        if (t == 15) { float* dp = DEC + (size_t)sc * 256 + ch0; *(f32x4*)dp = (f32x4){d0[0], d0[1], d0[2], d0[3]}; *(f32x4*)(dp + 4) = (f32x4){d0[4], d0[5], d0[6], d0[7]}; }
        if (t == 0) { float* dp = DEC + ((size_t)NSUB + sc) * 256 + ch0; *(f32x4*)dp = (f32x4){d1[0], d1[1], d1[2], d1[3]}; *(f32x4*)(dp + 4) = (f32x4){d1[4], d1[5], d1[6], d1[7]}; }
    }
}
DI void hg_state_step(f32x4 (&S)[4][4], const LAS bf16_t* kt, const LAS bf16_t* vt, int n, int h, int cq, int g, int q4, int p4, const float* dec  ) {
    const int r1 = 16 * n + ((8 * g + q4) & 15), r2 = 16 * n + ((8 * g + 4 + q4) & 15);
    bf16x8 a[4], bv[4];
#pragma unroll
    for (int mb = 0; mb < 4; ++mb) { const int co = h * 64 + 16 * mb + 4 * p4; a[mb] = cat8(tr16(kt + r1 * RT_TS + co), tr16(kt + r2 * RT_TS + co)); }
#pragma unroll
    for (int nb = 0; nb < 4; ++nb) { const int co = h * 64 + 16 * nb + 4 * p4; const bf16x8 v = cat8(tr16(vt + r1 * RT_TS + co), tr16(vt + r2 * RT_TS + co)); bv[nb] = (g < 2) ? v : (bf16x8){0, 0, 0, 0, 0, 0, 0, 0}; }
#pragma unroll
    for (int mb = 0; mb < 4; ++mb) { const f32x4 dv4 = *(const f32x4*)(dec + h * 64 + 16 * mb + 4 * g);
#pragma unroll
        for (int nb = 0; nb < 4; ++nb) { S[mb][nb] = MFMA16(a[mb], bv[nb], S[mb][nb]); S[mb][nb] = S[mb][nb] * dv4; } }
}
DI void hg_pass1(const Ctx& C, LAS unsigned char* lds, int wave, int lane) {
    LAS bf16_t* vt = (LAS bf16_t*)lds; LAS bf16_t* k0t = vt + 64 * RT_TS; LAS bf16_t* k1t = k0t + 64 * RT_TS;
    const int tid = wave * 64 + lane, cq = lane & 15, g = lane >> 4, q4 = cq >> 2, p4 = cq & 3, h = wave & 3, d = wave >> 2;
    const bf16_t* P = C.P(); const bf16_t* HP = C.HGP(); bf16_t* ST = C.HGS(); const float* DEC = C.HGDEC() + (size_t)d * NSUB * 256;
    for (int U = (int)blockIdx.x + ((NB * NCHK - (int)blockIdx.x + (int)gridDim.x - 1) / (int)gridDim.x) * (int)gridDim.x; U < 2 * NB * NCHK; U += gridDim.x) {
        const int u = U - NB * NCHK, b = u / NCHK, c = u % NCHK; const size_t R0 = (size_t)b * LSEQ + 64 * c;
        __syncthreads();
        stage_tile64x256(vt, P + R0 * DIN + C_HGI, DIN, tid);
        stage_tile64x256(k0t, HP + 1 * RETP_T + R0 * 256, 256, tid);
        stage_tile64x256(k1t, HP + 3 * RETP_T + R0 * 256, 256, tid);
        __syncthreads();
        const LAS bf16_t* kt = d ? k1t : k0t;
        f32x4 S[4][4];
#pragma unroll
        for (int mb = 0; mb < 4; ++mb)
#pragma unroll
            for (int nb = 0; nb < 4; ++nb) S[mb][nb] = (f32x4){0.f, 0.f, 0.f, 0.f};
#pragma unroll 1
        for (int sidx = 0; sidx < 4; ++sidx) { const int n = d ? 3 - sidx : sidx;
            hg_state_step(S, kt, vt, n, h, cq, g, q4, p4, DEC + (R0 / 16 + n) * 256); }
        if (lane < 16) { const float* dp = DEC + (R0 / 16) * 256 + h * 64 + 4 * lane;
            *(f32x4*)(C.HGDT() + ((size_t)(((b * 4 + h) * 2 + d) * NCHK + c)) * 64 + 4 * lane) = *(const f32x4*)dp * *(const f32x4*)(dp + 256) * *(const f32x4*)(dp + 512) * *(const f32x4*)(dp + 768); }
        bf16_t* sp = ST + st_off(b, h, d, c);
#pragma unroll
        for (int mb = 0; mb < 4; ++mb)
#pragma unroll
            for (int nb = 0; nb < 4; ++nb) { u32x2 w; w.x = pk2(S[mb][nb][0], S[mb][nb][1]); w.y = pk2(S[mb][nb][2], S[mb][nb][3]); *(u32x2*)(sp + (16 * nb + cq) * 64 + 16 * mb + 4 * g) = w; }
    }
}
DI void hg_carry(const Ctx& C, int gw, int ngw, int lane) {
    bf16_t* ST = C.HGS();
    for (int it = gw; it < 64 * 16; it += ngw) {
        const int chain = it >> 4, e0 = ((it & 15) * 64 + lane) * 4, d = chain & 1, dk0 = e0 & 63;
        const char* DTb = (const char*)(C.HGDT() + (size_t)chain * NCHK * 64); const unsigned doff = (unsigned)dk0 * 4u;
        const char* cb = (const char*)ST + (size_t)chain * NCHK * 8192; const unsigned voff = (unsigned)e0 * 2u;
        f32x4 S = (f32x4){0.f, 0.f, 0.f, 0.f};
#pragma unroll 1
        for (int s0 = 0; s0 < NCHK; s0 += NCHK / 4) {
            u32x2 w[NCHK / 4]; f32x4 dt[NCHK / 4];
#pragma unroll
            for (int k = 0; k < NCHK / 4; ++k) { const int c = chunk_at(d, s0 + k); w[k] = *(const u32x2*)(cb + (size_t)c * 8192 + voff); dt[k] = *(const f32x4*)(DTb + (size_t)c * 256 + doff); }
#pragma unroll
            for (int k = 0; k < NCHK / 4; ++k) { const f32x4 raw = (f32x4){lo_f(w[k].x), hi_f(w[k].x), lo_f(w[k].y), hi_f(w[k].y)};
                u32x2 ow; ow.x = pk2(S[0], S[1]); ow.y = pk2(S[2], S[3]);
                *(u32x2*)((char*)cb + (size_t)chunk_at(d, s0 + k) * 8192 + voff) = ow;
                S = S * dt[k] + raw; }
        }
    }
}
DI void hg_pass2(const Ctx& C, int li, LAS unsigned char* lds, int wave, int lane) {
    LAS bf16_t* vt = (LAS bf16_t*)lds; LAS bf16_t* k0t = vt + 64 * RT_TS; LAS bf16_t* k1t = k0t + 64 * RT_TS;
    const int tid = wave * 64 + lane, cq = lane & 15, g = lane >> 4, q4 = cq >> 2, p4 = cq & 3, h = wave & 3, d = wave >> 2;
    const bf16_t* P = C.P(); const bf16_t* HP = C.HGP(); const bf16_t* ST = C.HGS(); const float* DEC = C.HGDEC() + (size_t)d * NSUB * 256;
    const bf16_t* QD = HP + (size_t)(2 * d) * RETP_T; const bf16_t* KD = HP + (size_t)(2 * d + 1) * RETP_T;
    bf16_t* OUT = C.OHGB() + (size_t)d * NTOK * 256;
    for (int U = (int)blockIdx.x + ((NB * NCHK - (int)blockIdx.x + (int)gridDim.x - 1) / (int)gridDim.x) * (int)gridDim.x; U < 2 * NB * NCHK; U += gridDim.x) {
        const int u = U - NB * NCHK, b = u / NCHK, c = u % NCHK; const size_t R0 = (size_t)b * LSEQ + 64 * c;
        if (li == DEPTH - 1 && c < 4) continue;
        __syncthreads();
        stage_tile64x256(vt, P + R0 * DIN + C_HGI, DIN, tid);
        stage_tile64x256(k0t, HP + 1 * RETP_T + R0 * 256, 256, tid);
        stage_tile64x256(k1t, HP + 3 * RETP_T + R0 * 256, 256, tid);
        __syncthreads();
        const LAS bf16_t* kt = d ? k1t : k0t;
        f32x4 S[4][4];
        { const bf16_t* sp = ST + st_off(b, h, d, c);
#pragma unroll
          for (int mb = 0; mb < 4; ++mb)
#pragma unroll
            for (int nb = 0; nb < 4; ++nb) { const u32x2 w = *(const u32x2*)(sp + (16 * nb + cq) * 64 + 16 * mb + 4 * g); S[mb][nb] = (f32x4){lo_f(w.x), hi_f(w.x), lo_f(w.y), hi_f(w.y)}; } }
#pragma unroll 1
        for (int sidx = 0; sidx < 4; ++sidx) { const int n = d ? 3 - sidx : sidx;
            const size_t Rt = R0 + 16 * n + cq;
            f32x4 at = (f32x4){0.f, 0.f, 0.f, 0.f};
#pragma unroll
            for (int ks = 0; ks < 2; ++ks) at = MFMA16(*(const LAS bf16x8*)(kt + (16 * n + cq) * RT_TS + h * 64 + 32 * ks + 8 * g), ld16(QD + Rt * 256 + h * 64 + 32 * ks + 8 * g), at);
#pragma unroll
            for (int e = 0; e < 4; ++e) { const int j = 4 * g + e; at[e] = (d == 0 ? (j <= cq) : (j >= cq)) ? at[e] : 0.f; }
            const bf16x8 pb = pack8(at, ((f32x4){0.f, 0.f, 0.f, 0.f}));
            bf16x8 qc[2];
#pragma unroll
            for (int s2 = 0; s2 < 2; ++s2) { const bf16_t* qp = QD + Rt * 256 + h * 64 + 32 * s2 + 4 * g; qc[s2] = cat8(*(const s16x4*)qp, *(const s16x4*)(qp + 16)); }
            f32x4 o[4];
#pragma unroll
            for (int db = 0; db < 4; ++db) {
                const s16x4 vv = tr16(vt + (16 * n + 4 * g + q4) * RT_TS + h * 64 + 16 * db + 4 * p4);
                o[db] = MFMA16(cat8(vv, vv), pb, ((f32x4){0.f, 0.f, 0.f, 0.f}));
                o[db] = MFMA16(pack8(S[0][db], S[1][db]), qc[0], o[db]); o[db] = MFMA16(pack8(S[2][db], S[3][db]), qc[1], o[db]);
                { u32x2 w; w.x = pk2(o[db][0], o[db][1]); w.y = pk2(o[db][2], o[db][3]); *(u32x2*)(OUT + Rt * 256 + h * 64 + 16 * db + 4 * g) = w; } }
            if (sidx < 3) hg_state_step(S, kt, vt, n, h, cq, g, q4, p4, DEC + (R0 / 16 + n) * 256);
        }
    }
}

DI void phase_mix(const Ctx& C, int li, LAS unsigned char* lds, int gw, int ngw, int wave, int lane) {
    LAS bf16_t* vl = (LAS bf16_t*)(lds + 8192 + wave * (64 * NA_VS * 2));
    LAS float* rpbt = (LAS float*)(lds + 8192 + 8 * (64 * NA_VS * 2));
    for (int i = wave * 64 + lane; i < 4 * 465; i += 512) rpbt[i] = C.in(I_RPB)[(size_t)li * 4 * 465 + i];
    __syncthreads();
    const int G = (int)gridDim.x;
    if ((G & 7) == 0 && G >= 8) {
        const int xb = (int)blockIdx.x & 7, nxw = (G >> 3) * 8, xw = ((int)blockIdx.x >> 3) * 8 + wave;
        for (int b = xb; b < NB; b += 8)
            for (int h = 0; h < 4; ++h) {
                for (int rc = xw; rc < 256; rc += nxw) na_unit(C, li, ((b * 64 + (rc >> 2)) * 4 + h) * 4 + (rc & 3), false, lane, vl, rpbt);
                if (li == 0) for (int cg = xw; cg < 16; cg += nxw) na_unit(C, li, (b * 4 + h) * 16 + cg, true, lane, vl, rpbt);
            }
    } else {
        const int nNA = NB * 64 * 4 * 4, nNAc = (li == 0) ? NB * 4 * 16 : 0;
        for (int it = gw; it < nNA + nNAc; it += ngw) { if (it < nNA) na_unit(C, li, it, false, lane, vl, rpbt); else na_unit(C, li, it - nNA, true, lane, vl, rpbt); }
    }
}
DI void phase_fin(const Ctx& C, int li, int gw, int ngw, int lane) {
    const int c0 = 4 * lane;
    const f32x4 hw = *(const f32x4*)(C.in(I_HGNW) + li * 64 + (c0 & 63));
    const bf16_t* OH = C.OHGB();
    for (int R0 = gw; R0 < NTOK; R0 += 4 * ngw) {
        u32x2 w0q[4], w1q[4], gq[4];
#pragma unroll
        for (int q = 0; q < 4; ++q) { const int Ri = R0 + q * ngw; if (Ri < NTOK) { const size_t R = (size_t)Ri;
            w0q[q] = *(const u32x2*)(OH + R * 256 + c0); w1q[q] = *(const u32x2*)(OH + ((size_t)NTOK + R) * 256 + c0); gq[q] = *(const u32x2*)(C.P() + R * DIN + C_HGG + c0); } }
#pragma unroll
        for (int q = 0; q < 4; ++q) { const int Ri = R0 + q * ngw; if (Ri >= NTOK) continue; const size_t R = (size_t)Ri;
            if (li == DEPTH - 1 && (Ri % LSEQ) < CTXL) continue;
            const u32x2 w0 = w0q[q], w1 = w1q[q], gw2 = gq[q];
            const f32x4 a = (f32x4){lo_f(w0.x) + lo_f(w1.x), hi_f(w0.x) + hi_f(w1.x), lo_f(w0.y) + lo_f(w1.y), hi_f(w0.y) + hi_f(w1.y)};
            float ss = a[0] * a[0] + a[1] * a[1] + a[2] * a[2] + a[3] * a[3];
            ss += shx<1>(ss); ss += shx<2>(ss); ss += shx<4>(ss); ss += shx<8>(ss);
            const float rs = __builtin_amdgcn_rsqf(ss * (1.0f / 64.0f) + EPS);
            u32x2 oo; oo.x = pk2(a[0] * rs * hw[0] * silu_(lo_f(gw2.x)), a[1] * rs * hw[1] * silu_(hi_f(gw2.x))); oo.y = pk2(a[2] * rs * hw[2] * silu_(lo_f(gw2.y)), a[3] * rs * hw[3] * silu_(hi_f(gw2.y)));
            *(u32x2*)(C.O() + R * DM + 512 + c0) = oo; }
    }
}

struct Args { const float* in[N_IN]; float* out; unsigned char* ws; int ph_lo, ph_hi, bar_region, pad; };
constexpr int NPL = 13, PH_TOTAL = 2 + DEPTH * NPL;

__global__ void __launch_bounds__(512, 2) fwd(Args args) {
    extern __shared__ __attribute__((aligned(16))) unsigned char lds_raw[];
    LAS unsigned char* lds = (LAS unsigned char*)lds_raw;
    const int G = gridDim.x, ngw = G * 8;
    const int wave_id = __builtin_amdgcn_readfirstlane((int)threadIdx.x >> 6);
#define PHASE_IDS int wv_ = wave_id; asm volatile("" : "+s"(wv_)); int ln_ = lane_id(); asm volatile("" : "+v"(ln_)); const int lane = ln_, wave = wv_, gw = blockIdx.x * 8 + wave; (void)lane; (void)gw;
    { int t0 = wave_id * 64 + lane_id(); asm volatile("" : "+v"(t0)); for (int u = t0; u < (LDS_BYTES - LDSCTL_OFF) / 4; u += 512) ((LAS unsigned*)(lds + LDSCTL_OFF))[u] = 0u; }
    __syncthreads();
    int lo, hi; XcdBarrier bar;
    { const Ctx C0{kargs()}; lo = *(const __attribute__((address_space(4))) int*)(C0.ka + 8 * N_IN + 16); hi = *(const __attribute__((address_space(4))) int*)(C0.ka + 8 * N_IN + 20);
      bar.bar = (unsigned*)(C0.ws() + WS_CTL) + 4096 + *(const __attribute__((address_space(4))) int*)(C0.ka + 8 * N_IN + 24) * XCD_BAR_WORDS; bar.x = 0; bar.st = nullptr; bar.wave = wave_id;
      if (hi - lo > 1) bar = xcd_barrier_post(bar.bar, (volatile LAS unsigned*)(lds + MISC_OFF + 32), wave_id); }
#define IN(k) (lo <= (k) && (k) < hi)
#ifndef PH_MASK
#define PH_MASK 0xFFFF
#endif
#define PH_EN(k) (((PH_MASK) >> (k)) & 1)
#define SEAM(k) do { if ((k) + 1 < hi) xcd_barrier(bar); } while (0)
#ifndef PROBE_DUP
#define PROBE_DUP 0
#endif
#define REPS(k) for (int rep_ = 0; rep_ < ((((PROBE_DUP) >> (k)) & 1) ? 2 : 1); ++rep_)
#define REP_BAR(k) do { if ((((PROBE_DUP) >> (k)) & 1) && rep_ == 0) xcd_barrier(bar); } while (0)

#ifndef NO_PRO
    if (IN(0)) { const Ctx C{kargs()}; PHASE_IDS phase_prologue(C, lds, gw, ngw, wave, lane);
#ifdef PROBE_PRO
        xcd_barrier(bar); phase_prologue(C, lds, gw, ngw, wave, lane);
#endif
        SEAM(0); }
#endif

    for (int li = 0; li < DEPTH; ++li) {
        const int pb = 1 + li * NPL;
        if (PH_EN(0) && IN(pb + 0)) { REPS(0) {
            const Ctx C{kargs()}; PHASE_IDS
#ifdef PROBE_A1
            if (li == 1) { phase_norm1(C, li, gw, ngw, lane, (float*)C.P()); xcd_barrier(bar); }
#endif
            phase_norm1(C, li, gw, ngw, lane, C.X());
#ifdef PROBE_A0
            if (li == 0) { xcd_barrier(bar); phase_norm1(C, li, gw, ngw, lane, C.X()); }
#endif
            REP_BAR(0); } SEAM(pb + 0);
        }
        if (PH_EN(1) && IN(pb + 1)) { REPS(1) {
            const Ctx C{kargs()}; PHASE_IDS
            { SchedWin S{(unsigned)WS_H, (unsigned)(WS_WIN + (size_t)li * DIN * DM * 2), G, (int)blockIdx.x, C_GATE / 256, (unsigned)(DM * 2)};
              EpiP E{C.P(), DIN};
              pg8::gemm_phase<EpiP, SchedWin>(lds, wave, lane, (const char*)C.ws(), DM, DM, DM, S, E); }
            { const Ctx C2{kargs()}; int wv2 = wave_id; asm volatile("" : "+s"(wv2)); int ln2 = lane_id(); asm volatile("" : "+v"(ln2));
              SchedWin S{(unsigned)WS_H8, (unsigned)(WS_WIN + (size_t)li * DIN * DM * 2 + WS_WIN8_OFF), G, (int)blockIdx.x, 16, (unsigned)DM};
              EpiSig8 E{(unsigned char*)C2.P()};
              pg8::gemm_phase<EpiSig8, SchedWin, true>(lds, wv2, ln2, (const char*)C2.ws(), DM / 2, DM / 2, DM / 2, S, E); }
            REP_BAR(1); } SEAM(pb + 1);
        }
        if (PH_EN(2) && IN(pb + 2)) { REPS(2) { const Ctx C{kargs()}; PHASE_IDS phase_prep(C, li, gw, ngw, lane); prep_ret(C, li, gw, ngw, lane); prep_hg(C, li, gw, ngw, lane); prep_s5(C, gw, ngw, lane);
#if defined(PROBE_PREP) && PROBE_PREP == 1
            phase_prep(C, li, gw, ngw, lane);
#elif defined(PROBE_PREP) && PROBE_PREP == 2
            prep_ret(C, li, gw, ngw, lane);
#elif defined(PROBE_PREP) && PROBE_PREP == 3
            prep_hg(C, li, gw, ngw, lane);
#elif defined(PROBE_PREP) && PROBE_PREP == 4
            prep_s5(C, gw, ngw, lane);
#endif
            REP_BAR(2); } SEAM(pb + 2); }
        if (PH_EN(3) && IN(pb + 3)) { REPS(3) {
            const Ctx C{kargs()}; PHASE_IDS
            ret_pass1(C, lds, wave, lane); __syncthreads();
            hg_pass1(C, lds, wave, lane); __syncthreads();
#ifdef PROBE_P1
            xcd_barrier(bar); ret_pass1(C, lds, wave, lane); __syncthreads(); hg_pass1(C, lds, wave, lane); __syncthreads(); xcd_barrier(bar);
#endif
            phase_mix(C, li, lds, gw, ngw, wave, lane); __syncthreads();
#ifdef PROBE_NA
            xcd_barrier(bar); phase_mix(C, li, lds, gw, ngw, wave, lane); __syncthreads(); xcd_barrier(bar);
#endif
            { const Ctx C{kargs()}; PHASE_IDS SchedS5 S{(unsigned)WS_UG, (unsigned)(WS_S5W1 + (size_t)li * 16 * 65536 * 2), G, (int)blockIdx.x, 65536u * 2u}; EpiS5S E{C.S5S()};
              pg8::gemm_phase<EpiS5S, SchedS5>(lds, wave, lane, (const char*)C.ws(), 256, 512, 256, S, E); }
            REP_BAR(3); } SEAM(pb + 3); }
        if (PH_EN(4) && IN(pb + 4)) { REPS(4) { const Ctx C{kargs()}; PHASE_IDS ret_carry(C, li, gw, ngw, lane); hg_carry(C, gw, ngw, lane); s5_carry(C, li, gw, ngw, lane); convert_experts(C, li, 1280 % ngw, gw, ngw, (LAS float*)(lds + 40960 + wave * 8704), lane);     REP_BAR(4); } SEAM(pb + 4); }
        if (PH_EN(5) && IN(pb + 5)) { REPS(5) { const Ctx C{kargs()}; PHASE_IDS ret_pass2(C, li, lds, wave, lane); __syncthreads(); hg_pass2(C, li, lds, wave, lane); __syncthreads();
            { const Ctx C{kargs()}; PHASE_IDS SchedS5 S{(unsigned)WS_UG, (unsigned)(WS_S5W2 + (size_t)li * 16 * 131072 * 2), G, (int)blockIdx.x, 131072u * 2u}; EpiS5Z E{C.Z()};
              pg8::gemm_phase<EpiS5Z, SchedS5>(lds, wave, lane, (const char*)C.ws(), 512, 512, 512, S, E); }
            REP_BAR(5); } SEAM(pb + 5); }
        if (PH_EN(6) && IN(pb + 6)) { REPS(6) { const Ctx C{kargs()}; PHASE_IDS phase_fin(C, li, gw, ngw, lane);
            { const Ctx C{kargs()}; PHASE_IDS SchedGlu S{(unsigned)WS_Z, (unsigned)(WS_GLUT + (size_t)li * 65536 * 2), G, (int)blockIdx.x, li}; EpiGlu E{C.O(), C.Z()};
              pg8::gemm_phase<EpiGlu, SchedGlu>(lds, wave, lane, (const char*)C.ws(), 256, 256, 256, S, E); }
            REP_BAR(6); } SEAM(pb + 6); }
        if (PH_EN(7) && IN(pb + 7)) { REPS(7) {
            const Ctx C{kargs()}; PHASE_IDS
            SchedMerge S{(unsigned)WS_O, (unsigned)(WS_WBR + (size_t)li * DM * DM * 2), G, (int)blockIdx.x, li};
            EpiMerge E{C.MB(), (const unsigned char*)C.P()};
            pg8::gemm_phase<EpiMerge, SchedMerge, false, 1>(lds, wave, lane, (const char*)C.ws(), DM, DM, DM, S, E);
            REP_BAR(7); } SEAM(pb + 7);
        }
        if (PH_EN(8) && IN(pb + 8)) { REPS(8) {
            const Ctx C{kargs()}; PHASE_IDS
            SchedOut S{(unsigned)WS_MB, (unsigned)(WS_WOUT + (size_t)li * DM * DM * 2), G, (int)blockIdx.x, li};
#ifdef PROBE_D2
            { EpiResid E0{C.X(), C.mod() + li * 9 * 6144, (float*)C.P(), li == 0 ? C.in(I_X) : nullptr, li == 0 ? C.in(I_CTX) : nullptr}; pg8::gemm_phase<EpiResid, SchedOut>(lds, wave, lane, (const char*)C.ws(), DM, DM, DM, S, E0); xcd_barrier(bar); }
#endif
            EpiResid E{C.X(), C.mod() + li * 9 * 6144, C.X(), li == 0 ? C.in(I_X) : nullptr, li == 0 ? C.in(I_CTX) : nullptr};
            pg8::gemm_phase<EpiResid, SchedOut>(lds, wave, lane, (const char*)C.ws(), DM, DM, DM, S, E);
            REP_BAR(8); } SEAM(pb + 8);
        }
        if (PH_EN(9) && IN(pb + 9)) { REPS(9) { const Ctx C{kargs()}; PHASE_IDS phase_norm2(C, li, lds, gw, ngw, wave, lane); REP_BAR(9); } SEAM(pb + 9); }
        if (PH_EN(10) && IN(pb + 10)) { REPS(10) { const Ctx C{kargs()}; PHASE_IDS phase_topk(C, li, lds, wave, lane); REP_BAR(10); } SEAM(pb + 10); }
        if (PH_EN(11) && IN(pb + 11)) { REPS(11) {
            const Ctx C{kargs()}; PHASE_IDS
            SchedE1 S{(unsigned)WS_XE, (unsigned)WS_EXW, G, (int)blockIdx.x, li == 0 ? 17 : 16};
            EpiSwiGLU E{(unsigned char*)C.P()};
            pg8::gemm_phase<EpiSwiGLU, SchedE1, true>(lds, wave, lane, (const char*)C.ws(), DM / 2, DM / 2, DM / 2, S, E);
            REP_BAR(11); } SEAM(pb + 11);
        }
        if (PH_EN(12) && IN(pb + 12)) { REPS(12) {
            const Ctx C{kargs()}; PHASE_IDS
            SchedE2 S{(unsigned)WS_P, (unsigned)WS_W2T, G, (int)blockIdx.x, li == 0 ? 17 : 16};
            EpiExpOut E{C.XE(), C.gate()};
            pg8::gemm_phase<EpiExpOut, SchedE2, true>(lds, wave, lane, (const char*)C.ws(), DF / 2, DF / 2, DF / 2, S, E);
            REP_BAR(12); } SEAM(pb + 12);
        }
    }
    if (IN(PH_TOTAL - 1)) { const Ctx C{kargs()}; PHASE_IDS phase_final(C, gw, ngw, lane);
#ifdef PROBE_FINAL
        xcd_barrier(bar); phase_final(C, gw, ngw, lane);
#endif
    }
#undef IN
#undef SEAM
}

extern "C" void kernel_launch(void* const* d_in, const int* in_sizes, int n_in, void* d_out, int out_size, void* d_ws, size_t ws_size, hipStream_t stream) {
    static int grid = 0;
    if (grid == 0) {
        if (n_in != N_IN || ws_size < WS_END) { fprintf(stderr, "kernel_launch: unexpected n_in %d or ws_size %zu (need %zu)\n", n_in, ws_size, (size_t)WS_END); grid = -1; return; }
        int dev = 0, cus = 0, per_cu = 0;
        if (hipGetDevice(&dev) != hipSuccess || hipDeviceGetAttribute(&cus, hipDeviceAttributeMultiprocessorCount, dev) != hipSuccess) { grid = -1; return; }
        if (hipFuncSetAttribute((const void*)fwd, hipFuncAttributeMaxDynamicSharedMemorySize, LDS_BYTES) != hipSuccess) { fprintf(stderr, "kernel_launch: hipFuncSetAttribute failed\n"); grid = -1; return; }
        if (hipOccupancyMaxActiveBlocksPerMultiprocessor(&per_cu, (const void*)fwd, 512, LDS_BYTES) != hipSuccess || per_cu < 1) fprintf(stderr, "kernel_launch: occupancy query says %d\n", per_cu);
        (void)hipGetLastError();
        grid = cus;
    }
    if (grid < 0) return;
    (void)hipMemsetAsync((char*)d_ws + WS_CTL, 0, CTL_ZERO_BYTES, stream);
    Args a{};
    for (int i = 0; i < N_IN; ++i) a.in[i] = (const float*)d_in[i];
    a.out = (float*)d_out; a.ws = (unsigned char*)d_ws;
#if MK_PER_PHASE
    for (int p = 0; p < PH_TOTAL; ++p) { a.ph_lo = p; a.ph_hi = p + 1; a.bar_region = 0; hipLaunchKernelGGL(fwd, dim3(grid), dim3(512), LDS_BYTES, stream, a); }
#elif defined(PROBE_PH)
    a.ph_lo = 0; a.ph_hi = PROBE_PH + 1; a.bar_region = 0; hipLaunchKernelGGL(fwd, dim3(grid), dim3(512), LDS_BYTES, stream, a);
    a.ph_lo = PROBE_PH; a.ph_hi = PROBE_PH + 1; a.bar_region = 1; hipLaunchKernelGGL(fwd, dim3(grid), dim3(512), LDS_BYTES, stream, a);
    a.ph_lo = PROBE_PH + 1; a.ph_hi = PH_TOTAL; a.bar_region = 2; hipLaunchKernelGGL(fwd, dim3(grid), dim3(512), LDS_BYTES, stream, a);
#elif defined(PROBE_CUT)
    a.ph_lo = 0; a.ph_hi = PROBE_CUT + 1; a.bar_region = 0; hipLaunchKernelGGL(fwd, dim3(grid), dim3(512), LDS_BYTES, stream, a);
    a.ph_lo = PROBE_CUT + 1; a.ph_hi = PH_TOTAL; a.bar_region = 2; hipLaunchKernelGGL(fwd, dim3(grid), dim3(512), LDS_BYTES, stream, a);
#else
    a.ph_lo = 0; a.ph_hi = PH_TOTAL; a.bar_region = 0;
    hipLaunchKernelGGL(fwd, dim3(grid), dim3(512), LDS_BYTES, stream, a);
#endif
}
```

```cpp
#include <hip/hip_runtime.h>
#include <cstdio>
#include <cstdint>

#ifndef MK_PER_PHASE
#define MK_PER_PHASE 0
#endif

#define LAS __attribute__((address_space(3)))
#define DI __device__ __forceinline__
typedef unsigned short bf16_t;
typedef short bf16x8 __attribute__((ext_vector_type(8)));
typedef float f32x4 __attribute__((ext_vector_type(4)));
typedef float f32x2 __attribute__((ext_vector_type(2)));
typedef unsigned u32x4 __attribute__((ext_vector_type(4)));
typedef unsigned u32x2 __attribute__((ext_vector_type(2)));

constexpr int DM = 1024, NB = 8, SEQ = 4096, CTXL = 256, LSEQ = SEQ + CTXL, NTOK = NB * LSEQ, DIN = 7424, NE = 16, DF = 2816, DEPTH = 2;
constexpr int CAP_L = 512, CAP_C = 32, EROWS = NB * CAP_L + NB * CAP_C;
constexpr float EPS = 1e-6f;
constexpr int C_S5U = 0, C_NAQ = 256, C_NAK = 512, C_NAV = 768, C_HGQ = 1024, C_HGF = 1280, C_HGI = 1792, C_HGG = 2048, C_RTQ = 2304, C_RTK = 2560, C_RTV = 2816, C_RTG = 3072, C_GATE = 3328;
enum { I_X = 0, I_C, I_CTX, I_CCTX, I_ADAW, I_ADAB, I_NMIX, I_NFFN, I_WIN, I_LRE, I_LIM, I_LSTEP, I_BRE, I_BIM, I_CRE, I_CIM, I_S5D, I_GLU, I_NAQN, I_NAKN, I_RPB, I_HGLB, I_HGNW, I_RETD, I_WBR, I_WOUT, I_RW, I_EWG, I_EWU, I_EWD, N_IN };

constexpr size_t MiB = 1u << 20;
constexpr size_t WS_CTL = 0, CTL_ZERO_BYTES = 1 * MiB;
constexpr size_t WS_MOD = 1 * MiB;
constexpr size_t WS_LB = 1 * MiB + 512 * 1024;
constexpr size_t WS_AFF = 2 * MiB;
constexpr size_t WS_SEL = 5 * MiB;
constexpr size_t WS_GATE = 8 * MiB;
constexpr size_t WS_WBR = 10 * MiB;
constexpr size_t WS_WOUT = 14 * MiB;
constexpr size_t WS_WIN = 18 * MiB;
constexpr size_t WS_X = 48 * MiB;
constexpr size_t WS_H = 184 * MiB;
constexpr size_t WS_O = 252 * MiB;
constexpr size_t WS_MB = 320 * MiB;
constexpr size_t WS_P = 388 * MiB;
constexpr size_t WS_XE = 881 * MiB;
constexpr size_t WS_EXW = 1017 * MiB;
constexpr size_t WS_W2T = WS_EXW + (size_t)NE * 5632 * 1024;
constexpr size_t WS_QKN = 1281 * MiB;
constexpr size_t WS_RETS = 1315 * MiB;
constexpr size_t WS_HGS = 1349 * MiB;
constexpr size_t WS_HGDEC = 1383 * MiB;
constexpr size_t WS_S5W1 = 1388 * MiB;
constexpr size_t WS_S5W2 = 1392 * MiB;
constexpr size_t WS_GLUT = 1400 * MiB;
constexpr size_t WS_HGDT = 1401 * MiB;
constexpr size_t WS_END = 1403 * MiB;
constexpr int S5CH = NTOK / 16, S5ROWS = 2304;
constexpr size_t WS_UG = WS_XE;
constexpr size_t WS_S5S = WS_XE + 36 * MiB;
constexpr size_t WS_OHG = WS_XE + 72 * MiB;
constexpr size_t WS_Z = WS_QKN;
constexpr size_t WS_HGP = WS_MB;
constexpr int NSUB = NTOK / 16;
constexpr size_t WS_H8 = WS_O;
constexpr size_t WS_WIN8_OFF = (size_t)C_GATE * DM * 2;
constexpr size_t WS_RETP = WS_H;
constexpr size_t RETP_T = (size_t)NTOK * 256;
constexpr int NCHK = LSEQ / 64;
static_assert(WS_W2T + (size_t)NE * 1024 * DF * 2 <= WS_QKN, "ws map");
static_assert(WS_P + (size_t)NTOK * DIN * 2 <= WS_XE && WS_XE + (size_t)NE * EROWS * 1024 * 2 <= WS_EXW, "ws map");

constexpr int RING_BYTES = 131072, LDSCTL_OFF = RING_BYTES, MISC_OFF = LDSCTL_OFF + 320, LDS_BYTES = 147456;

DI float bf2f(unsigned short h) { return __uint_as_float(((unsigned)h) << 16); }
DI float lo_f(unsigned w) { return __uint_as_float(w << 16); }
DI float hi_f(unsigned w) { return __uint_as_float(w & 0xffff0000u); }
DI unsigned f2bf(float f) { unsigned u = __float_as_uint(f); return (u + 0x7fffu + ((u >> 16) & 1u)) >> 16; }
DI unsigned pk2(float lo, float hi) { return f2bf(lo) | (f2bf(hi) << 16); }
DI unsigned pk4_fp8(float a, float b, float c, float d) {
    a = __builtin_amdgcn_fmed3f(a, -448.f, 448.f); b = __builtin_amdgcn_fmed3f(b, -448.f, 448.f); c = __builtin_amdgcn_fmed3f(c, -448.f, 448.f); d = __builtin_amdgcn_fmed3f(d, -448.f, 448.f);
    int p = 0; p = __builtin_amdgcn_cvt_pk_fp8_f32(a, b, p, false); p = __builtin_amdgcn_cvt_pk_fp8_f32(c, d, p, true); return (unsigned)p; }
DI int lane_id() { int l; asm volatile("v_mbcnt_lo_u32_b32 %0, -1, 0\n\tv_mbcnt_hi_u32_b32 %0, -1, %0" : "=v"(l)); return l; }
template <int M> DI float shx(float v) {
    if constexpr (M < 32) return __int_as_float(__builtin_amdgcn_ds_swizzle(__float_as_int(v), 0x1f | (M << 10)));
    else return __int_as_float(__builtin_amdgcn_ds_bpermute((lane_id() ^ 32) << 2, __float_as_int(v)));
}
DI float wave_sum(float v) { v += shx<1>(v); v += shx<2>(v); v += shx<4>(v); v += shx<8>(v); v += shx<16>(v); v += shx<32>(v); return v; }
DI float sigm(float x) { return __builtin_amdgcn_rcpf(1.0f + __expf(-x)); }
DI float silu_(float x) { return x * sigm(x); }
DI f32x4 exp2n4(f32x4 t) { return (f32x4){__builtin_amdgcn_exp2f(t[0]), __builtin_amdgcn_exp2f(t[1]), __builtin_amdgcn_exp2f(t[2]), __builtin_amdgcn_exp2f(t[3])}; }
DI f32x4 rcp4(f32x4 d) { return (f32x4){__builtin_amdgcn_rcpf(d[0]), __builtin_amdgcn_rcpf(d[1]), __builtin_amdgcn_rcpf(d[2]), __builtin_amdgcn_rcpf(d[3])}; }
DI f32x4 sigm4(f32x4 x) { return rcp4(exp2n4(x * -1.4426950408889634f) + 1.0f); }
DI unsigned pack_u8x4(f32x4 s) { const f32x4 t = s * 255.0f + 8388608.0f;
    const unsigned ab = __builtin_amdgcn_perm(__float_as_uint(t[1]), __float_as_uint(t[0]), 0x0c0c0400u), cd = __builtin_amdgcn_perm(__float_as_uint(t[3]), __float_as_uint(t[2]), 0x04000c0cu); return ab | cd; }
DI float gelu_tanh(float x) { const float u = 1.5957691216057308f * (x + 0.044715f * x * x * x); return x * __builtin_amdgcn_rcpf(1.0f + __expf(-u)); }
#define LDS_WAIT() asm volatile("s_waitcnt lgkmcnt(0)" ::: "memory")
#define VM_WAIT() asm volatile("s_waitcnt vmcnt(0)" ::: "memory")

#define XB_TMO      128
#define XB_XCNT(j)  (256  + 64 * (j))
#define XB_XSUB(j)  (1280 + 64 * (j))
#define XB_XGEN(j)  (2304 + 64 * (j))
#define XB_TOP      3328
#define XB_TOPGEN   3392
#define XCD_BAR_WORDS 3456
#define XB_SPIN_CAP (1u << 22)

__device__ __forceinline__ unsigned xb_ld(unsigned* p)              { return __hip_atomic_load(p, __ATOMIC_RELAXED, __HIP_MEMORY_SCOPE_AGENT); }
__device__ __forceinline__ unsigned xb_add(unsigned* p, unsigned v) { return __hip_atomic_fetch_add(p, v, __ATOMIC_RELAXED, __HIP_MEMORY_SCOPE_AGENT); }
__device__ __forceinline__ unsigned xb_xcc_id() { return (unsigned)__builtin_amdgcn_s_getreg((3 << 11) | 20) & 0xFu; }
#define XB_SPIN(cond, bar) do { unsigned _sp = 0; while (cond) { __builtin_amdgcn_s_sleep(1); \
    if ((++_sp & 255u) == 0u) { if (xb_ld(&(bar)[XB_TMO])) break; if (_sp > XB_SPIN_CAP) { atomicAdd(&(bar)[XB_TMO], 1u); break; } } } } while (0)

struct XcdBarrier { unsigned* bar; unsigned x; volatile LAS unsigned* st; int wave; };

__device__ __forceinline__ XcdBarrier xcd_barrier_post(unsigned* bar, volatile LAS unsigned* st, int wave) {
    XcdBarrier b; b.bar = bar; b.x = xb_xcc_id(); b.st = st; b.wave = wave;
    if (wave == 0 && lane_id() == 0) (void)xb_add(&bar[XB_XCNT(b.x)], 1u);
    return b;
}
__device__ __forceinline__ void xcd_barrier_complete(unsigned* bar, unsigned x, unsigned& nloc, unsigned& nx) {
    const unsigned G = gridDim.x * gridDim.y * gridDim.z;
    unsigned sum, cnt, mine, sp = 0u;
    for (;;) {
        sum = 0u; cnt = 0u; mine = 0u;
#pragma unroll
        for (unsigned j = 0; j < 16; ++j) { const unsigned c = xb_ld(&bar[XB_XCNT(j)]); sum += c; cnt += (c > 0u) ? 1u : 0u; mine = (j == x) ? c : mine; }
        if (sum == G) break;
        __builtin_amdgcn_s_sleep(1);
        if ((++sp & 255u) == 0u) { if (xb_ld(&bar[XB_TMO])) break; if (sp > XB_SPIN_CAP) { atomicAdd(&bar[XB_TMO], 1u); break; } }
    }
    nloc = mine > 0u ? mine : 1u; nx = cnt > 0u ? cnt : 1u;
}
__device__ __forceinline__ void xcd_barrier(const XcdBarrier& b) {
    asm volatile("s_waitcnt vmcnt(0)" ::: "memory");
    __syncthreads();
    if (b.wave == 0 && lane_id() == 0) {
        unsigned* bar = b.bar;
        __builtin_amdgcn_s_waitcnt(0);
        unsigned nloc = b.st[0], nx = b.st[1];
        unsigned bx = b.x; asm volatile("" : "+s"(bx));
        if (nloc == 0u) { xcd_barrier_complete(bar, bx, nloc, nx); b.st[0] = nloc; b.st[1] = nx; }
        const unsigned old = xb_add(&bar[XB_XSUB(bx)], 1u);
        const unsigned gen = old / nloc;
        if (old + 1u == (gen + 1u) * nloc) {
            __builtin_amdgcn_fence(__ATOMIC_RELEASE, "agent");
            asm volatile("s_waitcnt vmcnt(0)" ::: "memory");
            const unsigned og = xb_add(&bar[XB_TOP], 1u);
            const unsigned tg = og / nx;
            if (og + 1u == (tg + 1u) * nx) xb_add(&bar[XB_TOPGEN], 1u);
            else XB_SPIN(xb_ld(&bar[XB_TOPGEN]) == tg, bar);
            __builtin_amdgcn_fence(__ATOMIC_ACQUIRE, "agent");
            xb_add(&bar[XB_XGEN(bx)], 1u);
            asm volatile("s_waitcnt vmcnt(0)" ::: "memory");
        } else {
            XB_SPIN(xb_ld(&bar[XB_XGEN(bx)]) == gen, bar);
            __builtin_amdgcn_fence(__ATOMIC_ACQUIRE, "agent");
            asm volatile("s_waitcnt vmcnt(0)" ::: "memory");
        }
    }
    __syncthreads();
}

namespace pg8 {
constexpr int BM = 256, BK = 64, HALF = 128, HTB = HALF * BK * 2, STAGE_BYTES = 8 * HTB;
__host__ __device__ __forceinline__ int lds_byte(int r, int c) { const int st = (r >> 4) * 2 + (c >> 5), rr = r & 15, cc = c & 31, ob = rr * 64 + cc * 2; return st * 1024 + (ob ^ (((ob >> 9) & 1) << 5)); }
__host__ __device__ __forceinline__ void stage_rc(int b, int& R, int& C) { const int st = b / 1024, sb = b % 1024, swz = sb ^ (((sb >> 9) & 1) << 5); R = (st >> 1) * 16 + swz / 64; C = (st & 1) * 32 + (swz % 64) / 2; }
__host__ __device__ __forceinline__ int perm32(int rho) { const int n = rho >> 4, i = rho & 15; return 8 * (i >> 2) + 4 * n + (i & 3); }

struct Unit { unsigned a, b; int pm, pn, e, br;
    __device__ __forceinline__ void uniform() { a = __builtin_amdgcn_readfirstlane(a); b = __builtin_amdgcn_readfirstlane(b); pm = __builtin_amdgcn_readfirstlane(pm); pn = __builtin_amdgcn_readfirstlane(pn); e = __builtin_amdgcn_readfirstlane(e); br = __builtin_amdgcn_readfirstlane(br); } };

__device__ __forceinline__ unsigned cvt_pk_bf16(float lo, float hi) { unsigned r; asm volatile("v_cvt_pk_bf16_f32 %0, %1, %2" : "=v"(r) : "v"(lo), "v"(hi)); return r; }

typedef int i32x8 __attribute__((ext_vector_type(8)));
typedef int i32x4 __attribute__((ext_vector_type(4)));
template <class Epi, class Sched, bool FP8 = false, int MODE = 0>
__device__ __forceinline__ void gemm_phase(LAS unsigned char* lds, const int wid, const int lane, const char* base, const int K, const int lda, const int ldb, const Sched& S, const Epi& E) {
    const int tid = wid * 64 + lane, wr = wid >> 2, wc = wid & 3, fr = lane & 15, fq = lane >> 4;
    int nt = K / BK; asm volatile("" : "+s"(nt));
    unsigned voffA, voffB;
    { int R, C; stage_rc(tid * 16, R, C); const int Rb = Epi::PERM ? ((R & ~31) + perm32(R & 31)) : R; voffA = (unsigned)(R * lda + C) * 2u; voffB = (unsigned)(Rb * ldb + C) * 2u; }
    unsigned qstepA = (unsigned)(64 * lda * 2), qstepB = (unsigned)(64 * ldb * 2); asm volatile("" : "+s"(qstepA), "+s"(qstepB));
    unsigned kstep = (unsigned)(BK * 2), hstepA = (unsigned)(HALF * lda * 2), hstepB = (unsigned)(HALF * ldb * 2);
    asm volatile("" : "+s"(kstep), "+s"(hstepA), "+s"(hstepB));
    const unsigned ldsw = (unsigned)wid * 1024u;
    const int aoff = lds_byte(wr * 64 + fr, fq * 8), boff = lds_byte(wc * 32 + fr, fq * 8);
#define PG8_SA(b, h) (((b) * 2 + (h)) * HTB)
#define PG8_SB(b, h) ((4 + (b) * 2 + (h)) * HTB)
#define qoffA qstepA
#define qoffB qstepB
#define PG8_STAGE(bufoff, gbase, voff) do { _Pragma("unroll") for (int _i = 0; _i < 2; ++_i) \
        { unsigned sb_ = (gbase) + _i * q##voff; asm volatile("" : "+s"(sb_));     \
          __builtin_amdgcn_global_load_lds((const unsigned*)(base + (size_t)(unsigned)(sb_ + v##voff)), (LAS unsigned*)(lds + (bufoff) + ldsw + _i * 8192), 16, 0, 0); } } while (0)
#define PG8_LDA(dst, b, h) do { if constexpr (FP8) { _Pragma("unroll") for (int m = 0; m < 4; ++m) { const i32x4 lo_ = *(const LAS i32x4*)(lds + PG8_SA(b, h) + aoff + m * 2048), hi_ = *(const LAS i32x4*)(lds + PG8_SA(b, h) + aoff + 1024 + m * 2048); dst##8[m] = __builtin_shufflevector(lo_, hi_, 0, 1, 2, 3, 4, 5, 6, 7); } } \
        else { _Pragma("unroll") for (int m = 0; m < 4; ++m) _Pragma("unroll") for (int k = 0; k < 2; ++k) dst[m][k] = *(const LAS bf16x8*)(lds + PG8_SA(b, h) + aoff + m * 2048 + k * 1024); } } while (0)
#define PG8_LDB(dst, b, h) do { if constexpr (FP8) { _Pragma("unroll") for (int n = 0; n < 2; ++n) { const i32x4 lo_ = *(const LAS i32x4*)(lds + PG8_SB(b, h) + boff + n * 2048), hi_ = *(const LAS i32x4*)(lds + PG8_SB(b, h) + boff + 1024 + n * 2048); dst##8[n] = __builtin_shufflevector(lo_, hi_, 0, 1, 2, 3, 4, 5, 6, 7); } } \
        else { _Pragma("unroll") for (int n = 0; n < 2; ++n) _Pragma("unroll") for (int k = 0; k < 2; ++k) dst[n][k] = *(const LAS bf16x8*)(lds + PG8_SB(b, h) + boff + n * 2048 + k * 1024); } } while (0)
#define PG8_MMA_(ai, bj, At, Bt, Z) do { if constexpr (MODE == 1 && (bj) == 1) break; __builtin_amdgcn_s_setprio(1); if constexpr (FP8) { _Pragma("unroll") for (int m = 0; m < 4; ++m) _Pragma("unroll") for (int n = 0; n < 2; ++n) \
        acc[ai][bj][m][n] = __builtin_amdgcn_mfma_scale_f32_16x16x128_f8f6f4(Bt##8[n], At##8[m], (Z) ? (f32x4){0.f, 0.f, 0.f, 0.f} : acc[ai][bj][m][n], 0, 0, 0, Epi::SCALE_W, 0, Epi::SCALE_X); } \
        else { _Pragma("unroll") for (int m = 0; m < 4; ++m) _Pragma("unroll") for (int n = 0; n < 2; ++n) _Pragma("unroll") for (int k = 0; k < 2; ++k) \
        acc[ai][bj][m][n] = __builtin_amdgcn_mfma_f32_16x16x32_bf16(Bt[n][k], At[m][k], ((Z) && k == 0) ? (f32x4){0.f, 0.f, 0.f, 0.f} : acc[ai][bj][m][n], 0, 0, 0); } __builtin_amdgcn_s_setprio(0); } while (0)
#define PG8_MMA(ai, bj, At, Bt) PG8_MMA_(ai, bj, At, Bt, false)
#define PG8_MMA0(ai, bj, At, Bt) do { if (t == 0) PG8_MMA_(ai, bj, At, Bt, true); else PG8_MMA_(ai, bj, At, Bt, false); } while (0)
#define PG8_WAIT_V(n) asm volatile("s_waitcnt vmcnt(" #n ")" ::: "memory")
#define PG8_WAIT_L(n) asm volatile("s_waitcnt lgkmcnt(" #n ")" ::: "memory")
#define PG8_BAR __builtin_amdgcn_s_barrier()
#define PG8_SCHED __builtin_amdgcn_sched_barrier(0)
    Unit cur, nxt; int ui = 0;
    if (!S.next(0, cur)) return;
    f32x4 acc[2][2][4][2];
    if constexpr (MODE == 1) {
#pragma unroll
        for (int a = 0; a < 2; ++a)
#pragma unroll
            for (int m = 0; m < 4; ++m)
#pragma unroll
                for (int n = 0; n < 2; ++n) acc[a][1][m][n] = (f32x4){0.f, 0.f, 0.f, 0.f};
    }
    bf16x8 At[4][2], B0[2][2], B1[2][2]; i32x8 At8[4], B08[2], B18[2];
    unsigned cA = cur.a, cB = cur.b;
    PG8_STAGE(PG8_SB(0, 0), cB, offB); PG8_STAGE(PG8_SB(0, 1), cB + hstepB, offB); PG8_STAGE(PG8_SA(0, 0), cA, offA); PG8_STAGE(PG8_SA(0, 1), cA + hstepA, offA);
    if (wr == 1) PG8_BAR;
    PG8_WAIT_V(2); PG8_BAR;
    PG8_STAGE(PG8_SB(1, 0), cB + kstep, offB); PG8_STAGE(PG8_SA(1, 0), cA + kstep, offA); PG8_STAGE(PG8_SB(1, 1), cB + hstepB + kstep, offB);
    PG8_WAIT_V(6); PG8_BAR;
    for (;;) {
        const bool has_next = S.next(ui + 1, nxt);
        const unsigned nA = has_next ? nxt.a : cA, nB = has_next ? nxt.b : cB;
#pragma unroll 1
        for (int t = 0; t < nt; t += 2) {
            const bool last = (t == nt - 2);
            const unsigned a1 = cA + (unsigned)(t + 1) * kstep;
            const unsigned a2 = last ? nA : cA + (unsigned)(t + 2) * kstep, b2 = last ? nB : cB + (unsigned)(t + 2) * kstep;
            const unsigned a3 = a2 + kstep, b3 = b2 + kstep;
            PG8_LDB(B0, 0, 0); PG8_LDB(B1, 0, 1); PG8_SCHED; PG8_LDA(At, 0, 0); PG8_STAGE(PG8_SA(1, 1), a1 + hstepA, offA);
            PG8_WAIT_V(8); PG8_WAIT_L(0); PG8_BAR; PG8_MMA0(0, 0, At, B0); PG8_MMA0(0, 1, At, B1); PG8_BAR; PG8_SCHED;
            PG8_LDA(At, 0, 1); PG8_STAGE(PG8_SB(0, 0), b2, offB); PG8_STAGE(PG8_SB(0, 1), b2 + hstepB, offB); PG8_STAGE(PG8_SA(0, 0), a2, offA);
            PG8_WAIT_V(8); PG8_WAIT_L(0); PG8_BAR; PG8_MMA0(1, 0, At, B0); PG8_MMA0(1, 1, At, B1); PG8_BAR; PG8_SCHED;
            PG8_LDB(B0, 1, 0); PG8_LDB(B1, 1, 1); PG8_SCHED; PG8_LDA(At, 1, 0); PG8_STAGE(PG8_SA(0, 1), a2 + hstepA, offA);
            PG8_WAIT_V(8); PG8_WAIT_L(0); PG8_BAR; PG8_MMA(0, 0, At, B0); PG8_MMA(0, 1, At, B1); PG8_BAR; PG8_SCHED;
            PG8_LDA(At, 1, 1); PG8_STAGE(PG8_SB(1, 0), b3, offB); PG8_STAGE(PG8_SB(1, 1), b3 + hstepB, offB); PG8_STAGE(PG8_SA(1, 0), a3, offA);
            PG8_WAIT_V(8); PG8_WAIT_L(0); PG8_BAR; PG8_MMA(1, 0, At, B0); PG8_MMA(1, 1, At, B1); PG8_BAR; PG8_SCHED;
            if constexpr (MODE == 1) { if (((t + 2) & 3) == 0 && !last) { const int l2_ = lane_id(); E.mid(acc, cur, (t + 2) / 4 - 1, wr, wc, l2_ & 15, l2_ >> 4); } }
        }
        if (wr == 0) PG8_BAR;
        { const int l2_ = lane_id();
          E(acc, cur, wr, wc, l2_ & 15, l2_ >> 4); }
        if (!has_next) break;
        if constexpr (MODE == 1) {
#pragma unroll
            for (int a = 0; a < 2; ++a)
#pragma unroll
                for (int m = 0; m < 4; ++m)
#pragma unroll
                    for (int n = 0; n < 2; ++n) acc[a][1][m][n] = (f32x4){0.f, 0.f, 0.f, 0.f};
        }
        cur = nxt; cA = nA; cB = nB; ++ui;
        if (wr == 1) PG8_BAR;
    }
    PG8_WAIT_V(0);
    PG8_BAR;
#undef PG8_SA
#undef PG8_SB
#undef PG8_STAGE
#undef qoffA
#undef qoffB
#undef PG8_LDA
#undef PG8_LDB
#undef PG8_MMA
#undef PG8_MMA_
#undef PG8_MMA0
#undef PG8_WAIT_V
#undef PG8_WAIT_L
#undef PG8_BAR
#undef PG8_SCHED
}
}
using pg8::Unit;

typedef const __attribute__((address_space(4))) unsigned char* KPtr;
DI KPtr kargs() { KPtr p = (KPtr)__builtin_amdgcn_kernarg_segment_ptr(); asm volatile("" : "+s"(p)); return p; }
struct Ctx {
    KPtr ka;
    DI const float* in(int i) const { return *(const float* const __attribute__((address_space(4)))*)(ka + 8 * i); }
    DI float* out() const { return *(float* const __attribute__((address_space(4)))*)(ka + 8 * N_IN); }
    DI unsigned char* ws() const { return *(unsigned char* const __attribute__((address_space(4)))*)(ka + 8 * N_IN + 8); }
    DI float* mod() const { return (float*)(ws() + WS_MOD); }
    DI float* lb() const { return (float*)(ws() + WS_LB); }
    DI float* aff() const { return (float*)(ws() + WS_AFF); }
    DI float* gate() const { return (float*)(ws() + WS_GATE); }
    DI float* X() const { return (float*)(ws() + WS_X); }
    DI int* sel() const { return (int*)(ws() + WS_SEL); }
    DI bf16_t* wbr() const { return (bf16_t*)(ws() + WS_WBR); }
    DI bf16_t* wout() const { return (bf16_t*)(ws() + WS_WOUT); }
    DI bf16_t* win() const { return (bf16_t*)(ws() + WS_WIN); }
    DI bf16_t* H() const { return (bf16_t*)(ws() + WS_H); }
    DI bf16_t* O() const { return (bf16_t*)(ws() + WS_O); }
    DI bf16_t* MB() const { return (bf16_t*)(ws() + WS_MB); }
    DI bf16_t* P() const { return (bf16_t*)(ws() + WS_P); }
    DI bf16_t* XE() const { return (bf16_t*)(ws() + WS_XE); }
    DI unsigned char* W1T() const { return ws() + WS_EXW; }
    DI unsigned char* W2T() const { return ws() + WS_W2T; }
    DI bf16_t* QKN() const { return (bf16_t*)(ws() + WS_QKN); }
    DI float* YS5() const { return (float*)(ws() + WS_XE); }
    DI float* OHG() const { return (float*)(ws() + WS_XE + (size_t)2 * NTOK * 256 * 4); }
    DI float* ORET() const { return (float*)(ws() + WS_MB); }
    DI bf16_t* RETP() const { return (bf16_t*)(ws() + WS_RETP); }
    DI bf16_t* RETS() const { return (bf16_t*)(ws() + WS_RETS); }
    DI bf16_t* HGS() const { return (bf16_t*)(ws() + WS_HGS); }
    DI bf16_t* UG() const { return (bf16_t*)(ws() + WS_UG); }
    DI float* S5S() const { return (float*)(ws() + WS_S5S); }
    DI bf16_t* OHGB() const { return (bf16_t*)(ws() + WS_OHG); }
    DI bf16_t* Z() const { return (bf16_t*)(ws() + WS_Z); }
    DI bf16_t* S5W1() const { return (bf16_t*)(ws() + WS_S5W1); }
    DI bf16_t* S5W2() const { return (bf16_t*)(ws() + WS_S5W2); }
    DI bf16_t* GLUT() const { return (bf16_t*)(ws() + WS_GLUT); }
    DI bf16_t* HGP() const { return (bf16_t*)(ws() + WS_HGP); }
    DI float* HGDEC() const { return (float*)(ws() + WS_HGDEC); }
    DI float* HGDT() const { return (float*)(ws() + WS_HGDT); }
};
DI size_t seqrow(int b, int dir, int s) { return (size_t)b * LSEQ + (dir == 0 ? s : (s < CTXL ? (CTXL - 1 - s) : (LSEQ + CTXL - 1 - s))); }

struct EpiP {
    static constexpr bool PERM = true;
    bf16_t* O; int ldc;
    DI void operator()(const f32x4 (&acc)[2][2][4][2], const Unit& u, int wr, int wc, int fr, int fq) const {
        const int row0 = u.pm * 256 + wr * 64 + fr, col0 = u.pn * 256 + wc * 32 + 8 * fq;
#pragma unroll
        for (int ai = 0; ai < 2; ++ai)
#pragma unroll
            for (int m = 0; m < 4; ++m) { bf16_t* rowp = O + (size_t)(row0 + ai * 128 + m * 16) * ldc + col0;
#pragma unroll
                for (int bj = 0; bj < 2; ++bj) { const f32x4 v0 = acc[ai][bj][m][0], v1 = acc[ai][bj][m][1];
                    u32x4 w; w.x = pg8::cvt_pk_bf16(v0[0], v0[1]); w.y = pg8::cvt_pk_bf16(v0[2], v0[3]); w.z = pg8::cvt_pk_bf16(v1[0], v1[1]); w.w = pg8::cvt_pk_bf16(v1[2], v1[3]);
                    *(u32x4*)(rowp + bj * 128) = w; } }
    }
};
constexpr float FP8_WS = 16.0f, FP8_XS = 16.0f, FP8_AS = 16.0f;
struct EpiSig8 {
    static constexpr bool PERM = true; static constexpr int SCALE_W = 0x7b7b7b7b, SCALE_X = 0x7b7b7b7b;
    unsigned char* Pb;
    DI void operator()(const f32x4 (&acc)[2][2][4][2], const Unit& u, int wr, int wc, int fr, int fq) const {
        const int row0 = u.pm * 256 + wr * 64 + fr, col0 = u.pn * 256 + wc * 32 + 8 * fq;
#pragma unroll
        for (int ai = 0; ai < 2; ++ai)
#pragma unroll
            for (int m = 0; m < 4; ++m) { unsigned char* rowp = Pb + (size_t)(row0 + ai * 128 + m * 16) * (DIN * 2) + 2 * C_GATE + col0;
#pragma unroll
                for (int bj = 0; bj < 2; ++bj) { const f32x4 v0 = acc[ai][bj][m][0], v1 = acc[ai][bj][m][1];
                    u32x2 w; w.x = pack_u8x4(sigm4(v0)); w.y = pack_u8x4(sigm4(v1));
                    *(u32x2*)(rowp + bj * 128) = w; } }
    }
};
struct EpiMerge {
    static constexpr bool PERM = true;
    bf16_t* MB; const unsigned char* Pb;
    DI void mid(f32x4 (&acc)[2][2][4][2], const Unit& u, int br, int wr, int wc, int fr, int fq) const {
        const int row0 = u.pm * 256 + wr * 64 + fr, col0 = u.pn * 128 + wc * 32 + 8 * fq;
        u32x2 gt[2][4];
#pragma unroll
        for (int ai = 0; ai < 2; ++ai)
#pragma unroll
            for (int m = 0; m < 4; ++m) gt[ai][m] = *(const u32x2*)(Pb + (size_t)(row0 + ai * 128 + m * 16) * (DIN * 2) + 2 * C_GATE + br * 1024 + col0);
        const float q = 1.0f / 255.0f;
#pragma unroll
        for (int ai = 0; ai < 2; ++ai)
#pragma unroll
            for (int m = 0; m < 4; ++m) { const u32x2 g = gt[ai][m];
                acc[ai][1][m][0] = acc[ai][1][m][0] + acc[ai][0][m][0] * (f32x4){(float)(g.x & 255u) * q, (float)((g.x >> 8) & 255u) * q, (float)((g.x >> 16) & 255u) * q, (float)(g.x >> 24) * q};
                acc[ai][1][m][1] = acc[ai][1][m][1] + acc[ai][0][m][1] * (f32x4){(float)(g.y & 255u) * q, (float)((g.y >> 8) & 255u) * q, (float)((g.y >> 16) & 255u) * q, (float)(g.y >> 24) * q};
                acc[ai][0][m][0] = (f32x4){0.f, 0.f, 0.f, 0.f}; acc[ai][0][m][1] = (f32x4){0.f, 0.f, 0.f, 0.f}; }
    }
    DI void operator()(const f32x4 (&acc)[2][2][4][2], const Unit& u, int wr, int wc, int fr, int fq) const {
        const int row0 = u.pm * 256 + wr * 64 + fr, col0 = u.pn * 128 + wc * 32 + 8 * fq;
        u32x2 gt[2][4];
#pragma unroll
        for (int ai = 0; ai < 2; ++ai)
#pragma unroll
            for (int m = 0; m < 4; ++m) gt[ai][m] = *(const u32x2*)(Pb + (size_t)(row0 + ai * 128 + m * 16) * (DIN * 2) + 2 * C_GATE + 3 * 1024 + col0);
        const float q = 1.0f / 255.0f;
#pragma unroll
        for (int ai = 0; ai < 2; ++ai)
#pragma unroll
            for (int m = 0; m < 4; ++m) { const u32x2 g = gt[ai][m];
                const f32x4 r0 = acc[ai][1][m][0] + acc[ai][0][m][0] * (f32x4){(float)(g.x & 255u) * q, (float)((g.x >> 8) & 255u) * q, (float)((g.x >> 16) & 255u) * q, (float)(g.x >> 24) * q};
                const f32x4 r1 = acc[ai][1][m][1] + acc[ai][0][m][1] * (f32x4){(float)(g.y & 255u) * q, (float)((g.y >> 8) & 255u) * q, (float)((g.y >> 16) & 255u) * q, (float)(g.y >> 24) * q};
                u32x4 w; w.x = pg8::cvt_pk_bf16(r0[0], r0[1]); w.y = pg8::cvt_pk_bf16(r0[2], r0[3]); w.z = pg8::cvt_pk_bf16(r1[0], r1[1]); w.w = pg8::cvt_pk_bf16(r1[2], r1[3]);
                *(u32x4*)(MB + (size_t)(row0 + ai * 128 + m * 16) * DM + col0) = w; }
    }
};
struct EpiResid {
    static constexpr bool PERM = false;
    float* X; const float* mod; float* Xo; const float* xin; const float* cin;
    DI void operator()(const f32x4 (&acc)[2][2][4][2], const Unit& u, int wr, int wc, int fr, int fq) const {
        const int row0 = u.pm * 256 + wr * 64 + fr, col0 = u.pn * 256 + wc * 32 + 4 * fq;
        const int b = u.pm / 17, tl = u.pm % 17, mr = (tl == 0) ? 8 : b;
        const float* g1 = mod + mr * 6144 + 2 * 1024;
        const float* srcb = xin ? (tl == 0 ? cin + (size_t)b * CTXL * DM : xin + ((size_t)b * SEQ + (tl - 1) * 256) * DM) - (size_t)u.pm * 256 * DM : X;
        f32x4 gv[2][2];
#pragma unroll
        for (int bj = 0; bj < 2; ++bj)
#pragma unroll
            for (int n = 0; n < 2; ++n) gv[bj][n] = *(const f32x4*)(g1 + col0 + bj * 128 + n * 16);
#pragma unroll
        for (int ai = 0; ai < 2; ++ai)
#pragma unroll
            for (int mh = 0; mh < 2; ++mh) {
                f32x4 xv[2][2][2];
#pragma unroll
                for (int m2 = 0; m2 < 2; ++m2)
#pragma unroll
                    for (int bj = 0; bj < 2; ++bj)
#pragma unroll
                        for (int n = 0; n < 2; ++n) xv[m2][bj][n] = *(const f32x4*)(srcb + (size_t)(row0 + ai * 128 + (2 * mh + m2) * 16) * DM + col0 + bj * 128 + n * 16);
#pragma unroll
                for (int m2 = 0; m2 < 2; ++m2)
#pragma unroll
                    for (int bj = 0; bj < 2; ++bj)
#pragma unroll
                        for (int n = 0; n < 2; ++n) *(f32x4*)(Xo + (size_t)(row0 + ai * 128 + (2 * mh + m2) * 16) * DM + col0 + bj * 128 + n * 16) = xv[m2][bj][n] + gv[bj][n] * acc[ai][bj][2 * mh + m2][n];
                asm volatile("" ::: "memory"); }
    }
};
struct EpiSwiGLU {
    static constexpr bool PERM = true; static constexpr int SCALE_W = 0x7b7b7b7b, SCALE_X = 0x7b7b7b7b;
    unsigned char* ACT;
    DI void operator()(const f32x4 (&acc)[2][2][4][2], const Unit& u, int wr, int wc, int fr, int fq) const {
        const int row0 = u.pm * 256 + wr * 64 + fr, col0 = u.pn * 128 + wc * 32 + 8 * fq;
#pragma unroll
        for (int ai = 0; ai < 2; ++ai)
#pragma unroll
            for (int m = 0; m < 4; ++m) { unsigned char* rowp = ACT + ((size_t)u.e * EROWS + row0 + ai * 128 + m * 16) * DF + col0;
                f32x4 q[2];
#pragma unroll
                for (int n = 0; n < 2; ++n) { const f32x4 g = acc[ai][0][m][n], up = acc[ai][1][m][n];
                    q[n] = (g * up) * rcp4(exp2n4(g * -1.4426950408889634f) * (1.0f / FP8_AS) + (1.0f / FP8_AS)); }
                u32x2 w; w.x = pk4_fp8(q[0][0], q[0][1], q[0][2], q[0][3]); w.y = pk4_fp8(q[1][0], q[1][1], q[1][2], q[1][3]);
                *(u32x2*)rowp = w; }
    }
};
struct EpiExpOut {
    static constexpr bool PERM = true; static constexpr int SCALE_W = 0x7b7b7b7b, SCALE_X = 0x7b7b7b7b;
    bf16_t* YB; const float* gate;
    DI void operator()(const f32x4 (&acc)[2][2][4][2], const Unit& u, int wr, int wc, int fr, int fq) const {
        const int row0 = u.pm * 256 + wr * 64 + fr, col0 = u.pn * 256 + wc * 32 + 8 * fq;
#pragma unroll
        for (int ai = 0; ai < 2; ++ai)
#pragma unroll
            for (int m = 0; m < 4; ++m) { const size_t er = (size_t)u.e * EROWS + row0 + ai * 128 + m * 16; const float g = gate[er]; bf16_t* rowp = YB + er * DM + col0;
#pragma unroll
                for (int bj = 0; bj < 2; ++bj) { const f32x4 v0 = acc[ai][bj][m][0] * g, v1 = acc[ai][bj][m][1] * g;
                    u32x4 w; w.x = pg8::cvt_pk_bf16(v0[0], v0[1]); w.y = pg8::cvt_pk_bf16(v0[2], v0[3]); w.z = pg8::cvt_pk_bf16(v1[0], v1[1]); w.w = pg8::cvt_pk_bf16(v1[2], v1[3]);
                    *(u32x4*)(rowp + bj * 128) = w; } }
    }
};

DI int xcd_remap(int L, int nwg) { const int q = nwg / 8, r = nwg % 8, x = L % 8, off = L / 8; return (x < r ? x * (q + 1) : r * (q + 1) + (x - r) * q) + off; }
DI void tile_of(int T, int nM, int nN, int& pm, int& pn) { const int nig = 8 * nN, gid = T / nig, fm = gid * 8, gsz = (nM - fm) < 8 ? (nM - fm) : 8; pm = fm + ((T % nig) % gsz); pn = (T % nig) / gsz; }
struct SchedWin {
    unsigned A, B; int G, c, nN; unsigned rowb;
    DI bool next(int i, Unit& u) const {
        const int nM = NTOK / 256, L = i * G + c; if (L >= nM * nN) return false;
        tile_of(xcd_remap(L, nM * nN), nM, nN, u.pm, u.pn); u.e = 0; u.br = 0;
        u.a = A + (unsigned)u.pm * 256u * rowb; u.b = B + (unsigned)u.pn * 256u * rowb; u.uniform(); return true;
    }
};
DI int pm_of(int li, int pmi) { return li == 0 ? pmi : (pmi / 16) * 17 + 1 + (pmi % 16); }
struct SchedMerge {
    unsigned O, WBR; int G, c, li;
    DI bool next(int i, Unit& u) const {
        const int nM = (li == 0 ? 136 : 128), ntile = nM * 8, L = i * G + c; if (L >= ntile) return false;
        int pmi; tile_of(xcd_remap(L, ntile), nM, 8, pmi, u.pn); u.br = 0; u.pm = pm_of(li, pmi); u.e = 0;
        u.a = O + (unsigned)u.pm * 256u * DM * 2u; u.b = WBR + (unsigned)u.pn * 128u * DM * 2u; u.uniform(); return true;
    }
};
struct SchedOut {
    unsigned MBp, W; int G, c, li;
    DI bool next(int i, Unit& u) const {
        const int nM = (li == 0 ? 136 : 128), ntile = nM * 4, L = i * G + c; if (L >= ntile) return false;
        int pmi; tile_of(xcd_remap(L, ntile), nM, 4, pmi, u.pn); u.br = 0; u.pm = pm_of(li, pmi); u.e = 0;
        u.a = MBp + (unsigned)u.pm * 256u * DM * 2u; u.b = W + (unsigned)u.pn * 256u * DM * 2u; u.uniform(); return true;
    }
};
struct SchedE1 {
    unsigned XE, W; int G, c, pmN;
    DI bool next(int i, Unit& u) const {
        const int per = pmN * 22, L0 = i * G + c; if (L0 >= NE * per) return false;
        const int L = xcd_remap(L0, NE * per); u.e = L / per; tile_of(L % per, pmN, 22, u.pm, u.pn); u.br = 0;
        u.a = XE + ((unsigned)u.e * EROWS + u.pm * 256u) * DM; u.b = W + ((unsigned)u.e * 5632u + u.pn * 256u) * DM; u.uniform(); return true;
    }
};
struct SchedE2 {
    unsigned ACT, W; int G, c, pmN;
    DI bool next(int i, Unit& u) const {
        const int per = pmN * 4, L0 = i * G + c; if (L0 >= NE * per) return false;
        const int L = xcd_remap(L0, NE * per); u.e = L / per; tile_of(L % per, pmN, 4, u.pm, u.pn); u.br = 0;
        u.a = ACT + ((unsigned)u.e * EROWS + u.pm * 256u) * DF; u.b = W + ((unsigned)u.e * 1024u + u.pn * 256u) * DF; u.uniform(); return true;
    }
};


DI void s5_build_w(const Ctx& C, int li, int g, int part4, LAS float* L, int tid) {
    LAS float* pwr = L; LAS float* pwi = pwr + 2176; LAS float* bbr = pwi + 2176; LAS float* bbi = bbr + 2048; LAS float* ccr = bbi + 2048; LAS float* cci = ccr + 2048; LAS float* Kt = cci + 2048;
    __syncthreads();
    if (tid < 128) { const int d = tid >> 6, n = tid & 63, pg = (li * 2 + d) * 16 + g;
        const float lr = C.in(I_LRE)[pg * 64 + n], lim = C.in(I_LIM)[pg * 64 + n], dt = expf(C.in(I_LSTEP)[pg]);
        const float mag = expf(lr * dt); float sn, cs; sincosf(lim * dt, &sn, &cs);
        const float ar = mag * cs, ai = mag * sn, den = lr * lr + lim * lim;
        const float zr = ((ar - 1.0f) * lr + ai * lim) / den, zi = (ai * lr - (ar - 1.0f) * lim) / den;
        float pr = 1.0f, pi = 0.0f;
        for (int t = 0; t <= 16; ++t) { pwr[(d * 17 + t) * 64 + n] = pr; pwi[(d * 17 + t) * 64 + n] = pi; const float nr = pr * ar - pi * ai, ni = pr * ai + pi * ar; pr = nr; pi = ni; }
        for (int p = 0; p < 16; ++p) { const float br = C.in(I_BRE)[((size_t)pg * 64 + n) * 16 + p], bi = C.in(I_BIM)[((size_t)pg * 64 + n) * 16 + p];
            bbr[(d * 64 + n) * 16 + p] = zr * br - zi * bi; bbi[(d * 64 + n) * 16 + p] = zr * bi + zi * br;
            ccr[(d * 16 + p) * 64 + n] = C.in(I_CRE)[((size_t)pg * 16 + p) * 64 + n]; cci[(d * 16 + p) * 64 + n] = C.in(I_CIM)[((size_t)pg * 16 + p) * 64 + n]; } }
    __syncthreads();
    for (int e2 = tid; e2 < 2048; e2 += 512) { const int d = e2 >> 10, tau = (e2 >> 6) & 15, p = 4 * part4 + ((e2 >> 4) & 3), pp = e2 & 15; float acc = 0.f;
        for (int n = 0; n < 64; ++n) { const float cr = ccr[(d * 16 + p) * 64 + n], ci = cci[(d * 16 + p) * 64 + n], pr = pwr[(d * 17 + tau) * 64 + n], pi = pwi[(d * 17 + tau) * 64 + n];
            const float wr = cr * pr - ci * pi, wi = cr * pi + ci * pr; acc += wr * bbr[(d * 64 + n) * 16 + pp] - wi * bbi[(d * 64 + n) * 16 + pp]; }
        Kt[((d * 16 + tau) * 16 + p) * 16 + pp] = acc; }
    __syncthreads();
    {
        const int rl = tid >> 3, t = rl >> 2, p = 4 * part4 + (rl & 3), row = t * 16 + p; const float dsk = C.in(I_S5D)[li * 256 + g * 16 + p];
        bf16_t* dst = C.S5W2() + ((size_t)(li * 16 + g) * 256 + row) * 512;
        for (int k8 = (tid & 7) * 8; k8 < (tid & 7) * 8 + 8; ++k8) { float v[8];
#pragma unroll
            for (int j = 0; j < 8; ++j) { const int kk = (k8 * 8 + j) & 255;
                if (k8 < 32) { const int tp = kk >> 4, pp = kk & 15; float a = 0.f;
                    if (tp <= t) a += Kt[((0 * 16 + (t - tp)) * 16 + p) * 16 + pp];
                    if (tp >= t) a += Kt[((1 * 16 + (tp - t)) * 16 + p) * 16 + pp];
                    if (kk == row) a += dsk; v[j] = a; }
                else { const int d = kk >> 7, part = (kk >> 6) & 1, n = kk & 63, ex = d ? 16 - t : t + 1;
                    const float cr = ccr[(d * 16 + p) * 64 + n], ci = cci[(d * 16 + p) * 64 + n], pr = pwr[(d * 17 + ex) * 64 + n], pi = pwi[(d * 17 + ex) * 64 + n];
                    v[j] = part ? -(cr * pi + ci * pr) : (cr * pr - ci * pi); } }
            u32x4 o; o.x = pk2(v[0], v[1]); o.y = pk2(v[2], v[3]); o.z = pk2(v[4], v[5]); o.w = pk2(v[6], v[7]); *(u32x4*)(dst + k8 * 8) = o; } }
    {
        const int np = 64 * part4 + (tid >> 3), d = np >> 7, part = (np >> 6) & 1, n = np & 63;
        bf16_t* dst = C.S5W1() + ((size_t)(li * 16 + g) * 256 + np) * 256;
        for (int k8 = (tid & 7) * 4; k8 < (tid & 7) * 4 + 4; ++k8) { float v[8];
#pragma unroll
            for (int j = 0; j < 8; ++j) { const int kk = k8 * 8 + j, t = kk >> 4, p = kk & 15, ex = d ? t : 15 - t;
                const float pr = pwr[(d * 17 + ex) * 64 + n], pi = pwi[(d * 17 + ex) * 64 + n], br = bbr[(d * 64 + n) * 16 + p], bi = bbi[(d * 64 + n) * 16 + p];
                v[j] = part ? (pr * bi + pi * br) : (pr * br - pi * bi); }
            u32x4 o; o.x = pk2(v[0], v[1]); o.y = pk2(v[2], v[3]); o.z = pk2(v[4], v[5]); o.w = pk2(v[6], v[7]); *(u32x4*)(dst + k8 * 8) = o; } }
    __syncthreads();
}
DI void prep_s5(const Ctx& C, int gw, int ngw, int lane) {
    const bf16_t* P = C.P(); bf16_t* UG = C.UG();
    for (int ch = gw; ch < S5CH; ch += ngw) {
#pragma unroll
        for (int i = 0; i < 4; ++i) { const int pr = lane + 64 * i, t = pr >> 4, g = pr & 15;
            const u32x4* src = (const u32x4*)(P + ((size_t)ch * 16 + t) * DIN + C_S5U + g * 16); u32x4* dst = (u32x4*)(UG + ((size_t)g * S5ROWS + ch) * 512 + t * 16);
            dst[0] = src[0]; dst[1] = src[1]; }
    }
}
DI void s5_carry(const Ctx& C, int li, int gw, int ngw, int lane) {
    const float* SS = C.S5S(); bf16_t* UG = C.UG();
    for (int it = gw; it < NB * 2 * 16; it += ngw) {
        const int b = it >> 5, d = (it >> 4) & 1, g = it & 15, n = lane, pg = (li * 2 + d) * 16 + g;
        const float lr = C.in(I_LRE)[pg * 64 + n], lim = C.in(I_LIM)[pg * 64 + n], dt = expf(C.in(I_LSTEP)[pg]);
        const float mag = expf(16.0f * lr * dt); float sn, cs; sincosf(16.0f * lim * dt, &sn, &cs);
        const float ar = mag * cs, ai = mag * sn;
        float xr = 0.f, xi = 0.f;
#pragma unroll 1
        for (int s0 = 0; s0 < 272; s0 += 34) {
            float sr[34], si[34];
#pragma unroll
            for (int k = 0; k < 34; ++k) { const int s = s0 + k, c = d == 0 ? s : (s < 16 ? 15 - s : 287 - s); const size_t rowi = (size_t)g * S5ROWS + b * 272 + c;
                sr[k] = SS[rowi * 256 + d * 128 + n]; si[k] = SS[rowi * 256 + d * 128 + 64 + n]; }
#pragma unroll
            for (int k = 0; k < 34; ++k) { const int s = s0 + k, c = d == 0 ? s : (s < 16 ? 15 - s : 287 - s); const size_t rowi = (size_t)g * S5ROWS + b * 272 + c;
                UG[rowi * 512 + 256 + d * 128 + n] = (bf16_t)f2bf(xr); UG[rowi * 512 + 256 + d * 128 + 64 + n] = (bf16_t)f2bf(xi);
                const float nr = ar * xr - ai * xi + sr[k], ni = ar * xi + ai * xr + si[k]; xr = nr; xi = ni; }
        }
    }
}
struct SchedS5 {
    unsigned A, B; int G, c; unsigned bstride;
    DI bool next(int i, Unit& u) const {
        const int L = i * G + c; if (L >= 16 * 9) return false;
        u.e = L / 9; u.pm = L % 9; u.pn = 0; u.br = 0;
        u.a = A + ((unsigned)u.e * S5ROWS + u.pm * 256u) * 512u * 2u; u.b = B + (unsigned)u.e * bstride; u.uniform(); return true;
    }
};
struct EpiS5S {
    static constexpr bool PERM = false;
    float* SS;
    DI void operator()(const f32x4 (&acc)[2][2][4][2], const Unit& u, int wr, int wc, int fr, int fq) const {
        const int row0 = u.pm * 256 + wr * 64 + fr, col0 = wc * 32 + 4 * fq;
#pragma unroll
        for (int ai = 0; ai < 2; ++ai)
#pragma unroll
            for (int m = 0; m < 4; ++m) { float* rowp = SS + ((size_t)u.e * S5ROWS + row0 + ai * 128 + m * 16) * 256 + col0;
#pragma unroll
                for (int bj = 0; bj < 2; ++bj)
#pragma unroll
                    for (int n = 0; n < 2; ++n) *(f32x4*)(rowp + bj * 128 + n * 16) = acc[ai][bj][m][n]; }
    }
};
struct EpiS5Z {
    static constexpr bool PERM = true;
    bf16_t* Z;
    DI void operator()(const f32x4 (&acc)[2][2][4][2], const Unit& u, int wr, int wc, int fr, int fq) const {
        const int row0 = u.pm * 256 + wr * 64 + fr;
#pragma unroll
        for (int ai = 0; ai < 2; ++ai)
#pragma unroll
            for (int m = 0; m < 4; ++m) { const int ch = row0 + ai * 128 + m * 16; if (ch >= S5CH) continue;
#pragma unroll
                for (int bj = 0; bj < 2; ++bj) { const int col = bj * 128 + wc * 32 + 8 * fq, t = col >> 4, p0 = col & 15;
                    const f32x4 v0 = acc[ai][bj][m][0], v1 = acc[ai][bj][m][1];
                    u32x4 w; w.x = pk2(gelu_tanh(v0[0]), gelu_tanh(v0[1])); w.y = pk2(gelu_tanh(v0[2]), gelu_tanh(v0[3])); w.z = pk2(gelu_tanh(v1[0]), gelu_tanh(v1[1])); w.w = pk2(gelu_tanh(v1[2]), gelu_tanh(v1[3]));
                    *(u32x4*)(Z + ((size_t)ch * 16 + t) * 256 + u.e * 16 + p0) = w; } }
    }
};
struct SchedGlu {
    unsigned A, B; int G, c, li;
    DI bool next(int i, Unit& u) const {
        const int L = i * G + c; if (L >= (li == 0 ? 136 : 128)) return false;
        u.pm = pm_of(li, L); u.pn = 0; u.e = 0; u.br = 0; u.a = A + (unsigned)u.pm * 256u * 256u * 2u; u.b = B; u.uniform(); return true;
    }
};
struct EpiGlu {
    static constexpr bool PERM = true;
    bf16_t* O; const bf16_t* Z;
    DI void operator()(const f32x4 (&acc)[2][2][4][2], const Unit& u, int wr, int wc, int fr, int fq) const {
        const int row0 = u.pm * 256 + wr * 64 + fr, col0 = wc * 32 + 8 * fq;
#pragma unroll
        for (int ai = 0; ai < 2; ++ai)
#pragma unroll
            for (int m = 0; m < 4; ++m) { const size_t row = (size_t)(row0 + ai * 128 + m * 16);
#pragma unroll
                for (int bj = 0; bj < 2; ++bj) { const int col = col0 + bj * 128; const u32x4 z = *(const u32x4*)(Z + row * 256 + col);
                    const f32x4 v0 = acc[ai][bj][m][0], v1 = acc[ai][bj][m][1];
                    u32x4 w; w.x = pk2(lo_f(z.x) * sigm(v0[0]), hi_f(z.x) * sigm(v0[1])); w.y = pk2(lo_f(z.y) * sigm(v0[2]), hi_f(z.y) * sigm(v0[3]));
                    w.z = pk2(lo_f(z.z) * sigm(v1[0]), hi_f(z.z) * sigm(v1[1])); w.w = pk2(lo_f(z.w) * sigm(v1[2]), hi_f(z.w) * sigm(v1[3]));
                    *(u32x4*)(O + row * DM + col) = w; }
                if (m == 3) asm volatile("" ::: "memory"); }
    }
};

DI void transpose_item(const float* src, size_t ldw, bf16_t* dst, size_t ldo, LAS float* scr, int lane) {
    const int kq = lane >> 3, n4 = lane & 7;
    f32x4 tv[8];
#pragma unroll
    for (int i = 0; i < 8; ++i) tv[i] = __builtin_nontemporal_load((const f32x4*)(src + (size_t)(8 * kq + i) * ldw + 4 * n4));
    LAS unsigned char* t8 = (LAS unsigned char*)scr;
#pragma unroll
    for (int j = 0; j < 4; ++j) { u32x4 w; w.x = pk2(tv[0][j], tv[1][j]); w.y = pk2(tv[2][j], tv[3][j]); w.z = pk2(tv[4][j], tv[5][j]); w.w = pk2(tv[6][j], tv[7][j]);
        *(LAS u32x4*)(t8 + (4 * n4 + j) * 144 + 16 * kq) = w; }
    LDS_WAIT(); asm volatile("" ::: "memory");
    { const int n = lane >> 1, hf = lane & 1; const LAS u32x4* rp = (const LAS u32x4*)(t8 + n * 144 + 64 * hf);
      const u32x4 a0 = rp[0], a1 = rp[1], a2 = rp[2], a3 = rp[3];
      u32x4* gp = (u32x4*)(dst + (size_t)n * ldo + 32 * hf);
      gp[0] = a0; gp[1] = a1; gp[2] = a2; gp[3] = a3; }
    LDS_WAIT(); asm volatile("" ::: "memory");
}
DI void tr_plain(const float* W, int K, int N, bf16_t* WT, LAS float* scr, int item, int lane) {
    const int nblk = N / 32, kb = item / nblk, nb = item % nblk;
    transpose_item(W + (size_t)(64 * kb) * N + 32 * nb, N, WT + (size_t)(32 * nb) * K + 64 * kb, K, scr, lane);
}
DI void transpose_item8(const float* src, size_t ldw, unsigned char* dst, size_t ldo, LAS float* scr, int lane) {
    const int kq = lane >> 3, n4 = lane & 7;
    f32x4 tv[8];
#pragma unroll
    for (int i = 0; i < 8; ++i) tv[i] = __builtin_nontemporal_load((const f32x4*)(src + (size_t)(8 * kq + i) * ldw + 4 * n4));
    LAS unsigned char* t8 = (LAS unsigned char*)scr;
#pragma unroll
    for (int j = 0; j < 4; ++j) { u32x2 w; w.x = pk4_fp8(tv[0][j] * FP8_WS, tv[1][j] * FP8_WS, tv[2][j] * FP8_WS, tv[3][j] * FP8_WS); w.y = pk4_fp8(tv[4][j] * FP8_WS, tv[5][j] * FP8_WS, tv[6][j] * FP8_WS, tv[7][j] * FP8_WS);
        *(LAS u32x2*)(t8 + (4 * n4 + j) * 72 + 8 * kq) = w; }
    LDS_WAIT(); asm volatile("" ::: "memory");
    { const int n = lane >> 1, hf = lane & 1; const LAS u32x2* rp = (const LAS u32x2*)(t8 + n * 72 + 32 * hf);
      const u32x2 a0 = rp[0], a1 = rp[1], a2 = rp[2], a3 = rp[3];
      u32x4* gp = (u32x4*)(dst + (size_t)n * ldo + 32 * hf);
      gp[0] = (u32x4){a0.x, a0.y, a1.x, a1.y}; gp[1] = (u32x4){a2.x, a2.y, a3.x, a3.y}; }
    LDS_WAIT(); asm volatile("" ::: "memory");
}
DI void tr_gu(const float* W, unsigned char* W1T, int half, LAS float* scr, int item, int lane) {
    const int nblk = DF / 32, kb = item / nblk, nb = item % nblk, n0 = 32 * nb, drow = (n0 / 128) * 256 + half * 128 + (n0 % 128);
    transpose_item8(W + (size_t)(64 * kb) * DF + n0, DF, W1T + (size_t)drow * DM + 64 * kb, DM, scr, lane);
}
DI void convert_experts(const Ctx& C, int li, int it0, int gw, int ngw, LAS float* scr, int lane) {
    constexpr int PER = 16 * 88;
    constexpr int TOT = 3 * NE * PER, NQ = 8, PERQ = TOT / NQ, CH = 4;
    const int qi = (int)(blockIdx.x & 7);
    unsigned* head = (unsigned*)(C.ws() + WS_CTL + 524288) + (li * NQ + qi) * 32;
    for (;;) {
        unsigned b0 = 0; if (lane == 0) b0 = atomicAdd(head, (unsigned)CH);
        b0 = (unsigned)__builtin_amdgcn_readfirstlane((int)b0);
        if (b0 >= (unsigned)PERQ) break;
#pragma unroll 1
        for (int k = 0; k < CH; ++k) { const int it = qi * PERQ + (int)b0 + k;
            const int which = it / (NE * PER), r = it % (NE * PER), e = r / PER, item = r % PER;
            if (which == 0) tr_gu(C.in(I_EWG) + ((size_t)li * NE + e) * DM * DF, C.W1T() + (size_t)e * 5632 * DM, 0, scr, item, lane);
            else if (which == 1) tr_gu(C.in(I_EWU) + ((size_t)li * NE + e) * DM * DF, C.W1T() + (size_t)e * 5632 * DM, 1, scr, item, lane);
            else { const int nblk = DM / 32, kb = item / nblk, nb = item % nblk;
                transpose_item8(C.in(I_EWD) + ((size_t)li * NE + e) * DF * DM + (size_t)(64 * kb) * DM + 32 * nb, DM, C.W2T() + (size_t)e * DM * DF + (size_t)(32 * nb) * DF + 64 * kb, DF, scr, lane); } }
    }
}
DI void phase_prologue(const Ctx& C, LAS unsigned char* lds, int gw, int ngw, int wave, int lane) {
    const int tid_ = wave * 64 + lane;
    if (blockIdx.x < 96) { for (int li = 0; li < 2; ++li) {
        const int col = (blockIdx.x % 96) * 64 + lane; const float* w = C.in(I_ADAW) + (size_t)li * DM * 6144 + (size_t)(128 * wave) * 6144 + col;
        float cr[9][2];
#pragma unroll
        for (int q = 0; q < 9; ++q)
#pragma unroll
            for (int j = 0; j < 2; ++j) { const int k = 128 * wave + 64 * j + lane; cr[q][j] = silu_(q < 8 ? C.in(I_C)[q * 1024 + k] : C.in(I_CCTX)[k]); }
        float acc[9];
#pragma unroll
        for (int q = 0; q < 9; ++q) acc[q] = 0.f;
#pragma unroll
        for (int k0 = 0; k0 < 128; k0 += 32) { float wv[32];
#pragma unroll
            for (int k = 0; k < 32; ++k) wv[k] = w[(size_t)(k0 + k) * 6144];
#pragma unroll
            for (int k = 0; k < 32; ++k)
#pragma unroll
                for (int q = 0; q < 9; ++q) acc[q] += __uint_as_float(__builtin_amdgcn_readlane(__float_as_uint(cr[q][(k0 + k) >> 6]), (k0 + k) & 63)) * wv[k]; }
        LAS float* red = (LAS float*)(lds + 40960);
#pragma unroll
        for (int q = 0; q < 9; ++q) red[(wave * 9 + q) * 64 + lane] = acc[q];
        __syncthreads();
        for (int e = tid_; e < 9 * 64; e += 512) { const int q = e >> 6, cl = e & 63; float sum = 0.f;
#pragma unroll
            for (int wv2 = 0; wv2 < 8; ++wv2) sum += red[(wv2 * 9 + q) * 64 + cl];
            const int cc = (blockIdx.x % 96) * 64 + cl; C.mod()[(li * 9 + q) * 6144 + cc] = sum + C.in(I_ADAB)[li * 6144 + cc]; }
        __syncthreads(); }
    } else if (blockIdx.x < 224) { const int j = blockIdx.x - 96; s5_build_w(C, j >> 6, (j >> 2) & 15, j & 3, (LAS float*)(lds + 40960), tid_); }
    LAS float* scr = (LAS float*)(lds + 40960 + wave * 8704);
    if (blockIdx.x == 0 && tid_ < 256) {
        const float v0 = C.in(I_HGLB)[tid_], v1 = C.in(I_HGLB)[256 + tid_];
        C.lb()[tid_] = 0.f; C.lb()[256 + tid_] = 1.0f / (1.0f + expf(v0 - v1));
    }
    constexpr int N_MOD = 0, N_WIN = 2 * 16 * 232,     N_WBR = 8 * 4 * 32, N_WOUT = 2 * 16 * 32, N_GLU = 2 * 4 * 8;
    for (int it = gw; it < N_MOD + N_WIN + N_WBR + N_WOUT + N_GLU; it += ngw) {
        int r = it;
        r -= N_MOD;
        if (r < N_WIN) { const int li = r / (16 * 232), it2 = r % (16 * 232), kb = it2 / 232, nb = it2 % 232; const float* src = C.in(I_WIN) + (size_t)li * DM * DIN + (size_t)(64 * kb) * DIN + 32 * nb;
            if (nb < C_GATE / 32) transpose_item(src, DIN, C.win() + (size_t)li * DIN * DM + (size_t)(32 * nb) * DM + 64 * kb, DM, scr, lane);
            else transpose_item8(src, DIN, C.ws() + WS_WIN + (size_t)li * DIN * DM * 2 + WS_WIN8_OFF + (size_t)(32 * nb - C_GATE) * DM + 64 * kb, DM, scr, lane);
            continue; }
        r -= N_WIN;
        if (r < N_WBR) { const int m = r / 128, it2 = r % 128, kb = it2 / 32, nb = it2 % 32;
            transpose_item(C.in(I_WBR) + (size_t)m * 256 * DM + (size_t)(64 * kb) * DM + 32 * nb, DM, C.wbr() + (size_t)(m >> 2) * DM * DM + (size_t)(32 * nb) * DM + (m & 3) * 256 + 64 * kb, DM, scr, lane); continue; }
        r -= N_WBR;
        if (r < N_WOUT) { const int li = r / 512; tr_plain(C.in(I_WOUT) + (size_t)li * DM * DM, DM, DM, C.wout() + (size_t)li * DM * DM, scr, r % 512, lane); continue; }
        r -= N_WOUT;
        { const int li = r / 32; tr_plain(C.in(I_GLU) + (size_t)li * 65536, 256, 256, C.GLUT() + (size_t)li * 65536, scr, r % 32, lane); }
    }
}

DI void moe_combine_row(const Ctx& C, size_t R, const float* g2, f32x4 (&v)[4], int lane) {
    f32x4 a[4];
#pragma unroll
    for (int j = 0; j < 4; ++j) a[j] = (f32x4){0.f, 0.f, 0.f, 0.f};
    int sv[NE];
#pragma unroll
    for (int e = 0; e < NE; ++e) sv[e] = C.sel()[(size_t)e * NTOK + R];
#pragma unroll
    for (int e = 0; e < NE; ++e) { const int s = __builtin_amdgcn_readfirstlane(sv[e]);
        if (s >= 0) { const bf16_t* y = C.XE() + ((size_t)e * EROWS + s) * DM;
#pragma unroll
            for (int j = 0; j < 4; ++j) { const u32x2 w = __builtin_nontemporal_load((const u32x2*)(y + 4 * (lane + 64 * j))); a[j][0] += lo_f(w.x); a[j][1] += hi_f(w.x); a[j][2] += lo_f(w.y); a[j][3] += hi_f(w.y); } }
    }
#pragma unroll
    for (int j = 0; j < 4; ++j) v[j] = v[j] + *(const f32x4*)(g2 + 4 * (lane + 64 * j)) * a[j];
}
DI void norm1_row(const Ctx& C, int li, int R, const float* nw, int lane, float* Xout, f32x4 (&v)[4]) {
    const int b = R / LSEQ, i = R % LSEQ, mr = (i < CTXL) ? 8 : b;
    if (li > 0) moe_combine_row(C, R, C.mod() + ((li - 1) * 9 + mr) * 6144 + 5 * 1024, v, lane);
    float ss = 0.f;
#pragma unroll
    for (int j = 0; j < 4; ++j) { if (li > 0) *(f32x4*)(Xout + (size_t)R * DM + 4 * (lane + 64 * j)) = v[j];     ss += v[j][0] * v[j][0] + v[j][1] * v[j][1] + v[j][2] * v[j][2] + v[j][3] * v[j][3]; }
    const float rstd = 1.0f / sqrtf(wave_sum(ss) * (1.0f / DM) + EPS);
    const float* md = C.mod() + (li * 9 + mr) * 6144;
#pragma unroll
    for (int j = 0; j < 4; ++j) { const int c = 4 * (lane + 64 * j);
        const f32x4 w = *(const f32x4*)(nw + c), sh = *(const f32x4*)(md + c), sc = *(const f32x4*)(md + 1024 + c);
        const f32x4 h = v[j] * rstd * w * (sc + 1.0f) + sh;
        u32x2 o; o.x = pk2(h[0], h[1]); o.y = pk2(h[2], h[3]);
        *(u32x2*)(C.H() + (size_t)R * DM + c) = o;
        *(unsigned*)(C.ws() + WS_H8 + (size_t)R * DM + c) = pk4_fp8(h[0] * FP8_XS, h[1] * FP8_XS, h[2] * FP8_XS, h[3] * FP8_XS); }
}
DI const float* xrow_src(const Ctx& C, int li, int R) {
    if (li > 0) return C.X() + (size_t)R * DM;
    const int b = R / LSEQ, i = R % LSEQ;
    return (i < CTXL) ? C.in(I_CTX) + ((size_t)b * CTXL + i) * DM : C.in(I_X) + ((size_t)b * SEQ + (i - CTXL)) * DM;
}
DI void phase_norm1(const Ctx& C, int li, int gw, int ngw, int lane, float* Xout) {
    const float* nw = C.in(I_NMIX) + li * DM;
    for (int R = gw; R < NTOK; R += 4 * ngw) {
        f32x4 v[4][4];
#pragma unroll
        for (int q = 0; q < 4; ++q) { const int Rq = R + q * ngw; if (Rq < NTOK) { const float* src = xrow_src(C, li, Rq);
#pragma unroll
            for (int j = 0; j < 4; ++j) v[q][j] = *(const f32x4*)(src + 4 * (lane + 64 * j)); } }
#pragma unroll
        for (int q = 0; q < 4; ++q) { const int Rq = R + q * ngw; if (Rq < NTOK) norm1_row(C, li, Rq, nw, lane, Xout, v[q]); }
    }
}
DI void phase_final(const Ctx& C, int gw, int ngw, int lane) {
    for (int t0 = gw; t0 < NB * SEQ; t0 += 4 * ngw) {
        f32x4 v[4][4];
#pragma unroll
        for (int q = 0; q < 4; ++q) { const int t = t0 + q * ngw; if (t < NB * SEQ) { const size_t R = (size_t)(t / SEQ) * LSEQ + CTXL + (t % SEQ);
#pragma unroll
            for (int j = 0; j < 4; ++j) v[q][j] = __builtin_nontemporal_load((const f32x4*)(C.X() + R * DM + 4 * (lane + 64 * j))); } }
#pragma unroll
        for (int q = 0; q < 4; ++q) { const int t = t0 + q * ngw; if (t < NB * SEQ) { const int b = t / SEQ; const size_t R = (size_t)b * LSEQ + CTXL + (t % SEQ);
            moe_combine_row(C, R, C.mod() + (1 * 9 + b) * 6144 + 5 * 1024, v[q], lane);
#pragma unroll
            for (int j = 0; j < 4; ++j) __builtin_nontemporal_store(v[q][j], (f32x4*)(C.out() + (size_t)t * DM + 4 * (lane + 64 * j))); } }
    }
}

DI void phase_norm2(const Ctx& C, int li, LAS unsigned char* lds, int gw, int ngw, int wave, int lane) {
    const int tid_ = wave * 64 + lane;
    LAS float* rwT = (LAS float*)lds;
    for (int i = tid_; i < DM * NE / 4; i += 512) { const f32x4 v = ((const f32x4*)(C.in(I_RW) + (size_t)li * DM * NE))[i]; const int c = i >> 2, e0 = (i & 3) * 4;
        rwT[(e0 + 0) * DM + c] = v[0]; rwT[(e0 + 1) * DM + c] = v[1]; rwT[(e0 + 2) * DM + c] = v[2]; rwT[(e0 + 3) * DM + c] = v[3]; }
    __syncthreads();
    const float* nw = C.in(I_NFFN) + li * DM;
    for (int R0 = gw; R0 < NTOK; R0 += 4 * ngw) {
      f32x4 vq[4][4];
#pragma unroll
      for (int q = 0; q < 4; ++q) { const int R = R0 + q * ngw; if (R < NTOK) {
#pragma unroll
          for (int j = 0; j < 4; ++j) vq[q][j] = *(const f32x4*)(C.X() + (size_t)R * DM + 4 * (lane + 64 * j)); } }
#pragma unroll
      for (int q = 0; q < 4; ++q) { const int R = R0 + q * ngw; if (R >= NTOK) continue;
        const int b = R / LSEQ, i = R % LSEQ, mr = (i < CTXL) ? 8 : b;
        if (li == DEPTH - 1 && i < CTXL) continue;
        f32x4 (&v)[4] = vq[q]; float ss = 0.f;
#pragma unroll
        for (int j = 0; j < 4; ++j) ss += v[j][0] * v[j][0] + v[j][1] * v[j][1] + v[j][2] * v[j][2] + v[j][3] * v[j][3];
        const float rstd = 1.0f / sqrtf(wave_sum(ss) * (1.0f / DM) + EPS);
        const float* md = C.mod() + (li * 9 + mr) * 6144;
        float y[NE];
#pragma unroll
        for (int e = 0; e < NE; ++e) y[e] = 0.f;
#pragma unroll
        for (int j = 0; j < 4; ++j) { const int c = 4 * (lane + 64 * j);
            const f32x4 w = *(const f32x4*)(nw + c), sh = *(const f32x4*)(md + 3 * 1024 + c), sc = *(const f32x4*)(md + 4 * 1024 + c);
            const f32x4 h = v[j] * rstd * w * (sc + 1.0f) + sh;
            u32x2 o; o.x = pk2(h[0], h[1]); o.y = pk2(h[2], h[3]);
            *(u32x2*)(C.H() + (size_t)R * DM + c) = o;
#pragma unroll
            for (int e = 0; e < NE; ++e) { const f32x4 r4 = *(const LAS f32x4*)(rwT + e * DM + c); y[e] += h[0] * r4[0] + h[1] * r4[1] + h[2] * r4[2] + h[3] * r4[3]; } }
        float y8[8], y4[4], y2[2], lg;
        { const bool hi = (lane & 32) != 0;
#pragma unroll
          for (int k = 0; k < 8; ++k) { const float keep = hi ? y[k + 8] : y[k], send = hi ? y[k] : y[k + 8]; y8[k] = keep + shx<32>(send); } }
        { const bool hi = (lane & 16) != 0;
#pragma unroll
          for (int k = 0; k < 4; ++k) { const float keep = hi ? y8[k + 4] : y8[k], send = hi ? y8[k] : y8[k + 4]; y4[k] = keep + shx<16>(send); } }
        { const bool hi = (lane & 8) != 0;
#pragma unroll
          for (int k = 0; k < 2; ++k) { const float keep = hi ? y4[k + 2] : y4[k], send = hi ? y4[k] : y4[k + 2]; y2[k] = keep + shx<8>(send); } }
        { const bool hi = (lane & 4) != 0; const float keep = hi ? y2[1] : y2[0], send = hi ? y2[0] : y2[1]; lg = keep + shx<4>(send); }
        lg += shx<2>(lg); lg += shx<1>(lg);
        float mx = lg;
        mx = fmaxf(mx, shx<4>(mx)); mx = fmaxf(mx, shx<8>(mx)); mx = fmaxf(mx, shx<16>(mx)); mx = fmaxf(mx, shx<32>(mx));
        const float ex = expf(lg - mx);
        float den = ex;
        den += shx<4>(den); den += shx<8>(den); den += shx<16>(den); den += shx<32>(den);
        if ((lane & 3) == 0) C.aff()[(size_t)R * NE + ((lane >> 2) & 15)] = ex / den;
      }
    }
}

DI void phase_topk(const Ctx& C, int li, LAS unsigned char* lds, int wave, int lane) {
    LAS unsigned* cnt = (LAS unsigned*)lds;
    LAS int* rows = (LAS int*)(lds + 64);
    const int tid = wave * 64 + lane, nunit = (li == DEPTH - 1) ? 128 : 256;
    for (int u = blockIdx.x; u < nunit; u += gridDim.x) {
        const int kind = u >> 7, b = (u >> 4) & 7, e = u & 15;
        const int n = kind ? CTXL : SEQ, cap = kind ? CAP_C : CAP_L, per = n / 512 + (kind ? 1 : 0);
        const size_t rbase = (size_t)b * LSEQ + (kind ? 0 : CTXL);
        unsigned v[8];
#pragma unroll
        for (int j = 0; j < 8; ++j) { const int t = tid + 512 * j; v[j] = (j < per && t < n) ? __float_as_uint(C.aff()[(rbase + t) * NE + e]) : 0u; }
        unsigned thr = 0u;
        for (int bit = 30; bit >= 0; --bit) {
            const unsigned cand = thr | (1u << bit);
            if (tid == 0) cnt[0] = 0u;
            __syncthreads();
            unsigned c = 0;
#pragma unroll
            for (int j = 0; j < 8; ++j) c += (v[j] >= cand) ? 1u : 0u;
            c = (unsigned)wave_sum((float)c);
            if (lane == 0) atomicAdd((unsigned*)cnt, c);
            __syncthreads();
            if (cnt[0] >= (unsigned)cap) thr = cand;
            __syncthreads();
        }
        if (tid == 0) { cnt[1] = 0u; cnt[2] = 0u; }
        __syncthreads();
        unsigned ngt = 0;
#pragma unroll
        for (int j = 0; j < 8; ++j) ngt += (v[j] > thr) ? 1u : 0u;
        ngt = (unsigned)wave_sum((float)ngt);
        if (lane == 0) atomicAdd((unsigned*)cnt + 1, ngt);
        __syncthreads();
        const unsigned n_gt = cnt[1];
        __syncthreads();
        if (tid == 0) cnt[1] = 0u;
        __syncthreads();
        const int srow0 = kind ? (NB * CAP_L + b * CAP_C) : b * CAP_L;
#pragma unroll
        for (int j = 0; j < 8; ++j) { const int t = tid + 512 * j;
            if (j < per && t < n) {
                int slot = -1;
                if (v[j] > thr) slot = (int)atomicAdd((unsigned*)cnt + 1, 1u);
                else if (v[j] == thr) { const unsigned k = atomicAdd((unsigned*)cnt + 2, 1u); if (n_gt + k < (unsigned)cap) slot = (int)(n_gt + k); }
                C.sel()[(size_t)e * NTOK + rbase + t] = (slot >= 0) ? srow0 + slot : -1;
                if (slot >= 0) { rows[slot] = (int)(rbase + t); C.gate()[(size_t)e * EROWS + srow0 + slot] = __uint_as_float(v[j]); }
            } }
        __syncthreads();
        for (int s0 = wave; s0 < cap; s0 += 32) {
            u32x4 xa[4], xb[4];
#pragma unroll
            for (int q = 0; q < 4; ++q) { const int sq = s0 + 8 * q; if (sq < cap) { const u32x4* src = (const u32x4*)(C.H() + (size_t)rows[sq] * DM) + 2 * lane; xa[q] = src[0]; xb[q] = src[1]; } }
#pragma unroll
            for (int q = 0; q < 4; ++q) { const int sq = s0 + 8 * q; if (sq >= cap) continue; const u32x4 x0 = xa[q], x1 = xb[q];
                u32x4 o; o.x = pk4_fp8(lo_f(x0.x) * FP8_XS, hi_f(x0.x) * FP8_XS, lo_f(x0.y) * FP8_XS, hi_f(x0.y) * FP8_XS); o.y = pk4_fp8(lo_f(x0.z) * FP8_XS, hi_f(x0.z) * FP8_XS, lo_f(x0.w) * FP8_XS, hi_f(x0.w) * FP8_XS);
                o.z = pk4_fp8(lo_f(x1.x) * FP8_XS, hi_f(x1.x) * FP8_XS, lo_f(x1.y) * FP8_XS, hi_f(x1.y) * FP8_XS); o.w = pk4_fp8(lo_f(x1.z) * FP8_XS, hi_f(x1.z) * FP8_XS, lo_f(x1.w) * FP8_XS, hi_f(x1.w) * FP8_XS);
                *((u32x4*)((unsigned char*)C.XE() + ((size_t)e * EROWS + srow0 + sq) * DM) + lane) = o; }
        }
        __syncthreads();
    }
}

DI void phase_prep(const Ctx& C, int li, int gw, int ngw, int lane) {
    const float* wq = C.in(I_NAQN) + li * 64; const float* wk = C.in(I_NAKN) + li * 64;
    const int d0 = (lane & 7) * 8; const bool isq = lane < 32;
    float w[8];
#pragma unroll
    for (int j = 0; j < 8; ++j) w[j] = isq ? wq[d0 + j] * 0.125f : wk[d0 + j];
    for (int R0 = gw; R0 < NTOK; R0 += 4 * ngw) {
        u32x4 xq[4];
#pragma unroll
        for (int q = 0; q < 4; ++q) { const int R = R0 + q * ngw; if (R < NTOK) xq[q] = *(const u32x4*)(C.P() + (size_t)R * DIN + C_NAQ + 8 * lane); }
#pragma unroll
        for (int q = 0; q < 4; ++q) { const int R = R0 + q * ngw; if (R >= NTOK) continue; const u32x4 x = xq[q];
            float f[8] = {lo_f(x.x), hi_f(x.x), lo_f(x.y), hi_f(x.y), lo_f(x.z), hi_f(x.z), lo_f(x.w), hi_f(x.w)};
            float ss = 0.f;
#pragma unroll
            for (int j = 0; j < 8; ++j) ss += f[j] * f[j];
            ss += shx<1>(ss); ss += shx<2>(ss); ss += shx<4>(ss);
            const float rs = __builtin_amdgcn_rsqf(ss * (1.0f / 64.0f) + EPS);
            u32x4 o; o.x = pk2(f[0] * rs * w[0], f[1] * rs * w[1]); o.y = pk2(f[2] * rs * w[2], f[3] * rs * w[3]); o.z = pk2(f[4] * rs * w[4], f[5] * rs * w[5]); o.w = pk2(f[6] * rs * w[6], f[7] * rs * w[7]);
            *(u32x4*)(C.QKN() + (size_t)R * 512 + 8 * lane) = o; }
    }
}

typedef short s16x4 __attribute__((ext_vector_type(4)));
#define MFMA16(a, b, c) __builtin_amdgcn_mfma_f32_16x16x32_bf16((a), (b), (c), 0, 0, 0)
DI bf16x8 ld16(const bf16_t* p) { return *(const bf16x8*)p; }
DI s16x4 tr16(const LAS bf16_t* p) { return __builtin_amdgcn_ds_read_tr16_b64_v4i16((LAS s16x4*)p); }
DI bf16x8 cat8(s16x4 a, s16x4 b) { return __builtin_shufflevector(a, b, 0, 1, 2, 3, 4, 5, 6, 7); }
DI bf16x8 pack8(const f32x4& a, const f32x4& b) { u32x4 w; w.x = pg8::cvt_pk_bf16(a[0], a[1]); w.y = pg8::cvt_pk_bf16(a[2], a[3]); w.z = pg8::cvt_pk_bf16(b[0], b[1]); w.w = pg8::cvt_pk_bf16(b[2], b[3]); return __builtin_bit_cast(bf16x8, w); }

constexpr int NA_VS = 80;
DI void na_unit(const Ctx& C, int li, int wu, bool isctx, int lane, LAS bf16_t* vl, const LAS float* rpbt) {
    const int cq = lane & 15, g = lane >> 4;
    int b, h, r, c; size_t Rq;
    if (!isctx) { c = wu & 3; h = (wu >> 2) & 3; r = (wu >> 4) & 63; b = wu >> 10; Rq = (size_t)b * LSEQ + CTXL + r * 64 + 16 * c + cq; }
    else { c = wu & 15; h = (wu >> 4) & 3; b = wu >> 6; r = 0; Rq = (size_t)b * LSEQ + 16 * c + cq; }
    const bf16_t* QKN = C.QKN(); const bf16_t* P = C.P();
    bf16x8 qf[2];
    qf[0] = ld16(QKN + Rq * 512 + h * 64 + 8 * g); qf[1] = ld16(QKN + Rq * 512 + h * 64 + 32 + 8 * g);
    f32x4 o[4];
#pragma unroll
    for (int d = 0; d < 4; ++d) o[d] = (f32x4){0.f, 0.f, 0.f, 0.f};
    float lsum = 0.f;
    const int r0 = min(max(r - 4, 0), 56), kc0 = (c == 0) ? 0 : (c == 1) ? 8 : (c == 2) ? 24 : 32, qi = 16 * c + cq, cs = min(max(qi - 8, 0), 48);
    const LAS float* rpb = rpbt + h * 465;
    const size_t rowb = (size_t)b * LSEQ;
    const int nch = isctx ? 4 : 8;
    const int dwin = kc0 + 4 * g - cs, ebias = kc0 + 4 * g - qi + 15;
    const unsigned voffV = (unsigned)((lane >> 3) * DIN + 8 * (lane & 7)) * 2u, voffK = (unsigned)(cq * 512 + 8 * g) * 2u;
    const __amdgpu_buffer_rsrc_t rsP = __builtin_amdgcn_make_buffer_rsrc((void*)P, 0, 0x7fffffff, 0x00020000), rsK = __builtin_amdgcn_make_buffer_rsrc((void*)QKN, 0, 0x7fffffff, 0x00020000);
    const unsigned Pv0 = (unsigned)(C_NAV + h * 64) * 2u, Kv0 = (unsigned)(256 + h * 64) * 2u;
#define NA_CHROW(ch_) ((!isctx && (ch_) < 4) ? (rowb + CTXL + (size_t)(r0 + 2 * (ch_)) * 64 + kc0) : (rowb + 64 * (size_t)(isctx ? (ch_) : (ch_) - 4)))
#define NA_VSTEP(ch_, i) ((!isctx && (ch_) < 4) ? (((i) >> 2) * 64 + 8 * ((i) & 3)) : 8 * (i))
#define NA_KSTEP(ch_, kb) ((!isctx && (ch_) < 4) ? (((kb) >> 1) * 64 + 16 * ((kb) & 1)) : 16 * (kb))
    bf16x8 vA[8], kA[8], vB[8], kB[8];
#define NA_PREFETCH(VR, KR, ch_) do { const size_t cr_ = NA_CHROW(ch_); \
        _Pragma("unroll") for (int i = 0; i < 8; ++i) VR[i] = __builtin_bit_cast(bf16x8, __builtin_amdgcn_raw_buffer_load_b128(rsP, voffV, (unsigned)(cr_ + NA_VSTEP(ch_, i)) * (unsigned)(DIN * 2) + Pv0, 0)); \
        _Pragma("unroll") for (int kb = 0; kb < 4; ++kb) { const unsigned ko_ = (unsigned)(cr_ + NA_KSTEP(ch_, kb)) * 1024u + Kv0; \
            KR[2 * kb] = __builtin_bit_cast(bf16x8, __builtin_amdgcn_raw_buffer_load_b128(rsK, voffK, ko_, 0)); KR[2 * kb + 1] = __builtin_bit_cast(bf16x8, __builtin_amdgcn_raw_buffer_load_b128(rsK, voffK, ko_ + 64u, 0)); } } while (0)
#define NA_BODY(VR, KR, ch_) do { const int chv = (ch_); const bool local = !isctx && chv < 4; \
          \
        _Pragma("unroll") for (int i = 0; i < 8; ++i) *(LAS bf16x8*)(vl + (lane >> 3) * NA_VS + 8 * (lane & 7) + i * 8 * NA_VS) = VR[i]; \
        f32x4 s[4]; \
        _Pragma("unroll") for (int kb = 0; kb < 4; ++kb) { s[kb] = MFMA16(KR[2 * kb], qf[0], ((f32x4){0.f, 0.f, 0.f, 0.f})); s[kb] = MFMA16(KR[2 * kb + 1], qf[1], s[kb]); } \
        asm volatile("" : "+v"(s[0]), "+v"(s[1]), "+v"(s[2]), "+v"(s[3]));     \
        if (chv + 2 < nch) NA_PREFETCH(VR, KR, chv + 2); \
        _Pragma("unroll") for (int kb = 0; kb < 4; ++kb) \
            _Pragma("unroll") for (int i = 0; i < 4; ++i) { float pv; \
                if (local) { const int dcol = dwin + 16 * (kb & 1) + i; const bool ok = (unsigned)dcol < 16u; \
                    const int bi = ok ? ((r0 + 2 * chv + (kb >> 1) - r + 7) * 31 + ebias + 16 * (kb & 1) + i) : 0; \
                    pv = ok ? __expf(s[kb][i] + rpb[bi] - 8.0f) : 0.f; } \
                else pv = __expf(s[kb][i] - 8.0f); \
                s[kb][i] = pv; lsum += pv; } \
        const bf16x8 pb0 = pack8(s[0], s[1]), pb1 = pack8(s[2], s[3]); \
        const int q4 = cq >> 2, p4 = cq & 3; \
        _Pragma("unroll") for (int db = 0; db < 4; ++db) { \
            const LAS bf16_t* base = vl + (4 * g + q4) * NA_VS + 16 * db + 4 * p4; \
            const bf16x8 va0 = cat8(tr16(base), tr16(base + 16 * NA_VS)), va1 = cat8(tr16(base + 32 * NA_VS), tr16(base + 48 * NA_VS)); \
            o[db] = MFMA16(va0, pb0, o[db]); o[db] = MFMA16(va1, pb1, o[db]); } } while (0)
    NA_PREFETCH(vA, kA, 0); NA_PREFETCH(vB, kB, 1);
    for (int ch = 0; ch < nch; ch += 2) { NA_BODY(vA, kA, ch); NA_BODY(vB, kB, ch + 1); }
#undef NA_BODY
#undef NA_CHROW
#undef NA_VSTEP
#undef NA_KSTEP
#undef NA_PREFETCH
    lsum += shx<16>(lsum); lsum += shx<32>(lsum);
    const float il = 1.0f / lsum;
    bf16_t* op = C.O() + Rq * DM + 256 + h * 64 + 4 * g;
#pragma unroll
    for (int db = 0; db < 4; ++db) { u32x2 w; w.x = pk2(o[db][0] * il, o[db][1] * il); w.y = pk2(o[db][2] * il, o[db][3] * il); *(u32x2*)(op + 16 * db) = w; }
}


DI void prep_ret(const Ctx& C, int li, int gw, int ngw, int lane) {
    const int rsub = lane >> 4, h = (lane >> 2) & 3, jb = lane & 3;
    const float lg0 = __log2f(sigm(C.in(I_RETD)[(li * 2 + 0) * 4 + h])), lg1 = __log2f(sigm(C.in(I_RETD)[(li * 2 + 1) * 4 + h]));
    float inv[8];
#pragma unroll
    for (int e = 0; e < 8; ++e) inv[e] = exp2f(-(float)(8 * (jb & 1) + e) * (13.287712379549449f / 16.0f));
    bf16_t* RP = C.RETP(); const bf16_t* P = C.P();
    for (int it = gw; it < NTOK / 4; it += ngw) {
        const size_t R = (size_t)it * 4 + rsub; const int i = (int)(R % LSEQ), il = i & 63;
        const size_t pq = R * DIN + C_RTQ + h * 64 + 8 * jb, pk = R * DIN + C_RTK + h * 64 + 8 * jb;
        const u32x4 q1w = *(const u32x4*)(P + pq), q2w = *(const u32x4*)(P + pq + 32), k1w = *(const u32x4*)(P + pk), k2w = *(const u32x4*)(P + pk + 32);
        float q1[8] = {lo_f(q1w.x), hi_f(q1w.x), lo_f(q1w.y), hi_f(q1w.y), lo_f(q1w.z), hi_f(q1w.z), lo_f(q1w.w), hi_f(q1w.w)};
        float q2[8] = {lo_f(q2w.x), hi_f(q2w.x), lo_f(q2w.y), hi_f(q2w.y), lo_f(q2w.z), hi_f(q2w.z), lo_f(q2w.w), hi_f(q2w.w)};
        float k1[8] = {lo_f(k1w.x), hi_f(k1w.x), lo_f(k1w.y), hi_f(k1w.y), lo_f(k1w.z), hi_f(k1w.z), lo_f(k1w.w), hi_f(k1w.w)};
        float k2[8] = {lo_f(k2w.x), hi_f(k2w.x), lo_f(k2w.y), hi_f(k2w.y), lo_f(k2w.z), hi_f(k2w.z), lo_f(k2w.w), hi_f(k2w.w)};
        if (i >= CTXL) { const int t = i - CTXL; const float pos = (float)((jb < 2) ? (t >> 6) : (t & 63));
#pragma unroll
            for (int e = 0; e < 8; ++e) { const float ang = pos * inv[e], sn = __sinf(ang), cs = __cosf(ang);
                const float a = q1[e] * cs - q2[e] * sn, b2 = q2[e] * cs + q1[e] * sn; q1[e] = a; q2[e] = b2;
                const float c2 = k1[e] * cs - k2[e] * sn, d2 = k2[e] * cs + k1[e] * sn; k1[e] = c2; k2[e] = d2; } }
        const float fil = (float)il;
        const float sq0 = exp2f(fil * lg0), sk0 = 0.125f * exp2f(-fil * lg0), sq1 = exp2f(-fil * lg1), sk1 = 0.125f * exp2f(fil * lg1);
        const size_t o = R * 256 + h * 64 + 8 * jb;
#define PK8(arr, sc) ((u32x4){pk2(arr[0] * sc, arr[1] * sc), pk2(arr[2] * sc, arr[3] * sc), pk2(arr[4] * sc, arr[5] * sc), pk2(arr[6] * sc, arr[7] * sc)})
        *(u32x4*)(RP + 0 * RETP_T + o) = PK8(q1, sq0); *(u32x4*)(RP + 0 * RETP_T + o + 32) = PK8(q2, sq0);
        *(u32x4*)(RP + 1 * RETP_T + o) = PK8(k1, sk0); *(u32x4*)(RP + 1 * RETP_T + o + 32) = PK8(k2, sk0);
        *(u32x4*)(RP + 2 * RETP_T + o) = PK8(q1, sq1); *(u32x4*)(RP + 2 * RETP_T + o + 32) = PK8(q2, sq1);
        *(u32x4*)(RP + 3 * RETP_T + o) = PK8(k1, sk1); *(u32x4*)(RP + 3 * RETP_T + o + 32) = PK8(k2, sk1);
#undef PK8
    }
}
constexpr int RT_TS = 272;
DI void stage_tile64x256(LAS bf16_t* dst, const bf16_t* src, size_t srcld, int tid) {
#pragma unroll
    for (int i = 0; i < 4; ++i) { const int p = tid + 512 * i, row = p >> 5, c16 = p & 31;
        *(LAS bf16x8*)(dst + row * RT_TS + 8 * c16) = ld16(src + (size_t)row * srcld + 8 * c16); }
}
DI size_t st_off(int b, int h, int d, int c) { return ((size_t)(((b * 4 + h) * 2 + d) * NCHK + c)) * 4096; }
DI void ret_pass1(const Ctx& C, LAS unsigned char* lds, int wave, int lane) {
    LAS bf16_t* vt = (LAS bf16_t*)lds; LAS bf16_t* k0t = vt + 64 * RT_TS; LAS bf16_t* k1t = k0t + 64 * RT_TS;
    const int tid = wave * 64 + lane, cq = lane & 15, g = lane >> 4, q4 = cq >> 2, p4 = cq & 3, h = wave & 3, d = wave >> 2;
    const bf16_t* P = C.P(); const bf16_t* RP = C.RETP(); bf16_t* ST = C.RETS();
    for (int u = blockIdx.x; u < NB * NCHK; u += gridDim.x) {
        const int b = u / NCHK, c = u % NCHK; const size_t R0 = (size_t)b * LSEQ + 64 * c;
        __syncthreads();
        stage_tile64x256(vt, P + R0 * DIN + C_RTV, DIN, tid);
        stage_tile64x256(k0t, RP + 1 * RETP_T + R0 * 256, 256, tid);
        stage_tile64x256(k1t, RP + 3 * RETP_T + R0 * 256, 256, tid);
        __syncthreads();
        const LAS bf16_t* kt = d ? k1t : k0t;
        f32x4 S[4][4];
#pragma unroll
        for (int mb = 0; mb < 4; ++mb)
#pragma unroll
            for (int nb = 0; nb < 4; ++nb) S[mb][nb] = (f32x4){0.f, 0.f, 0.f, 0.f};
#pragma unroll
        for (int ks = 0; ks < 2; ++ks) {
            bf16x8 a[4], bv[4];
#pragma unroll
            for (int mb = 0; mb < 4; ++mb) { const LAS bf16_t* p = kt + (32 * ks + 8 * g + q4) * RT_TS + h * 64 + 16 * mb + 4 * p4; a[mb] = cat8(tr16(p), tr16(p + 4 * RT_TS)); }
#pragma unroll
            for (int nb = 0; nb < 4; ++nb) { const LAS bf16_t* p = vt + (32 * ks + 8 * g + q4) * RT_TS + h * 64 + 16 * nb + 4 * p4; bv[nb] = cat8(tr16(p), tr16(p + 4 * RT_TS)); }
#pragma unroll
            for (int mb = 0; mb < 4; ++mb)
#pragma unroll
                for (int nb = 0; nb < 4; ++nb) S[mb][nb] = MFMA16(a[mb], bv[nb], S[mb][nb]);
        }
        bf16_t* sp = ST + st_off(b, h, d, c);
#pragma unroll
        for (int mb = 0; mb < 4; ++mb)
#pragma unroll
            for (int nb = 0; nb < 4; ++nb) { u32x2 w; w.x = pk2(S[mb][nb][0], S[mb][nb][1]); w.y = pk2(S[mb][nb][2], S[mb][nb][3]); *(u32x2*)(sp + (16 * nb + cq) * 64 + 16 * mb + 4 * g) = w; }
    }
}
DI int chunk_at(int d, int s) { return d == 0 ? s : (s < 4 ? 3 - s : NCHK + 3 - s); }
DI void ret_carry(const Ctx& C, int li, int gw, int ngw, int lane) {
    bf16_t* ST = C.RETS();
    for (int it = gw; it < 64 * 16; it += ngw) {
        const int chain = it >> 4, e0 = ((it & 15) * 64 + lane) * 4, d = chain & 1, h = (chain >> 1) & 3;
        const float gm = sigm(C.in(I_RETD)[(li * 2 + d) * 4 + h]), g64 = __powf(gm, 64.0f);
        const float fo = d ? g64 : gm, dc = g64, sc = d ? 1.0f : __powf(gm, 63.0f);
        const char* cb = (const char*)ST + (size_t)chain * NCHK * 8192; const unsigned voff = (unsigned)e0 * 2u;
        f32x4 S = (f32x4){0.f, 0.f, 0.f, 0.f};
#pragma unroll 1
        for (int s0 = 0; s0 < NCHK; s0 += NCHK / 2) {
            u32x2 w[NCHK / 2];
#pragma unroll
            for (int k = 0; k < NCHK / 2; ++k) w[k] = *(const u32x2*)(cb + (size_t)chunk_at(d, s0 + k) * 8192 + voff);
#pragma unroll
            for (int k = 0; k < NCHK / 2; ++k) { const f32x4 raw = (f32x4){lo_f(w[k].x), hi_f(w[k].x), lo_f(w[k].y), hi_f(w[k].y)};
                const f32x4 o = S * fo; u32x2 ow; ow.x = pk2(o[0], o[1]); ow.y = pk2(o[2], o[3]);
                *(u32x2*)((char*)cb + (size_t)chunk_at(d, s0 + k) * 8192 + voff) = ow;
                S = S * dc + raw * sc; }
        }
    }
}
DI void ret_pass2(const Ctx& C, int li, LAS unsigned char* lds, int wave, int lane) {
    LAS bf16_t* vt = (LAS bf16_t*)lds; LAS bf16_t* k0t = vt + 64 * RT_TS; LAS bf16_t* k1t = k0t + 64 * RT_TS;
    const int tid = wave * 64 + lane, cq = lane & 15, g = lane >> 4, q4 = cq >> 2, p4 = cq & 3, h = wave & 3, half = wave >> 2;
    const bf16_t* P = C.P(); const bf16_t* RP = C.RETP(); const bf16_t* ST = C.RETS(); bf16_t* O = C.O();
    for (int u = blockIdx.x; u < NB * NCHK; u += gridDim.x) {
        const int b = u / NCHK, c = u % NCHK; const size_t R0 = (size_t)b * LSEQ + 64 * c;
        if (li == DEPTH - 1 && c < 4) continue;
        __syncthreads();
        stage_tile64x256(vt, P + R0 * DIN + C_RTV, DIN, tid);
        stage_tile64x256(k0t, RP + 1 * RETP_T + R0 * 256, 256, tid);
        stage_tile64x256(k1t, RP + 3 * RETP_T + R0 * 256, 256, tid);
        bf16x8 sf[2][4][2];
#pragma unroll
        for (int d = 0; d < 2; ++d)
#pragma unroll
            for (int db = 0; db < 4; ++db) { const bf16_t* sp = ST + st_off(b, h, d, c) + (16 * db + cq) * 64 + 8 * g; sf[d][db][0] = ld16(sp); sf[d][db][1] = ld16(sp + 32); }
        __syncthreads();
#pragma unroll 1
        for (int ib = 2 * half; ib < 2 * half + 2; ++ib) {
            const size_t Ri = R0 + 16 * ib + cq;
            bf16x8 qb[2][2];
#pragma unroll
            for (int d = 0; d < 2; ++d)
#pragma unroll
                for (int ks = 0; ks < 2; ++ks) qb[d][ks] = ld16(RP + (size_t)(2 * d) * RETP_T + Ri * 256 + h * 64 + 32 * ks + 8 * g);
            u32x2 gq[4];
#pragma unroll
            for (int db = 0; db < 4; ++db) gq[db] = *(const u32x2*)(P + Ri * DIN + C_RTG + h * 64 + 16 * db + 4 * g);
            f32x4 pT[4];
#pragma unroll
            for (int jb = 0; jb < 4; ++jb) { const int kro = (16 * jb + cq) * RT_TS + h * 64 + 8 * g;
                f32x4 a0 = (f32x4){0.f, 0.f, 0.f, 0.f}, a1 = (f32x4){0.f, 0.f, 0.f, 0.f};
#pragma unroll
                for (int ks = 0; ks < 2; ++ks) { a0 = MFMA16(*(const LAS bf16x8*)(k0t + kro + 32 * ks), qb[0][ks], a0);
                                                 a1 = MFMA16(*(const LAS bf16x8*)(k1t + kro + 32 * ks), qb[1][ks], a1); }
#pragma unroll
                for (int e = 0; e < 4; ++e) { const int j = 16 * jb + 4 * g + e, i = 16 * ib + cq; pT[jb][e] = (j <= i ? a0[e] : 0.f) + (j >= i ? a1[e] : 0.f); } }
            const bf16x8 pb0 = pack8(pT[0], pT[1]), pb1 = pack8(pT[2], pT[3]);
            f32x4 o[4];
#pragma unroll
            for (int db = 0; db < 4; ++db) {
                const LAS bf16_t* base = vt + (4 * g + q4) * RT_TS + h * 64 + 16 * db + 4 * p4;
                const bf16x8 va0 = cat8(tr16(base), tr16(base + 16 * RT_TS)), va1 = cat8(tr16(base + 32 * RT_TS), tr16(base + 48 * RT_TS));
                o[db] = MFMA16(va0, pb0, ((f32x4){0.f, 0.f, 0.f, 0.f})); o[db] = MFMA16(va1, pb1, o[db]);
#pragma unroll
                for (int d = 0; d < 2; ++d) { o[db] = MFMA16(sf[d][db][0], qb[d][0], o[db]); o[db] = MFMA16(sf[d][db][1], qb[d][1], o[db]); }
            }
            float ss = 0.f;
#pragma unroll
            for (int db = 0; db < 4; ++db) ss += o[db][0] * o[db][0] + o[db][1] * o[db][1] + o[db][2] * o[db][2] + o[db][3] * o[db][3];
            ss += shx<16>(ss); ss += shx<32>(ss);
            const float rs = __builtin_amdgcn_rsqf(ss * (1.0f / 64.0f) + EPS);
#pragma unroll
            for (int db = 0; db < 4; ++db) { const u32x2 gw2 = gq[db];
                u32x2 w; w.x = pk2(o[db][0] * rs * silu_(lo_f(gw2.x)), o[db][1] * rs * silu_(hi_f(gw2.x))); w.y = pk2(o[db][2] * rs * silu_(lo_f(gw2.y)), o[db][3] * rs * silu_(hi_f(gw2.y)));
                *(u32x2*)(O + Ri * DM + 768 + h * 64 + 16 * db + 4 * g) = w; }
        }
    }
}


template <int CTRL> DI float dpp_mov0(float x) { return __int_as_float(__builtin_amdgcn_update_dpp(0, __float_as_int(x), CTRL, 0xf, 0xf, true)); }
DI float row_prefix(float x) { x += dpp_mov0<0x111>(x); x += dpp_mov0<0x112>(x); x += dpp_mov0<0x114>(x); x += dpp_mov0<0x118>(x); return x; }
DI float row_suffix(float x) { x += dpp_mov0<0x101>(x); x += dpp_mov0<0x102>(x); x += dpp_mov0<0x104>(x); x += dpp_mov0<0x108>(x); return x; }
DI void prep_hg(const Ctx& C, int li, int gw, int ngw, int lane) {
    const bf16_t* P = C.P(); bf16_t* HP = C.HGP(); float* DEC = C.HGDEC();
    const int t = lane & 15, cg = lane >> 4;
    for (int it = gw; it < NSUB * 8; it += ngw) {
        const int sc = it >> 3, ch0 = (it & 7) * 32 + 8 * cg; const size_t R = (size_t)sc * 16 + t;
        const u32x4 qw = *(const u32x4*)(P + R * DIN + C_HGQ + ch0), f0w = *(const u32x4*)(P + R * DIN + C_HGF + ch0), f1w = *(const u32x4*)(P + R * DIN + C_HGF + 256 + ch0);
        const f32x4 lb0 = *(const f32x4*)(C.lb() + li * 256 + ch0), lb1 = *(const f32x4*)(C.lb() + li * 256 + ch0 + 4);
        const float q[8] = {lo_f(qw.x), hi_f(qw.x), lo_f(qw.y), hi_f(qw.y), lo_f(qw.z), hi_f(qw.z), lo_f(qw.w), hi_f(qw.w)};
        const float f0[8] = {lo_f(f0w.x), hi_f(f0w.x), lo_f(f0w.y), hi_f(f0w.y), lo_f(f0w.z), hi_f(f0w.z), lo_f(f0w.w), hi_f(f0w.w)};
        const float f1[8] = {lo_f(f1w.x), hi_f(f1w.x), lo_f(f1w.y), hi_f(f1w.y), lo_f(f1w.z), hi_f(f1w.z), lo_f(f1w.w), hi_f(f1w.w)};
        float qd0[8], kd0[8], qd1[8], kd1[8], d0[8], d1[8];
#pragma unroll
        for (int e = 0; e < 8; ++e) { const float lb = e < 4 ? lb0[e] : lb1[e - 4];
            const float g0 = lb + (1.0f - lb) * sigm(f0[e]), g1 = lb + (1.0f - lb) * sigm(f1[e]), qs = silu_(q[e]);
            const float c0 = row_prefix(__logf(g0)), c1 = row_suffix(__logf(g1));
            qd0[e] = qs * __expf(c0); kd0[e] = (1.0f - g0) * __expf(fminf(-c0, 80.0f)); qd1[e] = qs * __expf(c1); kd1[e] = (1.0f - g1) * __expf(fminf(-c1, 80.0f));
            d0[e] = __expf(c0); d1[e] = __expf(c1); }
        const size_t o = R * 256 + ch0;
#define PK8V(a) ((u32x4){pk2(a[0], a[1]), pk2(a[2], a[3]), pk2(a[4], a[5]), pk2(a[6], a[7])})
        *(u32x4*)(HP + 0 * RETP_T + o) = PK8V(qd0); *(u32x4*)(HP + 1 * RETP_T + o) = PK8V(kd0); *(u32x4*)(HP + 2 * RETP_T + o) = PK8V(qd1); *(u32x4*)(HP + 3 * RETP_T + o) = PK8V(kd1);
#undef PK8V
        if (t == 15) { float* dp = DEC + (size_t)sc * 256 + ch0; *(f32x4*)dp = (f32x4){d0[0], d0[1], d0[2], d0[3]}; *(f32x4*)(dp + 4) = (f32x4){d0[4], d0[5], d0[6], d0[7]}; }
        if (t == 0) { float* dp = DEC + ((size_t)NSUB + sc) * 256 + ch0; *(f32x4*)dp = (f32x4){d1[0], d1[1], d1[2], d1[3]}; *(f32x4*)(dp + 4) = (f32x4){d1[4], d1[5], d1[6], d1[7]}; }
    }
}
DI void hg_state_step(f32x4 (&S)[4][4], const LAS bf16_t* kt, const LAS bf16_t* vt, int n, int h, int cq, int g, int q4, int p4, const float* dec  ) {
    const int r1 = 16 * n + ((8 * g + q4) & 15), r2 = 16 * n + ((8 * g + 4 + q4) & 15);
    bf16x8 a[4], bv[4];
#pragma unroll
    for (int mb = 0; mb < 4; ++mb) { const int co = h * 64 + 16 * mb + 4 * p4; a[mb] = cat8(tr16(kt + r1 * RT_TS + co), tr16(kt + r2 * RT_TS + co)); }
#pragma unroll
    for (int nb = 0; nb < 4; ++nb) { const int co = h * 64 + 16 * nb + 4 * p4; const bf16x8 v = cat8(tr16(vt + r1 * RT_TS + co), tr16(vt + r2 * RT_TS + co)); bv[nb] = (g < 2) ? v : (bf16x8){0, 0, 0, 0, 0, 0, 0, 0}; }
#pragma unroll
    for (int mb = 0; mb < 4; ++mb) { const f32x4 dv4 = *(const f32x4*)(dec + h * 64 + 16 * mb + 4 * g);
#pragma unroll
        for (int nb = 0; nb < 4; ++nb) { S[mb][nb] = MFMA16(a[mb], bv[nb], S[mb][nb]); S[mb][nb] = S[mb][nb] * dv4; } }
}
DI void hg_pass1(const Ctx& C, LAS unsigned char* lds, int wave, int lane) {
    LAS bf16_t* vt = (LAS bf16_t*)lds; LAS bf16_t* k0t = vt + 64 * RT_TS; LAS bf16_t* k1t = k0t + 64 * RT_TS;
    const int tid = wave * 64 + lane, cq = lane & 15, g = lane >> 4, q4 = cq >> 2, p4 = cq & 3, h = wave & 3, d = wave >> 2;
    const bf16_t* P = C.P(); const bf16_t* HP = C.HGP(); bf16_t* ST = C.HGS(); const float* DEC = C.HGDEC() + (size_t)d * NSUB * 256;
    for (int U = (int)blockIdx.x + ((NB * NCHK - (int)blockIdx.x + (int)gridDim.x - 1) / (int)gridDim.x) * (int)gridDim.x; U < 2 * NB * NCHK; U += gridDim.x) {
        const int u = U - NB * NCHK, b = u / NCHK, c = u % NCHK; const size_t R0 = (size_t)b * LSEQ + 64 * c;
        __syncthreads();
        stage_tile64x256(vt, P + R0 * DIN + C_HGI, DIN, tid);
        stage_tile64x256(k0t, HP + 1 * RETP_T + R0 * 256, 256, tid);
        stage_tile64x256(k1t, HP + 3 * RETP_T + R0 * 256, 256, tid);
        __syncthreads();
        const LAS bf16_t* kt = d ? k1t : k0t;
        f32x4 S[4][4];
#pragma unroll
        for (int mb = 0; mb < 4; ++mb)
#pragma unroll
            for (int nb = 0; nb < 4; ++nb) S[mb][nb] = (f32x4){0.f, 0.f, 0.f, 0.f};
#pragma unroll 1
        for (int sidx = 0; sidx < 4; ++sidx) { const int n = d ? 3 - sidx : sidx;
            hg_state_step(S, kt, vt, n, h, cq, g, q4, p4, DEC + (R0 / 16 + n) * 256); }
        if (lane < 16) { const float* dp = DEC + (R0 / 16) * 256 + h * 64 + 4 * lane;
            *(f32x4*)(C.HGDT() + ((size_t)(((b * 4 + h) * 2 + d) * NCHK + c)) * 64 + 4 * lane) = *(const f32x4*)dp * *(const f32x4*)(dp + 256) * *(const f32x4*)(dp + 512) * *(const f32x4*)(dp + 768); }
        bf16_t* sp = ST + st_off(b, h, d, c);
#pragma unroll
        for (int mb = 0; mb < 4; ++mb)
#pragma unroll
            for (int nb = 0; nb < 4; ++nb) { u32x2 w; w.x = pk2(S[mb][nb][0], S[mb][nb][1]); w.y = pk2(S[mb][nb][2], S[mb][nb][3]); *(u32x2*)(sp + (16 * nb + cq) * 64 + 16 * mb + 4 * g) = w; }
    }
}
DI void hg_carry(const Ctx& C, int gw, int ngw, int lane) {
    bf16_t* ST = C.HGS();
    for (int it = gw; it < 64 * 16; it += ngw) {
        const int chain = it >> 4, e0 = ((it & 15) * 64 + lane) * 4, d = chain & 1, dk0 = e0 & 63;
        const char* DTb = (const char*)(C.HGDT() + (size_t)chain * NCHK * 64); const unsigned doff = (unsigned)dk0 * 4u;
        const char* cb = (const char*)ST + (size_t)chain * NCHK * 8192; const unsigned voff = (unsigned)e0 * 2u;
        f32x4 S = (f32x4){0.f, 0.f, 0.f, 0.f};
#pragma unroll 1
        for (int s0 = 0; s0 < NCHK; s0 += NCHK / 4) {
            u32x2 w[NCHK / 4]; f32x4 dt[NCHK / 4];
#pragma unroll
            for (int k = 0; k < NCHK / 4; ++k) { const int c = chunk_at(d, s0 + k); w[k] = *(const u32x2*)(cb + (size_t)c * 8192 + voff); dt[k] = *(const f32x4*)(DTb + (size_t)c * 256 + doff); }
#pragma unroll
            for (int k = 0; k < NCHK / 4; ++k) { const f32x4 raw = (f32x4){lo_f(w[k].x), hi_f(w[k].x), lo_f(w[k].y), hi_f(w[k].y)};
                u32x2 ow; ow.x = pk2(S[0], S[1]); ow.y = pk2(S[2], S[3]);
                *(u32x2*)((char*)cb + (size_t)chunk_at(d, s0 + k) * 8192 + voff) = ow;
                S = S * dt[k] + raw; }
        }
    }
}
DI void hg_pass2(const Ctx& C, int li, LAS unsigned char* lds, int wave, int lane) {
    LAS bf16_t* vt = (LAS bf16_t*)lds; LAS bf16_t* k0t = vt + 64 * RT_TS; LAS bf16_t* k1t = k0t + 64 * RT_TS;
    const int tid = wave * 64 + lane, cq = lane & 15, g = lane >> 4, q4 = cq >> 2, p4 = cq & 3, h = wave & 3, d = wave >> 2;
    const bf16_t* P = C.P(); const bf16_t* HP = C.HGP(); const bf16_t* ST = C.HGS(); const float* DEC = C.HGDEC() + (size_t)d * NSUB * 256;
    const bf16_t* QD = HP + (size_t)(2 * d) * RETP_T; const bf16_t* KD = HP + (size_t)(2 * d + 1) * RETP_T;
    bf16_t* OUT = C.OHGB() + (size_t)d * NTOK * 256;
    for (int U = (int)blockIdx.x + ((NB * NCHK - (int)blockIdx.x + (int)gridDim.x - 1) / (int)gridDim.x) * (int)gridDim.x; U < 2 * NB * NCHK; U += gridDim.x) {
        const int u = U - NB * NCHK, b = u / NCHK, c = u % NCHK; const size_t R0 = (size_t)b * LSEQ + 64 * c;
        if (li == DEPTH - 1 && c < 4) continue;
        __syncthreads();
        stage_tile64x256(vt, P + R0 * DIN + C_HGI, DIN, tid);
        stage_tile64x256(k0t, HP + 1 * RETP_T + R0 * 256, 256, tid);
        stage_tile64x256(k1t, HP + 3 * RETP_T + R0 * 256, 256, tid);
        __syncthreads();
        const LAS bf16_t* kt = d ? k1t : k0t;
        f32x4 S[4][4];
        { const bf16_t* sp = ST + st_off(b, h, d, c);
#pragma unroll
          for (int mb = 0; mb < 4; ++mb)
#pragma unroll
            for (int nb = 0; nb < 4; ++nb) { const u32x2 w = *(const u32x2*)(sp + (16 * nb + cq) * 64 + 16 * mb + 4 * g); S[mb][nb] = (f32x4){lo_f(w.x), hi_f(w.x), lo_f(w.y), hi_f(w.y)}; } }
#pragma unroll 1
        for (int sidx = 0; sidx < 4; ++sidx) { const int n = d ? 3 - sidx : sidx;
            const size_t Rt = R0 + 16 * n + cq;
            f32x4 at = (f32x4){0.f, 0.f, 0.f, 0.f};
#pragma unroll
            for (int ks = 0; ks < 2; ++ks) at = MFMA16(*(const LAS bf16x8*)(kt + (16 * n + cq) * RT_TS + h * 64 + 32 * ks + 8 * g), ld16(QD + Rt * 256 + h * 64 + 32 * ks + 8 * g), at);
#pragma unroll
            for (int e = 0; e < 4; ++e) { const int j = 4 * g + e; at[e] = (d == 0 ? (j <= cq) : (j >= cq)) ? at[e] : 0.f; }
            const bf16x8 pb = pack8(at, ((f32x4){0.f, 0.f, 0.f, 0.f}));
            bf16x8 qc[2];
#pragma unroll
            for (int s2 = 0; s2 < 2; ++s2) { const bf16_t* qp = QD + Rt * 256 + h * 64 + 32 * s2 + 4 * g; qc[s2] = cat8(*(const s16x4*)qp, *(const s16x4*)(qp + 16)); }
            f32x4 o[4];
#pragma unroll
            for (int db = 0; db < 4; ++db) {
                const s16x4 vv = tr16(vt + (16 * n + 4 * g + q4) * RT_TS + h * 64 + 16 * db + 4 * p4);
                o[db] = MFMA16(cat8(vv, vv), pb, ((f32x4){0.f, 0.f, 0.f, 0.f}));
                o[db] = MFMA16(pack8(S[0][db], S[1][db]), qc[0], o[db]); o[db] = MFMA16(pack8(S[2][db], S[3][db]), qc[1], o[db]);
                { u32x2 w; w.x = pk2(o[db][0], o[db][1]); w.y = pk2(o[db][2], o[db][3]); *(u32x2*)(OUT + Rt * 256 + h * 64 + 16 * db + 4 * g) = w; } }
            if (sidx < 3) hg_state_step(S, kt, vt, n, h, cq, g, q4, p4, DEC + (R0 / 16 + n) * 256);
        }
    }
}

DI void phase_mix(const Ctx& C, int li, LAS unsigned char* lds, int gw, int ngw, int wave, int lane) {
    LAS bf16_t* vl = (LAS bf16_t*)(lds + 8192 + wave * (64 * NA_VS * 2));
    LAS float* rpbt = (LAS float*)(lds + 8192 + 8 * (64 * NA_VS * 2));
    for (int i = wave * 64 + lane; i < 4 * 465; i += 512) rpbt[i] = C.in(I_RPB)[(size_t)li * 4 * 465 + i];
    __syncthreads();
    const int G = (int)gridDim.x;
    if ((G & 7) == 0 && G >= 8) {
        const int xb = (int)blockIdx.x & 7, nxw = (G >> 3) * 8, xw = ((int)blockIdx.x >> 3) * 8 + wave;
        for (int b = xb; b < NB; b += 8)
            for (int h = 0; h < 4; ++h) {
                for (int rc = xw; rc < 256; rc += nxw) na_unit(C, li, ((b * 64 + (rc >> 2)) * 4 + h) * 4 + (rc & 3), false, lane, vl, rpbt);
                if (li == 0) for (int cg = xw; cg < 16; cg += nxw) na_unit(C, li, (b * 4 + h) * 16 + cg, true, lane, vl, rpbt);
            }
    } else {
        const int nNA = NB * 64 * 4 * 4, nNAc = (li == 0) ? NB * 4 * 16 : 0;
        for (int it = gw; it < nNA + nNAc; it += ngw) { if (it < nNA) na_unit(C, li, it, false, lane, vl, rpbt); else na_unit(C, li, it - nNA, true, lane, vl, rpbt); }
    }
}
DI void phase_fin(const Ctx& C, int li, int gw, int ngw, int lane) {
    const int c0 = 4 * lane;
    const f32x4 hw = *(const f32x4*)(C.in(I_HGNW) + li * 64 + (c0 & 63));
    const bf16_t* OH = C.OHGB();
    for (int R0 = gw; R0 < NTOK; R0 += 4 * ngw) {
        u32x2 w0q[4], w1q[4], gq[4];
#pragma unroll
        for (int q = 0; q < 4; ++q) { const int Ri = R0 + q * ngw; if (Ri < NTOK) { const size_t R = (size_t)Ri;
            w0q[q] = *(const u32x2*)(OH + R * 256 + c0); w1q[q] = *(const u32x2*)(OH + ((size_t)NTOK + R) * 256 + c0); gq[q] = *(const u32x2*)(C.P() + R * DIN + C_HGG + c0); } }
#pragma unroll
        for (int q = 0; q < 4; ++q) { const int Ri = R0 + q * ngw; if (Ri >= NTOK) continue; const size_t R = (size_t)Ri;
            if (li == DEPTH - 1 && (Ri % LSEQ) < CTXL) continue;
            const u32x2 w0 = w0q[q], w1 = w1q[q], gw2 = gq[q];
            const f32x4 a = (f32x4){lo_f(w0.x) + lo_f(w1.x), hi_f(w0.x) + hi_f(w1.x), lo_f(w0.y) + lo_f(w1.y), hi_f(w0.y) + hi_f(w1.y)};
            float ss = a[0] * a[0] + a[1] * a[1] + a[2] * a[2] + a[3] * a[3];
            ss += shx<1>(ss); ss += shx<2>(ss); ss += shx<4>(ss); ss += shx<8>(ss);
            const float rs = __builtin_amdgcn_rsqf(ss * (1.0f / 64.0f) + EPS);
            u32x2 oo; oo.x = pk2(a[0] * rs * hw[0] * silu_(lo_f(gw2.x)), a[1] * rs * hw[1] * silu_(hi_f(gw2.x))); oo.y = pk2(a[2] * rs * hw[2] * silu_(lo_f(gw2.y)), a[3] * rs * hw[3] * silu_(hi_f(gw2.y)));
            *(u32x2*)(C.O() + R * DM + 512 + c0) = oo; }
    }
}

struct Args { const float* in[N_IN]; float* out; unsigned char* ws; int ph_lo, ph_hi, bar_region, pad; };
constexpr int NPL = 13, PH_TOTAL = 2 + DEPTH * NPL;

__global__ void __launch_bounds__(512, 2) fwd(Args args) {
    extern __shared__ __attribute__((aligned(16))) unsigned char lds_raw[];
    LAS unsigned char* lds = (LAS unsigned char*)lds_raw;
    const int G = gridDim.x, ngw = G * 8;
    const int wave_id = __builtin_amdgcn_readfirstlane((int)threadIdx.x >> 6);
#define PHASE_IDS int wv_ = wave_id; asm volatile("" : "+s"(wv_)); int ln_ = lane_id(); asm volatile("" : "+v"(ln_)); const int lane = ln_, wave = wv_, gw = blockIdx.x * 8 + wave; (void)lane; (void)gw;
    { int t0 = wave_id * 64 + lane_id(); asm volatile("" : "+v"(t0)); for (int u = t0; u < (LDS_BYTES - LDSCTL_OFF) / 4; u += 512) ((LAS unsigned*)(lds + LDSCTL_OFF))[u] = 0u; }
    __syncthreads();
    int lo, hi; XcdBarrier bar;
    { const Ctx C0{kargs()}; lo = *(const __attribute__((address_space(4))) int*)(C0.ka + 8 * N_IN + 16); hi = *(const __attribute__((address_space(4))) int*)(C0.ka + 8 * N_IN + 20);
      bar.bar = (unsigned*)(C0.ws() + WS_CTL) + 4096 + *(const __attribute__((address_space(4))) int*)(C0.ka + 8 * N_IN + 24) * XCD_BAR_WORDS; bar.x = 0; bar.st = nullptr; bar.wave = wave_id;
      if (hi - lo > 1) bar = xcd_barrier_post(bar.bar, (volatile LAS unsigned*)(lds + MISC_OFF + 32), wave_id); }
#define IN(k) (lo <= (k) && (k) < hi)
#ifndef PH_MASK
#define PH_MASK 0xFFFF
#endif
#define PH_EN(k) (((PH_MASK) >> (k)) & 1)
#define SEAM(k) do { if ((k) + 1 < hi) xcd_barrier(bar); } while (0)
#ifndef PROBE_DUP
#define PROBE_DUP 0
#endif
#define REPS(k) for (int rep_ = 0; rep_ < ((((PROBE_DUP) >> (k)) & 1) ? 2 : 1); ++rep_)
#define REP_BAR(k) do { if ((((PROBE_DUP) >> (k)) & 1) && rep_ == 0) xcd_barrier(bar); } while (0)

#ifndef NO_PRO
    if (IN(0)) { const Ctx C{kargs()}; PHASE_IDS phase_prologue(C, lds, gw, ngw, wave, lane);
#ifdef PROBE_PRO
        xcd_barrier(bar); phase_prologue(C, lds, gw, ngw, wave, lane);
#endif
        SEAM(0); }
#endif

    for (int li = 0; li < DEPTH; ++li) {
        const int pb = 1 + li * NPL;
        if (PH_EN(0) && IN(pb + 0)) { REPS(0) {
            const Ctx C{kargs()}; PHASE_IDS
#ifdef PROBE_A1
            if (li == 1) { phase_norm1(C, li, gw, ngw, lane, (float*)C.P()); xcd_barrier(bar); }
#endif
            phase_norm1(C, li, gw, ngw, lane, C.X());
#ifdef PROBE_A0
            if (li == 0) { xcd_barrier(bar); phase_norm1(C, li, gw, ngw, lane, C.X()); }
#endif
            REP_BAR(0); } SEAM(pb + 0);
        }
        if (PH_EN(1) && IN(pb + 1)) { REPS(1) {
            const Ctx C{kargs()}; PHASE_IDS
            { SchedWin S{(unsigned)WS_H, (unsigned)(WS_WIN + (size_t)li * DIN * DM * 2), G, (int)blockIdx.x, C_GATE / 256, (unsigned)(DM * 2)};
              EpiP E{C.P(), DIN};
              pg8::gemm_phase<EpiP, SchedWin>(lds, wave, lane, (const char*)C.ws(), DM, DM, DM, S, E); }
            { const Ctx C2{kargs()}; int wv2 = wave_id; asm volatile("" : "+s"(wv2)); int ln2 = lane_id(); asm volatile("" : "+v"(ln2));
              SchedWin S{(unsigned)WS_H8, (unsigned)(WS_WIN + (size_t)li * DIN * DM * 2 + WS_WIN8_OFF), G, (int)blockIdx.x, 16, (unsigned)DM};
              EpiSig8 E{(unsigned char*)C2.P()};
              pg8::gemm_phase<EpiSig8, SchedWin, true>(lds, wv2, ln2, (const char*)C2.ws(), DM / 2, DM / 2, DM / 2, S, E); }
            REP_BAR(1); } SEAM(pb + 1);
        }
        if (PH_EN(2) && IN(pb + 2)) { REPS(2) { const Ctx C{kargs()}; PHASE_IDS phase_prep(C, li, gw, ngw, lane); prep_ret(C, li, gw, ngw, lane); prep_hg(C, li, gw, ngw, lane); prep_s5(C, gw, ngw, lane);
#if defined(PROBE_PREP) && PROBE_PREP == 1
            phase_prep(C, li, gw, ngw, lane);
#elif defined(PROBE_PREP) && PROBE_PREP == 2
            prep_ret(C, li, gw, ngw, lane);
#elif defined(PROBE_PREP) && PROBE_PREP == 3
            prep_hg(C, li, gw, ngw, lane);
#elif defined(PROBE_PREP) && PROBE_PREP == 4
            prep_s5(C, gw, ngw, lane);
#endif
            REP_BAR(2); } SEAM(pb + 2); }
        if (PH_EN(3) && IN(pb + 3)) { REPS(3) {
            const Ctx C{kargs()}; PHASE_IDS
            ret_pass1(C, lds, wave, lane); __syncthreads();
            hg_pass1(C, lds, wave, lane); __syncthreads();
#ifdef PROBE_P1
            xcd_barrier(bar); ret_pass1(C, lds, wave, lane); __syncthreads(); hg_pass1(C, lds, wave, lane); __syncthreads(); xcd_barrier(bar);
#endif
            phase_mix(C, li, lds, gw, ngw, wave, lane); __syncthreads();
#ifdef PROBE_NA
            xcd_barrier(bar); phase_mix(C, li, lds, gw, ngw, wave, lane); __syncthreads(); xcd_barrier(bar);
#endif
            { const Ctx C{kargs()}; PHASE_IDS SchedS5 S{(unsigned)WS_UG, (unsigned)(WS_S5W1 + (size_t)li * 16 * 65536 * 2), G, (int)blockIdx.x, 65536u * 2u}; EpiS5S E{C.S5S()};
              pg8::gemm_phase<EpiS5S, SchedS5>(lds, wave, lane, (const char*)C.ws(), 256, 512, 256, S, E); }
            REP_BAR(3); } SEAM(pb + 3); }
        if (PH_EN(4) && IN(pb + 4)) { REPS(4) { const Ctx C{kargs()}; PHASE_IDS ret_carry(C, li, gw, ngw, lane); hg_carry(C, gw, ngw, lane); s5_carry(C, li, gw, ngw, lane); convert_experts(C, li, 1280 % ngw, gw, ngw, (LAS float*)(lds + 40960 + wave * 8704), lane);     REP_BAR(4); } SEAM(pb + 4); }
        if (PH_EN(5) && IN(pb + 5)) { REPS(5) { const Ctx C{kargs()}; PHASE_IDS ret_pass2(C, li, lds, wave, lane); __syncthreads(); hg_pass2(C, li, lds, wave, lane); __syncthreads();
            { const Ctx C{kargs()}; PHASE_IDS SchedS5 S{(unsigned)WS_UG, (unsigned)(WS_S5W2 + (size_t)li * 16 * 131072 * 2), G, (int)blockIdx.x, 131072u * 2u}; EpiS5Z E{C.Z()};
              pg8::gemm_phase<EpiS5Z, SchedS5>(lds, wave, lane, (const char*)C.ws(), 512, 512, 512, S, E); }
            REP_BAR(5); } SEAM(pb + 5); }
        if (PH_EN(6) && IN(pb + 6)) { REPS(6) { const Ctx C{kargs()}; PHASE_IDS phase_fin(C, li, gw, ngw, lane);
            { const Ctx C{kargs()}; PHASE_IDS SchedGlu S{(unsigned)WS_Z, (unsigned)(WS_GLUT + (size_t)li * 65536 * 2), G, (int)blockIdx.x, li}; EpiGlu E{C.O(), C.Z()};
              pg8::gemm_phase<EpiGlu, SchedGlu>(lds, wave, lane, (const char*)C.ws(), 256, 256, 256, S, E); }
            REP_BAR(6); } SEAM(pb + 6); }
        if (PH_EN(7) && IN(pb + 7)) { REPS(7) {
            const Ctx C{kargs()}; PHASE_IDS
            SchedMerge S{(unsigned)WS_O, (unsigned)(WS_WBR + (size_t)li * DM * DM * 2), G, (int)blockIdx.x, li};
            EpiMerge E{C.MB(), (const unsigned char*)C.P()};
            pg8::gemm_phase<EpiMerge, SchedMerge, false, 1>(lds, wave, lane, (const char*)C.ws(), DM, DM, DM, S, E);
            REP_BAR(7); } SEAM(pb + 7);
        }
        if (PH_EN(8) && IN(pb + 8)) { REPS(8) {
            const Ctx C{kargs()}; PHASE_IDS
            SchedOut S{(unsigned)WS_MB, (unsigned)(WS_WOUT + (size_t)li * DM * DM * 2), G, (int)blockIdx.x, li};
#ifdef PROBE_D2
            { EpiResid E0{C.X(), C.mod() + li * 9 * 6144, (float*)C.P(), li == 0 ? C.in(I_X) : nullptr, li == 0 ? C.in(I_CTX) : nullptr}; pg8::gemm_phase<EpiResid, SchedOut>(lds, wave, lane, (const char*)C.ws(), DM, DM, DM, S, E0); xcd_barrier(bar); }
#endif
            EpiResid E{C.X(), C.mod() + li * 9 * 6144, C.X(), li == 0 ? C.in(I_X) : nullptr, li == 0 ? C.in(I_CTX) : nullptr};
            pg8::gemm_phase<EpiResid, SchedOut>(lds, wave, lane, (const char*)C.ws(), DM, DM, DM, S, E);
            REP_BAR(8); } SEAM(pb + 8);
        }
        if (PH_EN(9) && IN(pb + 9)) { REPS(9) { const Ctx C{kargs()}; PHASE_IDS phase_norm2(C, li, lds, gw, ngw, wave, lane); REP_BAR(9); } SEAM(pb + 9); }
        if (PH_EN(10) && IN(pb + 10)) { REPS(10) { const Ctx C{kargs()}; PHASE_IDS phase_topk(C, li, lds, wave, lane); REP_BAR(10); } SEAM(pb + 10); }
        if (PH_EN(11) && IN(pb + 11)) { REPS(11) {
            const Ctx C{kargs()}; PHASE_IDS
            SchedE1 S{(unsigned)WS_XE, (unsigned)WS_EXW, G, (int)blockIdx.x, li == 0 ? 17 : 16};
            EpiSwiGLU E{(unsigned char*)C.P()};
            pg8::gemm_phase<EpiSwiGLU, SchedE1, true>(lds, wave, lane, (const char*)C.ws(), DM / 2, DM / 2, DM / 2, S, E);
            REP_BAR(11); } SEAM(pb + 11);
        }
        if (PH_EN(12) && IN(pb + 12)) { REPS(12) {
            const Ctx C{kargs()}; PHASE_IDS
            SchedE2 S{(unsigned)WS_P, (unsigned)WS_W2T, G, (int)blockIdx.x, li == 0 ? 17 : 16};
            EpiExpOut E{C.XE(), C.gate()};
            pg8::gemm_phase<EpiExpOut, SchedE2, true>(lds, wave, lane, (const char*)C.ws(), DF / 2, DF / 2, DF / 2, S, E);
            REP_BAR(12); } SEAM(pb + 12);
        }
    }
    if (IN(PH_TOTAL - 1)) { const Ctx C{kargs()}; PHASE_IDS phase_final(C, gw, ngw, lane);
#ifdef PROBE_FINAL
        xcd_barrier(bar); phase_final(C, gw, ngw, lane);
#endif
    }
#undef IN
#undef SEAM
}

extern "C" void kernel_launch(void* const* d_in, const int* in_sizes, int n_in, void* d_out, int out_size, void* d_ws, size_t ws_size, hipStream_t stream) {
    static int grid = 0;
    if (grid == 0) {
        if (n_in != N_IN || ws_size < WS_END) { fprintf(stderr, "kernel_launch: unexpected n_in %d or ws_size %zu (need %zu)\n", n_in, ws_size, (size_t)WS_END); grid = -1; return; }
        int dev = 0, cus = 0, per_cu = 0;
        if (hipGetDevice(&dev) != hipSuccess || hipDeviceGetAttribute(&cus, hipDeviceAttributeMultiprocessorCount, dev) != hipSuccess) { grid = -1; return; }
        if (hipFuncSetAttribute((const void*)fwd, hipFuncAttributeMaxDynamicSharedMemorySize, LDS_BYTES) != hipSuccess) { fprintf(stderr, "kernel_launch: hipFuncSetAttribute failed\n"); grid = -1; return; }
        if (hipOccupancyMaxActiveBlocksPerMultiprocessor(&per_cu, (const void*)fwd, 512, LDS_BYTES) != hipSuccess || per_cu < 1) fprintf(stderr, "kernel_launch: occupancy query says %d\n", per_cu);
        (void)hipGetLastError();
        grid = cus;
    }
    if (grid < 0) return;
    (void)hipMemsetAsync((char*)d_ws + WS_CTL, 0, CTL_ZERO_BYTES, stream);
    Args a{};
    for (int i = 0; i < N_IN; ++i) a.in[i] = (const float*)d_in[i];
    a.out = (float*)d_out; a.ws = (unsigned char*)d_ws;
#if MK_PER_PHASE
    for (int p = 0; p < PH_TOTAL; ++p) { a.ph_lo = p; a.ph_hi = p + 1; a.bar_region = 0; hipLaunchKernelGGL(fwd, dim3(grid), dim3(512), LDS_BYTES, stream, a); }
#elif defined(PROBE_PH)
    a.ph_lo = 0; a.ph_hi = PROBE_PH + 1; a.bar_region = 0; hipLaunchKernelGGL(fwd, dim3(grid), dim3(512), LDS_BYTES, stream, a);
    a.ph_lo = PROBE_PH; a.ph_hi = PROBE_PH + 1; a.bar_region = 1; hipLaunchKernelGGL(fwd, dim3(grid), dim3(512), LDS_BYTES, stream, a);
    a.ph_lo = PROBE_PH + 1; a.ph_hi = PH_TOTAL; a.bar_region = 2; hipLaunchKernelGGL(fwd, dim3(grid), dim3(512), LDS_BYTES, stream, a);
#elif defined(PROBE_CUT)
    a.ph_lo = 0; a.ph_hi = PROBE_CUT + 1; a.bar_region = 0; hipLaunchKernelGGL(fwd, dim3(grid), dim3(512), LDS_BYTES, stream, a);
    a.ph_lo = PROBE_CUT + 1; a.ph_hi = PH_TOTAL; a.bar_region = 2; hipLaunchKernelGGL(fwd, dim3(grid), dim3(512), LDS_BYTES, stream, a);
#else
    a.ph_lo = 0; a.ph_hi = PH_TOTAL; a.bar_region = 0;
    hipLaunchKernelGGL(fwd, dim3(grid), dim3(512), LDS_BYTES, stream, a);
#endif
}
```

```cpp
#include <hip/hip_runtime.h>
#include <cstdio>
#include <cstdint>

#ifndef MK_PER_PHASE
#define MK_PER_PHASE 0
#endif

#define LAS __attribute__((address_space(3)))
#define DI __device__ __forceinline__
typedef unsigned short bf16_t;
typedef short bf16x8 __attribute__((ext_vector_type(8)));
typedef float f32x4 __attribute__((ext_vector_type(4)));
typedef float f32x2 __attribute__((ext_vector_type(2)));
typedef unsigned u32x4 __attribute__((ext_vector_type(4)));
typedef unsigned u32x2 __attribute__((ext_vector_type(2)));

constexpr int DM = 1024, NB = 8, SEQ = 4096, CTXL = 256, LSEQ = SEQ + CTXL, NTOK = NB * LSEQ, DIN = 7424, NE = 16, DF = 2816, DEPTH = 2;
constexpr int CAP_L = 512, CAP_C = 32, EROWS = NB * CAP_L + NB * CAP_C;
constexpr float EPS = 1e-6f;
constexpr int C_S5U = 0, C_NAQ = 256, C_NAK = 512, C_NAV = 768, C_HGQ = 1024, C_HGF = 1280, C_HGI = 1792, C_HGG = 2048, C_RTQ = 2304, C_RTK = 2560, C_RTV = 2816, C_RTG = 3072, C_GATE = 3328;
enum { I_X = 0, I_C, I_CTX, I_CCTX, I_ADAW, I_ADAB, I_NMIX, I_NFFN, I_WIN, I_LRE, I_LIM, I_LSTEP, I_BRE, I_BIM, I_CRE, I_CIM, I_S5D, I_GLU, I_NAQN, I_NAKN, I_RPB, I_HGLB, I_HGNW, I_RETD, I_WBR, I_WOUT, I_RW, I_EWG, I_EWU, I_EWD, N_IN };

constexpr size_t MiB = 1u << 20;
constexpr size_t WS_CTL = 0, CTL_ZERO_BYTES = 1 * MiB;
constexpr size_t WS_MOD = 1 * MiB;
constexpr size_t WS_LB = 1 * MiB + 512 * 1024;
constexpr size_t WS_AFF = 2 * MiB;
constexpr size_t WS_SEL = 5 * MiB;
constexpr size_t WS_WMF = 7602176;
constexpr size_t WS_RB = WS_WMF + 9 * 32 * 2 * 1024;
constexpr size_t WS_GATE = 8 * MiB;
constexpr size_t WS_WBR = 10 * MiB;
constexpr size_t WS_WOUT = 14 * MiB;
constexpr size_t WS_WIN = 18 * MiB;
constexpr size_t WS_X = 48 * MiB;
constexpr size_t WS_H = 184 * MiB;
constexpr size_t WS_O = 252 * MiB;
constexpr size_t WS_MB = 320 * MiB;
constexpr size_t WS_P = 388 * MiB;
constexpr size_t WS_XE = 881 * MiB;
constexpr size_t WS_EXW = 1017 * MiB;
constexpr size_t WS_W2T = WS_EXW + (size_t)NE * 5632 * 1024;
constexpr size_t EXW_LAYER = 132 * MiB;
constexpr size_t WS_QKN = 1281 * MiB;
constexpr size_t WS_RETS = 1315 * MiB;
constexpr size_t WS_HGS = 1349 * MiB;
constexpr size_t WS_HGDEC = 1383 * MiB;
constexpr size_t WS_S5W1 = 1388 * MiB;
constexpr size_t WS_S5W2 = 1392 * MiB;
constexpr size_t WS_GLUT = 1400 * MiB;
constexpr size_t WS_HGDT = 1401 * MiB;
constexpr size_t WS_END = 1403 * MiB;
constexpr int S5CH = NTOK / 16, S5ROWS = 2304;
constexpr size_t WS_UG = WS_XE;
constexpr size_t WS_S5S = WS_XE + 36 * MiB;
constexpr size_t WS_OHG = WS_XE + 72 * MiB;
constexpr size_t WS_Z = WS_QKN;
constexpr size_t WS_HGP = WS_MB;
constexpr int NSUB = NTOK / 16;
constexpr size_t WS_H8 = WS_O;
constexpr size_t WS_WIN8_OFF = (size_t)C_GATE * DM * 2;
constexpr size_t WS_RETP = WS_X + 68 * MiB;
constexpr size_t RETP_T = (size_t)NTOK * 256;
constexpr int NCHK = LSEQ / 64;
static_assert(WS_W2T + (size_t)NE * 1024 * DF * 2 <= WS_QKN, "ws map");
static_assert((size_t)NE * 5632 * 1024 + (size_t)NE * 1024 * DF <= EXW_LAYER && WS_EXW + (size_t)DEPTH * EXW_LAYER <= WS_QKN, "ws map");
static_assert(WS_P + (size_t)NTOK * DIN * 2 <= WS_XE && WS_XE + (size_t)NE * EROWS * 1024 * 2 <= WS_EXW, "ws map");

constexpr int RING_BYTES = 131072, LDSCTL_OFF = RING_BYTES, MISC_OFF = LDSCTL_OFF + 320, LDS_BYTES = 147456;

DI float bf2f(unsigned short h) { return __uint_as_float(((unsigned)h) << 16); }
DI float lo_f(unsigned w) { return __uint_as_float(w << 16); }
DI float hi_f(unsigned w) { return __uint_as_float(w & 0xffff0000u); }
DI unsigned f2bf(float f) { unsigned u = __float_as_uint(f); return (u + 0x7fffu + ((u >> 16) & 1u)) >> 16; }
typedef __bf16 bf16v2_t __attribute__((ext_vector_type(2)));
DI unsigned pk2(float lo, float hi) { const bf16v2_t r = __builtin_convertvector((f32x2){lo, hi}, bf16v2_t); return __builtin_bit_cast(unsigned, r); }
DI unsigned pk4_fp8(float a, float b, float c, float d) {
    a = __builtin_amdgcn_fmed3f(a, -448.f, 448.f); b = __builtin_amdgcn_fmed3f(b, -448.f, 448.f); c = __builtin_amdgcn_fmed3f(c, -448.f, 448.f); d = __builtin_amdgcn_fmed3f(d, -448.f, 448.f);
    int p = 0; p = __builtin_amdgcn_cvt_pk_fp8_f32(a, b, p, false); p = __builtin_amdgcn_cvt_pk_fp8_f32(c, d, p, true); return (unsigned)p; }
DI int lane_id() { int l; asm volatile("v_mbcnt_lo_u32_b32 %0, -1, 0\n\tv_mbcnt_hi_u32_b32 %0, -1, %0" : "=v"(l)); return l; }
template <int M> DI float shx(float v) {
    if constexpr (M < 32) return __int_as_float(__builtin_amdgcn_ds_swizzle(__float_as_int(v), 0x1f | (M << 10)));
    else return __int_as_float(__builtin_amdgcn_ds_bpermute((lane_id() ^ 32) << 2, __float_as_int(v)));
}
DI float wave_sum(float v) { v += shx<1>(v); v += shx<2>(v); v += shx<4>(v); v += shx<8>(v); v += shx<16>(v); v += shx<32>(v); return v; }
DI float sigm(float x) { return __builtin_amdgcn_rcpf(1.0f + __expf(-x)); }
DI float silu_(float x) { return x * sigm(x); }
DI f32x4 exp2n4(f32x4 t) { return (f32x4){__builtin_amdgcn_exp2f(t[0]), __builtin_amdgcn_exp2f(t[1]), __builtin_amdgcn_exp2f(t[2]), __builtin_amdgcn_exp2f(t[3])}; }
DI f32x4 rcp4(f32x4 d) { return (f32x4){__builtin_amdgcn_rcpf(d[0]), __builtin_amdgcn_rcpf(d[1]), __builtin_amdgcn_rcpf(d[2]), __builtin_amdgcn_rcpf(d[3])}; }
DI f32x4 sigm4(f32x4 x) { return rcp4(exp2n4(x * -1.4426950408889634f) + 1.0f); }
DI unsigned pack_u8x4(f32x4 s) { const f32x4 t = s * 255.0f + 8388608.0f;
    const unsigned ab = __builtin_amdgcn_perm(__float_as_uint(t[1]), __float_as_uint(t[0]), 0x0c0c0400u), cd = __builtin_amdgcn_perm(__float_as_uint(t[3]), __float_as_uint(t[2]), 0x04000c0cu); return ab | cd; }
DI float gelu_tanh(float x) { const float u = 1.5957691216057308f * (x + 0.044715f * x * x * x); return x * __builtin_amdgcn_rcpf(1.0f + __expf(-u)); }
#define LDS_WAIT() asm volatile("s_waitcnt lgkmcnt(0)" ::: "memory")
#define VM_WAIT() asm volatile("s_waitcnt vmcnt(0)" ::: "memory")

#define XB_TMO      128
#define XB_XCNT(j)  (256  + 64 * (j))
#define XB_XSUB(j)  (1280 + 64 * (j))
#define XB_XGEN(j)  (2304 + 64 * (j))
#define XB_TOP      3328
#define XB_TOPGEN   3392
#define XCD_BAR_WORDS 3456
#define XB_SPIN_CAP (1u << 22)

__device__ __forceinline__ unsigned xb_ld(unsigned* p)              { return __hip_atomic_load(p, __ATOMIC_RELAXED, __HIP_MEMORY_SCOPE_AGENT); }
__device__ __forceinline__ unsigned xb_add(unsigned* p, unsigned v) { return __hip_atomic_fetch_add(p, v, __ATOMIC_RELAXED, __HIP_MEMORY_SCOPE_AGENT); }
__device__ __forceinline__ unsigned xb_xcc_id() { return (unsigned)__builtin_amdgcn_s_getreg((3 << 11) | 20) & 0xFu; }
#define XB_SPIN(cond, bar) do { unsigned _sp = 0; while (cond) { __builtin_amdgcn_s_sleep(1); \
    if ((++_sp & 255u) == 0u) { if (xb_ld(&(bar)[XB_TMO])) break; if (_sp > XB_SPIN_CAP) { atomicAdd(&(bar)[XB_TMO], 1u); break; } } } } while (0)

struct XcdBarrier { unsigned* bar; unsigned x; volatile LAS unsigned* st; int wave; };

__device__ __forceinline__ XcdBarrier xcd_barrier_post(unsigned* bar, volatile LAS unsigned* st, int wave) {
    XcdBarrier b; b.bar = bar; b.x = xb_xcc_id(); b.st = st; b.wave = wave;
    if (wave == 0 && lane_id() == 0) (void)xb_add(&bar[XB_XCNT(b.x)], 1u);
    return b;
}
__device__ __forceinline__ void xcd_barrier_complete(unsigned* bar, unsigned x, unsigned& nloc, unsigned& nx) {
    const unsigned G = gridDim.x * gridDim.y * gridDim.z;
    unsigned sum, cnt, mine, sp = 0u;
    for (;;) {
        sum = 0u; cnt = 0u; mine = 0u;
#pragma unroll
        for (unsigned j = 0; j < 16; ++j) { const unsigned c = xb_ld(&bar[XB_XCNT(j)]); sum += c; cnt += (c > 0u) ? 1u : 0u; mine = (j == x) ? c : mine; }
        if (sum == G) break;
        __builtin_amdgcn_s_sleep(1);
        if ((++sp & 255u) == 0u) { if (xb_ld(&bar[XB_TMO])) break; if (sp > XB_SPIN_CAP) { atomicAdd(&bar[XB_TMO], 1u); break; } }
    }
    nloc = mine > 0u ? mine : 1u; nx = cnt > 0u ? cnt : 1u;
}
__device__ __forceinline__ void xcd_barrier(const XcdBarrier& b) {
    asm volatile("s_waitcnt vmcnt(0)" ::: "memory");
    __syncthreads();
    if (b.wave == 0 && lane_id() == 0) {
        unsigned* bar = b.bar;
        __builtin_amdgcn_s_waitcnt(0);
        unsigned nloc = b.st[0], nx = b.st[1];
        unsigned bx = b.x; asm volatile("" : "+s"(bx));
        if (nloc == 0u) { xcd_barrier_complete(bar, bx, nloc, nx); b.st[0] = nloc; b.st[1] = nx; }
        const unsigned old = xb_add(&bar[XB_XSUB(bx)], 1u);
        const unsigned gen = old / nloc;
        if (old + 1u == (gen + 1u) * nloc) {
            __builtin_amdgcn_fence(__ATOMIC_RELEASE, "agent");
            asm volatile("s_waitcnt vmcnt(0)" ::: "memory");
            const unsigned og = xb_add(&bar[XB_TOP], 1u);
            const unsigned tg = og / nx;
            if (og + 1u == (tg + 1u) * nx) xb_add(&bar[XB_TOPGEN], 1u);
            else XB_SPIN(xb_ld(&bar[XB_TOPGEN]) == tg, bar);
            __builtin_amdgcn_fence(__ATOMIC_ACQUIRE, "agent");
            xb_add(&bar[XB_XGEN(bx)], 1u);
            asm volatile("s_waitcnt vmcnt(0)" ::: "memory");
        } else {
            XB_SPIN(xb_ld(&bar[XB_XGEN(bx)]) == gen, bar);
            __builtin_amdgcn_fence(__ATOMIC_ACQUIRE, "agent");
            asm volatile("s_waitcnt vmcnt(0)" ::: "memory");
        }
    }
    __syncthreads();
}

namespace pg8 {
constexpr int BM = 256, BK = 64, HALF = 128, HTB = HALF * BK * 2, STAGE_BYTES = 8 * HTB;
__host__ __device__ __forceinline__ int lds_byte(int r, int c) { const int st = (r >> 4) * 2 + (c >> 5), rr = r & 15, cc = c & 31, ob = rr * 64 + cc * 2; return st * 1024 + (ob ^ (((ob >> 9) & 1) << 5)); }
__host__ __device__ __forceinline__ void stage_rc(int b, int& R, int& C) { const int st = b / 1024, sb = b % 1024, swz = sb ^ (((sb >> 9) & 1) << 5); R = (st >> 1) * 16 + swz / 64; C = (st & 1) * 32 + (swz % 64) / 2; }
__host__ __device__ __forceinline__ int perm32(int rho) { const int n = rho >> 4, i = rho & 15; return 8 * (i >> 2) + 4 * n + (i & 3); }

struct Unit { unsigned a, b; int pm, pn, e, br;
    __device__ __forceinline__ void uniform() { a = __builtin_amdgcn_readfirstlane(a); b = __builtin_amdgcn_readfirstlane(b); pm = __builtin_amdgcn_readfirstlane(pm); pn = __builtin_amdgcn_readfirstlane(pn); e = __builtin_amdgcn_readfirstlane(e); br = __builtin_amdgcn_readfirstlane(br); } };

__device__ __forceinline__ unsigned cvt_pk_bf16(float lo, float hi) { unsigned r; asm volatile("v_cvt_pk_bf16_f32 %0, %1, %2" : "=v"(r) : "v"(lo), "v"(hi)); return r; }

typedef int i32x8 __attribute__((ext_vector_type(8)));
typedef int i32x4 __attribute__((ext_vector_type(4)));
template <class Epi, class Sched, bool FP8 = false, int MODE = 0>
__device__ __forceinline__ void gemm_phase(LAS unsigned char* lds, const int wid, const int lane, const char* base, const int K, const int lda, const int ldb, const Sched& S, const Epi& E) {
    const int tid = wid * 64 + lane, wr = wid >> 2, wc = wid & 3, fr = lane & 15, fq = lane >> 4;
    int nt = K / BK; asm volatile("" : "+s"(nt));
    unsigned voffA, voffB;
    { int R, C; stage_rc(tid * 16, R, C); const int Rb = Epi::PERM ? ((R & ~31) + perm32(R & 31)) : R; voffA = (unsigned)(R * lda + C) * 2u; voffB = (unsigned)(Rb * ldb + C) * 2u; }
    unsigned qstepA = (unsigned)(64 * lda * 2), qstepB = (unsigned)(64 * ldb * 2); asm volatile("" : "+s"(qstepA), "+s"(qstepB));
    unsigned kstep = (unsigned)(BK * 2), hstepA = (unsigned)(HALF * lda * 2), hstepB = (unsigned)(HALF * ldb * 2);
    asm volatile("" : "+s"(kstep), "+s"(hstepA), "+s"(hstepB));
    const unsigned ldsw = (unsigned)wid * 1024u;
    const int aoff = lds_byte(wr * 64 + fr, fq * 8), boff = lds_byte(wc * 32 + fr, fq * 8);
#define PG8_SA(b, h) (((b) * 2 + (h)) * HTB)
#define PG8_SB(b, h) ((4 + (b) * 2 + (h)) * HTB)
#define qoffA qstepA
#define qoffB qstepB
#define PG8_STAGE(bufoff, gbase, voff) do { _Pragma("unroll") for (int _i = 0; _i < 2; ++_i) \
        { unsigned sb_ = (gbase) + _i * q##voff; asm volatile("" : "+s"(sb_));     \
          __builtin_amdgcn_global_load_lds((const unsigned*)(base + (size_t)(unsigned)(sb_ + v##voff)), (LAS unsigned*)(lds + (bufoff) + ldsw + _i * 8192), 16, 0, 0); } } while (0)
#define PG8_LDA(dst, b, h) do { if constexpr (FP8) { _Pragma("unroll") for (int m = 0; m < 4; ++m) { const i32x4 lo_ = *(const LAS i32x4*)(lds + PG8_SA(b, h) + aoff + m * 2048), hi_ = *(const LAS i32x4*)(lds + PG8_SA(b, h) + aoff + 1024 + m * 2048); dst##8[m] = __builtin_shufflevector(lo_, hi_, 0, 1, 2, 3, 4, 5, 6, 7); } } \
        else { _Pragma("unroll") for (int m = 0; m < 4; ++m) _Pragma("unroll") for (int k = 0; k < 2; ++k) dst[m][k] = *(const LAS bf16x8*)(lds + PG8_SA(b, h) + aoff + m * 2048 + k * 1024); } } while (0)
#define PG8_LDB(dst, b, h) do { if constexpr (FP8) { _Pragma("unroll") for (int n = 0; n < 2; ++n) { const i32x4 lo_ = *(const LAS i32x4*)(lds + PG8_SB(b, h) + boff + n * 2048), hi_ = *(const LAS i32x4*)(lds + PG8_SB(b, h) + boff + 1024 + n * 2048); dst##8[n] = __builtin_shufflevector(lo_, hi_, 0, 1, 2, 3, 4, 5, 6, 7); } } \
        else { _Pragma("unroll") for (int n = 0; n < 2; ++n) _Pragma("unroll") for (int k = 0; k < 2; ++k) dst[n][k] = *(const LAS bf16x8*)(lds + PG8_SB(b, h) + boff + n * 2048 + k * 1024); } } while (0)
#define PG8_MMA_(ai, bj, At, Bt, Z) do { if constexpr (MODE == 1 && (bj) == 1) break; __builtin_amdgcn_s_setprio(1); if constexpr (FP8) { _Pragma("unroll") for (int m = 0; m < 4; ++m) _Pragma("unroll") for (int n = 0; n < 2; ++n) \
        acc[ai][bj][m][n] = __builtin_amdgcn_mfma_scale_f32_16x16x128_f8f6f4(Bt##8[n], At##8[m], (Z) ? (f32x4){0.f, 0.f, 0.f, 0.f} : acc[ai][bj][m][n], 0, 0, 0, Epi::SCALE_W, 0, Epi::SCALE_X); } \
        else { _Pragma("unroll") for (int m = 0; m < 4; ++m) _Pragma("unroll") for (int n = 0; n < 2; ++n) _Pragma("unroll") for (int k = 0; k < 2; ++k) \
        acc[ai][bj][m][n] = __builtin_amdgcn_mfma_f32_16x16x32_bf16(Bt[n][k], At[m][k], ((Z) && k == 0) ? (f32x4){0.f, 0.f, 0.f, 0.f} : acc[ai][bj][m][n], 0, 0, 0); } __builtin_amdgcn_s_setprio(0); } while (0)
#define PG8_MMA(ai, bj, At, Bt) PG8_MMA_(ai, bj, At, Bt, false)
#define PG8_MMA0(ai, bj, At, Bt) do { if (t == 0) PG8_MMA_(ai, bj, At, Bt, true); else PG8_MMA_(ai, bj, At, Bt, false); } while (0)
#define PG8_WAIT_V(n) asm volatile("s_waitcnt vmcnt(" #n ")" ::: "memory")
#define PG8_WAIT_L(n) asm volatile("s_waitcnt lgkmcnt(" #n ")" ::: "memory")
#define PG8_BAR __builtin_amdgcn_s_barrier()
#define PG8_SCHED __builtin_amdgcn_sched_barrier(0)
    Unit cur, nxt; int ui = 0;
    if (!S.next(0, cur)) return;
    f32x4 acc[2][2][4][2];
    if constexpr (MODE == 1) {
#pragma unroll
        for (int a = 0; a < 2; ++a)
#pragma unroll
            for (int m = 0; m < 4; ++m)
#pragma unroll
                for (int n = 0; n < 2; ++n) acc[a][1][m][n] = (f32x4){0.f, 0.f, 0.f, 0.f};
    }
    bf16x8 At[4][2], B0[2][2], B1[2][2]; i32x8 At8[4], B08[2], B18[2];
    unsigned cA = cur.a, cB = cur.b;
    PG8_STAGE(PG8_SB(0, 0), cB, offB); PG8_STAGE(PG8_SB(0, 1), cB + hstepB, offB); PG8_STAGE(PG8_SA(0, 0), cA, offA); PG8_STAGE(PG8_SA(0, 1), cA + hstepA, offA);
    if (wr == 1) PG8_BAR;
    PG8_WAIT_V(2); PG8_BAR;
    PG8_STAGE(PG8_SB(1, 0), cB + kstep, offB); PG8_STAGE(PG8_SA(1, 0), cA + kstep, offA); PG8_STAGE(PG8_SB(1, 1), cB + hstepB + kstep, offB);
    PG8_WAIT_V(6); PG8_BAR;
    for (;;) {
        const bool has_next = S.next(ui + 1, nxt);
        const unsigned nA = has_next ? nxt.a : cA, nB = has_next ? nxt.b : cB;
#pragma unroll 1
        for (int t = 0; t < nt; t += 2) {
            const bool last = (t == nt - 2);
            const unsigned a1 = cA + (unsigned)(t + 1) * kstep;
            const unsigned a2 = last ? nA : cA + (unsigned)(t + 2) * kstep, b2 = last ? nB : cB + (unsigned)(t + 2) * kstep;
            const unsigned a3 = a2 + kstep, b3 = b2 + kstep;
            PG8_LDB(B0, 0, 0); PG8_LDB(B1, 0, 1); PG8_SCHED; PG8_LDA(At, 0, 0); PG8_STAGE(PG8_SA(1, 1), a1 + hstepA, offA);
            PG8_WAIT_V(8); PG8_WAIT_L(0); PG8_BAR; PG8_MMA0(0, 0, At, B0); PG8_MMA0(0, 1, At, B1); PG8_BAR; PG8_SCHED;
            PG8_LDA(At, 0, 1); PG8_STAGE(PG8_SB(0, 0), b2, offB); PG8_STAGE(PG8_SB(0, 1), b2 + hstepB, offB); PG8_STAGE(PG8_SA(0, 0), a2, offA);
            PG8_WAIT_V(8); PG8_WAIT_L(0); PG8_BAR; PG8_MMA0(1, 0, At, B0); PG8_MMA0(1, 1, At, B1); PG8_BAR; PG8_SCHED;
            PG8_LDB(B0, 1, 0); PG8_LDB(B1, 1, 1); PG8_SCHED; PG8_LDA(At, 1, 0); PG8_STAGE(PG8_SA(0, 1), a2 + hstepA, offA);
            PG8_WAIT_V(8); PG8_WAIT_L(0); PG8_BAR; PG8_MMA(0, 0, At, B0); PG8_MMA(0, 1, At, B1); PG8_BAR; PG8_SCHED;
            PG8_LDA(At, 1, 1); PG8_STAGE(PG8_SB(1, 0), b3, offB); PG8_STAGE(PG8_SB(1, 1), b3 + hstepB, offB); PG8_STAGE(PG8_SA(1, 0), a3, offA);
            PG8_WAIT_V(8); PG8_WAIT_L(0); PG8_BAR; PG8_MMA(1, 0, At, B0); PG8_MMA(1, 1, At, B1); PG8_BAR; PG8_SCHED;
            if constexpr (MODE == 1) { if (((t + 2) & 3) == 0 && !last) { const int l2_ = lane_id(); E.mid(acc, cur, (t + 2) / 4 - 1, wr, wc, l2_ & 15, l2_ >> 4); } }
        }
        if (wr == 0) PG8_BAR;
        { const int l2_ = lane_id();
          E(acc, cur, wr, wc, l2_ & 15, l2_ >> 4); }
        if (!has_next) break;
        if constexpr (MODE == 1) {
#pragma unroll
            for (int a = 0; a < 2; ++a)
#pragma unroll
                for (int m = 0; m < 4; ++m)
#pragma unroll
                    for (int n = 0; n < 2; ++n) acc[a][1][m][n] = (f32x4){0.f, 0.f, 0.f, 0.f};
        }
        cur = nxt; cA = nA; cB = nB; ++ui;
        if (wr == 1) PG8_BAR;
    }
    PG8_WAIT_V(0);
    PG8_BAR;
#undef PG8_SA
#undef PG8_SB
#undef PG8_STAGE
#undef qoffA
#undef qoffB
#undef PG8_LDA
#undef PG8_LDB
#undef PG8_MMA
#undef PG8_MMA_
#undef PG8_MMA0
#undef PG8_WAIT_V
#undef PG8_WAIT_L
#undef PG8_BAR
#undef PG8_SCHED
}
}
using pg8::Unit;

typedef const __attribute__((address_space(4))) unsigned char* KPtr;
DI KPtr kargs() { KPtr p = (KPtr)__builtin_amdgcn_kernarg_segment_ptr(); asm volatile("" : "+s"(p)); return p; }
struct Ctx {
    KPtr ka;
    DI const float* in(int i) const { return *(const float* const __attribute__((address_space(4)))*)(ka + 8 * i); }
    DI float* out() const { return *(float* const __attribute__((address_space(4)))*)(ka + 8 * N_IN); }
    DI unsigned char* ws() const { return *(unsigned char* const __attribute__((address_space(4)))*)(ka + 8 * N_IN + 8); }
    DI float* mod() const { return (float*)(ws() + WS_MOD); }
    DI float* lb() const { return (float*)(ws() + WS_LB); }
    DI float* aff() const { return (float*)(ws() + WS_AFF); }
    DI float* gate() const { return (float*)(ws() + WS_GATE); }
    DI bf16_t* X() const { return (bf16_t*)(ws() + WS_X); }
    DI int* sel() const { return (int*)(ws() + WS_SEL); }
    DI bf16_t* wbr() const { return (bf16_t*)(ws() + WS_WBR); }
    DI bf16_t* wout() const { return (bf16_t*)(ws() + WS_WOUT); }
    DI bf16_t* win() const { return (bf16_t*)(ws() + WS_WIN); }
    DI bf16_t* H() const { return (bf16_t*)(ws() + WS_H); }
    DI bf16_t* O() const { return (bf16_t*)(ws() + WS_O); }
    DI bf16_t* MB() const { return (bf16_t*)(ws() + WS_MB); }
    DI bf16_t* P() const { return (bf16_t*)(ws() + WS_P); }
    DI bf16_t* XE() const { return (bf16_t*)(ws() + WS_XE); }
    DI unsigned char* W1T(int li) const { return ws() + WS_EXW + (size_t)li * EXW_LAYER; }
    DI unsigned char* W2T(int li) const { return ws() + WS_W2T + (size_t)li * EXW_LAYER; }
    DI bf16_t* QKN() const { return (bf16_t*)(ws() + WS_QKN); }
    DI float* YS5() const { return (float*)(ws() + WS_XE); }
    DI float* OHG() const { return (float*)(ws() + WS_XE + (size_t)2 * NTOK * 256 * 4); }
    DI float* ORET() const { return (float*)(ws() + WS_MB); }
    DI bf16_t* RETP() const { return (bf16_t*)(ws() + WS_RETP); }
    DI bf16_t* RETS() const { return (bf16_t*)(ws() + WS_RETS); }
    DI bf16_t* HGS() const { return (bf16_t*)(ws() + WS_HGS); }
    DI bf16_t* UG() const { return (bf16_t*)(ws() + WS_UG); }
    DI float* S5S() const { return (float*)(ws() + WS_S5S); }
    DI bf16_t* OHGB() const { return (bf16_t*)(ws() + WS_OHG); }
    DI bf16_t* Z() const { return (bf16_t*)(ws() + WS_Z); }
    DI bf16_t* S5W1() const { return (bf16_t*)(ws() + WS_S5W1); }
    DI bf16_t* S5W2() const { return (bf16_t*)(ws() + WS_S5W2); }
    DI bf16_t* GLUT() const { return (bf16_t*)(ws() + WS_GLUT); }
    DI bf16_t* HGP() const { return (bf16_t*)(ws() + WS_HGP); }
    DI float* HGDEC() const { return (float*)(ws() + WS_HGDEC); }
    DI float* HGDT() const { return (float*)(ws() + WS_HGDT); }
};
DI size_t seqrow(int b, int dir, int s) { return (size_t)b * LSEQ + (dir == 0 ? s : (s < CTXL ? (CTXL - 1 - s) : (LSEQ + CTXL - 1 - s))); }

struct EpiP {
    static constexpr bool PERM = true;
    bf16_t* O; int ldc; bf16_t* UG; bf16_t* QKN; const float* wq; const float* wk; bf16_t* RP; const float* retd;
    DI void operator()(const f32x4 (&acc)[2][2][4][2], const Unit& u, int wr, int wc, int fr, int fq) const {
        const int row0 = u.pm * 256 + wr * 64 + fr, col0 = u.pn * 256 + wc * 32 + 8 * fq;
        if (u.pn == 1 || u.pn == 2) {
            const bool isk = (u.pn == 2); const float* wp = isk ? wk : wq; const float sc = isk ? 1.0f : 0.125f;
            f32x4 w4[2][2];
#pragma unroll
            for (int bj = 0; bj < 2; ++bj)
#pragma unroll
                for (int n = 0; n < 2; ++n) w4[bj][n] = *(const f32x4*)(wp + 32 * bj + 8 * fq + 4 * n) * sc;
#pragma unroll
            for (int ai = 0; ai < 2; ++ai)
#pragma unroll
                for (int m = 0; m < 4; ++m) { const int R = row0 + ai * 128 + m * 16; float ss = 0.f;
#pragma unroll
                    for (int bj = 0; bj < 2; ++bj)
#pragma unroll
                        for (int n = 0; n < 2; ++n) { const f32x4 v = acc[ai][bj][m][n]; ss += v[0] * v[0] + v[1] * v[1] + v[2] * v[2] + v[3] * v[3]; }
                    ss += shx<16>(ss); ss += shx<32>(ss);
                    const float rs = __builtin_amdgcn_rsqf(ss * (1.0f / 64.0f) + EPS);
#pragma unroll
                    for (int bj = 0; bj < 2; ++bj) { const f32x4 v0 = acc[ai][bj][m][0] * rs * w4[bj][0], v1 = acc[ai][bj][m][1] * rs * w4[bj][1];
                        u32x4 w; w.x = pk2(v0[0], v0[1]); w.y = pk2(v0[2], v0[3]); w.z = pk2(v1[0], v1[1]); w.w = pk2(v1[2], v1[3]);
                        *(u32x4*)(QKN + (size_t)R * 512 + (isk ? 256 : 0) + wc * 64 + 32 * bj + 8 * fq) = w; } }
            return; }
        if (u.pn == 9 || u.pn == 10) {
            const bool isk = (u.pn == 10);
            const float lg0 = __log2f(sigm(retd[wc])), lg1 = __log2f(sigm(retd[4 + wc]));
            float inv[8];
#pragma unroll
            for (int e = 0; e < 8; ++e) inv[e] = __builtin_amdgcn_exp2f(-(float)(8 * (fq & 1) + e) * (13.287712379549449f / 16.0f));
#pragma unroll
            for (int ai = 0; ai < 2; ++ai)
#pragma unroll
                for (int m = 0; m < 4; ++m) { const int R = row0 + ai * 128 + m * 16, i = R % LSEQ, il = i & 63;
                    f32x4 a0 = acc[ai][0][m][0], a1 = acc[ai][0][m][1], b0 = acc[ai][1][m][0], b1 = acc[ai][1][m][1];
                    if (i >= CTXL) { const int t = i - CTXL; const float pos = (float)((fq < 2) ? (t >> 6) : (t & 63));
#pragma unroll
                        for (int j = 0; j < 4; ++j) { { const float ang = pos * inv[j], sn = __sinf(ang), cs = __cosf(ang); const float x1 = a0[j], x2 = b0[j]; a0[j] = x1 * cs - x2 * sn; b0[j] = x2 * cs + x1 * sn; }
                                                      { const float ang = pos * inv[4 + j], sn = __sinf(ang), cs = __cosf(ang); const float x1 = a1[j], x2 = b1[j]; a1[j] = x1 * cs - x2 * sn; b1[j] = x2 * cs + x1 * sn; } } }
                    const float fil = (float)il;
                    const float s0 = isk ? 0.125f * __builtin_amdgcn_exp2f(-fil * lg0) : __builtin_amdgcn_exp2f(fil * lg0), s1 = isk ? 0.125f * __builtin_amdgcn_exp2f(fil * lg1) : __builtin_amdgcn_exp2f(-fil * lg1);
                    const size_t o = (size_t)R * 256 + wc * 64 + 8 * fq;
                    bf16_t* t0 = RP + (isk ? 1 : 0) * RETP_T + o; bf16_t* t1 = RP + (isk ? 3 : 2) * RETP_T + o;
                    { const f32x4 p = a0 * s0, q = a1 * s0, r = b0 * s0, z = b1 * s0; *(u32x4*)t0 = (u32x4){pk2(p[0], p[1]), pk2(p[2], p[3]), pk2(q[0], q[1]), pk2(q[2], q[3])}; *(u32x4*)(t0 + 32) = (u32x4){pk2(r[0], r[1]), pk2(r[2], r[3]), pk2(z[0], z[1]), pk2(z[2], z[3])}; }
                    { const f32x4 p = a0 * s1, q = a1 * s1, r = b0 * s1, z = b1 * s1; *(u32x4*)t1 = (u32x4){pk2(p[0], p[1]), pk2(p[2], p[3]), pk2(q[0], q[1]), pk2(q[2], q[3])}; *(u32x4*)(t1 + 32) = (u32x4){pk2(r[0], r[1]), pk2(r[2], r[3]), pk2(z[0], z[1]), pk2(z[2], z[3])}; } }
            return; }
        const bool s5 = (u.pn == 0);
#pragma unroll
        for (int ai = 0; ai < 2; ++ai)
#pragma unroll
            for (int m = 0; m < 4; ++m) { const int R = row0 + ai * 128 + m * 16; bf16_t* rowp = O + (size_t)R * ldc + col0;
#pragma unroll
                for (int bj = 0; bj < 2; ++bj) { const f32x4 v0 = acc[ai][bj][m][0], v1 = acc[ai][bj][m][1];
                    u32x4 w; w.x = pg8::cvt_pk_bf16(v0[0], v0[1]); w.y = pg8::cvt_pk_bf16(v0[2], v0[3]); w.z = pg8::cvt_pk_bf16(v1[0], v1[1]); w.w = pg8::cvt_pk_bf16(v1[2], v1[3]);
                    if (s5) { const int c = wc * 32 + 8 * fq + bj * 128; *(u32x4*)(UG + ((size_t)(c >> 4) * S5ROWS + (R >> 4)) * 512 + (R & 15) * 16 + (c & 15)) = w; }
                    else *(u32x4*)(rowp + bj * 128) = w; } }
    }
};
constexpr float FP8_WS = 16.0f, FP8_XS = 16.0f, FP8_AS = 16.0f;
struct EpiSig8 {
    static constexpr bool PERM = true; static constexpr int SCALE_W = 0x7b7b7b7b, SCALE_X = 0x7b7b7b7b;
    unsigned char* Pb;
    DI void operator()(const f32x4 (&acc)[2][2][4][2], const Unit& u, int wr, int wc, int fr, int fq) const {
        const int row0 = u.pm * 256 + wr * 64 + fr, col0 = u.pn * 256 + wc * 32 + 8 * fq;
#pragma unroll
        for (int ai = 0; ai < 2; ++ai)
#pragma unroll
            for (int m = 0; m < 4; ++m) { unsigned char* rowp = Pb + (size_t)(row0 + ai * 128 + m * 16) * (DIN * 2) + 2 * C_GATE + col0;
#pragma unroll
                for (int bj = 0; bj < 2; ++bj) { const f32x4 v0 = acc[ai][bj][m][0], v1 = acc[ai][bj][m][1];
                    u32x2 w; w.x = pack_u8x4(sigm4(v0)); w.y = pack_u8x4(sigm4(v1));
                    *(u32x2*)(rowp + bj * 128) = w; } }
    }
};
struct EpiMerge {
    static constexpr bool PERM = true;
    bf16_t* MB; const unsigned char* Pb;
    DI void mid(f32x4 (&acc)[2][2][4][2], const Unit& u, int br, int wr, int wc, int fr, int fq) const {
        const int row0 = u.pm * 256 + wr * 64 + fr, col0 = u.pn * 128 + wc * 32 + 8 * fq;
        u32x2 gt[2][4];
#pragma unroll
        for (int ai = 0; ai < 2; ++ai)
#pragma unroll
            for (int m = 0; m < 4; ++m) gt[ai][m] = *(const u32x2*)(Pb + (size_t)(row0 + ai * 128 + m * 16) * (DIN * 2) + 2 * C_GATE + br * 1024 + col0);
        const float q = 1.0f / 255.0f;
#pragma unroll
        for (int ai = 0; ai < 2; ++ai)
#pragma unroll
            for (int m = 0; m < 4; ++m) { const u32x2 g = gt[ai][m];
                acc[ai][1][m][0] = acc[ai][1][m][0] + acc[ai][0][m][0] * (f32x4){(float)(g.x & 255u) * q, (float)((g.x >> 8) & 255u) * q, (float)((g.x >> 16) & 255u) * q, (float)(g.x >> 24) * q};
                acc[ai][1][m][1] = acc[ai][1][m][1] + acc[ai][0][m][1] * (f32x4){(float)(g.y & 255u) * q, (float)((g.y >> 8) & 255u) * q, (float)((g.y >> 16) & 255u) * q, (float)(g.y >> 24) * q};
                acc[ai][0][m][0] = (f32x4){0.f, 0.f, 0.f, 0.f}; acc[ai][0][m][1] = (f32x4){0.f, 0.f, 0.f, 0.f}; }
    }
    DI void operator()(const f32x4 (&acc)[2][2][4][2], const Unit& u, int wr, int wc, int fr, int fq) const {
        const int row0 = u.pm * 256 + wr * 64 + fr, col0 = u.pn * 128 + wc * 32 + 8 * fq;
        u32x2 gt[2][4];
#pragma unroll
        for (int ai = 0; ai < 2; ++ai)
#pragma unroll
            for (int m = 0; m < 4; ++m) gt[ai][m] = *(const u32x2*)(Pb + (size_t)(row0 + ai * 128 + m * 16) * (DIN * 2) + 2 * C_GATE + 3 * 1024 + col0);
        const float q = 1.0f / 255.0f;
#pragma unroll
        for (int ai = 0; ai < 2; ++ai)
#pragma unroll
            for (int m = 0; m < 4; ++m) { const u32x2 g = gt[ai][m];
                const f32x4 r0 = acc[ai][1][m][0] + acc[ai][0][m][0] * (f32x4){(float)(g.x & 255u) * q, (float)((g.x >> 8) & 255u) * q, (float)((g.x >> 16) & 255u) * q, (float)(g.x >> 24) * q};
                const f32x4 r1 = acc[ai][1][m][1] + acc[ai][0][m][1] * (f32x4){(float)(g.y & 255u) * q, (float)((g.y >> 8) & 255u) * q, (float)((g.y >> 16) & 255u) * q, (float)(g.y >> 24) * q};
                u32x4 w; w.x = pg8::cvt_pk_bf16(r0[0], r0[1]); w.y = pg8::cvt_pk_bf16(r0[2], r0[3]); w.z = pg8::cvt_pk_bf16(r1[0], r1[1]); w.w = pg8::cvt_pk_bf16(r1[2], r1[3]);
                *(u32x4*)(MB + (size_t)(row0 + ai * 128 + m * 16) * DM + col0) = w; }
    }
};
struct EpiResid {
    static constexpr bool PERM = true; static constexpr int PF = 0;
    bf16_t* X; const float* mod; bf16_t* Xo; const float* xin; const float* cin;
    DI void operator()(const f32x4 (&acc)[2][2][4][2], const Unit& u, int wr, int wc, int fr, int fq) const {
        const int row0 = u.pm * 256 + wr * 64 + fr, col0 = u.pn * 256 + wc * 32 + 8 * fq;
        const int b = u.pm / 17, tl = u.pm % 17, mr = (tl == 0) ? 8 : b;
        const float* g1 = mod + mr * 6144 + 2 * 1024;
        const float* srcb = xin ? (tl == 0 ? cin + (size_t)b * CTXL * DM : xin + ((size_t)b * SEQ + (tl - 1) * 256) * DM) - (size_t)u.pm * 256 * DM : nullptr;
        f32x4 gv[2][2];
#pragma unroll
        for (int bj = 0; bj < 2; ++bj)
#pragma unroll
            for (int n = 0; n < 2; ++n) gv[bj][n] = *(const f32x4*)(g1 + col0 + bj * 128 + 4 * n);
#pragma unroll
        for (int ai = 0; ai < 2; ++ai)
#pragma unroll
            for (int mh = 0; mh < 2; ++mh) {
                f32x4 xv[2][2][2];
#pragma unroll
                for (int m2 = 0; m2 < 2; ++m2)
#pragma unroll
                    for (int bj = 0; bj < 2; ++bj) { const size_t off = (size_t)(row0 + ai * 128 + (2 * mh + m2) * 16) * DM + col0 + bj * 128;
                        if (xin) { xv[m2][bj][0] = *(const f32x4*)(srcb + off); xv[m2][bj][1] = *(const f32x4*)(srcb + off + 4); }
                        else { const u32x4 w = *(const u32x4*)(X + off); xv[m2][bj][0] = (f32x4){lo_f(w.x), hi_f(w.x), lo_f(w.y), hi_f(w.y)}; xv[m2][bj][1] = (f32x4){lo_f(w.z), hi_f(w.z), lo_f(w.w), hi_f(w.w)}; } }
#pragma unroll
                for (int m2 = 0; m2 < 2; ++m2)
#pragma unroll
                    for (int bj = 0; bj < 2; ++bj) { const f32x4 r0 = xv[m2][bj][0] + gv[bj][0] * acc[ai][bj][2 * mh + m2][0], r1 = xv[m2][bj][1] + gv[bj][1] * acc[ai][bj][2 * mh + m2][1];
                        u32x4 w; w.x = pk2(r0[0], r0[1]); w.y = pk2(r0[2], r0[3]); w.z = pk2(r1[0], r1[1]); w.w = pk2(r1[2], r1[3]);
                        *(u32x4*)(Xo + (size_t)(row0 + ai * 128 + (2 * mh + m2) * 16) * DM + col0 + bj * 128) = w; }
                asm volatile("" ::: "memory"); }
    }
};
struct EpiSwiGLU {
    static constexpr bool PERM = true; static constexpr int SCALE_W = 0x7b7b7b7b, SCALE_X = 0x7b7b7b7b;
    unsigned char* ACT;
    DI void operator()(const f32x4 (&acc)[2][2][4][2], const Unit& u, int wr, int wc, int fr, int fq) const {
        const int row0 = u.pm * 256 + wr * 64 + fr, col0 = u.pn * 128 + wc * 32 + 8 * fq;
#pragma unroll
        for (int ai = 0; ai < 2; ++ai)
#pragma unroll
            for (int m = 0; m < 4; ++m) { unsigned char* rowp = ACT + ((size_t)u.e * EROWS + row0 + ai * 128 + m * 16) * DF + col0;
                f32x4 q[2];
#pragma unroll
                for (int n = 0; n < 2; ++n) { const f32x4 g = acc[ai][0][m][n], up = acc[ai][1][m][n];
                    q[n] = (g * up) * rcp4(exp2n4(g * -1.4426950408889634f) * (1.0f / FP8_AS) + (1.0f / FP8_AS)); }
                u32x2 w; w.x = pk4_fp8(q[0][0], q[0][1], q[0][2], q[0][3]); w.y = pk4_fp8(q[1][0], q[1][1], q[1][2], q[1][3]);
                *(u32x2*)rowp = w; }
    }
};
struct EpiExpOut {
    static constexpr bool PERM = true; static constexpr int SCALE_W = 0x7b7b7b7b, SCALE_X = 0x7b7b7b7b;
    bf16_t* YB; const float* gate;
    DI void operator()(const f32x4 (&acc)[2][2][4][2], const Unit& u, int wr, int wc, int fr, int fq) const {
        const int row0 = u.pm * 256 + wr * 64 + fr, col0 = u.pn * 256 + wc * 32 + 8 * fq;
#pragma unroll
        for (int ai = 0; ai < 2; ++ai)
#pragma unroll
            for (int m = 0; m < 4; ++m) { const size_t er = (size_t)u.e * EROWS + row0 + ai * 128 + m * 16; const float g = gate[er]; bf16_t* rowp = YB + er * DM + col0;
#pragma unroll
                for (int bj = 0; bj < 2; ++bj) { const f32x4 v0 = acc[ai][bj][m][0] * g, v1 = acc[ai][bj][m][1] * g;
                    u32x4 w; w.x = pg8::cvt_pk_bf16(v0[0], v0[1]); w.y = pg8::cvt_pk_bf16(v0[2], v0[3]); w.z = pg8::cvt_pk_bf16(v1[0], v1[1]); w.w = pg8::cvt_pk_bf16(v1[2], v1[3]);
                    *(u32x4*)(rowp + bj * 128) = w; } }
    }
};

DI int xcd_remap(int L, int nwg) { const int q = nwg / 8, r = nwg % 8, x = L % 8, off = L / 8; return (x < r ? x * (q + 1) : r * (q + 1) + (x - r) * q) + off; }
DI void tile_of(int T, int nM, int nN, int& pm, int& pn) { const int nig = 8 * nN, gid = T / nig, fm = gid * 8, gsz = (nM - fm) < 8 ? (nM - fm) : 8; pm = fm + ((T % nig) % gsz); pn = (T % nig) / gsz; }
DI int pm_of(int li, int pmi) { return li == 0 ? pmi : (pmi / 16) * 17 + 1 + (pmi % 16); }
struct SchedWin {
    unsigned A, B; int G, c, nN; unsigned rowb; int nM, lm;
    DI bool next(int i, Unit& u) const {
        const int L = i * G + c; if (L >= nM * nN) return false;
        int pmi; tile_of(xcd_remap(L, nM * nN), nM, nN, pmi, u.pn); u.pm = pm_of(lm, pmi); u.e = 0; u.br = 0;
        u.a = A + (unsigned)u.pm * 256u * rowb; u.b = B + (unsigned)u.pn * 256u * rowb; u.uniform(); return true;
    }
};
struct SchedMerge {
    unsigned O, WBR; int G, c, li;
    DI bool next(int i, Unit& u) const {
        const int nM = (li == 0 ? 136 : 128), ntile = nM * 8, L = i * G + c; if (L >= ntile) return false;
        int pmi; tile_of(xcd_remap(L, ntile), nM, 8, pmi, u.pn); u.br = 0; u.pm = pm_of(li, pmi); u.e = 0;
        u.a = O + (unsigned)u.pm * 256u * DM * 2u; u.b = WBR + (unsigned)u.pn * 128u * DM * 2u; u.uniform(); return true;
    }
};
struct SchedOut {
    unsigned MBp, W; int G, c, li;
    DI bool next(int i, Unit& u) const {
        const int nM = (li == 0 ? 136 : 128), ntile = nM * 4, L = i * G + c; if (L >= ntile) return false;
        int pmi; tile_of(xcd_remap(L, ntile), nM, 4, pmi, u.pn); u.br = 0; u.pm = pm_of(li, pmi); u.e = 0;
        u.a = MBp + (unsigned)u.pm * 256u * DM * 2u; u.b = W + (unsigned)u.pn * 256u * DM * 2u; u.uniform(); return true;
    }
};
struct SchedE1 {
    unsigned XE, W; int G, c, pmN;
    DI bool next(int i, Unit& u) const {
        const int per = pmN * 22, L0 = i * G + c; if (L0 >= NE * per) return false;
        const int L = xcd_remap(L0, NE * per); u.e = L / per; tile_of(L % per, pmN, 22, u.pm, u.pn); u.br = 0;
        u.a = XE + ((unsigned)u.e * EROWS + u.pm * 256u) * DM; u.b = W + ((unsigned)u.e * 5632u + u.pn * 256u) * DM; u.uniform(); return true;
    }
};
struct SchedE2 {
    unsigned ACT, W; int G, c, pmN;
    DI bool next(int i, Unit& u) const {
        const int per = pmN * 4, L0 = i * G + c; if (L0 >= NE * per) return false;
        const int L = xcd_remap(L0, NE * per); u.e = L / per; tile_of(L % per, pmN, 4, u.pm, u.pn); u.br = 0;
        u.a = ACT + ((unsigned)u.e * EROWS + u.pm * 256u) * DF; u.b = W + ((unsigned)u.e * 1024u + u.pn * 256u) * DF; u.uniform(); return true;
    }
};


DI void s5_build_w(const Ctx& C, int li, int g, int part4, LAS float* L, int tid) {
    LAS float* pwr = L; LAS float* pwi = pwr + 2176; LAS float* bbr = pwi + 2176; LAS float* bbi = bbr + 2048; LAS float* ccr = bbi + 2048; LAS float* cci = ccr + 2048; LAS float* Kt = cci + 2048;
    __syncthreads();
    if (tid < 128) { const int d = tid >> 6, n = tid & 63, pg = (li * 2 + d) * 16 + g;
        const float lr = C.in(I_LRE)[pg * 64 + n], lim = C.in(I_LIM)[pg * 64 + n], dt = expf(C.in(I_LSTEP)[pg]);
        const float mag = expf(lr * dt); float sn, cs; sincosf(lim * dt, &sn, &cs);
        const float ar = mag * cs, ai = mag * sn, den = lr * lr + lim * lim;
        const float zr = ((ar - 1.0f) * lr + ai * lim) / den, zi = (ai * lr - (ar - 1.0f) * lim) / den;
        float pr = 1.0f, pi = 0.0f;
        for (int t = 0; t <= 16; ++t) { pwr[(d * 17 + t) * 64 + n] = pr; pwi[(d * 17 + t) * 64 + n] = pi; const float nr = pr * ar - pi * ai, ni = pr * ai + pi * ar; pr = nr; pi = ni; }
        for (int p = 0; p < 16; ++p) { const float br = C.in(I_BRE)[((size_t)pg * 64 + n) * 16 + p], bi = C.in(I_BIM)[((size_t)pg * 64 + n) * 16 + p];
            bbr[(d * 64 + n) * 16 + p] = zr * br - zi * bi; bbi[(d * 64 + n) * 16 + p] = zr * bi + zi * br;
            ccr[(d * 16 + p) * 64 + n] = C.in(I_CRE)[((size_t)pg * 16 + p) * 64 + n]; cci[(d * 16 + p) * 64 + n] = C.in(I_CIM)[((size_t)pg * 16 + p) * 64 + n]; } }
    __syncthreads();
    for (int e2 = tid; e2 < 2048; e2 += 512) { const int d = e2 >> 10, tau = (e2 >> 6) & 15, p = 4 * part4 + ((e2 >> 4) & 3), pp = e2 & 15; float acc = 0.f;
        for (int n = 0; n < 64; ++n) { const float cr = ccr[(d * 16 + p) * 64 + n], ci = cci[(d * 16 + p) * 64 + n], pr = pwr[(d * 17 + tau) * 64 + n], pi = pwi[(d * 17 + tau) * 64 + n];
            const float wr = cr * pr - ci * pi, wi = cr * pi + ci * pr; acc += wr * bbr[(d * 64 + n) * 16 + pp] - wi * bbi[(d * 64 + n) * 16 + pp]; }
        Kt[((d * 16 + tau) * 16 + p) * 16 + pp] = acc; }
    __syncthreads();
    {
        const int rl = tid >> 3, t = rl >> 2, p = 4 * part4 + (rl & 3), row = t * 16 + p; const float dsk = C.in(I_S5D)[li * 256 + g * 16 + p];
        bf16_t* dst = C.S5W2() + ((size_t)(li * 16 + g) * 256 + row) * 512;
        for (int k8 = (tid & 7) * 8; k8 < (tid & 7) * 8 + 8; ++k8) { float v[8];
#pragma unroll
            for (int j = 0; j < 8; ++j) { const int kk = (k8 * 8 + j) & 255;
                if (k8 < 32) { const int tp = kk >> 4, pp = kk & 15; float a = 0.f;
                    if (tp <= t) a += Kt[((0 * 16 + (t - tp)) * 16 + p) * 16 + pp];
                    if (tp >= t) a += Kt[((1 * 16 + (tp - t)) * 16 + p) * 16 + pp];
                    if (kk == row) a += dsk; v[j] = a; }
                else { const int d = kk >> 7, part = (kk >> 6) & 1, n = kk & 63, ex = d ? 16 - t : t + 1;
                    const float cr = ccr[(d * 16 + p) * 64 + n], ci = cci[(d * 16 + p) * 64 + n], pr = pwr[(d * 17 + ex) * 64 + n], pi = pwi[(d * 17 + ex) * 64 + n];
                    v[j] = part ? -(cr * pi + ci * pr) : (cr * pr - ci * pi); } }
            u32x4 o; o.x = pk2(v[0], v[1]); o.y = pk2(v[2], v[3]); o.z = pk2(v[4], v[5]); o.w = pk2(v[6], v[7]); *(u32x4*)(dst + k8 * 8) = o; } }
    {
        const int np = 64 * part4 + (tid >> 3), d = np >> 7, part = (np >> 6) & 1, n = np & 63;
        bf16_t* dst = C.S5W1() + ((size_t)(li * 16 + g) * 256 + np) * 256;
        for (int k8 = (tid & 7) * 4; k8 < (tid & 7) * 4 + 4; ++k8) { float v[8];
#pragma unroll
            for (int j = 0; j < 8; ++j) { const int kk = k8 * 8 + j, t = kk >> 4, p = kk & 15, ex = d ? t : 15 - t;
                const float pr = pwr[(d * 17 + ex) * 64 + n], pi = pwi[(d * 17 + ex) * 64 + n], br = bbr[(d * 64 + n) * 16 + p], bi = bbi[(d * 64 + n) * 16 + p];
                v[j] = part ? (pr * bi + pi * br) : (pr * br - pi * bi); }
            u32x4 o; o.x = pk2(v[0], v[1]); o.y = pk2(v[2], v[3]); o.z = pk2(v[4], v[5]); o.w = pk2(v[6], v[7]); *(u32x4*)(dst + k8 * 8) = o; } }
    __syncthreads();
}
DI void prep_s5(const Ctx& C, int gw, int ngw, int lane) {
    const bf16_t* P = C.P(); bf16_t* UG = C.UG();
    for (int ch = gw; ch < S5CH; ch += ngw) {
#pragma unroll
        for (int i = 0; i < 4; ++i) { const int pr = lane + 64 * i, t = pr >> 4, g = pr & 15;
            const u32x4* src = (const u32x4*)(P + ((size_t)ch * 16 + t) * DIN + C_S5U + g * 16); u32x4* dst = (u32x4*)(UG + ((size_t)g * S5ROWS + ch) * 512 + t * 16);
            dst[0] = src[0]; dst[1] = src[1]; }
    }
}
DI void s5_carry(const Ctx& C, int li, int gw, int ngw, int lane) {
    const float* SS = C.S5S(); bf16_t* UG = C.UG();
    for (int it = gw; it < NB * 2 * 16; it += ngw) {
        const int b = it >> 5, d = (it >> 4) & 1, g = it & 15, n = lane, pg = (li * 2 + d) * 16 + g;
        const float lr = C.in(I_LRE)[pg * 64 + n], lim = C.in(I_LIM)[pg * 64 + n], dt = expf(C.in(I_LSTEP)[pg]);
        const float mag = expf(16.0f * lr * dt); float sn, cs; sincosf(16.0f * lim * dt, &sn, &cs);
        const float ar = mag * cs, ai = mag * sn;
        float xr = 0.f, xi = 0.f;
#pragma unroll 1
        for (int s0 = 0; s0 < 272; s0 += 34) {
            float sr[34], si[34];
#pragma unroll
            for (int k = 0; k < 34; ++k) { const int s = s0 + k, c = d == 0 ? s : (s < 16 ? 15 - s : 287 - s); const size_t rowi = (size_t)g * S5ROWS + b * 272 + c;
                sr[k] = SS[rowi * 256 + d * 128 + n]; si[k] = SS[rowi * 256 + d * 128 + 64 + n]; }
#pragma unroll
            for (int k = 0; k < 34; ++k) { const int s = s0 + k, c = d == 0 ? s : (s < 16 ? 15 - s : 287 - s); const size_t rowi = (size_t)g * S5ROWS + b * 272 + c;
                UG[rowi * 512 + 256 + d * 128 + n] = (bf16_t)f2bf(xr); UG[rowi * 512 + 256 + d * 128 + 64 + n] = (bf16_t)f2bf(xi);
                const float nr = ar * xr - ai * xi + sr[k], ni = ar * xi + ai * xr + si[k]; xr = nr; xi = ni; }
        }
    }
}
struct SchedS5 {
    unsigned A, B; int G, c; unsigned bstride;
    DI bool next(int i, Unit& u) const {
        const int L = i * G + c; if (L >= 16 * 9) return false;
        u.e = L / 9; u.pm = L % 9; u.pn = 0; u.br = 0;
        u.a = A + ((unsigned)u.e * S5ROWS + u.pm * 256u) * 512u * 2u; u.b = B + (unsigned)u.e * bstride; u.uniform(); return true;
    }
};
struct EpiS5S {
    static constexpr bool PERM = false;
    float* SS;
    DI void operator()(const f32x4 (&acc)[2][2][4][2], const Unit& u, int wr, int wc, int fr, int fq) const {
        const int row0 = u.pm * 256 + wr * 64 + fr, col0 = wc * 32 + 4 * fq;
#pragma unroll
        for (int ai = 0; ai < 2; ++ai)
#pragma unroll
            for (int m = 0; m < 4; ++m) { float* rowp = SS + ((size_t)u.e * S5ROWS + row0 + ai * 128 + m * 16) * 256 + col0;
#pragma unroll
                for (int bj = 0; bj < 2; ++bj)
#pragma unroll
                    for (int n = 0; n < 2; ++n) *(f32x4*)(rowp + bj * 128 + n * 16) = acc[ai][bj][m][n]; }
    }
};
struct EpiS5Z {
    static constexpr bool PERM = true;
    bf16_t* Z;
    DI void operator()(const f32x4 (&acc)[2][2][4][2], const Unit& u, int wr, int wc, int fr, int fq) const {
        const int row0 = u.pm * 256 + wr * 64 + fr;
#pragma unroll
        for (int ai = 0; ai < 2; ++ai)
#pragma unroll
            for (int m = 0; m < 4; ++m) { const int ch = row0 + ai * 128 + m * 16; if (ch >= S5CH) continue;
#pragma unroll
                for (int bj = 0; bj < 2; ++bj) { const int col = bj * 128 + wc * 32 + 8 * fq, t = col >> 4, p0 = col & 15;
                    const f32x4 v0 = acc[ai][bj][m][0], v1 = acc[ai][bj][m][1];
                    u32x4 w; w.x = pk2(gelu_tanh(v0[0]), gelu_tanh(v0[1])); w.y = pk2(gelu_tanh(v0[2]), gelu_tanh(v0[3])); w.z = pk2(gelu_tanh(v1[0]), gelu_tanh(v1[1])); w.w = pk2(gelu_tanh(v1[2]), gelu_tanh(v1[3]));
                    *(u32x4*)(Z + ((size_t)ch * 16 + t) * 256 + u.e * 16 + p0) = w; } }
    }
};
struct SchedGlu {
    unsigned A, B; int G, c, li;
    DI bool next(int i, Unit& u) const {
        const int L = i * G + c; if (L >= (li == 0 ? 136 : 128)) return false;
        u.pm = pm_of(li, L); u.pn = 0; u.e = 0; u.br = 0; u.a = A + (unsigned)u.pm * 256u * 256u * 2u; u.b = B; u.uniform(); return true;
    }
};
struct EpiGlu {
    static constexpr bool PERM = true;
    bf16_t* O; const bf16_t* Z;
    DI void operator()(const f32x4 (&acc)[2][2][4][2], const Unit& u, int wr, int wc, int fr, int fq) const {
        const int row0 = u.pm * 256 + wr * 64 + fr, col0 = wc * 32 + 8 * fq;
#pragma unroll
        for (int ai = 0; ai < 2; ++ai)
#pragma unroll
            for (int m = 0; m < 4; ++m) { const size_t row = (size_t)(row0 + ai * 128 + m * 16);
#pragma unroll
                for (int bj = 0; bj < 2; ++bj) { const int col = col0 + bj * 128; const u32x4 z = *(const u32x4*)(Z + row * 256 + col);
                    const f32x4 v0 = acc[ai][bj][m][0], v1 = acc[ai][bj][m][1];
                    u32x4 w; w.x = pk2(lo_f(z.x) * sigm(v0[0]), hi_f(z.x) * sigm(v0[1])); w.y = pk2(lo_f(z.y) * sigm(v0[2]), hi_f(z.y) * sigm(v0[3]));
                    w.z = pk2(lo_f(z.z) * sigm(v1[0]), hi_f(z.z) * sigm(v1[1])); w.w = pk2(lo_f(z.w) * sigm(v1[2]), hi_f(z.w) * sigm(v1[3]));
                    *(u32x4*)(O + row * DM + col) = w; }
                if (m == 3) asm volatile("" ::: "memory"); }
    }
};

DI void transpose_item(const float* src, size_t ldw, bf16_t* dst, size_t ldo, LAS float* scr, int lane) {
    const int kq = lane >> 3, n4 = lane & 7;
    f32x4 tv[8];
#pragma unroll
    for (int i = 0; i < 8; ++i) tv[i] = __builtin_nontemporal_load((const f32x4*)(src + (size_t)(8 * kq + i) * ldw + 4 * n4));
    LAS unsigned char* t8 = (LAS unsigned char*)scr;
#pragma unroll
    for (int j = 0; j < 4; ++j) { u32x4 w; w.x = pk2(tv[0][j], tv[1][j]); w.y = pk2(tv[2][j], tv[3][j]); w.z = pk2(tv[4][j], tv[5][j]); w.w = pk2(tv[6][j], tv[7][j]);
        *(LAS u32x4*)(t8 + (4 * n4 + j) * 144 + 16 * kq) = w; }
    LDS_WAIT(); asm volatile("" ::: "memory");
    { const int n = lane >> 1, hf = lane & 1; const LAS u32x4* rp = (const LAS u32x4*)(t8 + n * 144 + 64 * hf);
      const u32x4 a0 = rp[0], a1 = rp[1], a2 = rp[2], a3 = rp[3];
      u32x4* gp = (u32x4*)(dst + (size_t)n * ldo + 32 * hf);
      gp[0] = a0; gp[1] = a1; gp[2] = a2; gp[3] = a3; }
    LDS_WAIT(); asm volatile("" ::: "memory");
}
DI void tr_plain(const float* W, int K, int N, bf16_t* WT, LAS float* scr, int item, int lane) {
    const int nblk = N / 32, kb = item / nblk, nb = item % nblk;
    transpose_item(W + (size_t)(64 * kb) * N + 32 * nb, N, WT + (size_t)(32 * nb) * K + 64 * kb, K, scr, lane);
}
DI void transpose_item8(const float* src, size_t ldw, unsigned char* dst, size_t ldo, LAS float* scr, int lane) {
    const int kq = lane >> 3, n4 = lane & 7;
    f32x4 tv[8];
#pragma unroll
    for (int i = 0; i < 8; ++i) tv[i] = __builtin_nontemporal_load((const f32x4*)(src + (size_t)(8 * kq + i) * ldw + 4 * n4));
    LAS unsigned char* t8 = (LAS unsigned char*)scr;
#pragma unroll
    for (int j = 0; j < 4; ++j) { u32x2 w; w.x = pk4_fp8(tv[0][j] * FP8_WS, tv[1][j] * FP8_WS, tv[2][j] * FP8_WS, tv[3][j] * FP8_WS); w.y = pk4_fp8(tv[4][j] * FP8_WS, tv[5][j] * FP8_WS, tv[6][j] * FP8_WS, tv[7][j] * FP8_WS);
        *(LAS u32x2*)(t8 + (4 * n4 + j) * 72 + 8 * kq) = w; }
    LDS_WAIT(); asm volatile("" ::: "memory");
    { const int n = lane >> 1, hf = lane & 1; const LAS u32x2* rp = (const LAS u32x2*)(t8 + n * 72 + 32 * hf);
      const u32x2 a0 = rp[0], a1 = rp[1], a2 = rp[2], a3 = rp[3];
      u32x4* gp = (u32x4*)(dst + (size_t)n * ldo + 32 * hf);
      gp[0] = (u32x4){a0.x, a0.y, a1.x, a1.y}; gp[1] = (u32x4){a2.x, a2.y, a3.x, a3.y}; }
    LDS_WAIT(); asm volatile("" ::: "memory");
}
DI void tr_gu(const float* W, unsigned char* W1T, int half, LAS float* scr, int item, int lane) {
    const int nblk = DF / 32, kb = item / nblk, nb = item % nblk, n0 = 32 * nb, drow = (n0 / 128) * 256 + half * 128 + (n0 % 128);
    transpose_item8(W + (size_t)(64 * kb) * DF + n0, DF, W1T + (size_t)drow * DM + 64 * kb, DM, scr, lane);
}
DI bool convert_pull(const Ctx& C, int li, int n, LAS float* scr, int lane) {
    constexpr int PER = 16 * 88;
    constexpr int TOT = 3 * NE * PER, NQ = 8, PERQ = TOT / NQ;
    const int qi = (int)(blockIdx.x & 7);
    unsigned* head = (unsigned*)(C.ws() + WS_CTL + 524288) + (li * NQ + qi) * 32;
    unsigned b0 = 0; if (lane == 0) b0 = atomicAdd(head, (unsigned)n);
    b0 = (unsigned)__builtin_amdgcn_readfirstlane((int)b0);
    if (b0 >= (unsigned)PERQ) return false;
#pragma unroll 1
    for (int k = 0; k < n; ++k) { const int iq = (int)b0 + k; if (iq >= PERQ) break; const int it = qi * PERQ + iq;
        const int which = it / (NE * PER), r = it % (NE * PER), e = r / PER, item = r % PER;
        if (which == 0) tr_gu(C.in(I_EWG) + ((size_t)li * NE + e) * DM * DF, C.W1T(li) + (size_t)e * 5632 * DM, 0, scr, item, lane);
        else if (which == 1) tr_gu(C.in(I_EWU) + ((size_t)li * NE + e) * DM * DF, C.W1T(li) + (size_t)e * 5632 * DM, 1, scr, item, lane);
        else { const int nblk = DM / 32, kb = item / nblk, nb = item % nblk;
            transpose_item8(C.in(I_EWD) + ((size_t)li * NE + e) * DF * DM + (size_t)(64 * kb) * DM + 32 * nb, DM, C.W2T(li) + (size_t)e * DM * DF + (size_t)(32 * nb) * DF + 64 * kb, DF, scr, lane); } }
    return true;
}
DI void convert_experts(const Ctx& C, int li, int it0, int gw, int ngw, LAS float* scr, int lane) { while (convert_pull(C, li, 4, scr, lane)) { } }
DI void phase_prologue(const Ctx& C, LAS unsigned char* lds, int gw, int ngw, int wave, int lane) {
    const int tid_ = wave * 64 + lane;
    if (blockIdx.x < 96) { for (int li = 0; li < 2; ++li) {
        const int col = (blockIdx.x % 96) * 64 + lane; const float* w = C.in(I_ADAW) + (size_t)li * DM * 6144 + (size_t)(128 * wave) * 6144 + col;
        float cr[9][2];
#pragma unroll
        for (int q = 0; q < 9; ++q)
#pragma unroll
            for (int j = 0; j < 2; ++j) { const int k = 128 * wave + 64 * j + lane; cr[q][j] = silu_(q < 8 ? C.in(I_C)[q * 1024 + k] : C.in(I_CCTX)[k]); }
        float acc[9];
#pragma unroll
        for (int q = 0; q < 9; ++q) acc[q] = 0.f;
#pragma unroll
        for (int k0 = 0; k0 < 128; k0 += 32) { float wv[32];
#pragma unroll
            for (int k = 0; k < 32; ++k) wv[k] = w[(size_t)(k0 + k) * 6144];
#pragma unroll
            for (int k = 0; k < 32; ++k)
#pragma unroll
                for (int q = 0; q < 9; ++q) acc[q] += __uint_as_float(__builtin_amdgcn_readlane(__float_as_uint(cr[q][(k0 + k) >> 6]), (k0 + k) & 63)) * wv[k]; }
        LAS float* red = (LAS float*)(lds + 40960);
#pragma unroll
        for (int q = 0; q < 9; ++q) red[(wave * 9 + q) * 64 + lane] = acc[q];
        __syncthreads();
        for (int e = tid_; e < 9 * 64; e += 512) { const int q = e >> 6, cl = e & 63; float sum = 0.f;
#pragma unroll
            for (int wv2 = 0; wv2 < 8; ++wv2) sum += red[(wv2 * 9 + q) * 64 + cl];
            const int cc = (blockIdx.x % 96) * 64 + cl; C.mod()[(li * 9 + q) * 6144 + cc] = sum + C.in(I_ADAB)[li * 6144 + cc]; }
        __syncthreads(); }
    } else if (blockIdx.x < 224) { const int j = blockIdx.x - 96; s5_build_w(C, j >> 6, (j >> 2) & 15, j & 3, (LAS float*)(lds + 40960), tid_); }
    LAS float* scr = (LAS float*)(lds + 40960 + wave * 8704);
    if (blockIdx.x == 0 && tid_ < 256) {
        const float v0 = C.in(I_HGLB)[tid_], v1 = C.in(I_HGLB)[256 + tid_];
        C.lb()[tid_] = 0.f; C.lb()[256 + tid_] = 1.0f / (1.0f + expf(v0 - v1));
    }
    constexpr int N_MOD = 0, N_WIN = 2 * 16 * 232,     N_WBR = 8 * 4 * 32, N_WOUT = 2 * 16 * 32, N_GLU = 2 * 4 * 8;
    for (int it = gw; it < N_MOD + N_WIN + N_WBR + N_WOUT + N_GLU; it += ngw) {
        int r = it;
        r -= N_MOD;
        if (r < N_WIN) { const int li = r / (16 * 232), it2 = r % (16 * 232), kb = it2 / 232, nb = it2 % 232; const float* src = C.in(I_WIN) + (size_t)li * DM * DIN + (size_t)(64 * kb) * DIN + 32 * nb;
            if (nb < C_GATE / 32) {
                const int tl_ = nb >> 3, q_ = nb & 7, nbd = (tl_ == 1 || tl_ == 2 || tl_ == 9 || tl_ == 10) ? (tl_ * 8 + 4 * (q_ & 1) + (q_ >> 1)) : nb;
                transpose_item(src, DIN, C.win() + (size_t)li * DIN * DM + (size_t)(32 * nbd) * DM + 64 * kb, DM, scr, lane); }
            else transpose_item8(src, DIN, C.ws() + WS_WIN + (size_t)li * DIN * DM * 2 + WS_WIN8_OFF + (size_t)(32 * nb - C_GATE) * DM + 64 * kb, DM, scr, lane);
            continue; }
        r -= N_WIN;
        if (r < N_WBR) { const int m = r / 128, it2 = r % 128, kb = it2 / 32, nb = it2 % 32;
            transpose_item(C.in(I_WBR) + (size_t)m * 256 * DM + (size_t)(64 * kb) * DM + 32 * nb, DM, C.wbr() + (size_t)(m >> 2) * DM * DM + (size_t)(32 * nb) * DM + (m & 3) * 256 + 64 * kb, DM, scr, lane); continue; }
        r -= N_WBR;
        if (r < N_WOUT) { const int li = r / 512; tr_plain(C.in(I_WOUT) + (size_t)li * DM * DM, DM, DM, C.wout() + (size_t)li * DM * DM, scr, r % 512, lane); continue; }
        r -= N_WOUT;
        { const int li = r / 32; tr_plain(C.in(I_GLU) + (size_t)li * 65536, 256, 256, C.GLUT() + (size_t)li * 65536, scr, r % 32, lane); }
    }
}

DI int moe_sel_load(const Ctx& C, size_t R, int lane) { return lane < NE ? C.sel()[(size_t)lane * NTOK + R] : -1; }
struct SelList { const bf16_t* p0; const bf16_t* p1; const bf16_t* p2; int cnt; };
DI SelList moe_sel_list(const Ctx& C, int sv) {
    SelList L; L.p0 = nullptr; L.p1 = nullptr; L.p2 = nullptr; L.cnt = 0;
#pragma unroll
    for (int e = 0; e < NE; ++e) { const int sl = __builtin_amdgcn_readlane(sv, e);
        if (sl >= 0) { const bf16_t* y = C.XE() + ((size_t)e * EROWS + sl) * DM; if (L.cnt == 0) L.p0 = y; else if (L.cnt == 1) L.p1 = y; else if (L.cnt == 2) L.p2 = y; ++L.cnt; } }
    return L;
}
DI void moe_gather(const bf16_t* y, u32x2 (&g)[4], int lane) {
#pragma unroll
    for (int j = 0; j < 4; ++j) g[j] = __builtin_nontemporal_load((const u32x2*)(y + 4 * (lane + 64 * j)));
}
DI void moe_acc(f32x4 (&a)[4], const u32x2 (&g)[4]) {
#pragma unroll
    for (int j = 0; j < 4; ++j) { a[j][0] += lo_f(g[j].x); a[j][1] += hi_f(g[j].x); a[j][2] += lo_f(g[j].y); a[j][3] += hi_f(g[j].y); }
}
DI void moe_combine2(const Ctx& C, int sv0, int sv1, bool ok0, bool ok1, const float* g20, const float* g21, f32x4 (&v0)[4], f32x4 (&v1)[4], int lane) {
    SelList L0 = moe_sel_list(C, sv0), L1 = moe_sel_list(C, sv1);
    if (!ok0) L0.cnt = 0;
    if (!ok1) L1.cnt = 0;
    u32x2 ga[3][4], gb[3][4];
    if (L0.cnt > 0) moe_gather(L0.p0, ga[0], lane);
    if (L0.cnt > 1) moe_gather(L0.p1, ga[1], lane);
    if (L0.cnt > 2) moe_gather(L0.p2, ga[2], lane);
    if (L1.cnt > 0) moe_gather(L1.p0, gb[0], lane);
    if (L1.cnt > 1) moe_gather(L1.p1, gb[1], lane);
    if (L1.cnt > 2) moe_gather(L1.p2, gb[2], lane);
#pragma unroll
    for (int w = 0; w < 2; ++w) {
        const SelList& L = w ? L1 : L0; const int sv = w ? sv1 : sv0; f32x4 (&v)[4] = w ? v1 : v0; const float* g2 = w ? g21 : g20;
        if (L.cnt == 0) continue;
        f32x4 a[4];
#pragma unroll
        for (int j = 0; j < 4; ++j) a[j] = (f32x4){0.f, 0.f, 0.f, 0.f};
        if (w == 0) { moe_acc(a, ga[0]); if (L.cnt > 1) moe_acc(a, ga[1]); if (L.cnt > 2) moe_acc(a, ga[2]); }
        else        { moe_acc(a, gb[0]); if (L.cnt > 1) moe_acc(a, gb[1]); if (L.cnt > 2) moe_acc(a, gb[2]); }
        if (L.cnt > 3) { int seen = 0;
#pragma unroll 1
            for (int e = 0; e < NE; ++e) { const int sl = __builtin_amdgcn_readlane(sv, e);
                if (sl >= 0) { if (seen >= 3) { u32x2 g[4]; moe_gather(C.XE() + ((size_t)e * EROWS + sl) * DM, g, lane); moe_acc(a, g); } ++seen; } } }
#pragma unroll
        for (int j = 0; j < 4; ++j) v[j] = v[j] + *(const f32x4*)(g2 + 4 * (lane + 64 * j)) * a[j];
    }
}
DI void norm1_row(const Ctx& C, int li, int R, const float* nw, int lane, bf16_t* Xout, f32x4 (&v)[4]) {
    const int b = R / LSEQ, i = R % LSEQ, mr = (i < CTXL) ? 8 : b;
    float ss = 0.f;
#pragma unroll
    for (int j = 0; j < 4; ++j) { if (li > 0) { u32x2 w; w.x = pk2(v[j][0], v[j][1]); w.y = pk2(v[j][2], v[j][3]); *(u32x2*)(Xout + (size_t)R * DM + 4 * (lane + 64 * j)) = w; }     ss += v[j][0] * v[j][0] + v[j][1] * v[j][1] + v[j][2] * v[j][2] + v[j][3] * v[j][3]; }
    const float rstd = 1.0f / sqrtf(wave_sum(ss) * (1.0f / DM) + EPS);
    const float* md = C.mod() + (li * 9 + mr) * 6144;
#pragma unroll
    for (int j = 0; j < 4; ++j) { const int c = 4 * (lane + 64 * j);
        const f32x4 w = *(const f32x4*)(nw + c), sh = *(const f32x4*)(md + c), sc = *(const f32x4*)(md + 1024 + c);
        const f32x4 h = v[j] * rstd * w * (sc + 1.0f) + sh;
        u32x2 o; o.x = pk2(h[0], h[1]); o.y = pk2(h[2], h[3]);
        *(u32x2*)(C.H() + (size_t)R * DM + c) = o;
        *(unsigned*)(C.ws() + WS_H8 + (size_t)R * DM + c) = pk4_fp8(h[0] * FP8_XS, h[1] * FP8_XS, h[2] * FP8_XS, h[3] * FP8_XS); }
}
DI const float* xrow_src(const Ctx& C, int R) {
    const int b = R / LSEQ, i = R % LSEQ;
    return (i < CTXL) ? C.in(I_CTX) + ((size_t)b * CTXL + i) * DM : C.in(I_X) + ((size_t)b * SEQ + (i - CTXL)) * DM;
}
DI void phase_norm1(const Ctx& C, int li, int gw, int ngw, int lane, bf16_t* Xout) {
    const float* nw = C.in(I_NMIX) + li * DM;
    for (int R = gw; R < NTOK; R += 4 * ngw) {
        f32x4 v[4][4]; int sv[4];
#pragma unroll
        for (int q = 0; q < 4; ++q) { const int Rq = R + q * ngw; sv[q] = -1; if (Rq < NTOK) {
            if (li > 0) { sv[q] = moe_sel_load(C, (size_t)Rq, lane); const bf16_t* src = C.X() + (size_t)Rq * DM;
#pragma unroll
                for (int j = 0; j < 4; ++j) { const u32x2 w = *(const u32x2*)(src + 4 * (lane + 64 * j)); v[q][j] = (f32x4){lo_f(w.x), hi_f(w.x), lo_f(w.y), hi_f(w.y)}; } }
            else { const float* src = xrow_src(C, Rq);
#pragma unroll
                for (int j = 0; j < 4; ++j) v[q][j] = *(const f32x4*)(src + 4 * (lane + 64 * j)); } } }
        if (li > 0) {
#pragma unroll
            for (int q = 0; q < 4; q += 2) { const int Ra = R + q * ngw, Rb = R + (q + 1) * ngw; const bool oka = Ra < NTOK, okb = Rb < NTOK;
                const int ia = oka ? Ra % LSEQ : 0, ib = okb ? Rb % LSEQ : 0, mra = (ia < CTXL) ? 8 : Ra / LSEQ, mrb = (ib < CTXL) ? 8 : (okb ? Rb / LSEQ : 0);
                moe_combine2(C, sv[q], sv[q + 1], oka, okb, C.mod() + ((li - 1) * 9 + mra) * 6144 + 5 * 1024, C.mod() + ((li - 1) * 9 + mrb) * 6144 + 5 * 1024, v[q], v[q + 1], lane); } }
#pragma unroll
        for (int q = 0; q < 4; ++q) { const int Rq = R + q * ngw; if (Rq < NTOK) norm1_row(C, li, Rq, nw, lane, Xout, v[q]); }
    }
}
DI void phase_final(const Ctx& C, int gw, int ngw, int lane) {
    for (int t0 = gw; t0 < NB * SEQ; t0 += 4 * ngw) {
        f32x4 v[4][4]; int sv[4];
#pragma unroll
        for (int q = 0; q < 4; ++q) { const int t = t0 + q * ngw; sv[q] = -1; if (t < NB * SEQ) { const size_t R = (size_t)(t / SEQ) * LSEQ + CTXL + (t % SEQ); sv[q] = moe_sel_load(C, R, lane);
#pragma unroll
            for (int j = 0; j < 4; ++j) { const u32x2 w = __builtin_nontemporal_load((const u32x2*)(C.X() + R * DM + 4 * (lane + 64 * j))); v[q][j] = (f32x4){lo_f(w.x), hi_f(w.x), lo_f(w.y), hi_f(w.y)}; } } }
#pragma unroll
        for (int q = 0; q < 4; q += 2) { const int ta = t0 + q * ngw, tb = t0 + (q + 1) * ngw; const bool oka = ta < NB * SEQ, okb = tb < NB * SEQ; const int ba = oka ? ta / SEQ : 0, bb = okb ? tb / SEQ : 0;
            moe_combine2(C, sv[q], sv[q + 1], oka, okb, C.mod() + (1 * 9 + ba) * 6144 + 5 * 1024, C.mod() + (1 * 9 + bb) * 6144 + 5 * 1024, v[q], v[q + 1], lane); }
#pragma unroll
        for (int q = 0; q < 4; ++q) { const int t = t0 + q * ngw; if (t < NB * SEQ) {
#pragma unroll
            for (int j = 0; j < 4; ++j) __builtin_nontemporal_store(v[q][j], (f32x4*)(C.out() + (size_t)t * DM + 4 * (lane + 64 * j))); } }
    }
}

DI void router_prep(const Ctx& C, int li, int gw, int ngw, int lane) {
    const float* rw = C.in(I_RW) + (size_t)li * DM * NE; const float* nw = C.in(I_NFFN) + li * DM;
    const int e = lane & 15, kb = lane >> 4;
    for (int it = gw; it < 9 * 32 + 9 * 8; it += ngw) {
        if (it < 9 * 32) { const int mr = it >> 5, s2 = it & 31; const float* md = C.mod() + (li * 9 + mr) * 6144 + 4 * 1024;
            float wm[8];
#pragma unroll
            for (int j = 0; j < 8; ++j) { const int k = 32 * s2 + 8 * kb + j; wm[j] = rw[k * NE + e] * nw[k] * (1.0f + md[k]); }
            u32x4 hi, lo; hi.x = pk2(wm[0], wm[1]); hi.y = pk2(wm[2], wm[3]); hi.z = pk2(wm[4], wm[5]); hi.w = pk2(wm[6], wm[7]);
            lo.x = pk2(wm[0] - lo_f(hi.x), wm[1] - hi_f(hi.x)); lo.y = pk2(wm[2] - lo_f(hi.y), wm[3] - hi_f(hi.y)); lo.z = pk2(wm[4] - lo_f(hi.z), wm[5] - hi_f(hi.z)); lo.w = pk2(wm[6] - lo_f(hi.w), wm[7] - hi_f(hi.w));
            unsigned char* dst = C.ws() + WS_WMF + (size_t)it * 2048 + lane * 16;
            *(u32x4*)dst = hi; *(u32x4*)(dst + 1024) = lo; }
        else { const int it2 = it - 9 * 32, mr = it2 >> 3, q = it2 & 7; const float* sh = C.mod() + (li * 9 + mr) * 6144 + 3 * 1024; float sum = 0.f;
#pragma unroll
            for (int i = 0; i < 32; ++i) { const int k = 128 * q + kb + 4 * i; sum += sh[k] * rw[k * NE + e]; }
            sum += shx<16>(sum); sum += shx<32>(sum);
            if (lane < 16) ((float*)(C.ws() + WS_RB))[it2 * 16 + e] = sum; }
    }
}
DI void phase_norm2(const Ctx& C, int li, LAS unsigned char* lds, int gw, int ngw, int wave, int lane) {
    const int tk = lane & 15, kb = lane >> 4, tid_ = wave * 64 + lane, tsel = wave >> 2, kq = wave & 3;
    LAS unsigned char* wfl = lds;
    LAS float* wmt = (LAS float*)(lds + 65536); LAS float* sht = wmt + 1024;
    LAS float* red = sht + 1024;
    const float* nw = C.in(I_NFFN) + li * DM;
    constexpr int NPAIR = NTOK / 32;
    const bool lat_only = (li == DEPTH - 1);
    const int NQ = lat_only ? NB * (SEQ / 32) : NPAIR;
    const int p0 = (int)(((long)blockIdx.x * NQ) / (long)gridDim.x), p1 = (int)(((long)(blockIdx.x + 1) * NQ) / (long)gridDim.x);
    int cur_mr = -1, par = 0;
    for (int q_ = p0; q_ < p1; ++q_) {
        const int p = lat_only ? (q_ / (SEQ / 32)) * (LSEQ / 32) + CTXL / 32 + (q_ % (SEQ / 32)) : q_;
        const int R00 = p * 32, b = R00 / LSEQ, i0 = R00 % LSEQ, mr = (i0 < CTXL) ? 8 : b;
        if (mr != cur_mr) { cur_mr = mr;
            __syncthreads();
            const u32x4* src = (const u32x4*)(C.ws() + WS_WMF + (size_t)mr * 32 * 2048);
#pragma unroll
            for (int i = 0; i < 8; ++i) ((LAS u32x4*)wfl)[tid_ + 512 * i] = src[tid_ + 512 * i];
            const float* md = C.mod() + (li * 9 + mr) * 6144;
            for (int c = tid_; c < DM; c += 512) { wmt[c] = nw[c] * (1.0f + md[4 * 1024 + c]); sht[c] = md[3 * 1024 + c]; }
            __syncthreads(); }
        const int R0 = R00 + tsel * 16;
        const bf16_t* xr = C.X() + (size_t)(R0 + tk) * DM + 256 * kq + 8 * kb;
        u32x4 hr[8];
#pragma unroll
        for (int i = 0; i < 8; ++i) hr[i] = *(const u32x4*)(xr + 32 * i);
        f32x4 acc = (f32x4){0.f, 0.f, 0.f, 0.f}; float ss = 0.f;
#pragma unroll
        for (int i = 0; i < 8; ++i) { const int s2 = 8 * kq + i; const u32x4 h = hr[i];
            const bf16x8 wh = *(const LAS bf16x8*)(wfl + s2 * 2048 + lane * 16), wl = *(const LAS bf16x8*)(wfl + s2 * 2048 + 1024 + lane * 16);
            const f32x4 x0 = (f32x4){lo_f(h.x), hi_f(h.x), lo_f(h.y), hi_f(h.y)}, x1 = (f32x4){lo_f(h.z), hi_f(h.z), lo_f(h.w), hi_f(h.w)};
            ss += x0[0] * x0[0] + x0[1] * x0[1] + x0[2] * x0[2] + x0[3] * x0[3] + x1[0] * x1[0] + x1[1] * x1[1] + x1[2] * x1[2] + x1[3] * x1[3];
            const bf16x8 xh = __builtin_bit_cast(bf16x8, h);
            acc = __builtin_amdgcn_mfma_f32_16x16x32_bf16(wh, xh, acc, 0, 0, 0);
            acc = __builtin_amdgcn_mfma_f32_16x16x32_bf16(wl, xh, acc, 0, 0, 0); }
        ss += shx<16>(ss); ss += shx<32>(ss);
        LAS float* rt = red + ((par * 2 + tsel) * 4) * 272;
        *(LAS f32x4*)(rt + kq * 272 + lane * 4) = acc; if (kb == 0) rt[kq * 272 + 256 + tk] = ss;
        __syncthreads();
        f32x4 at = (f32x4){0.f, 0.f, 0.f, 0.f}; float st = 0.f;
#pragma unroll
        for (int q = 0; q < 4; ++q) { at = at + *(const LAS f32x4*)(rt + q * 272 + lane * 4); st += rt[q * 272 + 256 + tk]; }
        par ^= 1;
        const float rstd = 1.0f / sqrtf(st * (1.0f / DM) + EPS);
        if (kq == 0) {
            f32x4 bias = (f32x4){0.f, 0.f, 0.f, 0.f};
#pragma unroll
            for (int q = 0; q < 8; ++q) bias = bias + *(const f32x4*)((const float*)(C.ws() + WS_RB) + (mr * 8 + q) * 16 + 4 * kb);
            const f32x4 lg = at * rstd + bias;
            float mx = fmaxf(fmaxf(lg[0], lg[1]), fmaxf(lg[2], lg[3])); mx = fmaxf(mx, shx<16>(mx)); mx = fmaxf(mx, shx<32>(mx));
            const f32x4 ex = (f32x4){expf(lg[0] - mx), expf(lg[1] - mx), expf(lg[2] - mx), expf(lg[3] - mx)};
            float den = (ex[0] + ex[1]) + (ex[2] + ex[3]); den += shx<16>(den); den += shx<32>(den);
            const float inv = 1.0f / den;
            *(f32x4*)(C.aff() + (size_t)(R0 + tk) * NE + 4 * kb) = ex * inv; }
        unsigned char* hp = (unsigned char*)C.H() + (size_t)(R0 + tk) * DM + 256 * kq + 8 * kb;
#pragma unroll
        for (int i = 0; i < 8; ++i) { const u32x4 hw = hr[i]; const int c0 = 256 * kq + 32 * i + 8 * kb;
            const f32x4 w0 = *(const LAS f32x4*)(wmt + c0), w1 = *(const LAS f32x4*)(wmt + c0 + 4), b0 = *(const LAS f32x4*)(sht + c0), b1 = *(const LAS f32x4*)(sht + c0 + 4);
            const f32x4 h0 = ((f32x4){lo_f(hw.x), hi_f(hw.x), lo_f(hw.y), hi_f(hw.y)} * rstd * w0 + b0) * FP8_XS, h1 = ((f32x4){lo_f(hw.z), hi_f(hw.z), lo_f(hw.w), hi_f(hw.w)} * rstd * w1 + b1) * FP8_XS;
            u32x2 o; o.x = pk4_fp8(h0[0], h0[1], h0[2], h0[3]); o.y = pk4_fp8(h1[0], h1[1], h1[2], h1[3]);
            *(u32x2*)(hp + 32 * i) = o; }
    }
}

DI void phase_topk(const Ctx& C, int li, LAS unsigned char* lds, int wave, int lane) {
    LAS unsigned* cnt = (LAS unsigned*)lds;
    LAS int* rows = (LAS int*)(lds + 256);
    const int tid = wave * 64 + lane, nunit = (li == DEPTH - 1) ? 128 : 256;
    for (int u = blockIdx.x; u < nunit; u += gridDim.x) {
        const int kind = u >> 7, b = (u >> 4) & 7, e = u & 15;
        const int n = kind ? CTXL : SEQ, cap = kind ? CAP_C : CAP_L, per = n / 512 + (kind ? 1 : 0);
        const size_t rbase = (size_t)b * LSEQ + (kind ? 0 : CTXL);
        unsigned v[8];
#pragma unroll
        for (int j = 0; j < 8; ++j) { const int t = tid + 512 * j; v[j] = (j < per && t < n) ? __float_as_uint(C.aff()[(rbase + t) * NE + e]) : 0u; }
        if (tid < 48) cnt[tid] = 0u;
        __syncthreads();
        unsigned thr = 0u;
        for (int bit = 30; bit >= 0; --bit) {
            const unsigned cand = thr | (1u << bit);
            unsigned c = 0;
#pragma unroll
            for (int j = 0; j < 8; ++j) c += (unsigned)__builtin_popcountll(__builtin_amdgcn_ballot_w64(v[j] >= cand));
            if (lane == 0) atomicAdd((unsigned*)cnt + 8 + bit, c);
            __syncthreads();
            if (cnt[8 + bit] >= (unsigned)cap) thr = cand;
        }
        unsigned ngt = 0;
#pragma unroll
        for (int j = 0; j < 8; ++j) ngt += (unsigned)__builtin_popcountll(__builtin_amdgcn_ballot_w64(v[j] > thr));
        if (lane == 0) atomicAdd((unsigned*)cnt + 1, ngt);
        __syncthreads();
        const unsigned n_gt = cnt[1];
        __syncthreads();
        if (tid == 0) cnt[1] = 0u;
        __syncthreads();
        const int srow0 = kind ? (NB * CAP_L + b * CAP_C) : b * CAP_L;
#pragma unroll
        for (int j = 0; j < 8; ++j) { const int t = tid + 512 * j;
            if (j < per && t < n) {
                int slot = -1;
                if (v[j] > thr) slot = (int)atomicAdd((unsigned*)cnt + 1, 1u);
                else if (v[j] == thr) { const unsigned k = atomicAdd((unsigned*)cnt + 2, 1u); if (n_gt + k < (unsigned)cap) slot = (int)(n_gt + k); }
                C.sel()[(size_t)e * NTOK + rbase + t] = (slot >= 0) ? srow0 + slot : -1;
                if (slot >= 0) { rows[slot] = (int)(rbase + t); C.gate()[(size_t)e * EROWS + srow0 + slot] = __uint_as_float(v[j]); }
            } }
        __syncthreads();
        for (int s0 = wave; s0 < cap; s0 += 128) {
            u32x4 xa[16];
#pragma unroll
            for (int q = 0; q < 16; ++q) { const int sq = s0 + 8 * q; if (sq < cap) xa[q] = *((const u32x4*)((const unsigned char*)C.H() + (size_t)rows[sq] * DM) + lane); }
#pragma unroll
            for (int q = 0; q < 16; ++q) { const int sq = s0 + 8 * q; if (sq < cap) *((u32x4*)((unsigned char*)C.XE() + ((size_t)e * EROWS + srow0 + sq) * DM) + lane) = xa[q]; }
        }
        __syncthreads();
    }
}

DI void phase_prep(const Ctx& C, int li, int gw, int ngw, int lane) {
    const float* wq = C.in(I_NAQN) + li * 64; const float* wk = C.in(I_NAKN) + li * 64;
    const int d0 = (lane & 7) * 8; const bool isq = lane < 32;
    float w[8];
#pragma unroll
    for (int j = 0; j < 8; ++j) w[j] = isq ? wq[d0 + j] * 0.125f : wk[d0 + j];
    for (int R0 = gw; R0 < NTOK; R0 += 4 * ngw) {
        u32x4 xq[4];
#pragma unroll
        for (int q = 0; q < 4; ++q) { const int R = R0 + q * ngw; if (R < NTOK) xq[q] = *(const u32x4*)(C.P() + (size_t)R * DIN + C_NAQ + 8 * lane); }
#pragma unroll
        for (int q = 0; q < 4; ++q) { const int R = R0 + q * ngw; if (R >= NTOK) continue; const u32x4 x = xq[q];
            float f[8] = {lo_f(x.x), hi_f(x.x), lo_f(x.y), hi_f(x.y), lo_f(x.z), hi_f(x.z), lo_f(x.w), hi_f(x.w)};
            float ss = 0.f;
#pragma unroll
            for (int j = 0; j < 8; ++j) ss += f[j] * f[j];
            ss += shx<1>(ss); ss += shx<2>(ss); ss += shx<4>(ss);
            const float rs = __builtin_amdgcn_rsqf(ss * (1.0f / 64.0f) + EPS);
            u32x4 o; o.x = pk2(f[0] * rs * w[0], f[1] * rs * w[1]); o.y = pk2(f[2] * rs * w[2], f[3] * rs * w[3]); o.z = pk2(f[4] * rs * w[4], f[5] * rs * w[5]); o.w = pk2(f[6] * rs * w[6], f[7] * rs * w[7]);
            *(u32x4*)(C.QKN() + (size_t)R * 512 + 8 * lane) = o; }
    }
}

typedef short s16x4 __attribute__((ext_vector_type(4)));
#define MFMA16(a, b, c) __builtin_amdgcn_mfma_f32_16x16x32_bf16((a), (b), (c), 0, 0, 0)
DI bf16x8 ld16(const bf16_t* p) { return *(const bf16x8*)p; }
DI s16x4 tr16(const LAS bf16_t* p) { return __builtin_amdgcn_ds_read_tr16_b64_v4i16((LAS s16x4*)p); }
DI bf16x8 cat8(s16x4 a, s16x4 b) { return __builtin_shufflevector(a, b, 0, 1, 2, 3, 4, 5, 6, 7); }
DI bf16x8 pack8(const f32x4& a, const f32x4& b) { u32x4 w; w.x = pg8::cvt_pk_bf16(a[0], a[1]); w.y = pg8::cvt_pk_bf16(a[2], a[3]); w.z = pg8::cvt_pk_bf16(b[0], b[1]); w.w = pg8::cvt_pk_bf16(b[2], b[3]); return __builtin_bit_cast(bf16x8, w); }

constexpr int NA_VS = 80;
DI void na_unit(const Ctx& C, int li, int wu, bool isctx, int lane, LAS bf16_t* vl, const LAS float* rpbt) {
    const int cq = lane & 15, g = lane >> 4;
    int b, h, r, c; size_t Rq;
    if (!isctx) { c = wu & 3; h = (wu >> 2) & 3; r = (wu >> 4) & 63; b = wu >> 10; Rq = (size_t)b * LSEQ + CTXL + r * 64 + 16 * c + cq; }
    else { c = wu & 15; h = (wu >> 4) & 3; b = wu >> 6; r = 0; Rq = (size_t)b * LSEQ + 16 * c + cq; }
    const bf16_t* QKN = C.QKN(); const bf16_t* P = C.P();
    bf16x8 qf[2];
    qf[0] = ld16(QKN + Rq * 512 + h * 64 + 8 * g); qf[1] = ld16(QKN + Rq * 512 + h * 64 + 32 + 8 * g);
    f32x4 o[4];
#pragma unroll
    for (int d = 0; d < 4; ++d) o[d] = (f32x4){0.f, 0.f, 0.f, 0.f};
    float lsum = 0.f;
    const int r0 = min(max(r - 4, 0), 56), kc0 = (c == 0) ? 0 : (c == 1) ? 8 : (c == 2) ? 24 : 32, qi = 16 * c + cq, cs = min(max(qi - 8, 0), 48);
    const LAS float* rpb = rpbt + h * 465;
    const size_t rowb = (size_t)b * LSEQ;
    const int nch = isctx ? 4 : 8;
    const int dwin = kc0 + 4 * g - cs, ebias = kc0 + 4 * g - qi + 15;
    const unsigned voffV = (unsigned)((lane >> 3) * DIN + 8 * (lane & 7)) * 2u, voffK = (unsigned)(cq * 512 + 8 * g) * 2u;
    const __amdgpu_buffer_rsrc_t rsP = __builtin_amdgcn_make_buffer_rsrc((void*)P, 0, 0x7fffffff, 0x00020000), rsK = __builtin_amdgcn_make_buffer_rsrc((void*)QKN, 0, 0x7fffffff, 0x00020000);
    const unsigned Pv0 = (unsigned)(C_NAV + h * 64) * 2u, Kv0 = (unsigned)(256 + h * 64) * 2u;
#define NA_CHROW(ch_) ((!isctx && (ch_) < 4) ? (rowb + CTXL + (size_t)(r0 + 2 * (ch_)) * 64 + kc0) : (rowb + 64 * (size_t)(isctx ? (ch_) : (ch_) - 4)))
#define NA_VSTEP(ch_, i) ((!isctx && (ch_) < 4) ? (((i) >> 2) * 64 + 8 * ((i) & 3)) : 8 * (i))
#define NA_KSTEP(ch_, kb) ((!isctx && (ch_) < 4) ? (((kb) >> 1) * 64 + 16 * ((kb) & 1)) : 16 * (kb))
    bf16x8 vA[8], kA[8], vB[8], kB[8];
#define NA_PREFETCH(VR, KR, ch_) do { const size_t cr_ = NA_CHROW(ch_); \
        _Pragma("unroll") for (int i = 0; i < 8; ++i) VR[i] = __builtin_bit_cast(bf16x8, __builtin_amdgcn_raw_buffer_load_b128(rsP, voffV, (unsigned)(cr_ + NA_VSTEP(ch_, i)) * (unsigned)(DIN * 2) + Pv0, 0)); \
        _Pragma("unroll") for (int kb = 0; kb < 4; ++kb) { const unsigned ko_ = (unsigned)(cr_ + NA_KSTEP(ch_, kb)) * 1024u + Kv0; \
            KR[2 * kb] = __builtin_bit_cast(bf16x8, __builtin_amdgcn_raw_buffer_load_b128(rsK, voffK, ko_, 0)); KR[2 * kb + 1] = __builtin_bit_cast(bf16x8, __builtin_amdgcn_raw_buffer_load_b128(rsK, voffK, ko_ + 64u, 0)); } } while (0)
#define NA_BODY(VR, KR, ch_) do { const int chv = (ch_); const bool local = !isctx && chv < 4; \
          \
        _Pragma("unroll") for (int i = 0; i < 8; ++i) *(LAS bf16x8*)(vl + (lane >> 3) * NA_VS + 8 * (lane & 7) + i * 8 * NA_VS) = VR[i]; \
        f32x4 s[4]; \
        _Pragma("unroll") for (int kb = 0; kb < 4; ++kb) { s[kb] = MFMA16(KR[2 * kb], qf[0], ((f32x4){0.f, 0.f, 0.f, 0.f})); s[kb] = MFMA16(KR[2 * kb + 1], qf[1], s[kb]); } \
        asm volatile("" : "+v"(s[0]), "+v"(s[1]), "+v"(s[2]), "+v"(s[3]));     \
        if (chv + 2 < nch) NA_PREFETCH(VR, KR, chv + 2); \
        _Pragma("unroll") for (int kb = 0; kb < 4; ++kb) \
            _Pragma("unroll") for (int i = 0; i < 4; ++i) { float pv; \
                if (local) { const int dcol = dwin + 16 * (kb & 1) + i; const bool ok = (unsigned)dcol < 16u; \
                    const int bi = ok ? ((r0 + 2 * chv + (kb >> 1) - r + 7) * 31 + ebias + 16 * (kb & 1) + i) : 0; \
                    pv = ok ? __expf(s[kb][i] + rpb[bi] - 8.0f) : 0.f; } \
                else pv = __expf(s[kb][i] - 8.0f); \
                s[kb][i] = pv; lsum += pv; } \
        const bf16x8 pb0 = pack8(s[0], s[1]), pb1 = pack8(s[2], s[3]); \
        const int q4 = cq >> 2, p4 = cq & 3; \
        _Pragma("unroll") for (int db = 0; db < 4; ++db) { \
            const LAS bf16_t* base = vl + (4 * g + q4) * NA_VS + 16 * db + 4 * p4; \
            const bf16x8 va0 = cat8(tr16(base), tr16(base + 16 * NA_VS)), va1 = cat8(tr16(base + 32 * NA_VS), tr16(base + 48 * NA_VS)); \
            o[db] = MFMA16(va0, pb0, o[db]); o[db] = MFMA16(va1, pb1, o[db]); } } while (0)
    NA_PREFETCH(vA, kA, 0); NA_PREFETCH(vB, kB, 1);
    for (int ch = 0; ch < nch; ch += 2) { NA_BODY(vA, kA, ch); NA_BODY(vB, kB, ch + 1); }
#undef NA_BODY
#undef NA_CHROW
#undef NA_VSTEP
#undef NA_KSTEP
#undef NA_PREFETCH
    lsum += shx<16>(lsum); lsum += shx<32>(lsum);
    const float il = 1.0f / lsum;
    bf16_t* op = C.O() + Rq * DM + 256 + h * 64 + 4 * g;
#pragma unroll
    for (int db = 0; db < 4; ++db) { u32x2 w; w.x = pk2(o[db][0] * il, o[db][1] * il); w.y = pk2(o[db][2] * il, o[db][3] * il); *(u32x2*)(op + 16 * db) = w; }
}


DI void prep_ret(const Ctx& C, int li, int gw, int ngw, int lane) {
    const int rsub = lane >> 4, h = (lane >> 2) & 3, jb = lane & 3;
    const float lg0 = __log2f(sigm(C.in(I_RETD)[(li * 2 + 0) * 4 + h])), lg1 = __log2f(sigm(C.in(I_RETD)[(li * 2 + 1) * 4 + h]));
    float inv[8];
#pragma unroll
    for (int e = 0; e < 8; ++e) inv[e] = exp2f(-(float)(8 * (jb & 1) + e) * (13.287712379549449f / 16.0f));
    bf16_t* RP = C.RETP(); const bf16_t* P = C.P();
    u32x4 n1, n2, n3, n4;
    if (gw < NTOK / 4) { const size_t R = (size_t)gw * 4 + rsub; const size_t pq = R * DIN + C_RTQ + h * 64 + 8 * jb, pk = R * DIN + C_RTK + h * 64 + 8 * jb;
        n1 = *(const u32x4*)(P + pq); n2 = *(const u32x4*)(P + pq + 32); n3 = *(const u32x4*)(P + pk); n4 = *(const u32x4*)(P + pk + 32); }
    for (int it = gw; it < NTOK / 4; it += ngw) {
        const size_t R = (size_t)it * 4 + rsub; const int i = (int)(R % LSEQ), il = i & 63;
        const u32x4 q1w = n1, q2w = n2, k1w = n3, k2w = n4;
        { const int itn = it + ngw; if (itn < NTOK / 4) { const size_t Rn = (size_t)itn * 4 + rsub; const size_t pq = Rn * DIN + C_RTQ + h * 64 + 8 * jb, pk = Rn * DIN + C_RTK + h * 64 + 8 * jb;
            n1 = *(const u32x4*)(P + pq); n2 = *(const u32x4*)(P + pq + 32); n3 = *(const u32x4*)(P + pk); n4 = *(const u32x4*)(P + pk + 32); } }
        float q1[8] = {lo_f(q1w.x), hi_f(q1w.x), lo_f(q1w.y), hi_f(q1w.y), lo_f(q1w.z), hi_f(q1w.z), lo_f(q1w.w), hi_f(q1w.w)};
        float q2[8] = {lo_f(q2w.x), hi_f(q2w.x), lo_f(q2w.y), hi_f(q2w.y), lo_f(q2w.z), hi_f(q2w.z), lo_f(q2w.w), hi_f(q2w.w)};
        float k1[8] = {lo_f(k1w.x), hi_f(k1w.x), lo_f(k1w.y), hi_f(k1w.y), lo_f(k1w.z), hi_f(k1w.z), lo_f(k1w.w), hi_f(k1w.w)};
        float k2[8] = {lo_f(k2w.x), hi_f(k2w.x), lo_f(k2w.y), hi_f(k2w.y), lo_f(k2w.z), hi_f(k2w.z), lo_f(k2w.w), hi_f(k2w.w)};
        if (i >= CTXL) { const int t = i - CTXL; const float pos = (float)((jb < 2) ? (t >> 6) : (t & 63));
#pragma unroll
            for (int e = 0; e < 8; ++e) { const float ang = pos * inv[e], sn = __sinf(ang), cs = __cosf(ang);
                const float a = q1[e] * cs - q2[e] * sn, b2 = q2[e] * cs + q1[e] * sn; q1[e] = a; q2[e] = b2;
                const float c2 = k1[e] * cs - k2[e] * sn, d2 = k2[e] * cs + k1[e] * sn; k1[e] = c2; k2[e] = d2; } }
        const float fil = (float)il;
        const float sq0 = exp2f(fil * lg0), sk0 = 0.125f * exp2f(-fil * lg0), sq1 = exp2f(-fil * lg1), sk1 = 0.125f * exp2f(fil * lg1);
        const size_t o = R * 256 + h * 64 + 8 * jb;
#define PK8(arr, sc) ((u32x4){pk2(arr[0] * sc, arr[1] * sc), pk2(arr[2] * sc, arr[3] * sc), pk2(arr[4] * sc, arr[5] * sc), pk2(arr[6] * sc, arr[7] * sc)})
        *(u32x4*)(RP + 0 * RETP_T + o) = PK8(q1, sq0); *(u32x4*)(RP + 0 * RETP_T + o + 32) = PK8(q2, sq0);
        *(u32x4*)(RP + 1 * RETP_T + o) = PK8(k1, sk0); *(u32x4*)(RP + 1 * RETP_T + o + 32) = PK8(k2, sk0);
        *(u32x4*)(RP + 2 * RETP_T + o) = PK8(q1, sq1); *(u32x4*)(RP + 2 * RETP_T + o + 32) = PK8(q2, sq1);
        *(u32x4*)(RP + 3 * RETP_T + o) = PK8(k1, sk1); *(u32x4*)(RP + 3 * RETP_T + o + 32) = PK8(k2, sk1);
#undef PK8
    }
}
constexpr int RT_TS = 272;
DI void stage_tile64x256(LAS bf16_t* dst, const bf16_t* src, size_t srcld, int tid) {
#pragma unroll
    for (int i = 0; i < 4; ++i) { const int p = tid + 512 * i, row = p >> 5, c16 = p & 31;
        *(LAS bf16x8*)(dst + row * RT_TS + 8 * c16) = ld16(src + (size_t)row * srcld + 8 * c16); }
}
DI size_t st_off(int b, int h, int d, int c) { return ((size_t)(((b * 4 + h) * 2 + d) * NCHK + c)) * 4096; }
DI void ret_pass1(const Ctx& C, LAS unsigned char* lds, int wave, int lane) {
    LAS bf16_t* vt = (LAS bf16_t*)lds; LAS bf16_t* k0t = vt + 64 * RT_TS; LAS bf16_t* k1t = k0t + 64 * RT_TS;
    const int tid = wave * 64 + lane, cq = lane & 15, g = lane >> 4, q4 = cq >> 2, p4 = cq & 3, h = wave & 3, d = wave >> 2;
    const bf16_t* P = C.P(); const bf16_t* RP = C.RETP(); bf16_t* ST = C.RETS();
    for (int u = blockIdx.x; u < NB * NCHK; u += gridDim.x) {
        const int b = u / NCHK, c = u % NCHK; const size_t R0 = (size_t)b * LSEQ + 64 * c;
        __syncthreads();
        stage_tile64x256(vt, P + R0 * DIN + C_RTV, DIN, tid);
        stage_tile64x256(k0t, RP + 1 * RETP_T + R0 * 256, 256, tid);
        stage_tile64x256(k1t, RP + 3 * RETP_T + R0 * 256, 256, tid);
        __syncthreads();
        const LAS bf16_t* kt = d ? k1t : k0t;
        f32x4 S[4][4];
#pragma unroll
        for (int mb = 0; mb < 4; ++mb)
#pragma unroll
            for (int nb = 0; nb < 4; ++nb) S[mb][nb] = (f32x4){0.f, 0.f, 0.f, 0.f};
#pragma unroll
        for (int ks = 0; ks < 2; ++ks) {
            bf16x8 a[4], bv[4];
#pragma unroll
            for (int mb = 0; mb < 4; ++mb) { const LAS bf16_t* p = kt + (32 * ks + 8 * g + q4) * RT_TS + h * 64 + 16 * mb + 4 * p4; a[mb] = cat8(tr16(p), tr16(p + 4 * RT_TS)); }
#pragma unroll
            for (int nb = 0; nb < 4; ++nb) { const LAS bf16_t* p = vt + (32 * ks + 8 * g + q4) * RT_TS + h * 64 + 16 * nb + 4 * p4; bv[nb] = cat8(tr16(p), tr16(p + 4 * RT_TS)); }
#pragma unroll
            for (int mb = 0; mb < 4; ++mb)
#pragma unroll
                for (int nb = 0; nb < 4; ++nb) S[mb][nb] = MFMA16(a[mb], bv[nb], S[mb][nb]);
        }
        bf16_t* sp = ST + st_off(b, h, d, c);
#pragma unroll
        for (int mb = 0; mb < 4; ++mb)
#pragma unroll
            for (int nb = 0; nb < 4; ++nb) { u32x2 w; w.x = pk2(S[mb][nb][0], S[mb][nb][1]); w.y = pk2(S[mb][nb][2], S[mb][nb][3]); *(u32x2*)(sp + (16 * nb + cq) * 64 + 16 * mb + 4 * g) = w; }
    }
}
DI int chunk_at(int d, int s) { return d == 0 ? s : (s < 4 ? 3 - s : NCHK + 3 - s); }
DI void ret_carry(const Ctx& C, int li, int gw, int ngw, int lane) {
    bf16_t* ST = C.RETS();
    for (int it = gw; it < 64 * 16; it += ngw) {
        const int chain = it >> 4, e0 = ((it & 15) * 64 + lane) * 4, d = chain & 1, h = (chain >> 1) & 3;
        const float gm = sigm(C.in(I_RETD)[(li * 2 + d) * 4 + h]), g64 = __powf(gm, 64.0f);
        const float fo = d ? g64 : gm, dc = g64, sc = d ? 1.0f : __powf(gm, 63.0f);
        const char* cb = (const char*)ST + (size_t)chain * NCHK * 8192; const unsigned voff = (unsigned)e0 * 2u;
        f32x4 S = (f32x4){0.f, 0.f, 0.f, 0.f};
#pragma unroll 1
        for (int s0 = 0; s0 < NCHK; s0 += NCHK / 2) {
            u32x2 w[NCHK / 2];
#pragma unroll
            for (int k = 0; k < NCHK / 2; ++k) w[k] = *(const u32x2*)(cb + (size_t)chunk_at(d, s0 + k) * 8192 + voff);
#pragma unroll
            for (int k = 0; k < NCHK / 2; ++k) { const f32x4 raw = (f32x4){lo_f(w[k].x), hi_f(w[k].x), lo_f(w[k].y), hi_f(w[k].y)};
                const f32x4 o = S * fo; u32x2 ow; ow.x = pk2(o[0], o[1]); ow.y = pk2(o[2], o[3]);
                *(u32x2*)((char*)cb + (size_t)chunk_at(d, s0 + k) * 8192 + voff) = ow;
                S = S * dc + raw * sc; }
        }
    }
}
DI void ret_pass2(const Ctx& C, int li, LAS unsigned char* lds, int wave, int lane) {
    LAS bf16_t* vt = (LAS bf16_t*)lds; LAS bf16_t* k0t = vt + 64 * RT_TS; LAS bf16_t* k1t = k0t + 64 * RT_TS;
    const int tid = wave * 64 + lane, cq = lane & 15, g = lane >> 4, q4 = cq >> 2, p4 = cq & 3, h = wave & 3, half = wave >> 2;
    const bf16_t* P = C.P(); const bf16_t* RP = C.RETP(); const bf16_t* ST = C.RETS(); bf16_t* O = C.O();
    const bool lastl = (li == DEPTH - 1); const int NU = lastl ? NB * 64 : NB * NCHK;
    for (int u = blockIdx.x; u < NU; u += gridDim.x) {
        const int b = lastl ? (u >> 6) : u / NCHK, c = lastl ? 4 + (u & 63) : u % NCHK; const size_t R0 = (size_t)b * LSEQ + 64 * c;
        __syncthreads();
        stage_tile64x256(vt, P + R0 * DIN + C_RTV, DIN, tid);
        stage_tile64x256(k0t, RP + 1 * RETP_T + R0 * 256, 256, tid);
        stage_tile64x256(k1t, RP + 3 * RETP_T + R0 * 256, 256, tid);
        bf16x8 sf[2][4][2];
#pragma unroll
        for (int d = 0; d < 2; ++d)
#pragma unroll
            for (int db = 0; db < 4; ++db) { const bf16_t* sp = ST + st_off(b, h, d, c) + (16 * db + cq) * 64 + 8 * g; sf[d][db][0] = ld16(sp); sf[d][db][1] = ld16(sp + 32); }
        __syncthreads();
#pragma unroll 1
        for (int ib = 2 * half; ib < 2 * half + 2; ++ib) {
            const size_t Ri = R0 + 16 * ib + cq;
            bf16x8 qb[2][2];
#pragma unroll
            for (int d = 0; d < 2; ++d)
#pragma unroll
                for (int ks = 0; ks < 2; ++ks) qb[d][ks] = ld16(RP + (size_t)(2 * d) * RETP_T + Ri * 256 + h * 64 + 32 * ks + 8 * g);
            u32x2 gq[4];
#pragma unroll
            for (int db = 0; db < 4; ++db) gq[db] = *(const u32x2*)(P + Ri * DIN + C_RTG + h * 64 + 16 * db + 4 * g);
            f32x4 pT[4];
#pragma unroll
            for (int jb = 0; jb < 4; ++jb) { const int kro = (16 * jb + cq) * RT_TS + h * 64 + 8 * g;
                f32x4 a0 = (f32x4){0.f, 0.f, 0.f, 0.f}, a1 = (f32x4){0.f, 0.f, 0.f, 0.f};
#pragma unroll
                for (int ks = 0; ks < 2; ++ks) { a0 = MFMA16(*(const LAS bf16x8*)(k0t + kro + 32 * ks), qb[0][ks], a0);
                                                 a1 = MFMA16(*(const LAS bf16x8*)(k1t + kro + 32 * ks), qb[1][ks], a1); }
#pragma unroll
                for (int e = 0; e < 4; ++e) { const int j = 16 * jb + 4 * g + e, i = 16 * ib + cq; pT[jb][e] = (j <= i ? a0[e] : 0.f) + (j >= i ? a1[e] : 0.f); } }
            const bf16x8 pb0 = pack8(pT[0], pT[1]), pb1 = pack8(pT[2], pT[3]);
            f32x4 o[4];
#pragma unroll
            for (int db = 0; db < 4; ++db) {
                const LAS bf16_t* base = vt + (4 * g + q4) * RT_TS + h * 64 + 16 * db + 4 * p4;
                const bf16x8 va0 = cat8(tr16(base), tr16(base + 16 * RT_TS)), va1 = cat8(tr16(base + 32 * RT_TS), tr16(base + 48 * RT_TS));
                o[db] = MFMA16(va0, pb0, ((f32x4){0.f, 0.f, 0.f, 0.f})); o[db] = MFMA16(va1, pb1, o[db]);
#pragma unroll
                for (int d = 0; d < 2; ++d) { o[db] = MFMA16(sf[d][db][0], qb[d][0], o[db]); o[db] = MFMA16(sf[d][db][1], qb[d][1], o[db]); }
            }
            float ss = 0.f;
#pragma unroll
            for (int db = 0; db < 4; ++db) ss += o[db][0] * o[db][0] + o[db][1] * o[db][1] + o[db][2] * o[db][2] + o[db][3] * o[db][3];
            ss += shx<16>(ss); ss += shx<32>(ss);
            const float rs = __builtin_amdgcn_rsqf(ss * (1.0f / 64.0f) + EPS);
#pragma unroll
            for (int db = 0; db < 4; ++db) { const u32x2 gw2 = gq[db];
                u32x2 w; w.x = pk2(o[db][0] * rs * silu_(lo_f(gw2.x)), o[db][1] * rs * silu_(hi_f(gw2.x))); w.y = pk2(o[db][2] * rs * silu_(lo_f(gw2.y)), o[db][3] * rs * silu_(hi_f(gw2.y)));
                *(u32x2*)(O + Ri * DM + 768 + h * 64 + 16 * db + 4 * g) = w; }
        }
    }
}


template <int CTRL> DI float dpp_mov0(float x) { return __int_as_float(__builtin_amdgcn_update_dpp(0, __float_as_int(x), CTRL, 0xf, 0xf, true)); }
DI float row_prefix(float x) { x += dpp_mov0<0x111>(x); x += dpp_mov0<0x112>(x); x += dpp_mov0<0x114>(x); x += dpp_mov0<0x118>(x); return x; }
DI float row_suffix(float x) { x += dpp_mov0<0x101>(x); x += dpp_mov0<0x102>(x); x += dpp_mov0<0x104>(x); x += dpp_mov0<0x108>(x); return x; }
DI void prep_hg_load(const Ctx& C, int li, int it, int lane, u32x4& qw, u32x4& f0w, u32x4& f1w, f32x4& lb0, f32x4& lb1) {
    const bf16_t* P = C.P(); const int t = lane & 15, cg = lane >> 4, sc = it >> 3, ch0 = (it & 7) * 32 + 8 * cg; const size_t R = (size_t)sc * 16 + t;
    qw = *(const u32x4*)(P + R * DIN + C_HGQ + ch0); f0w = *(const u32x4*)(P + R * DIN + C_HGF + ch0); f1w = *(const u32x4*)(P + R * DIN + C_HGF + 256 + ch0);
    lb0 = *(const f32x4*)(C.lb() + li * 256 + ch0); lb1 = *(const f32x4*)(C.lb() + li * 256 + ch0 + 4);
}
DI void prep_hg_item(const Ctx& C, int li, int it, int lane, const u32x4 qw, const u32x4 f0w, const u32x4 f1w, const f32x4 lb0, const f32x4 lb1) {
    bf16_t* HP = C.HGP(); float* DEC = C.HGDEC();
    const int t = lane & 15, cg = lane >> 4;
    {
        const int sc = it >> 3, ch0 = (it & 7) * 32 + 8 * cg; const size_t R = (size_t)sc * 16 + t;
        const float q[8] = {lo_f(qw.x), hi_f(qw.x), lo_f(qw.y), hi_f(qw.y), lo_f(qw.z), hi_f(qw.z), lo_f(qw.w), hi_f(qw.w)};
        const float f0[8] = {lo_f(f0w.x), hi_f(f0w.x), lo_f(f0w.y), hi_f(f0w.y), lo_f(f0w.z), hi_f(f0w.z), lo_f(f0w.w), hi_f(f0w.w)};
        const float f1[8] = {lo_f(f1w.x), hi_f(f1w.x), lo_f(f1w.y), hi_f(f1w.y), lo_f(f1w.z), hi_f(f1w.z), lo_f(f1w.w), hi_f(f1w.w)};
        float qd0[8], kd0[8], qd1[8], kd1[8], d0[8], d1[8];
#pragma unroll
        for (int e = 0; e < 8; ++e) { const float lb = e < 4 ? lb0[e] : lb1[e - 4];
            const float g0 = lb + (1.0f - lb) * sigm(f0[e]), g1 = lb + (1.0f - lb) * sigm(f1[e]), qs = silu_(q[e]);
            const float c0 = row_prefix(__logf(g0)), c1 = row_suffix(__logf(g1));
            qd0[e] = qs * __expf(c0); kd0[e] = (1.0f - g0) * __expf(fminf(-c0, 80.0f)); qd1[e] = qs * __expf(c1); kd1[e] = (1.0f - g1) * __expf(fminf(-c1, 80.0f));
            d0[e] = __expf(c0); d1[e] = __expf(c1); }
        const size_t o = R * 256 + ch0;
#define PK8V(a) ((u32x4){pk2(a[0], a[1]), pk2(a[2], a[3]), pk2(a[4], a[5]), pk2(a[6], a[7])})
        *(u32x4*)(HP + 0 * RETP_T + o) = PK8V(qd0); *(u32x4*)(HP + 1 * RETP_T + o) = PK8V(kd0); *(u32x4*)(HP + 2 * RETP_T + o) = PK8V(qd1); *(u32x4*)(HP + 3 * RETP_T + o) = PK8V(kd1);
#undef PK8V
        if (t == 15) { float* dp = DEC + (size_t)sc * 256 + ch0; *(f32x4*)dp = (f32x4){d0[0], d0[1], d0[2], d0[3]}; *(f32x4*)(dp + 4) = (f32x4){d0[4], d0[5], d0[6], d0[7]}; }
        if (t == 0) { float* dp = DEC + ((size_t)NSUB + sc) * 256 + ch0; *(f32x4*)dp = (f32x4){d1[0], d1[1], d1[2], d1[3]}; *(f32x4*)(dp + 4) = (f32x4){d1[4], d1[5], d1[6], d1[7]}; }
    }
}
DI void prep_hg(const Ctx& C, int li, int gw, int ngw, int lane) {
    const bf16_t* P = C.P(); bf16_t* HP = C.HGP(); float* DEC = C.HGDEC();
    const int t = lane & 15, cg = lane >> 4;
    u32x4 nq, nf0, nf1;
    if (gw < NSUB * 8) { const int sc = gw >> 3, ch0 = (gw & 7) * 32 + 8 * cg; const size_t R = (size_t)sc * 16 + t;
        nq = *(const u32x4*)(P + R * DIN + C_HGQ + ch0); nf0 = *(const u32x4*)(P + R * DIN + C_HGF + ch0); nf1 = *(const u32x4*)(P + R * DIN + C_HGF + 256 + ch0); }
    for (int it = gw; it < NSUB * 8; it += ngw) {
        const int sc = it >> 3, ch0 = (it & 7) * 32 + 8 * cg; const size_t R = (size_t)sc * 16 + t;
        const u32x4 qw = nq, f0w = nf0, f1w = nf1;
        { const int itn = it + ngw; if (itn < NSUB * 8) { const int scn = itn >> 3, chn = (itn & 7) * 32 + 8 * cg; const size_t Rn = (size_t)scn * 16 + t;
            nq = *(const u32x4*)(P + Rn * DIN + C_HGQ + chn); nf0 = *(const u32x4*)(P + Rn * DIN + C_HGF + chn); nf1 = *(const u32x4*)(P + Rn * DIN + C_HGF + 256 + chn); } }
        const f32x4 lb0 = *(const f32x4*)(C.lb() + li * 256 + ch0), lb1 = *(const f32x4*)(C.lb() + li * 256 + ch0 + 4);
        const float q[8] = {lo_f(qw.x), hi_f(qw.x), lo_f(qw.y), hi_f(qw.y), lo_f(qw.z), hi_f(qw.z), lo_f(qw.w), hi_f(qw.w)};
        const float f0[8] = {lo_f(f0w.x), hi_f(f0w.x), lo_f(f0w.y), hi_f(f0w.y), lo_f(f0w.z), hi_f(f0w.z), lo_f(f0w.w), hi_f(f0w.w)};
        const float f1[8] = {lo_f(f1w.x), hi_f(f1w.x), lo_f(f1w.y), hi_f(f1w.y), lo_f(f1w.z), hi_f(f1w.z), lo_f(f1w.w), hi_f(f1w.w)};
        float qd0[8], kd0[8], qd1[8], kd1[8], d0[8], d1[8];
#pragma unroll
        for (int e = 0; e < 8; ++e) { const float lb = e < 4 ? lb0[e] : lb1[e - 4];
            const float g0 = lb + (1.0f - lb) * sigm(f0[e]), g1 = lb + (1.0f - lb) * sigm(f1[e]), qs = silu_(q[e]);
            const float c0 = row_prefix(__logf(g0)), c1 = row_suffix(__logf(g1));
            qd0[e] = qs * __expf(c0); kd0[e] = (1.0f - g0) * __expf(fminf(-c0, 80.0f)); qd1[e] = qs * __expf(c1); kd1[e] = (1.0f - g1) * __expf(fminf(-c1, 80.0f));
            d0[e] = __expf(c0); d1[e] = __expf(c1); }
        const size_t o = R * 256 + ch0;
#define PK8V(a) ((u32x4){pk2(a[0], a[1]), pk2(a[2], a[3]), pk2(a[4], a[5]), pk2(a[6], a[7])})
        *(u32x4*)(HP + 0 * RETP_T + o) = PK8V(qd0); *(u32x4*)(HP + 1 * RETP_T + o) = PK8V(kd0); *(u32x4*)(HP + 2 * RETP_T + o) = PK8V(qd1); *(u32x4*)(HP + 3 * RETP_T + o) = PK8V(kd1);
#undef PK8V
        if (t == 15) { float* dp = DEC + (size_t)sc * 256 + ch0; *(f32x4*)dp = (f32x4){d0[0], d0[1], d0[2], d0[3]}; *(f32x4*)(dp + 4) = (f32x4){d0[4], d0[5], d0[6], d0[7]}; }
        if (t == 0) { float* dp = DEC + ((size_t)NSUB + sc) * 256 + ch0; *(f32x4*)dp = (f32x4){d1[0], d1[1], d1[2], d1[3]}; *(f32x4*)(dp + 4) = (f32x4){d1[4], d1[5], d1[6], d1[7]}; }
    }
}
DI void hg_state_step(f32x4 (&S)[4][4], const LAS bf16_t* kt, const LAS bf16_t* vt, int n, int h, int cq, int g, int q4, int p4, const float* dec  ) {
    const int r1 = 16 * n + ((8 * g + q4) & 15), r2 = 16 * n + ((8 * g + 4 + q4) & 15);
    bf16x8 a[4], bv[4];
#pragma unroll
    for (int mb = 0; mb < 4; ++mb) { const int co = h * 64 + 16 * mb + 4 * p4; a[mb] = cat8(tr16(kt + r1 * RT_TS + co), tr16(kt + r2 * RT_TS + co)); }
#pragma unroll
    for (int nb = 0; nb < 4; ++nb) { const int co = h * 64 + 16 * nb + 4 * p4; const bf16x8 v = cat8(tr16(vt + r1 * RT_TS + co), tr16(vt + r2 * RT_TS + co)); bv[nb] = (g < 2) ? v : (bf16x8){0, 0, 0, 0, 0, 0, 0, 0}; }
#pragma unroll
    for (int mb = 0; mb < 4; ++mb) { const f32x4 dv4 = *(const f32x4*)(dec + h * 64 + 16 * mb + 4 * g);
#pragma unroll
        for (int nb = 0; nb < 4; ++nb) { S[mb][nb] = MFMA16(a[mb], bv[nb], S[mb][nb]); S[mb][nb] = S[mb][nb] * dv4; } }
}
DI void hg_pass1(const Ctx& C, int li, LAS unsigned char* lds, int wave, int lane) {
    LAS bf16_t* vt = (LAS bf16_t*)lds; LAS bf16_t* k0t = vt + 64 * RT_TS; LAS bf16_t* k1t = k0t + 64 * RT_TS;
    const int tid = wave * 64 + lane, cq = lane & 15, g = lane >> 4, q4 = cq >> 2, p4 = cq & 3, h = wave & 3, d = wave >> 2;
    const bf16_t* P = C.P(); const bf16_t* HP = C.HGP(); bf16_t* ST = C.HGS(); const float* DEC = C.HGDEC() + (size_t)d * NSUB * 256;
    for (int U = (int)blockIdx.x + ((NB * NCHK - (int)blockIdx.x + (int)gridDim.x - 1) / (int)gridDim.x) * (int)gridDim.x; U < 2 * NB * NCHK; U += gridDim.x) {
        const int u = U - NB * NCHK, b = u / NCHK, c = u % NCHK; const size_t R0 = (size_t)b * LSEQ + 64 * c;
        { u32x4 pq[4], pf0[4], pf1[4]; f32x4 pl0[4], pl1[4];
#pragma unroll
          for (int k = 0; k < 4; ++k) { const int item = wave * 4 + k; prep_hg_load(C, li, ((int)(R0 / 16) + (item >> 3)) * 8 + (item & 7), lane, pq[k], pf0[k], pf1[k], pl0[k], pl1[k]); }
#pragma unroll
          for (int k = 0; k < 4; ++k) { const int item = wave * 4 + k; prep_hg_item(C, li, ((int)(R0 / 16) + (item >> 3)) * 8 + (item & 7), lane, pq[k], pf0[k], pf1[k], pl0[k], pl1[k]); } }
        asm volatile("s_waitcnt vmcnt(0)" ::: "memory");
        __syncthreads();
        stage_tile64x256(vt, P + R0 * DIN + C_HGI, DIN, tid);
        stage_tile64x256(k0t, HP + 1 * RETP_T + R0 * 256, 256, tid);
        stage_tile64x256(k1t, HP + 3 * RETP_T + R0 * 256, 256, tid);
        __syncthreads();
        const LAS bf16_t* kt = d ? k1t : k0t;
        f32x4 S[4][4];
#pragma unroll
        for (int mb = 0; mb < 4; ++mb)
#pragma unroll
            for (int nb = 0; nb < 4; ++nb) S[mb][nb] = (f32x4){0.f, 0.f, 0.f, 0.f};
#pragma unroll 1
        for (int sidx = 0; sidx < 4; ++sidx) { const int n = d ? 3 - sidx : sidx;
            hg_state_step(S, kt, vt, n, h, cq, g, q4, p4, DEC + (R0 / 16 + n) * 256); }
        if (lane < 16) { const float* dp = DEC + (R0 / 16) * 256 + h * 64 + 4 * lane;
            *(f32x4*)(C.HGDT() + ((size_t)(((b * 4 + h) * 2 + d) * NCHK + c)) * 64 + 4 * lane) = *(const f32x4*)dp * *(const f32x4*)(dp + 256) * *(const f32x4*)(dp + 512) * *(const f32x4*)(dp + 768); }
        bf16_t* sp = ST + st_off(b, h, d, c);
#pragma unroll
        for (int mb = 0; mb < 4; ++mb)
#pragma unroll
            for (int nb = 0; nb < 4; ++nb) { u32x2 w; w.x = pk2(S[mb][nb][0], S[mb][nb][1]); w.y = pk2(S[mb][nb][2], S[mb][nb][3]); *(u32x2*)(sp + (16 * nb + cq) * 64 + 16 * mb + 4 * g) = w; }
    }
}
DI void hg_carry(const Ctx& C, int gw, int ngw, int lane) {
    bf16_t* ST = C.HGS();
    for (int it = gw; it < 64 * 16; it += ngw) {
        const int chain = it >> 4, e0 = ((it & 15) * 64 + lane) * 4, d = chain & 1, dk0 = e0 & 63;
        const char* DTb = (const char*)(C.HGDT() + (size_t)chain * NCHK * 64); const unsigned doff = (unsigned)dk0 * 4u;
        const char* cb = (const char*)ST + (size_t)chain * NCHK * 8192; const unsigned voff = (unsigned)e0 * 2u;
        f32x4 S = (f32x4){0.f, 0.f, 0.f, 0.f};
#pragma unroll 1
        for (int s0 = 0; s0 < NCHK; s0 += NCHK / 4) {
            u32x2 w[NCHK / 4]; f32x4 dt[NCHK / 4];
#pragma unroll
            for (int k = 0; k < NCHK / 4; ++k) { const int c = chunk_at(d, s0 + k); w[k] = *(const u32x2*)(cb + (size_t)c * 8192 + voff); dt[k] = *(const f32x4*)(DTb + (size_t)c * 256 + doff); }
#pragma unroll
            for (int k = 0; k < NCHK / 4; ++k) { const f32x4 raw = (f32x4){lo_f(w[k].x), hi_f(w[k].x), lo_f(w[k].y), hi_f(w[k].y)};
                u32x2 ow; ow.x = pk2(S[0], S[1]); ow.y = pk2(S[2], S[3]);
                *(u32x2*)((char*)cb + (size_t)chunk_at(d, s0 + k) * 8192 + voff) = ow;
                S = S * dt[k] + raw; }
        }
    }
}
DI void hg_pass2(const Ctx& C, int li, LAS unsigned char* lds, int wave, int lane) {
    LAS bf16_t* vt = (LAS bf16_t*)lds; LAS bf16_t* k0t = vt + 64 * RT_TS; LAS bf16_t* k1t = k0t + 64 * RT_TS;
    const int tid = wave * 64 + lane, cq = lane & 15, g = lane >> 4, q4 = cq >> 2, p4 = cq & 3, h = wave & 3, d = wave >> 2;
    LAS bf16_t* stash = (h < 3) ? (LAS bf16_t*)(lds + 3 * 64 * RT_TS * 2 + h * 8192) : (LAS bf16_t*)(lds + MISC_OFF + 2048);
    const bf16_t* P = C.P(); const bf16_t* HP = C.HGP(); const bf16_t* ST = C.HGS(); const float* DEC = C.HGDEC() + (size_t)d * NSUB * 256;
    const bf16_t* QD = HP + (size_t)(2 * d) * RETP_T; const bf16_t* KD = HP + (size_t)(2 * d + 1) * RETP_T;
    const bool lastl = (li == DEPTH - 1); const int NU = lastl ? NB * 64 : NB * NCHK;
    for (int U = (int)blockIdx.x + ((NU - (int)blockIdx.x + (int)gridDim.x - 1) / (int)gridDim.x) * (int)gridDim.x; U < 2 * NU; U += gridDim.x) {
        const int u = U - NU, b = lastl ? (u >> 6) : u / NCHK, c = lastl ? 4 + (u & 63) : u % NCHK; const size_t R0 = (size_t)b * LSEQ + 64 * c;
        __syncthreads();
        stage_tile64x256(vt, P + R0 * DIN + C_HGI, DIN, tid);
        stage_tile64x256(k0t, HP + 1 * RETP_T + R0 * 256, 256, tid);
        stage_tile64x256(k1t, HP + 3 * RETP_T + R0 * 256, 256, tid);
        __syncthreads();
        const LAS bf16_t* kt = d ? k1t : k0t;
        f32x4 S[4][4];
        { const bf16_t* sp = ST + st_off(b, h, d, c);
#pragma unroll
          for (int mb = 0; mb < 4; ++mb)
#pragma unroll
            for (int nb = 0; nb < 4; ++nb) { const u32x2 w = *(const u32x2*)(sp + (16 * nb + cq) * 64 + 16 * mb + 4 * g); S[mb][nb] = (f32x4){lo_f(w.x), hi_f(w.x), lo_f(w.y), hi_f(w.y)}; } }
#pragma unroll 1
        for (int sidx = 0; sidx < 4; ++sidx) { const int n = d ? 3 - sidx : sidx;
            if (sidx == 2) __syncthreads();
            const size_t Rt = R0 + 16 * n + cq;
            f32x4 at = (f32x4){0.f, 0.f, 0.f, 0.f};
#pragma unroll
            for (int ks = 0; ks < 2; ++ks) at = MFMA16(*(const LAS bf16x8*)(kt + (16 * n + cq) * RT_TS + h * 64 + 32 * ks + 8 * g), ld16(QD + Rt * 256 + h * 64 + 32 * ks + 8 * g), at);
#pragma unroll
            for (int e = 0; e < 4; ++e) { const int j = 4 * g + e; at[e] = (d == 0 ? (j <= cq) : (j >= cq)) ? at[e] : 0.f; }
            const bf16x8 pb = pack8(at, ((f32x4){0.f, 0.f, 0.f, 0.f}));
            bf16x8 qc[2];
#pragma unroll
            for (int s2 = 0; s2 < 2; ++s2) { const bf16_t* qp = QD + Rt * 256 + h * 64 + 32 * s2 + 4 * g; qc[s2] = cat8(*(const s16x4*)qp, *(const s16x4*)(qp + 16)); }
            f32x4 o[4];
#pragma unroll
            for (int db = 0; db < 4; ++db) {
                const s16x4 vv = tr16(vt + (16 * n + 4 * g + q4) * RT_TS + h * 64 + 16 * db + 4 * p4);
                o[db] = MFMA16(cat8(vv, vv), pb, ((f32x4){0.f, 0.f, 0.f, 0.f}));
                o[db] = MFMA16(pack8(S[0][db], S[1][db]), qc[0], o[db]); o[db] = MFMA16(pack8(S[2][db], S[3][db]), qc[1], o[db]); }
            LAS bf16_t* stp = stash + (n * 16 + cq) * 64 + 4 * g;
            if (sidx < 2) {
#pragma unroll
                for (int db = 0; db < 4; ++db) { u32x2 w; w.x = pk2(o[db][0], o[db][1]); w.y = pk2(o[db][2], o[db][3]); *(LAS u32x2*)(stp + 16 * db) = w; } }
            else { float ss = 0.f; f32x4 a[4];
#pragma unroll
                for (int db = 0; db < 4; ++db) { const u32x2 w = *(const LAS u32x2*)(stp + 16 * db); a[db] = o[db] + (f32x4){lo_f(w.x), hi_f(w.x), lo_f(w.y), hi_f(w.y)}; ss += a[db][0] * a[db][0] + a[db][1] * a[db][1] + a[db][2] * a[db][2] + a[db][3] * a[db][3]; }
                ss += shx<16>(ss); ss += shx<32>(ss);
                const float rs = __builtin_amdgcn_rsqf(ss * (1.0f / 64.0f) + EPS);
#pragma unroll
                for (int db = 0; db < 4; ++db) { const int dc = 16 * db + 4 * g; const f32x4 hw4 = *(const f32x4*)(C.in(I_HGNW) + li * 64 + dc); const u32x2 gw2 = *(const u32x2*)(P + Rt * DIN + C_HGG + h * 64 + dc);
                    u32x2 oo; oo.x = pk2(a[db][0] * rs * hw4[0] * silu_(lo_f(gw2.x)), a[db][1] * rs * hw4[1] * silu_(hi_f(gw2.x))); oo.y = pk2(a[db][2] * rs * hw4[2] * silu_(lo_f(gw2.y)), a[db][3] * rs * hw4[3] * silu_(hi_f(gw2.y)));
                    *(u32x2*)(C.O() + Rt * DM + 512 + h * 64 + dc) = oo; } }
            if (sidx < 3) hg_state_step(S, kt, vt, n, h, cq, g, q4, p4, DEC + (R0 / 16 + n) * 256);
        }
    }
}

DI void phase_mix(const Ctx& C, int li, LAS unsigned char* lds, int gw, int ngw, int wave, int lane) {
    LAS bf16_t* vl = (LAS bf16_t*)(lds + 8192 + wave * (64 * NA_VS * 2));
    LAS float* rpbt = (LAS float*)(lds + 8192 + 8 * (64 * NA_VS * 2));
    for (int i = wave * 64 + lane; i < 4 * 465; i += 512) rpbt[i] = C.in(I_RPB)[(size_t)li * 4 * 465 + i];
    __syncthreads();
    const int G = (int)gridDim.x;
    if ((G & 7) == 0 && G >= 8) {
        const int xb = (int)blockIdx.x & 7, nxw = (G >> 3) * 8, xw = ((int)blockIdx.x >> 3) * 8 + wave;
        for (int b = xb; b < NB; b += 8)
            for (int h = 0; h < 4; ++h) {
                for (int rc = xw; rc < 256; rc += nxw) na_unit(C, li, ((b * 64 + (rc >> 2)) * 4 + h) * 4 + (rc & 3), false, lane, vl, rpbt);
                if (li == 0) {
                    if (nxw == 256) { const int j = xw - 64; if (j >= 0 && j % 3 == 0 && ((j / 3) >> 4) == h) na_unit(C, li, (b * 4 + h) * 16 + ((j / 3) & 15), true, lane, vl, rpbt); }
                    else for (int cg = xw; cg < 16; cg += nxw) na_unit(C, li, (b * 4 + h) * 16 + cg, true, lane, vl, rpbt); }
            }
    } else {
        const int nNA = NB * 64 * 4 * 4, nNAc = (li == 0) ? NB * 4 * 16 : 0;
        for (int it = gw; it < nNA + nNAc; it += ngw) { if (it < nNA) na_unit(C, li, it, false, lane, vl, rpbt); else na_unit(C, li, it - nNA, true, lane, vl, rpbt); }
    }
}
DI void phase_fin(const Ctx& C, int li, int gw, int ngw, int lane) {
    const int c0 = 4 * lane;
    const f32x4 hw = *(const f32x4*)(C.in(I_HGNW) + li * 64 + (c0 & 63));
    const bf16_t* OH = C.OHGB();
    for (int R0 = gw; R0 < NTOK; R0 += 4 * ngw) {
        u32x2 w0q[4], w1q[4], gq[4];
#pragma unroll
        for (int q = 0; q < 4; ++q) { const int Ri = R0 + q * ngw; if (Ri < NTOK) { const size_t R = (size_t)Ri;
            w0q[q] = *(const u32x2*)(OH + R * 256 + c0); w1q[q] = *(const u32x2*)(OH + ((size_t)NTOK + R) * 256 + c0); gq[q] = *(const u32x2*)(C.P() + R * DIN + C_HGG + c0); } }
#pragma unroll
        for (int q = 0; q < 4; ++q) { const int Ri = R0 + q * ngw; if (Ri >= NTOK) continue; const size_t R = (size_t)Ri;
            if (li == DEPTH - 1 && (Ri % LSEQ) < CTXL) continue;
            const u32x2 w0 = w0q[q], w1 = w1q[q], gw2 = gq[q];
            const f32x4 a = (f32x4){lo_f(w0.x) + lo_f(w1.x), hi_f(w0.x) + hi_f(w1.x), lo_f(w0.y) + lo_f(w1.y), hi_f(w0.y) + hi_f(w1.y)};
            float ss = a[0] * a[0] + a[1] * a[1] + a[2] * a[2] + a[3] * a[3];
            ss += shx<1>(ss); ss += shx<2>(ss); ss += shx<4>(ss); ss += shx<8>(ss);
            const float rs = __builtin_amdgcn_rsqf(ss * (1.0f / 64.0f) + EPS);
            u32x2 oo; oo.x = pk2(a[0] * rs * hw[0] * silu_(lo_f(gw2.x)), a[1] * rs * hw[1] * silu_(hi_f(gw2.x))); oo.y = pk2(a[2] * rs * hw[2] * silu_(lo_f(gw2.y)), a[3] * rs * hw[3] * silu_(hi_f(gw2.y)));
            *(u32x2*)(C.O() + R * DM + 512 + c0) = oo; }
    }
}

struct Args { const float* in[N_IN]; float* out; unsigned char* ws; int ph_lo, ph_hi, bar_region, pad; };
constexpr int NPL = 13, PH_TOTAL = 2 + DEPTH * NPL;

__global__ void __launch_bounds__(512, 2) fwd(Args args) {
    extern __shared__ __attribute__((aligned(16))) unsigned char lds_raw[];
    LAS unsigned char* lds = (LAS unsigned char*)lds_raw;
    const int G = gridDim.x, ngw = G * 8;
    const int wave_id = __builtin_amdgcn_readfirstlane((int)threadIdx.x >> 6);
#define PHASE_IDS int wv_ = wave_id; asm volatile("" : "+s"(wv_)); int ln_ = lane_id(); asm volatile("" : "+v"(ln_)); const int lane = ln_, wave = wv_, gw = blockIdx.x * 8 + wave; (void)lane; (void)gw;
    { int t0 = wave_id * 64 + lane_id(); asm volatile("" : "+v"(t0)); for (int u = t0; u < (LDS_BYTES - LDSCTL_OFF) / 4; u += 512) ((LAS unsigned*)(lds + LDSCTL_OFF))[u] = 0u; }
    __syncthreads();
    int lo, hi; XcdBarrier bar;
    { const Ctx C0{kargs()}; lo = *(const __attribute__((address_space(4))) int*)(C0.ka + 8 * N_IN + 16); hi = *(const __attribute__((address_space(4))) int*)(C0.ka + 8 * N_IN + 20);
      bar.bar = (unsigned*)(C0.ws() + WS_CTL) + 4096 + *(const __attribute__((address_space(4))) int*)(C0.ka + 8 * N_IN + 24) * XCD_BAR_WORDS; bar.x = 0; bar.st = nullptr; bar.wave = wave_id;
      if (hi - lo > 1) bar = xcd_barrier_post(bar.bar, (volatile LAS unsigned*)(lds + MISC_OFF + 32), wave_id); }
#define IN(k) (lo <= (k) && (k) < hi)
#ifndef PH_MASK
#define PH_MASK 0xFFFF
#endif
#define PH_EN(k) (((PH_MASK) >> (k)) & 1)
#define SEAM(k) do { if ((k) + 1 < hi) xcd_barrier(bar); } while (0)
#ifndef PROBE_DUP
#define PROBE_DUP 0
#endif
#define REPS(k) for (int rep_ = 0; rep_ < ((((PROBE_DUP) >> (k)) & 1) ? 2 : 1); ++rep_)
#define REP_BAR(k) do { if ((((PROBE_DUP) >> (k)) & 1) && rep_ == 0) xcd_barrier(bar); } while (0)

#ifndef NO_PRO
    if (IN(0)) { const Ctx C{kargs()}; PHASE_IDS phase_prologue(C, lds, gw, ngw, wave, lane);
#ifdef PROBE_PRO
        xcd_barrier(bar); phase_prologue(C, lds, gw, ngw, wave, lane);
#endif
        SEAM(0); }
#endif

    for (int li = 0; li < DEPTH; ++li) {
        const int pb = 1 + li * NPL;
        if (PH_EN(0) && IN(pb + 0)) { REPS(0) {
            const Ctx C{kargs()}; PHASE_IDS
#ifdef PROBE_A1
            if (li == 1) { phase_norm1(C, li, gw, ngw, lane, (float*)C.P()); xcd_barrier(bar); }
#endif
            phase_norm1(C, li, gw, ngw, lane, C.X());
            router_prep(C, li, gw, ngw, lane);
#ifdef PROBE_A0
            if (li == 0) { xcd_barrier(bar); phase_norm1(C, li, gw, ngw, lane, C.X()); }
#endif
            REP_BAR(0); } SEAM(pb + 0);
        }
        if (PH_EN(1) && IN(pb + 1)) { REPS(1) {
            const Ctx C{kargs()}; PHASE_IDS
            { SchedWin S{(unsigned)WS_H, (unsigned)(WS_WIN + (size_t)li * DIN * DM * 2), G, (int)blockIdx.x, C_GATE / 256, (unsigned)(DM * 2), NTOK / 256, 0};
              EpiP E{C.P(), DIN, C.UG(), C.QKN(), C.in(I_NAQN) + li * 64, C.in(I_NAKN) + li * 64, C.RETP(), C.in(I_RETD) + li * 8};
              pg8::gemm_phase<EpiP, SchedWin>(lds, wave, lane, (const char*)C.ws(), DM, DM, DM, S, E); }
            { const Ctx C2{kargs()}; int wv2 = wave_id; asm volatile("" : "+s"(wv2)); int ln2 = lane_id(); asm volatile("" : "+v"(ln2));
              SchedWin S{(unsigned)WS_H8, (unsigned)(WS_WIN + (size_t)li * DIN * DM * 2 + WS_WIN8_OFF), G, (int)blockIdx.x, 16, (unsigned)DM, li == DEPTH - 1 ? 128 : NTOK / 256, li == DEPTH - 1 ? 1 : 0};
              EpiSig8 E{(unsigned char*)C2.P()};
              pg8::gemm_phase<EpiSig8, SchedWin, true>(lds, wv2, ln2, (const char*)C2.ws(), DM / 2, DM / 2, DM / 2, S, E); }
            REP_BAR(1); } SEAM(pb + 1);
        }
        if (PH_EN(3) && IN(pb + 3)) { REPS(3) {
            const Ctx C{kargs()}; PHASE_IDS
            ret_pass1(C, lds, wave, lane); __syncthreads();
            hg_pass1(C, li, lds, wave, lane); __syncthreads();
#ifdef PROBE_P1
            xcd_barrier(bar); ret_pass1(C, lds, wave, lane); __syncthreads(); hg_pass1(C, li, lds, wave, lane); __syncthreads(); xcd_barrier(bar);
#endif
            phase_mix(C, li, lds, gw, ngw, wave, lane); __syncthreads();
#ifdef PROBE_NA
            xcd_barrier(bar); phase_mix(C, li, lds, gw, ngw, wave, lane); __syncthreads(); xcd_barrier(bar);
#endif
            { const Ctx C{kargs()}; PHASE_IDS SchedS5 S{(unsigned)WS_UG, (unsigned)(WS_S5W1 + (size_t)li * 16 * 65536 * 2), G, G > 144 ? (int)((blockIdx.x + 144u) % (unsigned)G) : (int)blockIdx.x, 65536u * 2u};     EpiS5S E{C.S5S()};
              pg8::gemm_phase<EpiS5S, SchedS5>(lds, wave, lane, (const char*)C.ws(), 256, 512, 256, S, E); }
            REP_BAR(3); } SEAM(pb + 3); }
        if (PH_EN(4) && IN(pb + 4)) { REPS(4) { const Ctx C{kargs()}; PHASE_IDS ret_carry(C, li, gw, ngw, lane); hg_carry(C, gw, ngw, lane); s5_carry(C, li, gw, ngw, lane); convert_experts(C, li, 1280 % ngw, gw, ngw, (LAS float*)(lds + 40960 + wave * 8704), lane);     REP_BAR(4); } SEAM(pb + 4); }
        if (PH_EN(5) && IN(pb + 5)) { REPS(5) { const Ctx C{kargs()}; PHASE_IDS ret_pass2(C, li, lds, wave, lane); __syncthreads(); hg_pass2(C, li, lds, wave, lane); __syncthreads();
            { const Ctx C{kargs()}; PHASE_IDS SchedS5 S{(unsigned)WS_UG, (unsigned)(WS_S5W2 + (size_t)li * 16 * 131072 * 2), G, G > 144 ? (int)((blockIdx.x + 144u) % (unsigned)G) : (int)blockIdx.x, 131072u * 2u}; EpiS5Z E{C.Z()};
              pg8::gemm_phase<EpiS5Z, SchedS5>(lds, wave, lane, (const char*)C.ws(), 512, 512, 512, S, E); }
            REP_BAR(5); } SEAM(pb + 5); }
        if (PH_EN(6) && IN(pb + 6)) { REPS(6) { const Ctx C{kargs()}; PHASE_IDS
            { const Ctx C{kargs()}; PHASE_IDS SchedGlu S{(unsigned)WS_Z, (unsigned)(WS_GLUT + (size_t)li * 65536 * 2), G, (int)blockIdx.x, li}; EpiGlu E{C.O(), C.Z()};
              pg8::gemm_phase<EpiGlu, SchedGlu>(lds, wave, lane, (const char*)C.ws(), 256, 256, 256, S, E); }
            REP_BAR(6); } SEAM(pb + 6); }
#pragma unroll 1
        for (int ph_ = 7; ph_ <= 12; ++ph_) { int phs = ph_; asm volatile("" : "+s"(phs));
        if (!(((PH_MASK) >> phs) & 1) || !IN(pb + phs)) continue;
        if (phs == 7) { REPS(7) {
            const Ctx C{kargs()}; PHASE_IDS
            SchedMerge S{(unsigned)WS_O, (unsigned)(WS_WBR + (size_t)li * DM * DM * 2), G, (int)blockIdx.x, li};
            EpiMerge E{C.MB(), (const unsigned char*)C.P()};
            pg8::gemm_phase<EpiMerge, SchedMerge, false, 1>(lds, wave, lane, (const char*)C.ws(), DM, DM, DM, S, E);
            REP_BAR(7); }
        }
        else if (phs == 8) { REPS(8) {
            const Ctx C{kargs()}; PHASE_IDS
            SchedOut S{(unsigned)WS_MB, (unsigned)(WS_WOUT + (size_t)li * DM * DM * 2), G, (int)blockIdx.x, li};
#ifdef PROBE_D2
            { EpiResid E0{C.X(), C.mod() + li * 9 * 6144, (bf16_t*)C.P(), li == 0 ? C.in(I_X) : nullptr, li == 0 ? C.in(I_CTX) : nullptr}; pg8::gemm_phase<EpiResid, SchedOut>(lds, wave, lane, (const char*)C.ws(), DM, DM, DM, S, E0); xcd_barrier(bar); }
#endif
            EpiResid E{C.X(), C.mod() + li * 9 * 6144, C.X(), li == 0 ? C.in(I_X) : nullptr, li == 0 ? C.in(I_CTX) : nullptr};
            pg8::gemm_phase<EpiResid, SchedOut>(lds, wave, lane, (const char*)C.ws(), DM, DM, DM, S, E);
            REP_BAR(8); }
        }
        else if (phs == 9) { REPS(9) { const Ctx C{kargs()}; PHASE_IDS phase_norm2(C, li, lds, gw, ngw, wave, lane); REP_BAR(9); } }
        else if (phs == 10) { REPS(10) { const Ctx C{kargs()}; PHASE_IDS phase_topk(C, li, lds, wave, lane); REP_BAR(10); } }
        else if (phs == 11) { REPS(11) {
            const Ctx C{kargs()}; PHASE_IDS
            SchedE1 S{(unsigned)WS_XE, (unsigned)(WS_EXW + (size_t)li * EXW_LAYER), G, (int)blockIdx.x, li == 0 ? 17 : 16};
            EpiSwiGLU E{(unsigned char*)C.P()};
            pg8::gemm_phase<EpiSwiGLU, SchedE1, true>(lds, wave, lane, (const char*)C.ws(), DM / 2, DM / 2, DM / 2, S, E);
            REP_BAR(11); }
        }
        else { REPS(12) {
            const Ctx C{kargs()}; PHASE_IDS
            SchedE2 S{(unsigned)WS_P, (unsigned)(WS_W2T + (size_t)li * EXW_LAYER), G, (int)blockIdx.x, li == 0 ? 17 : 16};
            EpiExpOut E{C.XE(), C.gate()};
            pg8::gemm_phase<EpiExpOut, SchedE2, true>(lds, wave, lane, (const char*)C.ws(), DF / 2, DF / 2, DF / 2, S, E);
            REP_BAR(12); }
        }
        if (li == 0 && DEPTH > 1 && G == 256) {
            const int first = phs == 7 ? 1088 % 256 : phs == 8 ? 544 % 256 : phs == 11 ? (NE * 17 * 22) % 256 : phs == 12 ? (NE * 17 * 4) % 256 : 256, nit = phs == 7 ? 2 : phs == 8 ? 4 : phs == 11 ? 2 : 6;
            if ((int)blockIdx.x >= first) { const Ctx Cc{kargs()}; int wq_ = wave_id; asm volatile("" : "+s"(wq_)); int lq_ = lane_id(); asm volatile("" : "+v"(lq_));
                (void)convert_pull(Cc, DEPTH - 1, nit, (LAS float*)(lds + 40960 + wq_ * 8704), lq_); } }
        SEAM(pb + phs);
        }
    }
    if (IN(PH_TOTAL - 1)) { const Ctx C{kargs()}; PHASE_IDS phase_final(C, gw, ngw, lane);
#ifdef PROBE_FINAL
        xcd_barrier(bar); phase_final(C, gw, ngw, lane);
#endif
    }
#undef IN
#undef SEAM
}

extern "C" void kernel_launch(void* const* d_in, const int* in_sizes, int n_in, void* d_out, int out_size, void* d_ws, size_t ws_size, hipStream_t stream) {
    static int grid = 0;
    if (grid == 0) {
        if (n_in != N_IN || ws_size < WS_END) { fprintf(stderr, "kernel_launch: unexpected n_in %d or ws_size %zu (need %zu)\n", n_in, ws_size, (size_t)WS_END); grid = -1; return; }
        int dev = 0, cus = 0, per_cu = 0;
        if (hipGetDevice(&dev) != hipSuccess || hipDeviceGetAttribute(&cus, hipDeviceAttributeMultiprocessorCount, dev) != hipSuccess) { grid = -1; return; }
        if (hipFuncSetAttribute((const void*)fwd, hipFuncAttributeMaxDynamicSharedMemorySize, LDS_BYTES) != hipSuccess) { fprintf(stderr, "kernel_launch: hipFuncSetAttribute failed\n"); grid = -1; return; }
        if (hipOccupancyMaxActiveBlocksPerMultiprocessor(&per_cu, (const void*)fwd, 512, LDS_BYTES) != hipSuccess || per_cu < 1) fprintf(stderr, "kernel_launch: occupancy query says %d\n", per_cu);
        (void)hipGetLastError();
        grid = cus;
    }
    if (grid < 0) return;
    (void)hipMemsetAsync((char*)d_ws + WS_CTL, 0, CTL_ZERO_BYTES, stream);
    Args a{};
    for (int i = 0; i < N_IN; ++i) a.in[i] = (const float*)d_in[i];
    a.out = (float*)d_out; a.ws = (unsigned char*)d_ws;
#if MK_PER_PHASE
    for (int p = 0; p < PH_TOTAL; ++p) { a.ph_lo = p; a.ph_hi = p + 1; a.bar_region = 0; hipLaunchKernelGGL(fwd, dim3(grid), dim3(512), LDS_BYTES, stream, a); }
#elif defined(PROBE_PH)
    a.ph_lo = 0; a.ph_hi = PROBE_PH + 1; a.bar_region = 0; hipLaunchKernelGGL(fwd, dim3(grid), dim3(512), LDS_BYTES, stream, a);
    a.ph_lo = PROBE_PH; a.ph_hi = PROBE_PH + 1; a.bar_region = 1; hipLaunchKernelGGL(fwd, dim3(grid), dim3(512), LDS_BYTES, stream, a);
    a.ph_lo = PROBE_PH + 1; a.ph_hi = PH_TOTAL; a.bar_region = 2; hipLaunchKernelGGL(fwd, dim3(grid), dim3(512), LDS_BYTES, stream, a);
#elif defined(PROBE_CUT)
    a.ph_lo = 0; a.ph_hi = PROBE_CUT + 1; a.bar_region = 0; hipLaunchKernelGGL(fwd, dim3(grid), dim3(512), LDS_BYTES, stream, a);
    a.ph_lo = PROBE_CUT + 1; a.ph_hi = PH_TOTAL; a.bar_region = 2; hipLaunchKernelGGL(fwd, dim3(grid), dim3(512), LDS_BYTES, stream, a);
#else
    a.ph_lo = 0; a.ph_hi = PH_TOTAL; a.bar_region = 0;
    hipLaunchKernelGGL(fwd, dim3(grid), dim3(512), LDS_BYTES, stream, a);
#endif
}
```
